# Optimizing an MI355X kernel written in HIP

```python
import jax, jax.numpy as jnp
from jax import lax
import numpy as np

D_MODEL = 2048
BATCH = 2
SEQ = 4096
DEPTH = 1
DEC_BATCH = 8
DEC_SEQ = 1
PAST_LEN = 16384
PAGE_SIZE = 128

HEAD_DIM = 128
N_MIX_HEADS = D_MODEL // HEAD_DIM
SB_HEADS = N_MIX_HEADS // 2
GDN_HEADS = N_MIX_HEADS - SB_HEADS
SB_WIDTH = SB_HEADS * HEAD_DIM
GDN_WIDTH = GDN_HEADS * HEAD_DIM
MIX_WIDTH = SB_WIDTH + GDN_WIDTH
SB_BLOCK = 128
SB_SCALE = HEAD_DIM ** -0.5
SB_LOGIT_BIAS_INIT = -8.0
GDN_CONV = 4
GDN_CONV_CH = 3 * GDN_WIDTH
GDN_CHUNK = 64
D_FF = ((8 * D_MODEL // 3 + 127) // 128) * 128
FFN_CONV = 3
PLE_DIM = 256
EPS = 1e-6

O_SB_Q = 0
O_SB_K = O_SB_Q + SB_WIDTH
O_SB_V = O_SB_K + SB_WIDTH
O_GDN_QKV = O_SB_V + SB_WIDTH
O_GDN_Z = O_GDN_QKV + GDN_CONV_CH
O_GDN_A = O_GDN_Z + GDN_WIDTH
O_GDN_B = O_GDN_A + GDN_HEADS
IN_COLS = O_GDN_B + GDN_HEADS

kernel_name = 'hymba_stickbreak_gdn_convffn_step'


def rms_norm(x, w):
    x32 = x.astype(jnp.float32)
    y = x32 * lax.rsqrt(jnp.mean(x32 * x32, axis=-1, keepdims=True) + EPS)
    return (y * w.astype(jnp.float32)).astype(x.dtype)


def l2_normalize(x):
    return x * lax.rsqrt(jnp.sum(x * x, axis=-1, keepdims=True) + 1e-6)


def causal_dwconv(xh, w):
    width = w.shape[0]
    t = xh.shape[1] - (width - 1)
    y = xh[:, 0:t] * w[0]
    for j in range(1, width):
        y = y + xh[:, j:j + t] * w[j]
    return y.astype(xh.dtype)


def sb_block(q_blk, k, v, logit_bias, q_start):
    tq, tk = q_blk.shape[1], k.shape[1]
    z = (jnp.einsum('bqhd,bkhd->bhqk', q_blk, k).astype(jnp.float32) * SB_SCALE
         + logit_bias.astype(jnp.float32)[None, :, None, None])
    qpos = q_start + jnp.arange(tq)
    kpos = jnp.arange(tk)
    valid = kpos[None, :] < qpos[:, None]
    log_beta = jax.nn.log_sigmoid(z)
    log_1m_beta = jnp.where(valid, log_beta - z, 0.0)
    between = lax.cumsum(log_1m_beta, axis=3, reverse=True) - log_1m_beta
    a = jnp.where(valid, jnp.exp(log_beta + between), 0.0)
    return jnp.einsum('bhqk,bkhd->bqhd', a.astype(v.dtype), v)


def sb_attention(q, k, v, logit_bias, q_offset):
    tq, tk = q.shape[1], k.shape[1]
    outs = []
    for start in range(0, tq, SB_BLOCK):
        stop = min(start + SB_BLOCK, tq)
        kend = min(tk, q_offset + stop)
        outs.append(sb_block(q[:, start:stop], k[:, :kend], v[:, :kend], logit_bias,
                             q_offset + start))
    return jnp.concatenate(outs, axis=1)


def to_chunks(x):
    b, tp, h = x.shape[:3]
    x = x.reshape((b, tp // GDN_CHUNK, GDN_CHUNK, h) + x.shape[3:])
    return jnp.moveaxis(x, (1, 3), (0, 2))


def gdn_chunked(q, k, v, g, beta, s0):
    b, t, h, dv = v.shape
    pad = (-t) % GDN_CHUNK
    if pad:
        padt = lambda a: jnp.pad(a, [(0, 0), (0, pad)] + [(0, 0)] * (a.ndim - 2))
        q, k, v, g, beta = padt(q), padt(k), padt(v), padt(g), padt(beta)
    q, k, v, g, beta = to_chunks(q), to_chunks(k), to_chunks(v), to_chunks(g), to_chunks(beta)
    gc = jnp.cumsum(g, axis=-1)
    kb = k * beta[..., None]
    vb = v * beta[..., None]
    idx = jnp.arange(GDN_CHUNK)
    tri = idx[:, None] >= idx[None, :]
    strict = idx[:, None] > idx[None, :]
    diff = gc[..., :, None] - gc[..., None, :]
    decay = jnp.where(tri, jnp.exp(jnp.where(tri, diff, 0.0)), 0.0)
    low = jnp.where(strict, jnp.einsum('nbhcd,nbhsd->nbhcs', kb, k) * decay, 0.0)
    unit_low = low + jnp.eye(GDN_CHUNK, dtype=low.dtype)
    rhs = jnp.concatenate([vb, kb * jnp.exp(gc)[..., None]], axis=-1)
    sol = lax.linalg.triangular_solve(unit_low, rhs, left_side=True, lower=True,
                                      unit_diagonal=True)
    u, w = sol[..., :dv], sol[..., dv:]
    qk = jnp.einsum('nbhcd,nbhsd->nbhcs', q, k) * decay

    def step(s, inp):
        q_i, k_i, u_i, w_i, qk_i, gc_i = inp
        v_new = u_i - jnp.einsum('bhcd,bhde->bhce', w_i, s)
        o_i = (jnp.einsum('bhcd,bhde->bhce', q_i * jnp.exp(gc_i)[..., None], s)
               + jnp.einsum('bhcs,bhse->bhce', qk_i, v_new))
        g_last = gc_i[..., -1:]
        s = (s * jnp.exp(g_last)[..., None]
             + jnp.einsum('bhcd,bhce->bhde', k_i * jnp.exp(g_last - gc_i)[..., None], v_new))
        return s, o_i

    s_final, o = lax.scan(step, s0, (q, k, u, w, qk, gc))
    o = jnp.moveaxis(o, (0, 2), (1, 3)).reshape(b, -1, h, dv)[:, :t]
    return o, s_final


def layer_forward(x, p, k_past, v_past, gdn_conv_hist, gdn_s0, ffn_conv_hist, q_offset,
                  attn_norm, w_in, sb_logit_bias, sb_out_norm, gdn_conv_w, gdn_a_log,
                  gdn_dt_bias, gdn_out_norm, w_out, ffn_norm, w_ffn_gate, w_ffn_up,
                  ffn_conv_w, w_ffn_down, ple_norm, w_ple_gate, w_ple_proj):
    b, t, _ = x.shape
    f32 = jnp.float32
    a = rms_norm(x, attn_norm)
    proj = a @ w_in

    sb_q = proj[..., O_SB_Q:O_SB_Q + SB_WIDTH].reshape(b, t, SB_HEADS, HEAD_DIM)
    sb_k = proj[..., O_SB_K:O_SB_K + SB_WIDTH].reshape(b, t, SB_HEADS, HEAD_DIM)
    sb_v = proj[..., O_SB_V:O_SB_V + SB_WIDTH].reshape(b, t, SB_HEADS, HEAD_DIM)
    if k_past is None:
        k_all, v_all = sb_k, sb_v
    else:
        k_all = jnp.concatenate([k_past.astype(sb_k.dtype), sb_k], axis=1)
        v_all = jnp.concatenate([v_past.astype(sb_v.dtype), sb_v], axis=1)
    o_sb = rms_norm(sb_attention(sb_q, k_all, v_all, sb_logit_bias, q_offset), sb_out_norm)

    conv_in = proj[..., O_GDN_QKV:O_GDN_QKV + GDN_CONV_CH]
    hist = jnp.concatenate([gdn_conv_hist.astype(conv_in.dtype), conv_in], axis=1)
    new_gdn_conv = hist[:, hist.shape[1] - (GDN_CONV - 1):]
    c = jax.nn.silu(causal_dwconv(hist, gdn_conv_w).astype(f32))
    gq = c[..., 0:GDN_WIDTH].reshape(b, t, GDN_HEADS, HEAD_DIM)
    gk = c[..., GDN_WIDTH:2 * GDN_WIDTH].reshape(b, t, GDN_HEADS, HEAD_DIM)
    gv = c[..., 2 * GDN_WIDTH:3 * GDN_WIDTH].reshape(b, t, GDN_HEADS, HEAD_DIM)
    gq = l2_normalize(gq) * (HEAD_DIM ** -0.5)
    gk = l2_normalize(gk)
    a_in = proj[..., O_GDN_A:O_GDN_A + GDN_HEADS].astype(f32)
    g = -jnp.exp(gdn_a_log.astype(f32)) * jax.nn.softplus(a_in + gdn_dt_bias.astype(f32))
    beta = jax.nn.sigmoid(proj[..., O_GDN_B:O_GDN_B + GDN_HEADS].astype(f32))
    o_gdn, s_new = gdn_chunked(gq, gk, gv, g, beta, gdn_s0.astype(f32))
    z = proj[..., O_GDN_Z:O_GDN_Z + GDN_WIDTH].reshape(b, t, GDN_HEADS, HEAD_DIM).astype(f32)
    o_gdn = rms_norm(o_gdn, gdn_out_norm) * jax.nn.silu(z)

    mix = jnp.concatenate([o_sb.reshape(b, t, SB_WIDTH).astype(x.dtype),
                           o_gdn.reshape(b, t, GDN_WIDTH).astype(x.dtype)], axis=-1)
    h = x + mix @ w_out

    f = rms_norm(h, ffn_norm)
    gate_pre = f @ w_ffn_gate
    ghist = jnp.concatenate([ffn_conv_hist.astype(gate_pre.dtype), gate_pre], axis=1)
    new_ffn_conv = ghist[:, ghist.shape[1] - (FFN_CONV - 1):]
    gate = causal_dwconv(ghist, ffn_conv_w)
    h = h + (jax.nn.silu(gate) * (f @ w_ffn_up)) @ w_ffn_down

    ple_gate = jax.nn.sigmoid(rms_norm(h, ple_norm) @ w_ple_gate)
    h = h + (p @ w_ple_proj) * ple_gate
    return h, sb_k, sb_v, new_gdn_conv, s_new.astype(gdn_s0.dtype), new_ffn_conv


def setup_inputs(seed: int = 0) -> dict:
    key = jax.random.key(seed)
    ks = jax.random.split(key, 32)
    f32 = jnp.float32
    n_pages = PAST_LEN // PAGE_SIZE
    n_pool = (DEC_BATCH * n_pages * 5) // 4

    def nrm(k, shape, scale=1.0):
        return jax.random.normal(k, shape, f32) * scale

    def gain(k, shape):
        return 1.0 + 0.01 * jax.random.normal(k, shape, f32)

    page_table = jax.random.permutation(ks[0], n_pool)[:DEC_BATCH * n_pages]
    page_table = page_table.reshape(DEC_BATCH, n_pages).astype(jnp.int32)
    dt = jnp.exp(jax.random.uniform(ks[1], (DEPTH, GDN_HEADS), f32,
                                    float(np.log(1e-3)), float(np.log(1e-1))))
    gdn_dt_bias = dt + jnp.log(-jnp.expm1(-dt))
    gdn_a_log = jnp.log(jax.random.uniform(ks[2], (DEPTH, GDN_HEADS), f32, 1.0, 16.0))
    return {
        'x_prompt': nrm(ks[3], (BATCH, SEQ, D_MODEL)),
        'x_sample': nrm(ks[4], (DEC_BATCH, DEC_SEQ, D_MODEL)),
        'cache_sb_k': nrm(ks[5], (DEPTH, n_pool, PAGE_SIZE, SB_HEADS, HEAD_DIM)),
        'cache_sb_v': nrm(ks[6], (DEPTH, n_pool, PAGE_SIZE, SB_HEADS, HEAD_DIM)),
        'page_table': page_table,
        'state_gdn_conv': nrm(ks[7], (DEPTH, DEC_BATCH, GDN_CONV - 1, GDN_CONV_CH)),
        'state_gdn_rec': nrm(ks[8], (DEPTH, DEC_BATCH, GDN_HEADS, HEAD_DIM, HEAD_DIM), 0.1),
        'state_ffn_conv': nrm(ks[9], (DEPTH, DEC_BATCH, FFN_CONV - 1, D_FF)),
        'p_prompt': nrm(ks[10], (DEPTH, BATCH, SEQ, PLE_DIM)),
        'p_sample': nrm(ks[11], (DEPTH, DEC_BATCH, DEC_SEQ, PLE_DIM)),
        'attn_norm': gain(ks[12], (DEPTH, D_MODEL)),
        'w_in': nrm(ks[13], (DEPTH, D_MODEL, IN_COLS), D_MODEL ** -0.5),
        'sb_logit_bias': SB_LOGIT_BIAS_INIT + 0.1 * jax.random.normal(ks[27], (DEPTH, SB_HEADS), f32),
        'sb_out_norm': gain(ks[14], (DEPTH, HEAD_DIM)),
        'gdn_conv_w': nrm(ks[15], (DEPTH, GDN_CONV, GDN_CONV_CH), GDN_CONV ** -0.5),
        'gdn_a_log': gdn_a_log,
        'gdn_dt_bias': gdn_dt_bias,
        'gdn_out_norm': gain(ks[16], (DEPTH, HEAD_DIM)),
        'w_out': nrm(ks[17], (DEPTH, MIX_WIDTH, D_MODEL), MIX_WIDTH ** -0.5),
        'ffn_norm': gain(ks[18], (DEPTH, D_MODEL)),
        'w_ffn_gate': nrm(ks[19], (DEPTH, D_MODEL, D_FF), D_MODEL ** -0.5),
        'w_ffn_up': nrm(ks[20], (DEPTH, D_MODEL, D_FF), D_MODEL ** -0.5),
        'ffn_conv_w': nrm(ks[21], (DEPTH, FFN_CONV, D_FF), FFN_CONV ** -0.5),
        'w_ffn_down': nrm(ks[22], (DEPTH, D_FF, D_MODEL), D_FF ** -0.5),
        'ple_norm': gain(ks[23], (DEPTH, D_MODEL)),
        'w_ple_gate': nrm(ks[24], (DEPTH, D_MODEL, D_MODEL), D_MODEL ** -0.5),
        'w_ple_proj': nrm(ks[25], (DEPTH, PLE_DIM, D_MODEL), PLE_DIM ** -0.5),
        'final_norm': gain(ks[26], (D_MODEL,)),
    }


def reference(x_prompt, x_sample, cache_sb_k, cache_sb_v, page_table, state_gdn_conv,
              state_gdn_rec, state_ffn_conv, p_prompt, p_sample, attn_norm, w_in,
              sb_logit_bias, sb_out_norm, gdn_conv_w, gdn_a_log, gdn_dt_bias, gdn_out_norm,
              w_out, ffn_norm, w_ffn_gate, w_ffn_up, ffn_conv_w, w_ffn_down, ple_norm,
              w_ple_gate, w_ple_proj, final_norm):
    bp = x_prompt.shape[0]
    bs = x_sample.shape[0]
    past_len = page_table.shape[1] * cache_sb_k.shape[2]
    hp, hs = x_prompt, x_sample
    out_p = ([], [], [], [], [])
    out_s = ([], [], [], [], [])
    for i in range(DEPTH):
        lw = (attn_norm[i], w_in[i], sb_logit_bias[i], sb_out_norm[i], gdn_conv_w[i],
              gdn_a_log[i], gdn_dt_bias[i], gdn_out_norm[i], w_out[i], ffn_norm[i],
              w_ffn_gate[i], w_ffn_up[i], ffn_conv_w[i], w_ffn_down[i], ple_norm[i],
              w_ple_gate[i], w_ple_proj[i])
        hp, *st_p = layer_forward(
            hp, p_prompt[i], None, None,
            jnp.zeros((bp, GDN_CONV - 1, GDN_CONV_CH), hp.dtype),
            jnp.zeros((bp, GDN_HEADS, HEAD_DIM, HEAD_DIM), hp.dtype),
            jnp.zeros((bp, FFN_CONV - 1, D_FF), hp.dtype), 0, *lw)
        for lst, s in zip(out_p, st_p):
            lst.append(s)
        k_past = cache_sb_k[i][page_table].reshape(bs, past_len, SB_HEADS, HEAD_DIM)
        v_past = cache_sb_v[i][page_table].reshape(bs, past_len, SB_HEADS, HEAD_DIM)
        hs, *st_s = layer_forward(
            hs, p_sample[i], k_past, v_past, state_gdn_conv[i], state_gdn_rec[i],
            state_ffn_conv[i], past_len, *lw)
        for lst, s in zip(out_s, st_s):
            lst.append(s)
    y_prompt = rms_norm(hp, final_norm)
    y_sample = rms_norm(hs, final_norm)
    sb_k_p, sb_v_p, gdn_conv_p, gdn_rec_p, ffn_conv_p = [jnp.stack(l, axis=0) for l in out_p]
    sb_k_s, sb_v_s, gdn_conv_s, gdn_rec_s, ffn_conv_s = [jnp.stack(l, axis=0) for l in out_s]
    return (y_prompt, y_sample, sb_k_p, sb_v_p, gdn_conv_p, gdn_rec_p, ffn_conv_p,
            sb_k_s, sb_v_s, gdn_conv_s, gdn_rec_s, ffn_conv_s)
```

```cpp
#include <hip/hip_runtime.h>
#include <cstdio>
#include <cstdint>

#ifndef MK_N_LAUNCHES
#define MK_N_LAUNCHES 1
#endif

namespace pg8 {
#define PG8_LAS __attribute__((address_space(3)))
typedef unsigned short bf16_t;
typedef short bf16x8 __attribute__((ext_vector_type(8)));
typedef float f32x4 __attribute__((ext_vector_type(4)));
typedef unsigned u32x4 __attribute__((ext_vector_type(4)));
constexpr int BM = 256, BK = 64, HALF = 128, HTB = HALF * BK * 2  , STAGE_BYTES = 8 * HTB, NXCD = 8, WGM = 8;

__host__ __device__ __forceinline__ int lds_byte(int r, int c) { const int st = (r >> 4) * 2 + (c >> 5), rr = r & 15, cc = c & 31, ob = rr * 64 + cc * 2; return st * 1024 + (ob ^ (((ob >> 9) & 1) << 5)); }
__host__ __device__ __forceinline__ void stage_rc(int b, int& R, int& C) { const int st = b / 1024, sb = b % 1024, swz = sb ^ (((sb >> 9) & 1) << 5); R = (st >> 1) * 16 + swz / 64; C = (st & 1) * 32 + (swz % 64) / 2; }
__host__ __device__ __forceinline__ int perm32(int rho) { const int n = rho >> 4, i = rho & 15; return 8 * (i >> 2) + 4 * n + (i & 3); }

struct Unit { int pm, pn; };
struct Gemm { const bf16_t* A; const bf16_t* Bt; int M, N, K; };

struct StaticOrder {
    int nM, nN, nwg, G, c;
    __host__ __device__ void init(int M, int N, int G_, int c_) { nM = M / BM; nN = N / BM; nwg = nM * nN; G = G_; c = c_; }
    __host__ __device__ bool next(int i, Unit& u) const {
        const long L = (long)i * G + c; if (L >= nwg) return false;
        int wgid = (int)L; { const int q = nwg / NXCD, r = nwg % NXCD, xcd = wgid % NXCD, off = wgid / NXCD; wgid = (xcd < r ? xcd * (q + 1) : r * (q + 1) + (xcd - r) * q) + off; }
        const int nig = WGM * nN, gid = wgid / nig, fm = gid * WGM, gsz = (nM - fm) < WGM ? (nM - fm) : WGM;
        u.pm = fm + ((wgid % nig) % gsz); u.pn = (wgid % nig) / gsz; return true;
    }
    __device__ __forceinline__ void a_ready(const Unit&) const {}
    __device__ __forceinline__ void done(const Unit&) const {}
};

__device__ __forceinline__ unsigned cvt_pk_bf16(float lo, float hi) { unsigned r; asm volatile("v_cvt_pk_bf16_f32 %0, %1, %2" : "=v"(r) : "v"(lo), "v"(hi)); return r; }
template <class Epi, class Sched, bool ALIGN_EPI = false, bool SP2 = false>
__device__ __forceinline__ void gemm_phase(PG8_LAS unsigned char* lds, const Gemm g, const Sched& S, const Epi& E) {
    const int tid = threadIdx.x, wid = __builtin_amdgcn_readfirstlane(tid >> 6), lane = tid & 63, wr = wid >> 2, wc = wid & 3, fr = lane & 15, fq = lane >> 4;
    const int K = g.K, nt = K / BK;
    unsigned voffA[2], voffB[2];
#pragma unroll
    for (int i = 0; i < 2; ++i) { int R, C; stage_rc(tid * 16 + i * 8192, R, C); const int Rb = Epi::PERM ? ((R & ~31) + perm32(R & 31)) : R;
        voffA[i] = (unsigned)(R * K + C) * 2u; voffB[i] = (unsigned)(Rb * K + C) * 2u; }
    const size_t kstep = (size_t)(BK * 2);
    const size_t hstep = (size_t)HALF * K * 2;
    const size_t tstep = 2 * hstep;
    const unsigned ldsw = (unsigned)wid * 1024u;
    const int aoff = lds_byte(wr * 64 + fr, fq * 8), boff = lds_byte(wc * 32 + fr, fq * 8);
#define PG8_SA(b, h) (((b) * 2 + (h)) * HTB)
#define PG8_SB(b, h) ((4 + (b) * 2 + (h)) * HTB)
#define PG8_STAGE(bufoff, gbase, voff) do { _Pragma("unroll") for (int _i = 0; _i < 2; ++_i) \
        __builtin_amdgcn_global_load_lds((const unsigned*)((const char*)(gbase) + (voff)[_i]), (PG8_LAS unsigned*)(lds + (bufoff) + ldsw + _i * 8192), 16, 0, 0); } while (0)
#define PG8_LDA(dst, b, h) do { _Pragma("unroll") for (int m = 0; m < 4; ++m) _Pragma("unroll") for (int k = 0; k < 2; ++k) dst[m][k] = *(const PG8_LAS bf16x8*)(lds + PG8_SA(b, h) + aoff + m * 2048 + k * 1024); } while (0)
#define PG8_LDB(dst, b, h) do { _Pragma("unroll") for (int n = 0; n < 2; ++n) _Pragma("unroll") for (int k = 0; k < 2; ++k) dst[n][k] = *(const PG8_LAS bf16x8*)(lds + PG8_SB(b, h) + boff + n * 2048 + k * 1024); } while (0)
#define PG8_MMA(ai, bj, At, Bt) do { __builtin_amdgcn_s_setprio(1); _Pragma("unroll") for (int m = 0; m < 4; ++m) _Pragma("unroll") for (int n = 0; n < 2; ++n) _Pragma("unroll") for (int k = 0; k < 2; ++k) \
        acc[ai][bj][m][n] = __builtin_amdgcn_mfma_f32_16x16x32_bf16(Bt[n][k], At[m][k], acc[ai][bj][m][n], 0, 0, 0); __builtin_amdgcn_s_setprio(0); } while (0)
#define PG8_WAIT_V(n) asm volatile("s_waitcnt vmcnt(" #n ")" ::: "memory")
#define PG8_WAIT_L(n) asm volatile("s_waitcnt lgkmcnt(" #n ")" ::: "memory")
#define PG8_BAR __builtin_amdgcn_s_barrier()
#define PG8_SCHED __builtin_amdgcn_sched_barrier(0)
    Unit cur, nxt; int ui = 0;
    if (!S.next(0, cur)) return;
    f32x4 acc[2][2][4][2];
#pragma unroll
    for (int a = 0; a < 2; ++a)
#pragma unroll
        for (int b = 0; b < 2; ++b)
#pragma unroll
            for (int m = 0; m < 4; ++m)
#pragma unroll
                for (int n = 0; n < 2; ++n) acc[a][b][m][n] = (f32x4){0.f, 0.f, 0.f, 0.f};
    bf16x8 At[4][2], B0[2][2], B1[2][2];
    const char* cA = (const char*)g.A + (size_t)cur.pm * tstep; const char* cB = (const char*)g.Bt + (size_t)cur.pn * tstep;
    S.a_ready(cur);
    if constexpr (SP2) {
        PG8_STAGE(PG8_SB(0, 0), cB, voffB); PG8_STAGE(PG8_SB(0, 1), cB + hstep, voffB); PG8_STAGE(PG8_SA(0, 0), cA, voffA); PG8_STAGE(PG8_SA(0, 1), cA + hstep, voffA);
        if (wr == 1) PG8_BAR;
        PG8_WAIT_V(2); PG8_BAR;
        PG8_STAGE(PG8_SB(1, 0), cB + kstep, voffB); PG8_STAGE(PG8_SA(1, 0), cA + kstep, voffA); PG8_STAGE(PG8_SB(1, 1), cB + hstep + kstep, voffB);
        PG8_WAIT_V(6); PG8_BAR;
    } else {
        PG8_STAGE(PG8_SB(0, 0), cB, voffB); PG8_STAGE(PG8_SA(0, 0), cA, voffA); PG8_STAGE(PG8_SB(0, 1), cB + hstep, voffB); PG8_STAGE(PG8_SA(0, 1), cA + hstep, voffA);
        if (wr == 1) PG8_BAR;
        PG8_WAIT_V(4); PG8_BAR;
        PG8_STAGE(PG8_SB(1, 0), cB + kstep, voffB); PG8_STAGE(PG8_SA(1, 0), cA + kstep, voffA); PG8_STAGE(PG8_SB(1, 1), cB + hstep + kstep, voffB);
        PG8_WAIT_V(6); PG8_BAR;
    }
    for (;;) {
        const bool has_next = S.next(ui + 1, nxt);
        const char* nA = has_next ? (const char*)g.A + (size_t)nxt.pm * tstep : cA; const char* nB = has_next ? (const char*)g.Bt + (size_t)nxt.pn * tstep : cB;
        for (int t = 0; t < nt; t += 2) {
            const bool last = (t == nt - 2);
            const char* a1 = cA + (size_t)(t + 1) * kstep;
            const char* a2 = last ? nA : cA + (size_t)(t + 2) * kstep; const char* b2 = last ? nB : cB + (size_t)(t + 2) * kstep;
            const char* a3 = a2 + kstep; const char* b3 = b2 + kstep;
            if (last && has_next) S.a_ready(nxt);
            if constexpr (SP2) {
            PG8_LDB(B0, 0, 0); PG8_LDB(B1, 0, 1); PG8_SCHED; PG8_LDA(At, 0, 0); PG8_STAGE(PG8_SA(1, 1), a1 + hstep, voffA);
            PG8_WAIT_V(8); PG8_WAIT_L(0); PG8_BAR; PG8_MMA(0, 0, At, B0); PG8_MMA(0, 1, At, B1); PG8_BAR; PG8_SCHED;
            PG8_LDA(At, 0, 1); PG8_STAGE(PG8_SB(0, 0), b2, voffB); PG8_STAGE(PG8_SB(0, 1), b2 + hstep, voffB); PG8_STAGE(PG8_SA(0, 0), a2, voffA);
            PG8_WAIT_V(8); PG8_WAIT_L(0); PG8_BAR; PG8_MMA(1, 0, At, B0); PG8_MMA(1, 1, At, B1); PG8_BAR; PG8_SCHED;
            PG8_LDB(B0, 1, 0); PG8_LDB(B1, 1, 1); PG8_SCHED; PG8_LDA(At, 1, 0); PG8_STAGE(PG8_SA(0, 1), a2 + hstep, voffA);
            PG8_WAIT_V(8); PG8_WAIT_L(0); PG8_BAR; PG8_MMA(0, 0, At, B0); PG8_MMA(0, 1, At, B1); PG8_BAR; PG8_SCHED;
            PG8_LDA(At, 1, 1); PG8_STAGE(PG8_SB(1, 0), b3, voffB); PG8_STAGE(PG8_SB(1, 1), b3 + hstep, voffB); PG8_STAGE(PG8_SA(1, 0), a3, voffA);
            PG8_WAIT_V(8); PG8_WAIT_L(0); PG8_BAR; PG8_MMA(1, 0, At, B0); PG8_MMA(1, 1, At, B1); PG8_BAR; PG8_SCHED;
            } else {
            PG8_LDB(B0, 0, 0); PG8_SCHED; PG8_LDA(At, 0, 0); PG8_STAGE(PG8_SA(1, 1), a1 + hstep, voffA);
            PG8_WAIT_L(8); PG8_BAR; PG8_WAIT_L(0); PG8_MMA(0, 0, At, B0); PG8_BAR; PG8_SCHED;
            PG8_LDB(B1, 0, 1); PG8_STAGE(PG8_SB(0, 0), b2, voffB);
            PG8_BAR; PG8_WAIT_L(0); PG8_MMA(0, 1, At, B1); PG8_BAR;
            PG8_LDA(At, 0, 1); PG8_STAGE(PG8_SA(0, 0), a2, voffA);
            PG8_BAR; PG8_WAIT_L(0); PG8_MMA(1, 0, At, B0); PG8_BAR; PG8_SCHED;
            PG8_STAGE(PG8_SB(0, 1), b2 + hstep, voffB);
            PG8_WAIT_V(6); PG8_BAR; PG8_MMA(1, 1, At, B1); PG8_BAR;
            PG8_LDB(B0, 1, 0); PG8_SCHED; PG8_LDA(At, 1, 0); PG8_STAGE(PG8_SA(0, 1), a2 + hstep, voffA);
            PG8_WAIT_L(8); PG8_BAR; PG8_WAIT_L(0); PG8_MMA(0, 0, At, B0); PG8_BAR; PG8_SCHED;
            PG8_LDB(B1, 1, 1); PG8_STAGE(PG8_SB(1, 0), b3, voffB);
            PG8_BAR; PG8_WAIT_L(0); PG8_MMA(0, 1, At, B1); PG8_BAR;
            PG8_LDA(At, 1, 1); PG8_STAGE(PG8_SA(1, 0), a3, voffA);
            PG8_BAR; PG8_WAIT_L(0); PG8_MMA(1, 0, At, B0); PG8_BAR; PG8_SCHED;
            PG8_STAGE(PG8_SB(1, 1), b3 + hstep, voffB);
            PG8_WAIT_V(6); PG8_BAR; PG8_MMA(1, 1, At, B1); PG8_BAR;
            }
        }
        if constexpr (ALIGN_EPI) { if (wr == 0) PG8_BAR; }
        if constexpr (!Epi::AFTER_DRAIN) { E(acc, cur, wr, wc, fr, fq); S.done(cur); }
        if (!has_next) break;
#pragma unroll
        for (int a = 0; a < 2; ++a)
#pragma unroll
            for (int b = 0; b < 2; ++b)
#pragma unroll
                for (int m = 0; m < 4; ++m)
#pragma unroll
                    for (int n = 0; n < 2; ++n) acc[a][b][m][n] = (f32x4){0.f, 0.f, 0.f, 0.f};
        cur = nxt; cA = nA; cB = nB; ++ui;
        if constexpr (ALIGN_EPI) { if (wr == 1) PG8_BAR; }
    }
    PG8_WAIT_V(0);
    if constexpr (!ALIGN_EPI) { if (wr == 0) PG8_BAR; }
    PG8_BAR;
    if constexpr (Epi::AFTER_DRAIN) { E.fused(acc, cur, wr, wc, fr, fq, lds, wid, lane); S.done(cur); }
#undef PG8_SA
#undef PG8_SB
#undef PG8_STAGE
#undef PG8_LDA
#undef PG8_LDB
#undef PG8_MMA
#undef PG8_WAIT_V
#undef PG8_WAIT_L
#undef PG8_BAR
#undef PG8_SCHED
}
}

constexpr int D = 2048, T = 4096, NB = 2, M = NB * T;
constexpr int MS = 8;
constexpr int HD = 128, NH = 8, SBW = NH * HD, GW = NH * HD;
constexpr int CONVCH = 3 * GW;
constexpr int IN_COLS = 7184, NPROJ_PAD = 7424;
constexpr int DFF = 5504, NGU = 2 * DFF;
constexpr int PLE = 256;
constexpr int PAST = 16384, PAGE = 128, NPAGES = PAST / PAGE, NPOOL = 1280;
constexpr float EPS = 1e-6f;
constexpr float SB_SCALE = 0.08838834764831845f;
constexpr int O_SB_K = 1024, O_SB_V = 2048, O_GQKV = 3072, O_GZ = 6144, O_GA = 7168, O_GB = 7176;

constexpr size_t OUT_Y = 0;
constexpr size_t OUT_YS = OUT_Y + (size_t)M * D;
constexpr size_t OUT_K = OUT_YS + (size_t)MS * D;
constexpr size_t OUT_V = OUT_K + (size_t)M * SBW;
constexpr size_t OUT_GCONV = OUT_V + (size_t)M * SBW;
constexpr size_t OUT_GREC = OUT_GCONV + (size_t)NB * 3 * CONVCH;
constexpr size_t OUT_FCONV = OUT_GREC + (size_t)NB * NH * HD * HD;
constexpr size_t OUT_KS = OUT_FCONV + (size_t)NB * 2 * DFF;
constexpr size_t OUT_VS = OUT_KS + (size_t)MS * SBW;
constexpr size_t OUT_GCONVS = OUT_VS + (size_t)MS * SBW;
constexpr size_t OUT_GRECS = OUT_GCONVS + (size_t)MS * 3 * CONVCH;
constexpr size_t OUT_FCONVS = OUT_GRECS + (size_t)MS * NH * HD * HD;
constexpr size_t OUT_END = OUT_FCONVS + (size_t)MS * 2 * DFF;

namespace pg8 {
__device__ __forceinline__ float silu_f(float x) { return x / (1.0f + __expf(-x)); }
__device__ __forceinline__ float sigmoid_f(float x) { return 1.0f / (1.0f + __expf(-x)); }
__device__ __forceinline__ float softplus_f(float x) { return fmaxf(x, 0.f) + log1pf(__expf(-fabsf(x))); }
typedef unsigned u32x2 __attribute__((ext_vector_type(2)));

struct EpiProj {
    static constexpr bool PERM = true, AFTER_DRAIN = false;
    bf16_t *Qb, *Kb, *Vb, *CIN, *Zb; float *outK, *outV, *outGconv; float *G, *BETA; const float *a_log, *dt_bias;
    __device__ __forceinline__ void operator()(const f32x4 (&acc)[2][2][4][2], const Unit& u, int wr, int wc, int fr, int fq) const {
        const int reg = u.pn >> 2;
#pragma unroll
        for (int ai = 0; ai < 2; ++ai)
#pragma unroll
            for (int m = 0; m < 4; ++m) {
                const int r = u.pm * BM + ai * HALF + wr * 64 + m * 16 + fr;
#pragma unroll
                for (int bj = 0; bj < 2; ++bj) {
                    const int c8 = u.pn * BM + bj * HALF + wc * 32 + 8 * fq;
                    const f32x4 v0 = acc[ai][bj][m][0], v1 = acc[ai][bj][m][1];
                    u32x4 w; w.x = cvt_pk_bf16(v0[0], v0[1]); w.y = cvt_pk_bf16(v0[2], v0[3]); w.z = cvt_pk_bf16(v1[0], v1[1]); w.w = cvt_pk_bf16(v1[2], v1[3]);
                    if (reg == 0) { *(u32x4*)(Qb + (size_t)r * SBW + c8) = w; }
                    else if (reg == 1) { const int c = c8 - O_SB_K; *(u32x4*)(Kb + (size_t)r * SBW + c) = w; float* o = outK + (size_t)r * SBW + c; *(f32x4*)o = v0; *(f32x4*)(o + 4) = v1; }
                    else if (reg == 2) { const int c = c8 - O_SB_V; *(u32x4*)(Vb + (size_t)r * SBW + c) = w; float* o = outV + (size_t)r * SBW + c; *(f32x4*)o = v0; *(f32x4*)(o + 4) = v1; }
                    else if (reg < 6) { const int c = c8 - O_GQKV; *(u32x4*)(CIN + (size_t)r * CONVCH + c) = w;
                        const int t = r & (T - 1); if (t >= T - 3) { float* o = outGconv + ((size_t)(r >> 12) * 3 + (t - (T - 3))) * CONVCH + c; *(f32x4*)o = v0; *(f32x4*)(o + 4) = v1; } }
                    else if (reg == 6) { const int c = c8 - O_GZ; *(u32x4*)(Zb + (size_t)r * GW + c) = w; }
                    else if (bj == 0 && wc == 0 && fq < 2 && u.pn == 28) {
                        float x[8] = {v0[0], v0[1], v0[2], v0[3], v1[0], v1[1], v1[2], v1[3]}; float y[8];
#pragma unroll
                        for (int h = 0; h < 8; ++h) y[h] = (fq == 0) ? -__expf(a_log[h]) * softplus_f(x[h] + dt_bias[h]) : sigmoid_f(x[h]);
                        float* o = (fq == 0 ? G : BETA) + (size_t)r * NH; *(f32x4*)o = (f32x4){y[0], y[1], y[2], y[3]}; *(f32x4*)(o + 4) = (f32x4){y[4], y[5], y[6], y[7]};
                    }
                }
            }
    }
};

struct EpiF32 {
    static constexpr bool PERM = false, AFTER_DRAIN = false;
    float* C; int ldc;
    __device__ __forceinline__ void operator()(const f32x4 (&acc)[2][2][4][2], const Unit& u, int wr, int wc, int fr, int fq) const {
        const int row0 = u.pm * BM + wr * 64 + fr, col0 = u.pn * BM + wc * 32 + 4 * fq;
#pragma unroll
        for (int ai = 0; ai < 2; ++ai)
#pragma unroll
            for (int m = 0; m < 4; ++m) { float* rowp = C + (size_t)(row0 + ai * HALF + m * 16) * ldc + col0;
#pragma unroll
                for (int bj = 0; bj < 2; ++bj)
#pragma unroll
                    for (int n = 0; n < 2; ++n) *(f32x4*)(rowp + bj * HALF + n * 16) = acc[ai][bj][m][n]; }
    }
};

struct EpiResid {
    static constexpr bool PERM = false, AFTER_DRAIN = false;
    const float* base; float* Hf; bf16_t* Hb; float* sumsq; int ldc;
    __device__ __forceinline__ void operator()(const f32x4 (&acc)[2][2][4][2], const Unit& u, int wr, int wc, int fr, int fq) const {
        const int row0 = u.pm * BM + wr * 64 + fr, col0 = u.pn * BM + wc * 32 + 4 * fq;
#pragma unroll
        for (int ai = 0; ai < 2; ++ai)
#pragma unroll
            for (int m = 0; m < 4; ++m) { const int r = row0 + ai * HALF + m * 16; const size_t off = (size_t)r * ldc + col0; float ss = 0.f;
#pragma unroll
                for (int bj = 0; bj < 2; ++bj)
#pragma unroll
                    for (int n = 0; n < 2; ++n) { const f32x4 b = *(const f32x4*)(base + off + bj * HALF + n * 16); const f32x4 h = b + acc[ai][bj][m][n];
                        *(f32x4*)(Hf + off + bj * HALF + n * 16) = h; u32x2 w; w.x = cvt_pk_bf16(h[0], h[1]); w.y = cvt_pk_bf16(h[2], h[3]); *(u32x2*)(Hb + off + bj * HALF + n * 16) = w;
                        ss += (h[0] * h[0] + h[1] * h[1]) + (h[2] * h[2] + h[3] * h[3]); }
                ss += __shfl_xor(ss, 16); ss += __shfl_xor(ss, 32);
                if (fq == 0) unsafeAtomicAdd(sumsq + r, ss); }
    }
};

struct EpiGateUp {
    static constexpr bool PERM = true, AFTER_DRAIN = false;
    const float* sumsq; const float* convw; bf16_t* ACT; float* TAIL; float* FIXG; float* FIXU; float* outFconv; PG8_LAS float* halo;
    __device__ __forceinline__ void operator()(const f32x4 (&acc)[2][2][4][2], const Unit& u, int wr, int wc, int fr, int fq) const {
        const int lane = fr + 16 * fq;
        const int cg = u.pn * HALF + wc * 32 + 8 * fq;
        float w0[8], w1[8], w2[8];
#pragma unroll
        for (int j = 0; j < 8; ++j) { w0[j] = convw[cg + j]; w1[j] = convw[DFF + cg + j]; w2[j] = convw[2 * DFF + cg + j]; }
        float gp[2][4][8], up[2][4][8];
#pragma unroll
        for (int ai = 0; ai < 2; ++ai)
#pragma unroll
            for (int m = 0; m < 4; ++m) { const int r = u.pm * BM + ai * HALF + wr * 64 + m * 16 + fr; const float rs = rsqrtf(sumsq[r] * (1.0f / D) + EPS);
#pragma unroll
                for (int n = 0; n < 2; ++n)
#pragma unroll
                    for (int j = 0; j < 4; ++j) { gp[ai][m][4 * n + j] = acc[ai][0][m][n][j] * rs; up[ai][m][4 * n + j] = acc[ai][1][m][n][j] * rs; } }
        if (fr >= 14) {
#pragma unroll
            for (int ai = 0; ai < 2; ++ai) { PG8_LAS float* hp = halo + ((wc * 4 + (2 * ai + wr)) * 2 + (fr - 14)) * 32 + 8 * fq;
                *(PG8_LAS f32x4*)hp = (f32x4){gp[ai][3][0], gp[ai][3][1], gp[ai][3][2], gp[ai][3][3]}; *(PG8_LAS f32x4*)(hp + 4) = (f32x4){gp[ai][3][4], gp[ai][3][5], gp[ai][3][6], gp[ai][3][7]}; }
        }
        asm volatile("s_waitcnt lgkmcnt(0)" ::: "memory"); __builtin_amdgcn_s_barrier(); asm volatile("" ::: "memory");
        const int src1 = (lane & 48) | ((fr - 1) & 15), src2 = (lane & 48) | ((fr - 2) & 15);
#pragma unroll
        for (int ai = 0; ai < 2; ++ai) {
            const int B = 2 * ai + wr;
            float h62[8], h63[8];
            if (B > 0) { const PG8_LAS float* hp = halo + ((wc * 4 + (B - 1)) * 2) * 32 + 8 * fq;
                const f32x4 a0 = *(const PG8_LAS f32x4*)hp, a1 = *(const PG8_LAS f32x4*)(hp + 4), b0 = *(const PG8_LAS f32x4*)(hp + 32), b1 = *(const PG8_LAS f32x4*)(hp + 36);
#pragma unroll
                for (int j = 0; j < 4; ++j) { h62[j] = a0[j]; h62[4 + j] = a1[j]; h63[j] = b0[j]; h63[4 + j] = b1[j]; } }
            else {
#pragma unroll
                for (int j = 0; j < 8; ++j) { h62[j] = 0.f; h63[j] = 0.f; } }
            float ps1[8], ps2[8];
#pragma unroll
            for (int j = 0; j < 8; ++j) { ps1[j] = h63[j]; ps2[j] = (fr == 0) ? h62[j] : h63[j]; }
#pragma unroll
            for (int m = 0; m < 4; ++m) {
                const int r = u.pm * BM + ai * HALF + wr * 64 + m * 16 + fr;
                float gate[8], a[8];
#pragma unroll
                for (int j = 0; j < 8; ++j) {
                    const float s1 = __shfl(gp[ai][m][j], src1), s2 = __shfl(gp[ai][m][j], src2);
                    const float p1 = (fr >= 1) ? s1 : ps1[j], p2 = (fr >= 2) ? s2 : ps2[j];
                    ps1[j] = s1; ps2[j] = s2;
                    gate[j] = w0[j] * p2 + w1[j] * p1 + w2[j] * gp[ai][m][j];
                    a[j] = silu_f(gate[j]) * up[ai][m][j];
                }
                u32x4 w; w.x = cvt_pk_bf16(a[0], a[1]); w.y = cvt_pk_bf16(a[2], a[3]); w.z = cvt_pk_bf16(a[4], a[5]); w.w = cvt_pk_bf16(a[6], a[7]);
                *(u32x4*)(ACT + (size_t)r * DFF + cg) = w;
                if (B == 0 && m == 0 && fr < 2 && (u.pm & 15) != 0) {
                    float* fg = FIXG + ((size_t)u.pm * 2 + fr) * DFF + cg; float* fu = FIXU + ((size_t)u.pm * 2 + fr) * DFF + cg;
                    *(f32x4*)fg = (f32x4){gate[0], gate[1], gate[2], gate[3]}; *(f32x4*)(fg + 4) = (f32x4){gate[4], gate[5], gate[6], gate[7]};
                    *(f32x4*)fu = (f32x4){up[ai][m][0], up[ai][m][1], up[ai][m][2], up[ai][m][3]}; *(f32x4*)(fu + 4) = (f32x4){up[ai][m][4], up[ai][m][5], up[ai][m][6], up[ai][m][7]};
                }
                if (B == 3 && m == 3 && fr >= 14) {
                    float* tp = TAIL + ((size_t)u.pm * 2 + (fr - 14)) * DFF + cg;
                    *(f32x4*)tp = (f32x4){gp[ai][m][0], gp[ai][m][1], gp[ai][m][2], gp[ai][m][3]}; *(f32x4*)(tp + 4) = (f32x4){gp[ai][m][4], gp[ai][m][5], gp[ai][m][6], gp[ai][m][7]};
                    if ((u.pm & 15) == 15) { float* op = outFconv + ((size_t)(u.pm >> 4) * 2 + (fr - 14)) * DFF + cg;
                        *(f32x4*)op = (f32x4){gp[ai][m][0], gp[ai][m][1], gp[ai][m][2], gp[ai][m][3]}; *(f32x4*)(op + 4) = (f32x4){gp[ai][m][4], gp[ai][m][5], gp[ai][m][6], gp[ai][m][7]}; }
                }
            }
        }
    }
};

struct EpiPle {
    static constexpr bool PERM = false, AFTER_DRAIN = false;
    const float* H2; const float* PP; const float* sumsq2; float* H3; float* sumsq3; int ldc;
    __device__ __forceinline__ void operator()(const f32x4 (&acc)[2][2][4][2], const Unit& u, int wr, int wc, int fr, int fq) const {
        const int row0 = u.pm * BM + wr * 64 + fr, col0 = u.pn * BM + wc * 32 + 4 * fq;
#pragma unroll
        for (int ai = 0; ai < 2; ++ai)
#pragma unroll
            for (int m = 0; m < 4; ++m) { const int r = row0 + ai * HALF + m * 16; const size_t off = (size_t)r * ldc + col0; float ss = 0.f;
                const float rs = rsqrtf(sumsq2[r] * (1.0f / D) + EPS);
#pragma unroll
                for (int bj = 0; bj < 2; ++bj)
#pragma unroll
                    for (int n = 0; n < 2; ++n) { const f32x4 b = *(const f32x4*)(H2 + off + bj * HALF + n * 16), p = *(const f32x4*)(PP + off + bj * HALF + n * 16); const f32x4 a = acc[ai][bj][m][n]; f32x4 h;
#pragma unroll
                        for (int j = 0; j < 4; ++j) h[j] = b[j] + p[j] * sigmoid_f(a[j] * rs);
                        *(f32x4*)(H3 + off + bj * HALF + n * 16) = h; ss += (h[0] * h[0] + h[1] * h[1]) + (h[2] * h[2] + h[3] * h[3]); }
                ss += __shfl_xor(ss, 16); ss += __shfl_xor(ss, 32);
                if (fq == 0) unsafeAtomicAdd(sumsq3 + r, ss); }
    }
};
}

constexpr size_t MiB = 1u << 20;
constexpr size_t WS_CTL = 0, CTL_ZERO_BYTES = 1 * MiB;
constexpr int CW_BAR = 4096;
constexpr int CW_SUMSQ1 = 32768, CW_SUMSQ2 = CW_SUMSQ1 + M, CW_SUMSQ3 = CW_SUMSQ2 + M;
static_assert((CW_SUMSQ3 + M) * 4 <= (int)CTL_ZERO_BYTES, "ctl");
constexpr size_t WS_WIN = 2 * MiB;
constexpr size_t WS_WOUT = WS_WIN + (size_t)NPROJ_PAD * D * 2;
constexpr size_t WS_WGU = WS_WOUT + (size_t)D * D * 2;
constexpr size_t WS_WDN = WS_WGU + (size_t)NGU * D * 2;
constexpr size_t WS_WPG = WS_WDN + (size_t)D * DFF * 2;
constexpr size_t WS_WPP = WS_WPG + (size_t)D * D * 2;
constexpr size_t WS_XN = WS_WPP + (size_t)D * PLE * 2;
constexpr size_t WS_PB = WS_XN + (size_t)M * D * 2;
constexpr size_t WS_Q = WS_PB + (size_t)M * PLE * 2;
constexpr size_t WS_K = WS_Q + (size_t)M * SBW * 2;
constexpr size_t WS_V = WS_K + (size_t)M * SBW * 2;
constexpr size_t WS_CIN = WS_V + (size_t)M * SBW * 2;
constexpr size_t WS_Z = WS_CIN + (size_t)M * CONVCH * 2;
constexpr size_t WS_G = WS_Z + (size_t)M * GW * 2;
constexpr size_t WS_BETA = WS_G + (size_t)M * NH * 4;
constexpr size_t WS_GQ = WS_BETA + (size_t)M * NH * 4;
constexpr size_t WS_GK = WS_GQ + (size_t)M * GW * 4;
constexpr size_t WS_GV = WS_GK + (size_t)M * GW * 4;
constexpr size_t WS_GO = WS_GV + (size_t)M * GW * 4;
constexpr size_t WS_MIX = WS_GO + (size_t)M * GW * 4;
constexpr size_t WS_H1 = WS_MIX + (size_t)M * D * 2;
constexpr size_t WS_H1B = WS_H1 + (size_t)M * D * 4;
constexpr size_t WS_ACT = WS_H1B + (size_t)M * D * 2;
constexpr size_t WS_TAIL = WS_ACT + (size_t)M * DFF * 2;
constexpr size_t WS_FIXG = WS_TAIL + (size_t)32 * 2 * DFF * 4;
constexpr size_t WS_FIXU = WS_FIXG + (size_t)32 * 2 * DFF * 4;
constexpr size_t WS_H2 = WS_FIXU + (size_t)32 * 2 * DFF * 4;
constexpr size_t WS_H2B = WS_H2 + (size_t)M * D * 4;
constexpr size_t WS_PP = WS_H2B + (size_t)M * D * 2;
constexpr size_t WS_S = WS_PP + (size_t)M * D * 4;
constexpr size_t S_A = 0;
constexpr size_t S_PROJ = S_A + MS * D;
constexpr size_t S_GQ = S_PROJ + MS * IN_COLS;
constexpr size_t S_GK = S_GQ + MS * GW;
constexpr size_t S_GV = S_GK + MS * GW;
constexpr size_t S_G = S_GV + MS * GW;
constexpr size_t S_BETA = S_G + 64;
constexpr size_t S_GO = S_BETA + 64;
constexpr size_t S_PART = S_GO + MS * GW;
constexpr int DSEG = 32, DPART = 132;
constexpr size_t S_MIX = S_PART + (size_t)MS * NH * DSEG * DPART;
constexpr size_t S_H1 = S_MIX + MS * D;
constexpr size_t S_GP = S_H1 + MS * D;
constexpr size_t S_UP = S_GP + MS * DFF;
constexpr size_t S_ACT = S_UP + MS * DFF;
constexpr size_t S_H2 = S_ACT + MS * DFF;
constexpr size_t S_PG = S_H2 + MS * D;
constexpr size_t S_PP = S_PG + MS * D;
constexpr size_t S_END = S_PP + MS * D;
constexpr size_t WS_END = WS_S + S_END * 4;

constexpr int RING_OFF = 0, RING_BYTES = 131072;
constexpr int HALO_OFF = RING_BYTES;
constexpr int LDSCTL_OFF = RING_BYTES + 8192, MISC_OFF = LDSCTL_OFF + 320;
constexpr int LDS_BYTES = 147456;
constexpr int NWAVES = 8;

#define GAS __attribute__((address_space(1)))
#define LAS __attribute__((address_space(3)))
typedef unsigned short bf16;
typedef unsigned v4u __attribute__((ext_vector_type(4)));
typedef unsigned v2u __attribute__((ext_vector_type(2)));
typedef float f32x4 __attribute__((ext_vector_type(4)));
typedef float f32x2 __attribute__((ext_vector_type(2)));
typedef GAS unsigned gu32;
#define RLX_AGENT __ATOMIC_RELAXED, __HIP_MEMORY_SCOPE_AGENT
#define LDS_WAIT() asm volatile("s_waitcnt lgkmcnt(0)" ::: "memory")
#define VM_WAIT() asm volatile("s_waitcnt vmcnt(0)" ::: "memory")
__device__ __forceinline__ unsigned f2bf(float f) { unsigned u = __builtin_bit_cast(unsigned, f); return (u + 0x7fffu + ((u >> 16) & 1u)) >> 16; }
__device__ __forceinline__ unsigned pk2(float lo, float hi) { return f2bf(lo) | (f2bf(hi) << 16); }
__device__ __forceinline__ float bf_lo(unsigned w) { return __builtin_bit_cast(float, w << 16); }
__device__ __forceinline__ float bf_hi(unsigned w) { return __builtin_bit_cast(float, w & 0xffff0000u); }
__device__ __forceinline__ float bf2f(bf16 b) { return __builtin_bit_cast(float, (unsigned)b << 16); }
using pg8::silu_f; using pg8::sigmoid_f; using pg8::softplus_f;

#define XB_TMO      128
#define XB_XCNT(j)  (256  + 64 * (j))
#define XB_XSUB(j)  (1280 + 64 * (j))
#define XB_XGEN(j)  (2304 + 64 * (j))
#define XB_TOP      3328
#define XB_TOPGEN   3392
#define XCD_BAR_WORDS 3456
#define XB_SPIN_CAP (1u << 18)
__device__ __forceinline__ unsigned xb_ld(unsigned* p)              { return __hip_atomic_load(p, __ATOMIC_RELAXED, __HIP_MEMORY_SCOPE_AGENT); }
__device__ __forceinline__ unsigned xb_add(unsigned* p, unsigned v) { return __hip_atomic_fetch_add(p, v, __ATOMIC_RELAXED, __HIP_MEMORY_SCOPE_AGENT); }
__device__ __forceinline__ unsigned xb_xcc_id() { return (unsigned)__builtin_amdgcn_s_getreg((3 << 11) | 20) & 0xFu; }
#define XB_SPIN(cond, bar) do { unsigned _sp = 0; while (cond) { __builtin_amdgcn_s_sleep(1); \
    if ((++_sp & 255u) == 0u) { if (xb_ld(&(bar)[XB_TMO])) break; if (_sp > XB_SPIN_CAP) { atomicAdd(&(bar)[XB_TMO], 1u); break; } } } } while (0)
struct XcdBarrier { unsigned* bar; unsigned x; volatile LAS unsigned* st; };
__device__ __forceinline__ XcdBarrier xcd_barrier_post(unsigned* bar, volatile LAS unsigned* st) {
    XcdBarrier b; b.bar = bar; b.x = xb_xcc_id(); b.st = st;
    if (threadIdx.x == 0) (void)xb_add(&bar[XB_XCNT(b.x)], 1u);
    return b;
}
__device__ __forceinline__ void xcd_barrier_complete(unsigned* bar, unsigned x, unsigned& nloc, unsigned& nx) {
    const unsigned G = gridDim.x * gridDim.y * gridDim.z;
    unsigned sum, cnt, mine, sp = 0u;
    for (;;) {
        sum = 0u; cnt = 0u; mine = 0u;
#pragma unroll
        for (unsigned j = 0; j < 16; ++j) { const unsigned c = xb_ld(&bar[XB_XCNT(j)]); sum += c; cnt += (c > 0u) ? 1u : 0u; mine = (j == x) ? c : mine; }
        if (sum == G) break;
        __builtin_amdgcn_s_sleep(1);
        if ((++sp & 255u) == 0u) { if (xb_ld(&bar[XB_TMO])) break; if (sp > XB_SPIN_CAP) { atomicAdd(&bar[XB_TMO], 1u); break; } }
    }
    nloc = mine > 0u ? mine : 1u; nx = cnt > 0u ? cnt : 1u;
}
__device__ __forceinline__ void xcd_barrier(const XcdBarrier& b) {
    asm volatile("s_waitcnt vmcnt(0)" ::: "memory");
    __syncthreads();
    if (threadIdx.x == 0) {
        unsigned* bar = b.bar;
        __builtin_amdgcn_s_waitcnt(0);
        unsigned nloc = b.st[0], nx = b.st[1];
        if (nloc == 0u) { xcd_barrier_complete(bar, b.x, nloc, nx); b.st[0] = nloc; b.st[1] = nx; }
        const unsigned old = xb_add(&bar[XB_XSUB(b.x)], 1u);
        const unsigned gen = old / nloc;
        if (old + 1u == (gen + 1u) * nloc) {
            __builtin_amdgcn_fence(__ATOMIC_RELEASE, "agent");
            asm volatile("s_waitcnt vmcnt(0)" ::: "memory");
            const unsigned og = xb_add(&bar[XB_TOP], 1u);
            const unsigned tg = og / nx;
            if (og + 1u == (tg + 1u) * nx) xb_add(&bar[XB_TOPGEN], 1u);
            else XB_SPIN(xb_ld(&bar[XB_TOPGEN]) == tg, bar);
            __builtin_amdgcn_fence(__ATOMIC_ACQUIRE, "agent");
            xb_add(&bar[XB_XGEN(b.x)], 1u);
            asm volatile("s_waitcnt vmcnt(0)" ::: "memory");
        } else {
            XB_SPIN(xb_ld(&bar[XB_XGEN(b.x)]) == gen, bar);
            __builtin_amdgcn_fence(__ATOMIC_ACQUIRE, "agent");
            asm volatile("s_waitcnt vmcnt(0)" ::: "memory");
        }
    }
    __syncthreads();
}

struct Frame {
    LAS unsigned char* lds;
    volatile LAS unsigned* MISC;
    unsigned* ctl;
    int tid, lane, wave, G, bid;
    const float* in[28];
    float* out;
    unsigned char* ws;
};
#define WSP(T_, off) ((T_*)(F.ws + (off)))
#define SSP(off) ((float*)(F.ws + WS_S) + (off))

__device__ __forceinline__ float wave_sum(float v) {
#pragma unroll
    for (int o = 1; o < 64; o <<= 1) v += __shfl_xor(v, o);
    return v;
}

__device__ __forceinline__ void p0_transpose_item(const float* W, int ldw, int nvalid, int K, bf16* WT, int drow, int k0, int n0, const float* kscale, LAS float* scr, int lane) {
#pragma unroll 8
    for (int i = 0; i < 32; ++i) { const int kk = 2 * i + (lane >> 5); const int n = n0 + (lane & 31);
        float v = (n < nvalid) ? W[(size_t)(k0 + kk) * ldw + n] : 0.f; if (kscale) v *= kscale[k0 + kk]; scr[kk * 33 + (lane & 31)] = v; }
    LDS_WAIT(); asm volatile("" ::: "memory");
    const int c = lane & 7;
#pragma unroll
    for (int j = 0; j < 4; ++j) { const int n = (lane >> 3) + 8 * j; const LAS float* s = scr + (8 * c) * 33 + n;
        v4u o; o.x = pk2(s[0 * 33], s[1 * 33]); o.y = pk2(s[2 * 33], s[3 * 33]); o.z = pk2(s[4 * 33], s[5 * 33]); o.w = pk2(s[6 * 33], s[7 * 33]);
        *(v4u*)(WT + (size_t)(drow + n) * K + k0 + 8 * c) = o; }
    LDS_WAIT(); asm volatile("" ::: "memory");
}
__device__ __forceinline__ void rms_row(const float* xrow, const float* w, bf16* ob, float* of, int lane) {
    const f32x4* xr = (const f32x4*)xrow + lane; const f32x4* wr_ = (const f32x4*)w + lane;
    f32x4 v[8]; float s = 0.f;
#pragma unroll
    for (int j = 0; j < 8; ++j) { v[j] = xr[64 * j]; s += (v[j].x * v[j].x + v[j].y * v[j].y) + (v[j].z * v[j].z + v[j].w * v[j].w); }
    const float rstd = rsqrtf(wave_sum(s) * (1.f / D) + EPS);
#pragma unroll
    for (int j = 0; j < 8; ++j) { const f32x4 g = wr_[64 * j]; const f32x4 y = v[j] * rstd * g;
        if (ob) ((unsigned long long*)ob)[lane + 64 * j] = (unsigned long long)pk2(y.x, y.y) | ((unsigned long long)pk2(y.z, y.w) << 32);
        if (of) ((f32x4*)of)[lane + 64 * j] = y; }
}

__device__ __forceinline__ void p0_prologue(Frame& F) {
    LAS float* scr = (LAS float*)(F.lds + RING_OFF + F.wave * 16384);
    const int gw = F.bid * NWAVES + F.wave, NGW = F.G * NWAVES;
    const float* w_in = F.in[11]; const float* w_out = F.in[18]; const float* w_g = F.in[20]; const float* w_u = F.in[21]; const float* w_d = F.in[23]; const float* w_pg = F.in[25]; const float* w_pp = F.in[26];
    const float* ffn_norm = F.in[19]; const float* ple_norm = F.in[24];
    bf16* Win = WSP(bf16, WS_WIN); bf16* Wout = WSP(bf16, WS_WOUT); bf16* Wgu = WSP(bf16, WS_WGU); bf16* Wdn = WSP(bf16, WS_WDN); bf16* Wpg = WSP(bf16, WS_WPG); bf16* Wpp = WSP(bf16, WS_WPP);
    constexpr int I_IN = (D / 64) * 225;
    constexpr int I_OUT = (D / 64) * (D / 32);
    constexpr int I_G = (D / 64) * (DFF / 32), I_U = I_G;
    constexpr int I_D = (DFF / 64) * (D / 32);
    constexpr int I_PG = I_OUT;
    constexpr int I_PP = (PLE / 64) * (D / 32);
    constexpr int NITEMS = I_IN + I_OUT + I_G + I_U + I_D + I_PG + I_PP;
    for (int it = gw; it < NITEMS; it += NGW) {
        int r = it;
        if (r < I_IN) { const int kb = r / 225, nb = r % 225; p0_transpose_item(w_in, IN_COLS, IN_COLS, D, Win, 32 * nb, 64 * kb, 32 * nb, nullptr, scr, F.lane); continue; } r -= I_IN;
        if (r < I_OUT) { const int kb = r / (D / 32), nb = r % (D / 32); p0_transpose_item(w_out, D, D, D, Wout, 32 * nb, 64 * kb, 32 * nb, nullptr, scr, F.lane); continue; } r -= I_OUT;
        if (r < I_G) { const int kb = r / (DFF / 32), nb = r % (DFF / 32); const int n0 = 32 * nb; p0_transpose_item(w_g, DFF, DFF, D, Wgu, 256 * (n0 >> 7) + (n0 & 127), 64 * kb, n0, ffn_norm, scr, F.lane); continue; } r -= I_G;
        if (r < I_U) { const int kb = r / (DFF / 32), nb = r % (DFF / 32); const int n0 = 32 * nb; p0_transpose_item(w_u, DFF, DFF, D, Wgu, 256 * (n0 >> 7) + 128 + (n0 & 127), 64 * kb, n0, ffn_norm, scr, F.lane); continue; } r -= I_U;
        if (r < I_D) { const int kb = r / (D / 32), nb = r % (D / 32); p0_transpose_item(w_d, D, D, DFF, Wdn, 32 * nb, 64 * kb, 32 * nb, nullptr, scr, F.lane); continue; } r -= I_D;
        if (r < I_PG) { const int kb = r / (D / 32), nb = r % (D / 32); p0_transpose_item(w_pg, D, D, D, Wpg, 32 * nb, 64 * kb, 32 * nb, ple_norm, scr, F.lane); continue; } r -= I_PG;
        { const int kb = r / (D / 32), nb = r % (D / 32); p0_transpose_item(w_pp, D, D, PLE, Wpp, 32 * nb, 64 * kb, 32 * nb, nullptr, scr, F.lane); }
    }
    { const size_t z0 = (size_t)7200 * D * 2, z1 = (size_t)NPROJ_PAD * D * 2; v4u* p = (v4u*)((unsigned char*)Win + z0); const size_t n16 = (z1 - z0) / 16;
      for (size_t i = (size_t)F.bid * 512 + F.tid; i < n16; i += (size_t)F.G * 512) p[i] = (v4u){0u, 0u, 0u, 0u}; }
    bf16* XN = WSP(bf16, WS_XN);
    for (int m = gw; m < M; m += NGW) rms_row(F.in[0] + (size_t)m * D, F.in[10], XN + (size_t)m * D, nullptr, F.lane);
    if (gw < MS) rms_row(F.in[1] + (size_t)gw * D, F.in[10], nullptr, SSP(S_A) + (size_t)gw * D, F.lane);
    { const f32x4* p = (const f32x4*)F.in[8]; v2u* o = (v2u*)WSP(bf16, WS_PB); const size_t n4 = (size_t)M * PLE / 4;
      for (size_t i = (size_t)F.bid * 512 + F.tid; i < n4; i += (size_t)F.G * 512) { const f32x4 v = p[i]; o[i] = (v2u){pk2(v.x, v.y), pk2(v.z, v.w)}; } }
}

template <class Epi>
__device__ __forceinline__ void sample_gemv(Frame& F, const float* A, int K, const float* nw, const float* W, int ldw, int N, const Epi& E) {
    LAS float* As = (LAS float*)(F.lds);
    LAS float* Red = (LAS float*)(F.lds + 65536);
    LAS float* Rs = (LAS float*)(F.lds + 65536 + 16384);
    const int ngroups = (N + 63) / 64;
    const int first = F.G - 1 - F.bid;
    if (first >= ngroups) return;
    __syncthreads();
    if (nw) { float s = 0.f; for (int k = F.lane; k < K; k += 64) { const float v = A[(size_t)F.wave * K + k]; s += v * v; } s = wave_sum(s); if (F.lane == 0) Rs[F.wave] = rsqrtf(s / (float)K + EPS); }
    else if (F.lane == 0) Rs[F.wave] = 1.f;
    __syncthreads();
    for (int g = first; g < ngroups; g += F.G) {
        float acc[8];
#pragma unroll
        for (int r = 0; r < 8; ++r) acc[r] = 0.f;
        const int n = 64 * g + F.lane; const bool nv = n < N;
        for (int kc = 0; kc < K; kc += 2048) {
            const int kn = (K - kc) < 2048 ? (K - kc) : 2048;
            __syncthreads();
            for (int idx = F.tid; idx < 8 * kn; idx += 512) { const int r = idx / kn, k = idx - r * kn; float v = A[(size_t)r * K + kc + k]; if (nw) v *= Rs[r] * nw[kc + k]; As[r * 2048 + k] = v; }
            __syncthreads();
            const int ks = kn / 8;
            for (int k = F.wave * ks; k < (F.wave + 1) * ks; k += 4) {
                float w4[4];
#pragma unroll
                for (int i = 0; i < 4; ++i) w4[i] = nv ? W[(size_t)(kc + k + i) * ldw + n] : 0.f;
#pragma unroll
                for (int r = 0; r < 8; ++r) { const f32x4 a = *(const LAS f32x4*)(As + r * 2048 + k); acc[r] += (a.x * w4[0] + a.y * w4[1]) + (a.z * w4[2] + a.w * w4[3]); }
            }
        }
        __syncthreads();
#pragma unroll
        for (int r = 0; r < 8; ++r) Red[(F.wave * 8 + r) * 64 + F.lane] = acc[r];
        __syncthreads();
        { const int r = F.tid >> 6, c = F.tid & 63; float s = 0.f;
#pragma unroll
          for (int w = 0; w < 8; ++w) s += Red[(w * 8 + r) * 64 + c];
          const int nn = 64 * g + c; if (nn < N) E(r, nn, s); }
    }
    __syncthreads();
}
struct SEpiStore { float* O; int ld; __device__ __forceinline__ void operator()(int r, int n, float v) const { O[(size_t)r * ld + n] = v; } };
struct SEpiAdd { const float* B; float* O; int ld; __device__ __forceinline__ void operator()(int r, int n, float v) const { O[(size_t)r * ld + n] = B[(size_t)r * ld + n] + v; } };

__device__ __forceinline__ void gdn_prep_prompt(Frame& F) {
    const int gw = F.bid * NWAVES + F.wave, NGW = F.G * NWAVES;
    const bf16* CIN = WSP(bf16, WS_CIN); const float* cw = F.in[14];
    float* GQ = WSP(float, WS_GQ); float* GK = WSP(float, WS_GK); float* GV = WSP(float, WS_GV);
    for (int it = gw; it < M * NH; it += NGW) {
        const int row = it >> 3, h = it & 7, t = row & (T - 1);
#pragma unroll
        for (int seg = 0; seg < 3; ++seg) {
            const int ch = seg * GW + h * HD + 2 * F.lane;
            float a0 = 0.f, a1 = 0.f;
#pragma unroll
            for (int j = 0; j < 4; ++j) { const int tt = t - 3 + j; if (tt >= 0) { const unsigned w = *(const unsigned*)(CIN + (size_t)(row - 3 + j) * CONVCH + ch); a0 += bf_lo(w) * cw[j * CONVCH + ch]; a1 += bf_hi(w) * cw[j * CONVCH + ch + 1]; } }
            a0 = silu_f(a0); a1 = silu_f(a1);
            float* dst = (seg == 0 ? GQ : seg == 1 ? GK : GV) + (size_t)row * GW + h * HD + 2 * F.lane;
            if (seg < 2) { const float ss = wave_sum(a0 * a0 + a1 * a1); float sc = rsqrtf(ss + 1e-6f); if (seg == 0) sc *= SB_SCALE; a0 *= sc; a1 *= sc; }
            *(f32x2*)dst = (f32x2){a0, a1};
        }
    }
}
__device__ __forceinline__ void gdn_prep_sample(Frame& F) {
    if (F.bid != 0) return;
    const float* PR = SSP(S_PROJ); const float* hist = F.in[5]; const float* cw = F.in[14];
    for (int i = F.tid; i < MS * SBW; i += 512) { const int b = i >> 10, c = i & 1023; F.out[OUT_KS + i] = PR[(size_t)b * IN_COLS + O_SB_K + c]; F.out[OUT_VS + i] = PR[(size_t)b * IN_COLS + O_SB_V + c]; }
    for (int i = F.tid; i < MS * 3 * CONVCH; i += 512) { const int b = i / (3 * CONVCH), rr = (i / CONVCH) % 3, c = i % CONVCH;
        F.out[OUT_GCONVS + i] = (rr < 2) ? hist[((size_t)b * 3 + rr + 1) * CONVCH + c] : PR[(size_t)b * IN_COLS + O_GQKV + c]; }
    if (F.tid < 64) { const int b = F.tid >> 3, h = F.tid & 7; SSP(S_G)[F.tid] = -__expf(F.in[15][h]) * softplus_f(PR[(size_t)b * IN_COLS + O_GA + h] + F.in[16][h]); SSP(S_BETA)[F.tid] = sigmoid_f(PR[(size_t)b * IN_COLS + O_GB + h]); }
    const int b = F.wave;
    for (int h = 0; h < NH; ++h)
#pragma unroll
        for (int seg = 0; seg < 3; ++seg) {
            const int ch = seg * GW + h * HD + 2 * F.lane; float a[2];
#pragma unroll
            for (int e = 0; e < 2; ++e) { float s = 0.f;
#pragma unroll
                for (int j = 0; j < 3; ++j) s += hist[((size_t)b * 3 + j) * CONVCH + ch + e] * cw[j * CONVCH + ch + e];
                s += PR[(size_t)b * IN_COLS + O_GQKV + ch + e] * cw[3 * CONVCH + ch + e]; a[e] = silu_f(s); }
            float* dst = SSP(seg == 0 ? S_GQ : seg == 1 ? S_GK : S_GV) + (size_t)b * GW + h * HD + 2 * F.lane;
            if (seg < 2) { const float ss = wave_sum(a[0] * a[0] + a[1] * a[1]); float sc = rsqrtf(ss + 1e-6f); if (seg == 0) sc *= SB_SCALE; a[0] *= sc; a[1] *= sc; }
            dst[0] = a[0]; dst[1] = a[1];
        }
}

template <bool PIPE>
__device__ __forceinline__ void gdn_recur_wave(const float* GQ, const float* GK, const float* GV, const float* Gg, const float* Gb, int ld, int gld, size_t row0, int ntok, int h, int slice,
                                               const float* S0, float* Sout, float* GO, int lane) {
    const int e = 4 * slice + (lane >> 4), d0 = 8 * (lane & 15);
    float S[8];
#pragma unroll
    for (int i = 0; i < 8; ++i) S[i] = S0 ? S0[(size_t)(d0 + i) * HD + e] : 0.f;
    constexpr int NT = PIPE ? 4 : 1;
    f32x4 ck0[NT], ck1[NT], cq0[NT], cq1[NT]; float cv[NT], cg[NT], cb[NT];
#define GDN_LOAD(dk0, dk1, dq0, dq1, dv, dg, db, tb) do { _Pragma("unroll") for (int i_ = 0; i_ < NT; ++i_) { const size_t row_ = row0 + (tb) + i_; \
        dk0[i_] = *(const f32x4*)(GK + row_ * ld + h * HD + d0); dk1[i_] = *(const f32x4*)(GK + row_ * ld + h * HD + d0 + 4); \
        dq0[i_] = *(const f32x4*)(GQ + row_ * ld + h * HD + d0); dq1[i_] = *(const f32x4*)(GQ + row_ * ld + h * HD + d0 + 4); \
        dv[i_] = GV[row_ * ld + h * HD + e]; dg[i_] = Gg[row_ * gld + h]; db[i_] = Gb[row_ * gld + h]; } } while (0)
    GDN_LOAD(ck0, ck1, cq0, cq1, cv, cg, cb, 0);
    for (int t = 0; t < ntok; t += NT) {
        f32x4 nk0[NT], nk1[NT], nq0[NT], nq1[NT]; float nv[NT], ng[NT], nb[NT];
        const int tn = (t + NT < ntok) ? t + NT : t;
        GDN_LOAD(nk0, nk1, nq0, nq1, nv, ng, nb, tn);
#pragma unroll
        for (int i = 0; i < NT; ++i) {
            const float kk[8] = {ck0[i].x, ck0[i].y, ck0[i].z, ck0[i].w, ck1[i].x, ck1[i].y, ck1[i].z, ck1[i].w}, qq[8] = {cq0[i].x, cq0[i].y, cq0[i].z, cq0[i].w, cq1[i].x, cq1[i].y, cq1[i].z, cq1[i].w};
            const float eg = __expf(cg[i]);
            float kv = 0.f;
#pragma unroll
            for (int j = 0; j < 8; ++j) kv += S[j] * kk[j];
            kv += __shfl_xor(kv, 1); kv += __shfl_xor(kv, 2); kv += __shfl_xor(kv, 4); kv += __shfl_xor(kv, 8);
            const float u = cb[i] * (cv[i] - eg * kv);
            float o = 0.f;
#pragma unroll
            for (int j = 0; j < 8; ++j) { S[j] = eg * S[j] + kk[j] * u; o += S[j] * qq[j]; }
            o += __shfl_xor(o, 1); o += __shfl_xor(o, 2); o += __shfl_xor(o, 4); o += __shfl_xor(o, 8);
            if ((lane & 15) == 0) GO[(row0 + t + i) * ld + h * HD + e] = o;
        }
#pragma unroll
        for (int i = 0; i < NT; ++i) { ck0[i] = nk0[i]; ck1[i] = nk1[i]; cq0[i] = nq0[i]; cq1[i] = nq1[i]; cv[i] = nv[i]; cg[i] = ng[i]; cb[i] = nb[i]; }
    }
#undef GDN_LOAD
#pragma unroll
    for (int i = 0; i < 8; ++i) Sout[(size_t)(d0 + i) * HD + e] = S[i];
}

__device__ __forceinline__ void sb_query_simple(Frame& F, int b, int h, int t, LAS float* qs) {
    const bf16* Qb = WSP(bf16, WS_Q); const bf16* Kb = WSP(bf16, WS_K); const bf16* Vb = WSP(bf16, WS_V); bf16* MIX = WSP(bf16, WS_MIX);
    const size_t row = (size_t)b * T + t; const int lane = F.lane;
    { const unsigned w = *(const unsigned*)(Qb + row * SBW + h * HD + 2 * lane); qs[2 * lane] = bf_lo(w); qs[2 * lane + 1] = bf_hi(w); }
    LDS_WAIT(); asm volatile("" ::: "memory");
    const float ch = F.in[12][h];
    float o0 = 0.f, o1 = 0.f, R = 0.f;
    const int nblk = (t + 63) >> 6;
    for (int blk = nblk - 1; blk >= 0; --blk) {
        const int k0 = blk * 64, key = k0 + lane; const bool valid = key < t;
        const v4u* kr = (const v4u*)(Kb + ((size_t)b * T + key) * SBW + h * HD);
        float dot = 0.f;
#pragma unroll
        for (int c = 0; c < 16; ++c) { const v4u w = kr[c]; const f32x4 qa = *(const LAS f32x4*)(qs + 8 * c), qb = *(const LAS f32x4*)(qs + 8 * c + 4);
            dot += bf_lo(w.x) * qa.x + bf_hi(w.x) * qa.y + bf_lo(w.y) * qa.z + bf_hi(w.y) * qa.w + bf_lo(w.z) * qb.x + bf_hi(w.z) * qb.y + bf_lo(w.w) * qb.z + bf_hi(w.w) * qb.w; }
        const float z = dot * SB_SCALE + ch;
        const float sp = softplus_f(z);
        const float L = valid ? -sp : 0.f, lb = z - sp;
        float s = L;
#pragma unroll
        for (int o = 1; o < 64; o <<= 1) { const float tmp = __shfl_down(s, o); if (lane + o < 64) s += tmp; }
        const float tot = __shfl(s, 0);
        const float a = valid ? __expf(lb + (s - L) + R) : 0.f;
        R += tot;
        const bf16* vr = Vb + ((size_t)b * T + k0) * SBW + h * HD + 2 * lane;
#pragma unroll 8
        for (int j = 0; j < 64; ++j) { const float aj = __shfl(a, j); const unsigned w = *(const unsigned*)(vr + (size_t)j * SBW); o0 += aj * bf_lo(w); o1 += aj * bf_hi(w); }
    }
    const float ss = wave_sum(o0 * o0 + o1 * o1); const float rs = rsqrtf(ss * (1.f / HD) + EPS);
    const float* nw = F.in[13];
    *(unsigned*)(MIX + row * D + h * HD + 2 * lane) = pk2(o0 * rs * nw[2 * lane], o1 * rs * nw[2 * lane + 1]);
}

__device__ __forceinline__ void sb_decode_segment(Frame& F, int b, int h, int seg) {
    const float* q = SSP(S_PROJ) + (size_t)b * IN_COLS + h * HD;
    const float* CK = F.in[2]; const float* CV = F.in[3]; const int* PT = (const int*)F.in[4];
    const int lane = F.lane, half = lane >> 5, l32 = lane & 31;
    const f32x4 q4 = *(const f32x4*)(q + 4 * l32);
    const float ch = F.in[12][h];
    float o0 = 0.f, o1 = 0.f, R = 0.f;
    for (int blk = 7; blk >= 0; --blk) {
        const int p0 = seg * 512 + blk * 64;
        const int page = PT[b * NPAGES + (p0 >> 7)];
        const size_t base = (((size_t)page * PAGE + (p0 & 127)) * NH + h) * HD;
        float z = 0.f;
#pragma unroll 8
        for (int i = 0; i < 32; ++i) {
            const f32x4 k4 = *(const f32x4*)(CK + base + (size_t)(2 * i + half) * (NH * HD) + 4 * l32);
            float p = (k4.x * q4.x + k4.y * q4.y) + (k4.z * q4.z + k4.w * q4.w);
            p += __shfl_xor(p, 1); p += __shfl_xor(p, 2); p += __shfl_xor(p, 4); p += __shfl_xor(p, 8); p += __shfl_xor(p, 16);
            const float pe = __shfl(p, 0), po = __shfl(p, 32);
            if (lane == 2 * i) z = pe; if (lane == 2 * i + 1) z = po;
        }
        z = z * SB_SCALE + ch;
        const float sp = softplus_f(z);
        const float L = -sp, lb = z - sp;
        float s = L;
#pragma unroll
        for (int o = 1; o < 64; o <<= 1) { const float tmp = __shfl_down(s, o); if (lane + o < 64) s += tmp; }
        const float tot = __shfl(s, 0);
        const float a = __expf(lb + (s - L) + R);
        R += tot;
#pragma unroll 8
        for (int j = 0; j < 64; ++j) { const float aj = __shfl(a, j); const f32x2 v = *(const f32x2*)(CV + base + (size_t)j * (NH * HD) + 2 * lane); o0 += aj * v.x; o1 += aj * v.y; }
    }
    float* P = SSP(S_PART) + ((size_t)(b * NH + h) * DSEG + seg) * DPART;
    P[2 * lane] = o0; P[2 * lane + 1] = o1; if (lane == 0) P[128] = R;
}

__device__ __forceinline__ void p2_mixers(Frame& F) {
    const int gw = F.bid * NWAVES + F.wave, NGW = F.G * NWAVES;
    for (int it = gw; it < NB * NH * 32; it += NGW) {
        const int chain = it >> 5, slice = it & 31, b = chain >> 3, h = chain & 7;
        gdn_recur_wave<true>(WSP(float, WS_GQ), WSP(float, WS_GK), WSP(float, WS_GV), WSP(float, WS_G), WSP(float, WS_BETA), GW, NH, (size_t)b * T, T, h, slice,
                             nullptr, F.out + OUT_GREC + (size_t)chain * HD * HD, WSP(float, WS_GO), F.lane);
    }
    for (int it = gw; it < MS * NH * 32; it += NGW) {
        const int chain = it >> 5, slice = it & 31, b = chain >> 3, h = chain & 7;
        gdn_recur_wave<false>(SSP(S_GQ), SSP(S_GK), SSP(S_GV), SSP(S_G), SSP(S_BETA), GW, NH, (size_t)b, 1, h, slice,
                              F.in[6] + (size_t)chain * HD * HD, F.out + OUT_GRECS + (size_t)chain * HD * HD, SSP(S_GO), F.lane);
    }
    for (int it = gw; it < MS * NH * DSEG; it += NGW) { const int bh = it / DSEG, seg = it % DSEG; sb_decode_segment(F, bh >> 3, bh & 7, seg); }
    LAS float* qs = (LAS float*)(F.lds + RING_OFF) + F.wave * 128;
    for (int it = gw; it < NB * NH * T; it += NGW) {
        const int t = T - 1 - (it >> 4), bh = it & 15;
        sb_query_simple(F, bh >> 3, bh & 7, t, qs);
    }
}

__device__ __forceinline__ void p2_finish(Frame& F) {
    const int gw = F.bid * NWAVES + F.wave, NGW = F.G * NWAVES;
    const float* GO = WSP(float, WS_GO); const bf16* Zb = WSP(bf16, WS_Z); bf16* MIX = WSP(bf16, WS_MIX); const float* gnw = F.in[17];
    for (int it = gw; it < M * NH; it += NGW) {
        const int row = it >> 3, h = it & 7;
        const f32x2 o = *(const f32x2*)(GO + (size_t)row * GW + h * HD + 2 * F.lane);
        const float rs = rsqrtf(wave_sum(o.x * o.x + o.y * o.y) * (1.f / HD) + EPS);
        const unsigned zw = *(const unsigned*)(Zb + (size_t)row * GW + h * HD + 2 * F.lane);
        *(unsigned*)(MIX + (size_t)row * D + SBW + h * HD + 2 * F.lane) = pk2(o.x * rs * gnw[2 * F.lane] * silu_f(bf_lo(zw)), o.y * rs * gnw[2 * F.lane + 1] * silu_f(bf_hi(zw)));
    }
    if (F.bid == F.G - 1) {
        for (int bh = F.wave; bh < MS * NH; bh += NWAVES) {
            const int b = bh >> 3, h = bh & 7;
            { const f32x2 o = *(const f32x2*)(SSP(S_GO) + (size_t)b * GW + h * HD + 2 * F.lane);
              const float rs = rsqrtf(wave_sum(o.x * o.x + o.y * o.y) * (1.f / HD) + EPS);
              const float* z = SSP(S_PROJ) + (size_t)b * IN_COLS + O_GZ + h * HD + 2 * F.lane;
              float* mo = SSP(S_MIX) + (size_t)b * D + SBW + h * HD + 2 * F.lane;
              mo[0] = o.x * rs * gnw[2 * F.lane] * silu_f(z[0]); mo[1] = o.y * rs * gnw[2 * F.lane + 1] * silu_f(z[1]); }
            { float o0 = 0.f, o1 = 0.f, R = 0.f;
              for (int seg = DSEG - 1; seg >= 0; --seg) { const float* P = SSP(S_PART) + ((size_t)bh * DSEG + seg) * DPART; const float e = __expf(R); o0 += e * P[2 * F.lane]; o1 += e * P[2 * F.lane + 1]; R += P[128]; }
              const float rs = rsqrtf(wave_sum(o0 * o0 + o1 * o1) * (1.f / HD) + EPS); const float* nw = F.in[13];
              float* mo = SSP(S_MIX) + (size_t)b * D + h * HD + 2 * F.lane; mo[0] = o0 * rs * nw[2 * F.lane]; mo[1] = o1 * rs * nw[2 * F.lane + 1]; }
        }
    }
}

__device__ __forceinline__ void p4b_fixup(Frame& F) {
    const float* TAIL = WSP(float, WS_TAIL); const float* FIXG = WSP(float, WS_FIXG); const float* FIXU = WSP(float, WS_FIXU); bf16* ACT = WSP(bf16, WS_ACT); const float* cw = F.in[22];
    const int total = 32 * 2 * DFF;
    for (int i = F.bid * 512 + F.tid; i < total; i += F.G * 512) {
        const int pm = i / (2 * DFF), rr = (i / DFF) & 1, c = i % DFF;
        if ((pm & 15) == 0) continue;
        const float t0 = TAIL[((size_t)(pm - 1) * 2 + 0) * DFF + c], t1 = TAIL[((size_t)(pm - 1) * 2 + 1) * DFF + c];
        float g = FIXG[((size_t)pm * 2 + rr) * DFF + c];
        g += (rr == 0) ? (cw[c] * t0 + cw[DFF + c] * t1) : (cw[c] * t1);
        ACT[(size_t)(pm * 256 + rr) * DFF + c] = (bf16)f2bf(silu_f(g) * FIXU[((size_t)pm * 2 + rr) * DFF + c]);
    }
    const float* st = F.in[7]; const float* GP = SSP(S_GP); const float* UP = SSP(S_UP); float* SACT = SSP(S_ACT);
    for (int i = F.bid * 512 + F.tid; i < MS * DFF; i += F.G * 512) {
        const int b = i / DFF, c = i % DFF;
        const float s0 = st[((size_t)b * 2 + 0) * DFF + c], s1 = st[((size_t)b * 2 + 1) * DFF + c], gp = GP[i];
        const float g = cw[c] * s0 + cw[DFF + c] * s1 + cw[2 * DFF + c] * gp;
        SACT[i] = silu_f(g) * UP[i];
        F.out[OUT_FCONVS + ((size_t)b * 2 + 0) * DFF + c] = s1; F.out[OUT_FCONVS + ((size_t)b * 2 + 1) * DFF + c] = gp;
    }
}

__device__ __forceinline__ void p7_final(Frame& F) {
    const int gw = F.bid * NWAVES + F.wave, NGW = F.G * NWAVES;
    const float* fw = F.in[27]; const float* ss3 = (const float*)(F.ctl + CW_SUMSQ3);
    for (int m = gw; m < M; m += NGW) {
        const float rs = rsqrtf(ss3[m] * (1.f / D) + EPS);
        f32x4* y = (f32x4*)(F.out + OUT_Y + (size_t)m * D) + F.lane; const f32x4* w = (const f32x4*)fw + F.lane;
#pragma unroll
        for (int j = 0; j < 8; ++j) y[64 * j] = y[64 * j] * rs * w[64 * j];
    }
    if (F.bid == 0) {
        const int b = F.wave; float v[32]; float s = 0.f;
#pragma unroll
        for (int j = 0; j < 32; ++j) { const int c = F.lane + 64 * j; const float h = SSP(S_H2)[(size_t)b * D + c] + SSP(S_PP)[(size_t)b * D + c] * sigmoid_f(SSP(S_PG)[(size_t)b * D + c]); v[j] = h; s += h * h; }
        const float rs = rsqrtf(wave_sum(s) * (1.f / D) + EPS);
#pragma unroll
        for (int j = 0; j < 32; ++j) { const int c = F.lane + 64 * j; F.out[OUT_YS + (size_t)b * D + c] = v[j] * rs * fw[c]; }
    }
}

constexpr int NPHASES = 12;
constexpr int N_LAUNCHES = MK_N_LAUNCHES;
struct Args { const float* in[28]; float* out; unsigned char* ws; int ph_lo, ph_hi; };
__global__ void __launch_bounds__(NWAVES * 64, 2) hymba_fwd(Args args) {
    extern __shared__ __attribute__((aligned(16))) unsigned char lds[];
    Frame F;
    F.lds = (LAS unsigned char*)lds;
    F.MISC = (volatile LAS unsigned*)(F.lds + MISC_OFF);
    F.tid = threadIdx.x; F.lane = F.tid & 63; F.wave = __builtin_amdgcn_readfirstlane(F.tid >> 6);
    F.G = gridDim.x; F.bid = blockIdx.x;
    F.ws = args.ws; F.ctl = (unsigned*)(args.ws + WS_CTL); F.out = args.out;
#pragma unroll
    for (int i = 0; i < 28; ++i) F.in[i] = args.in[i];
    for (int u = F.tid; u < (LDS_BYTES - LDSCTL_OFF) / 4; u += NWAVES * 64) ((LAS unsigned*)(F.lds + LDSCTL_OFF))[u] = 0u;
    __syncthreads();
    XcdBarrier bar; bar.bar = F.ctl + CW_BAR; bar.x = 0; bar.st = nullptr;
    if (N_LAUNCHES == 1) bar = xcd_barrier_post(F.ctl + CW_BAR, F.MISC + 8);
#define GRID_BAR() do { if (N_LAUNCHES == 1) xcd_barrier(bar); } while (0)
    const int lo = args.ph_lo, hi = args.ph_hi;
#define IN(k) (lo <= (k) && (k) < hi)
    float* ss1 = (float*)(F.ctl + CW_SUMSQ1); float* ss2 = (float*)(F.ctl + CW_SUMSQ2); float* ss3 = (float*)(F.ctl + CW_SUMSQ3);

    if (IN(0)) { p0_prologue(F); GRID_BAR(); }
    if (IN(1)) {
        { pg8::Gemm g{WSP(bf16, WS_XN), WSP(bf16, WS_WIN), M, NPROJ_PAD, D}; pg8::StaticOrder S; S.init(M, NPROJ_PAD, F.G, F.bid);
          pg8::EpiProj E{WSP(bf16, WS_Q), WSP(bf16, WS_K), WSP(bf16, WS_V), WSP(bf16, WS_CIN), WSP(bf16, WS_Z), F.out + OUT_K, F.out + OUT_V, F.out + OUT_GCONV, WSP(float, WS_G), WSP(float, WS_BETA), F.in[15], F.in[16]};
          pg8::gemm_phase<pg8::EpiProj, pg8::StaticOrder, true, true>(F.lds + RING_OFF, g, S, E); }
        { pg8::Gemm g{WSP(bf16, WS_PB), WSP(bf16, WS_WPP), M, D, PLE}; pg8::StaticOrder S; S.init(M, D, F.G, F.bid);
          pg8::EpiF32 E{WSP(float, WS_PP), D};
          pg8::gemm_phase<pg8::EpiF32, pg8::StaticOrder, true, true>(F.lds + RING_OFF, g, S, E); }
        { SEpiStore E{SSP(S_PROJ), IN_COLS}; sample_gemv(F, SSP(S_A), D, nullptr, F.in[11], IN_COLS, IN_COLS, E); }
        GRID_BAR();
    }
    if (IN(2)) { gdn_prep_prompt(F); gdn_prep_sample(F); GRID_BAR(); }
    if (IN(3)) { p2_mixers(F); GRID_BAR(); }
    if (IN(4)) { p2_finish(F); GRID_BAR(); }
    if (IN(5)) {
        { pg8::Gemm g{WSP(bf16, WS_MIX), WSP(bf16, WS_WOUT), M, D, D}; pg8::StaticOrder S; S.init(M, D, F.G, F.bid);
          pg8::EpiResid E{F.in[0], WSP(float, WS_H1), WSP(bf16, WS_H1B), ss1, D};
          pg8::gemm_phase<pg8::EpiResid, pg8::StaticOrder, true, true>(F.lds + RING_OFF, g, S, E); }
        { SEpiAdd E{F.in[1], SSP(S_H1), D}; sample_gemv(F, SSP(S_MIX), D, nullptr, F.in[18], D, D, E); }
        GRID_BAR();
    }
    if (IN(6)) {
        { pg8::Gemm g{WSP(bf16, WS_H1B), WSP(bf16, WS_WGU), M, NGU, D}; pg8::StaticOrder S; S.init(M, NGU, F.G, F.bid);
          pg8::EpiGateUp E{ss1, F.in[22], WSP(bf16, WS_ACT), WSP(float, WS_TAIL), WSP(float, WS_FIXG), WSP(float, WS_FIXU), F.out + OUT_FCONV, (PG8_LAS float*)(F.lds + HALO_OFF)};
          pg8::gemm_phase<pg8::EpiGateUp, pg8::StaticOrder, true, true>(F.lds + RING_OFF, g, S, E); }
        { SEpiStore E{SSP(S_GP), DFF}; sample_gemv(F, SSP(S_H1), D, F.in[19], F.in[20], DFF, DFF, E); }
        { SEpiStore E{SSP(S_UP), DFF}; sample_gemv(F, SSP(S_H1), D, F.in[19], F.in[21], DFF, DFF, E); }
        GRID_BAR();
    }
    if (IN(7)) { p4b_fixup(F); GRID_BAR(); }
    if (IN(8)) {
        { pg8::Gemm g{WSP(bf16, WS_ACT), WSP(bf16, WS_WDN), M, D, DFF}; pg8::StaticOrder S; S.init(M, D, F.G, F.bid);
          pg8::EpiResid E{WSP(float, WS_H1), WSP(float, WS_H2), WSP(bf16, WS_H2B), ss2, D};
          pg8::gemm_phase<pg8::EpiResid, pg8::StaticOrder, true, true>(F.lds + RING_OFF, g, S, E); }
        { SEpiAdd E{SSP(S_H1), SSP(S_H2), D}; sample_gemv(F, SSP(S_ACT), DFF, nullptr, F.in[23], D, D, E); }
        GRID_BAR();
    }
    if (IN(9)) {
        { pg8::Gemm g{WSP(bf16, WS_H2B), WSP(bf16, WS_WPG), M, D, D}; pg8::StaticOrder S; S.init(M, D, F.G, F.bid);
          pg8::EpiPle E{WSP(float, WS_H2), WSP(float, WS_PP), ss2, F.out + OUT_Y, ss3, D};
          pg8::gemm_phase<pg8::EpiPle, pg8::StaticOrder, true, true>(F.lds + RING_OFF, g, S, E); }
        { SEpiStore E{SSP(S_PG), D}; sample_gemv(F, SSP(S_H2), D, F.in[24], F.in[25], D, D, E); }
        { SEpiStore E{SSP(S_PP), D}; sample_gemv(F, F.in[9], PLE, nullptr, F.in[26], D, D, E); }
        GRID_BAR();
    }
    if (IN(10)) { p7_final(F); }
#undef IN
#undef GRID_BAR
}

extern "C" void kernel_launch(void* const* d_in, const int* in_sizes, int n_in, void* d_out, int out_size, void* d_ws, size_t ws_size, hipStream_t stream) {
    static int grid = 0;
    if (grid == 0) {
        if (n_in != 28 || (size_t)out_size != OUT_END || ws_size < WS_END) { fprintf(stderr, "kernel_launch: unexpected sizes n_in %d out %d ws %zu (need %zu, %zu)\n", n_in, out_size, ws_size, (size_t)OUT_END, (size_t)WS_END); grid = -1; return; }
        int dev = 0, cus = 0, per_cu = 0;
        if (hipGetDevice(&dev) != hipSuccess || hipDeviceGetAttribute(&cus, hipDeviceAttributeMultiprocessorCount, dev) != hipSuccess) { grid = -1; return; }
        if (hipFuncSetAttribute((const void*)hymba_fwd, hipFuncAttributeMaxDynamicSharedMemorySize, LDS_BYTES) != hipSuccess) { fprintf(stderr, "kernel_launch: hipFuncSetAttribute failed\n"); grid = -1; return; }
        if (hipOccupancyMaxActiveBlocksPerMultiprocessor(&per_cu, (const void*)hymba_fwd, NWAVES * 64, LDS_BYTES) != hipSuccess || per_cu < 1) { fprintf(stderr, "kernel_launch: occupancy query says %d\n", per_cu); }
        (void)hipGetLastError();
        grid = cus;
    }
    if (grid < 0) return;
    (void)hipMemsetAsync((char*)d_ws + WS_CTL, 0, CTL_ZERO_BYTES, stream);
    Args a{};
    for (int i = 0; i < 28; ++i) a.in[i] = (const float*)d_in[i];
    a.out = (float*)d_out; a.ws = (unsigned char*)d_ws;
    if (N_LAUNCHES == 1) { a.ph_lo = 0; a.ph_hi = NPHASES; hipLaunchKernelGGL(hymba_fwd, dim3(grid), dim3(NWAVES * 64), LDS_BYTES, stream, a); }
    else for (int p = 0; p < 11; ++p) { a.ph_lo = p; a.ph_hi = p + 1; hipLaunchKernelGGL(hymba_fwd, dim3(grid), dim3(NWAVES * 64), LDS_BYTES, stream, a); }
}
```

```cpp
#include <hip/hip_runtime.h>
#include <cstdio>
#include <cstdint>

#ifndef MK_N_LAUNCHES
#define MK_N_LAUNCHES 1
#endif

namespace pg8 {
#define PG8_LAS __attribute__((address_space(3)))
typedef unsigned short bf16_t;
typedef short bf16x8 __attribute__((ext_vector_type(8)));
typedef float f32x4 __attribute__((ext_vector_type(4)));
typedef unsigned u32x4 __attribute__((ext_vector_type(4)));
constexpr int BM = 256, BK = 64, HALF = 128, HTB = HALF * BK * 2  , STAGE_BYTES = 8 * HTB, NXCD = 8, WGM = 8;

__host__ __device__ __forceinline__ int lds_byte(int r, int c) { const int st = (r >> 4) * 2 + (c >> 5), rr = r & 15, cc = c & 31, ob = rr * 64 + cc * 2; return st * 1024 + (ob ^ (((ob >> 9) & 1) << 5)); }
__host__ __device__ __forceinline__ void stage_rc(int b, int& R, int& C) { const int st = b / 1024, sb = b % 1024, swz = sb ^ (((sb >> 9) & 1) << 5); R = (st >> 1) * 16 + swz / 64; C = (st & 1) * 32 + (swz % 64) / 2; }
__host__ __device__ __forceinline__ int perm32(int rho) { const int n = rho >> 4, i = rho & 15; return 8 * (i >> 2) + 4 * n + (i & 3); }

struct Unit { int pm, pn; };
struct Gemm { const bf16_t* A; const bf16_t* Bt; int M, N, K; };

struct StaticOrder {
    int nM, nN, nwg, G, c;
    __host__ __device__ void init(int M, int N, int G_, int c_) { nM = M / BM; nN = N / BM; nwg = nM * nN; G = G_; c = c_; }
    __host__ __device__ bool next(int i, Unit& u) const {
        const long L = (long)i * G + c; if (L >= nwg) return false;
        int wgid = (int)L; { const int q = nwg / NXCD, r = nwg % NXCD, xcd = wgid % NXCD, off = wgid / NXCD; wgid = (xcd < r ? xcd * (q + 1) : r * (q + 1) + (xcd - r) * q) + off; }
        const int nig = WGM * nN, gid = wgid / nig, fm = gid * WGM, gsz = (nM - fm) < WGM ? (nM - fm) : WGM;
        u.pm = fm + ((wgid % nig) % gsz); u.pn = (wgid % nig) / gsz; return true;
    }
    __device__ __forceinline__ void a_ready(const Unit&) const {}
    __device__ __forceinline__ void done(const Unit&) const {}
};

__device__ __forceinline__ unsigned cvt_pk_bf16(float lo, float hi) { unsigned r; asm volatile("v_cvt_pk_bf16_f32 %0, %1, %2" : "=v"(r) : "v"(lo), "v"(hi)); return r; }
template <class Epi, class Sched, bool ALIGN_EPI = false, bool SP2 = false>
__device__ __forceinline__ void gemm_phase(PG8_LAS unsigned char* lds, const Gemm g, const Sched& S, const Epi& E) {
    const int tid = threadIdx.x, wid = __builtin_amdgcn_readfirstlane(tid >> 6), lane = tid & 63, wr = wid >> 2, wc = wid & 3, fr = lane & 15, fq = lane >> 4;
    const int K = g.K, nt = K / BK;
    unsigned voffA[2], voffB[2];
#pragma unroll
    for (int i = 0; i < 2; ++i) { int R, C; stage_rc(tid * 16 + i * 8192, R, C); const int Rb = Epi::PERM ? ((R & ~31) + perm32(R & 31)) : R;
        voffA[i] = (unsigned)(R * K + C) * 2u; voffB[i] = (unsigned)(Rb * K + C) * 2u; }
    const size_t kstep = (size_t)(BK * 2);
    const size_t hstep = (size_t)HALF * K * 2;
    const size_t tstep = 2 * hstep;
    const unsigned ldsw = (unsigned)wid * 1024u;
    const int aoff = lds_byte(wr * 64 + fr, fq * 8), boff = lds_byte(wc * 32 + fr, fq * 8);
#define PG8_SA(b, h) (((b) * 2 + (h)) * HTB)
#define PG8_SB(b, h) ((4 + (b) * 2 + (h)) * HTB)
#define PG8_STAGE(bufoff, gbase, voff) do { _Pragma("unroll") for (int _i = 0; _i < 2; ++_i) \
        __builtin_amdgcn_global_load_lds((const unsigned*)((const char*)(gbase) + (voff)[_i]), (PG8_LAS unsigned*)(lds + (bufoff) + ldsw + _i * 8192), 16, 0, 0); } while (0)
#define PG8_LDA(dst, b, h) do { _Pragma("unroll") for (int m = 0; m < 4; ++m) _Pragma("unroll") for (int k = 0; k < 2; ++k) dst[m][k] = *(const PG8_LAS bf16x8*)(lds + PG8_SA(b, h) + aoff + m * 2048 + k * 1024); } while (0)
#define PG8_LDB(dst, b, h) do { _Pragma("unroll") for (int n = 0; n < 2; ++n) _Pragma("unroll") for (int k = 0; k < 2; ++k) dst[n][k] = *(const PG8_LAS bf16x8*)(lds + PG8_SB(b, h) + boff + n * 2048 + k * 1024); } while (0)
#define PG8_MMA(ai, bj, At, Bt) do { __builtin_amdgcn_s_setprio(1); _Pragma("unroll") for (int m = 0; m < 4; ++m) _Pragma("unroll") for (int n = 0; n < 2; ++n) _Pragma("unroll") for (int k = 0; k < 2; ++k) \
        acc[ai][bj][m][n] = __builtin_amdgcn_mfma_f32_16x16x32_bf16(Bt[n][k], At[m][k], acc[ai][bj][m][n], 0, 0, 0); __builtin_amdgcn_s_setprio(0); } while (0)
#define PG8_WAIT_V(n) asm volatile("s_waitcnt vmcnt(" #n ")" ::: "memory")
#define PG8_WAIT_L(n) asm volatile("s_waitcnt lgkmcnt(" #n ")" ::: "memory")
#define PG8_BAR __builtin_amdgcn_s_barrier()
#define PG8_SCHED __builtin_amdgcn_sched_barrier(0)
    Unit cur, nxt; int ui = 0;
    if (!S.next(0, cur)) return;
    f32x4 acc[2][2][4][2];
#pragma unroll
    for (int a = 0; a < 2; ++a)
#pragma unroll
        for (int b = 0; b < 2; ++b)
#pragma unroll
            for (int m = 0; m < 4; ++m)
#pragma unroll
                for (int n = 0; n < 2; ++n) acc[a][b][m][n] = (f32x4){0.f, 0.f, 0.f, 0.f};
    bf16x8 At[4][2], B0[2][2], B1[2][2];
    const char* cA = (const char*)g.A + (size_t)cur.pm * tstep; const char* cB = (const char*)g.Bt + (size_t)cur.pn * tstep;
    S.a_ready(cur);
    if constexpr (SP2) {
        PG8_STAGE(PG8_SB(0, 0), cB, voffB); PG8_STAGE(PG8_SB(0, 1), cB + hstep, voffB); PG8_STAGE(PG8_SA(0, 0), cA, voffA); PG8_STAGE(PG8_SA(0, 1), cA + hstep, voffA);
        if (wr == 1) PG8_BAR;
        PG8_WAIT_V(2); PG8_BAR;
        PG8_STAGE(PG8_SB(1, 0), cB + kstep, voffB); PG8_STAGE(PG8_SA(1, 0), cA + kstep, voffA); PG8_STAGE(PG8_SB(1, 1), cB + hstep + kstep, voffB);
        PG8_WAIT_V(6); PG8_BAR;
    } else {
        PG8_STAGE(PG8_SB(0, 0), cB, voffB); PG8_STAGE(PG8_SA(0, 0), cA, voffA); PG8_STAGE(PG8_SB(0, 1), cB + hstep, voffB); PG8_STAGE(PG8_SA(0, 1), cA + hstep, voffA);
        if (wr == 1) PG8_BAR;
        PG8_WAIT_V(4); PG8_BAR;
        PG8_STAGE(PG8_SB(1, 0), cB + kstep, voffB); PG8_STAGE(PG8_SA(1, 0), cA + kstep, voffA); PG8_STAGE(PG8_SB(1, 1), cB + hstep + kstep, voffB);
        PG8_WAIT_V(6); PG8_BAR;
    }
    for (;;) {
        const bool has_next = S.next(ui + 1, nxt);
        const char* nA = has_next ? (const char*)g.A + (size_t)nxt.pm * tstep : cA; const char* nB = has_next ? (const char*)g.Bt + (size_t)nxt.pn * tstep : cB;
        for (int t = 0; t < nt; t += 2) {
            const bool last = (t == nt - 2);
            const char* a1 = cA + (size_t)(t + 1) * kstep;
            const char* a2 = last ? nA : cA + (size_t)(t + 2) * kstep; const char* b2 = last ? nB : cB + (size_t)(t + 2) * kstep;
            const char* a3 = a2 + kstep; const char* b3 = b2 + kstep;
            if (last && has_next) S.a_ready(nxt);
            if constexpr (SP2) {
            PG8_LDB(B0, 0, 0); PG8_LDB(B1, 0, 1); PG8_SCHED; PG8_LDA(At, 0, 0); PG8_STAGE(PG8_SA(1, 1), a1 + hstep, voffA);
            PG8_WAIT_V(8); PG8_WAIT_L(0); PG8_BAR; PG8_MMA(0, 0, At, B0); PG8_MMA(0, 1, At, B1); PG8_BAR; PG8_SCHED;
            PG8_LDA(At, 0, 1); PG8_STAGE(PG8_SB(0, 0), b2, voffB); PG8_STAGE(PG8_SB(0, 1), b2 + hstep, voffB); PG8_STAGE(PG8_SA(0, 0), a2, voffA);
            PG8_WAIT_V(8); PG8_WAIT_L(0); PG8_BAR; PG8_MMA(1, 0, At, B0); PG8_MMA(1, 1, At, B1); PG8_BAR; PG8_SCHED;
            PG8_LDB(B0, 1, 0); PG8_LDB(B1, 1, 1); PG8_SCHED; PG8_LDA(At, 1, 0); PG8_STAGE(PG8_SA(0, 1), a2 + hstep, voffA);
            PG8_WAIT_V(8); PG8_WAIT_L(0); PG8_BAR; PG8_MMA(0, 0, At, B0); PG8_MMA(0, 1, At, B1); PG8_BAR; PG8_SCHED;
            PG8_LDA(At, 1, 1); PG8_STAGE(PG8_SB(1, 0), b3, voffB); PG8_STAGE(PG8_SB(1, 1), b3 + hstep, voffB); PG8_STAGE(PG8_SA(1, 0), a3, voffA);
            PG8_WAIT_V(8); PG8_WAIT_L(0); PG8_BAR; PG8_MMA(1, 0, At, B0); PG8_MMA(1, 1, At, B1); PG8_BAR; PG8_SCHED;
            } else {
            PG8_LDB(B0, 0, 0); PG8_SCHED; PG8_LDA(At, 0, 0); PG8_STAGE(PG8_SA(1, 1), a1 + hstep, voffA);
            PG8_WAIT_L(8); PG8_BAR; PG8_WAIT_L(0); PG8_MMA(0, 0, At, B0); PG8_BAR; PG8_SCHED;
            PG8_LDB(B1, 0, 1); PG8_STAGE(PG8_SB(0, 0), b2, voffB);
            PG8_BAR; PG8_WAIT_L(0); PG8_MMA(0, 1, At, B1); PG8_BAR;
            PG8_LDA(At, 0, 1); PG8_STAGE(PG8_SA(0, 0), a2, voffA);
            PG8_BAR; PG8_WAIT_L(0); PG8_MMA(1, 0, At, B0); PG8_BAR; PG8_SCHED;
            PG8_STAGE(PG8_SB(0, 1), b2 + hstep, voffB);
            PG8_WAIT_V(6); PG8_BAR; PG8_MMA(1, 1, At, B1); PG8_BAR;
            PG8_LDB(B0, 1, 0); PG8_SCHED; PG8_LDA(At, 1, 0); PG8_STAGE(PG8_SA(0, 1), a2 + hstep, voffA);
            PG8_WAIT_L(8); PG8_BAR; PG8_WAIT_L(0); PG8_MMA(0, 0, At, B0); PG8_BAR; PG8_SCHED;
            PG8_LDB(B1, 1, 1); PG8_STAGE(PG8_SB(1, 0), b3, voffB);
            PG8_BAR; PG8_WAIT_L(0); PG8_MMA(0, 1, At, B1); PG8_BAR;
            PG8_LDA(At, 1, 1); PG8_STAGE(PG8_SA(1, 0), a3, voffA);
            PG8_BAR; PG8_WAIT_L(0); PG8_MMA(1, 0, At, B0); PG8_BAR; PG8_SCHED;
            PG8_STAGE(PG8_SB(1, 1), b3 + hstep, voffB);
            PG8_WAIT_V(6); PG8_BAR; PG8_MMA(1, 1, At, B1); PG8_BAR;
            }
        }
        if constexpr (ALIGN_EPI) { if (wr == 0) PG8_BAR; }
        if constexpr (!Epi::AFTER_DRAIN) { E(acc, cur, wr, wc, fr, fq); S.done(cur); }
        if (!has_next) break;
#pragma unroll
        for (int a = 0; a < 2; ++a)
#pragma unroll
            for (int b = 0; b < 2; ++b)
#pragma unroll
                for (int m = 0; m < 4; ++m)
#pragma unroll
                    for (int n = 0; n < 2; ++n) acc[a][b][m][n] = (f32x4){0.f, 0.f, 0.f, 0.f};
        cur = nxt; cA = nA; cB = nB; ++ui;
        if constexpr (ALIGN_EPI) { if (wr == 1) PG8_BAR; }
    }
    PG8_WAIT_V(0);
    if constexpr (!ALIGN_EPI) { if (wr == 0) PG8_BAR; }
    PG8_BAR;
    if constexpr (Epi::AFTER_DRAIN) { E.fused(acc, cur, wr, wc, fr, fq, lds, wid, lane); S.done(cur); }
#undef PG8_SA
#undef PG8_SB
#undef PG8_STAGE
#undef PG8_LDA
#undef PG8_LDB
#undef PG8_MMA
#undef PG8_WAIT_V
#undef PG8_WAIT_L
#undef PG8_BAR
#undef PG8_SCHED
}
}

constexpr int D = 2048, T = 4096, NB = 2, M = NB * T;
constexpr int MS = 8;
constexpr int HD = 128, NH = 8, SBW = NH * HD, GW = NH * HD;
constexpr int CONVCH = 3 * GW;
constexpr int IN_COLS = 7184, NPROJ_PAD = 7424;
constexpr int DFF = 5504, NGU = 2 * DFF;
constexpr int PLE = 256;
constexpr int PAST = 16384, PAGE = 128, NPAGES = PAST / PAGE, NPOOL = 1280;
constexpr float EPS = 1e-6f;
constexpr float SB_SCALE = 0.08838834764831845f;
constexpr int O_SB_K = 1024, O_SB_V = 2048, O_GQKV = 3072, O_GZ = 6144, O_GA = 7168, O_GB = 7176;

constexpr size_t OUT_Y = 0;
constexpr size_t OUT_YS = OUT_Y + (size_t)M * D;
constexpr size_t OUT_K = OUT_YS + (size_t)MS * D;
constexpr size_t OUT_V = OUT_K + (size_t)M * SBW;
constexpr size_t OUT_GCONV = OUT_V + (size_t)M * SBW;
constexpr size_t OUT_GREC = OUT_GCONV + (size_t)NB * 3 * CONVCH;
constexpr size_t OUT_FCONV = OUT_GREC + (size_t)NB * NH * HD * HD;
constexpr size_t OUT_KS = OUT_FCONV + (size_t)NB * 2 * DFF;
constexpr size_t OUT_VS = OUT_KS + (size_t)MS * SBW;
constexpr size_t OUT_GCONVS = OUT_VS + (size_t)MS * SBW;
constexpr size_t OUT_GRECS = OUT_GCONVS + (size_t)MS * 3 * CONVCH;
constexpr size_t OUT_FCONVS = OUT_GRECS + (size_t)MS * NH * HD * HD;
constexpr size_t OUT_END = OUT_FCONVS + (size_t)MS * 2 * DFF;

namespace pg8 {
__device__ __forceinline__ float silu_f(float x) { return x / (1.0f + __expf(-x)); }
__device__ __forceinline__ float sigmoid_f(float x) { return 1.0f / (1.0f + __expf(-x)); }
__device__ __forceinline__ float softplus_f(float x) { return fmaxf(x, 0.f) + log1pf(__expf(-fabsf(x))); }
typedef unsigned u32x2 __attribute__((ext_vector_type(2)));

struct EpiProj {
    static constexpr bool PERM = true, AFTER_DRAIN = false;
    bf16_t *Qb, *Kb, *Vb, *CIN, *Zb; float *outK, *outV, *outGconv; float *G, *BETA; const float *a_log, *dt_bias;
    __device__ __forceinline__ void operator()(const f32x4 (&acc)[2][2][4][2], const Unit& u, int wr, int wc, int fr, int fq) const {
        const int reg = u.pn >> 2;
#pragma unroll
        for (int ai = 0; ai < 2; ++ai)
#pragma unroll
            for (int m = 0; m < 4; ++m) {
                const int r = u.pm * BM + ai * HALF + wr * 64 + m * 16 + fr;
#pragma unroll
                for (int bj = 0; bj < 2; ++bj) {
                    const int c8 = u.pn * BM + bj * HALF + wc * 32 + 8 * fq;
                    const f32x4 v0 = acc[ai][bj][m][0], v1 = acc[ai][bj][m][1];
                    u32x4 w; w.x = cvt_pk_bf16(v0[0], v0[1]); w.y = cvt_pk_bf16(v0[2], v0[3]); w.z = cvt_pk_bf16(v1[0], v1[1]); w.w = cvt_pk_bf16(v1[2], v1[3]);
                    if (reg == 0) { *(u32x4*)(Qb + (size_t)r * SBW + c8) = w; }
                    else if (reg == 1) { const int c = c8 - O_SB_K; *(u32x4*)(Kb + (size_t)r * SBW + c) = w; float* o = outK + (size_t)r * SBW + c; *(f32x4*)o = v0; *(f32x4*)(o + 4) = v1; }
                    else if (reg == 2) { const int c = c8 - O_SB_V; *(u32x4*)(Vb + (size_t)r * SBW + c) = w; float* o = outV + (size_t)r * SBW + c; *(f32x4*)o = v0; *(f32x4*)(o + 4) = v1; }
                    else if (reg < 6) { const int c = c8 - O_GQKV; *(u32x4*)(CIN + (size_t)r * CONVCH + c) = w;
                        const int t = r & (T - 1); if (t >= T - 3) { float* o = outGconv + ((size_t)(r >> 12) * 3 + (t - (T - 3))) * CONVCH + c; *(f32x4*)o = v0; *(f32x4*)(o + 4) = v1; } }
                    else if (reg == 6) { const int c = c8 - O_GZ; *(u32x4*)(Zb + (size_t)r * GW + c) = w; }
                    else if (bj == 0 && wc == 0 && fq < 2 && u.pn == 28) {
                        float x[8] = {v0[0], v0[1], v0[2], v0[3], v1[0], v1[1], v1[2], v1[3]}; float y[8];
#pragma unroll
                        for (int h = 0; h < 8; ++h) y[h] = (fq == 0) ? -__expf(a_log[h]) * softplus_f(x[h] + dt_bias[h]) : sigmoid_f(x[h]);
                        float* o = (fq == 0 ? G : BETA) + (size_t)r * NH; *(f32x4*)o = (f32x4){y[0], y[1], y[2], y[3]}; *(f32x4*)(o + 4) = (f32x4){y[4], y[5], y[6], y[7]};
                    }
                }
            }
    }
};

struct EpiF32 {
    static constexpr bool PERM = false, AFTER_DRAIN = false;
    float* C; int ldc;
    __device__ __forceinline__ void operator()(const f32x4 (&acc)[2][2][4][2], const Unit& u, int wr, int wc, int fr, int fq) const {
        const int row0 = u.pm * BM + wr * 64 + fr, col0 = u.pn * BM + wc * 32 + 4 * fq;
#pragma unroll
        for (int ai = 0; ai < 2; ++ai)
#pragma unroll
            for (int m = 0; m < 4; ++m) { float* rowp = C + (size_t)(row0 + ai * HALF + m * 16) * ldc + col0;
#pragma unroll
                for (int bj = 0; bj < 2; ++bj)
#pragma unroll
                    for (int n = 0; n < 2; ++n) *(f32x4*)(rowp + bj * HALF + n * 16) = acc[ai][bj][m][n]; }
    }
};

struct EpiResid {
    static constexpr bool PERM = false, AFTER_DRAIN = false;
    const float* base; float* Hf; bf16_t* Hb; float* sumsq; int ldc;
    __device__ __forceinline__ void operator()(const f32x4 (&acc)[2][2][4][2], const Unit& u, int wr, int wc, int fr, int fq) const {
        const int row0 = u.pm * BM + wr * 64 + fr, col0 = u.pn * BM + wc * 32 + 4 * fq;
#pragma unroll
        for (int ai = 0; ai < 2; ++ai)
#pragma unroll
            for (int m = 0; m < 4; ++m) { const int r = row0 + ai * HALF + m * 16; const size_t off = (size_t)r * ldc + col0; float ss = 0.f;
#pragma unroll
                for (int bj = 0; bj < 2; ++bj)
#pragma unroll
                    for (int n = 0; n < 2; ++n) { const f32x4 b = *(const f32x4*)(base + off + bj * HALF + n * 16); const f32x4 h = b + acc[ai][bj][m][n];
                        *(f32x4*)(Hf + off + bj * HALF + n * 16) = h; u32x2 w; w.x = cvt_pk_bf16(h[0], h[1]); w.y = cvt_pk_bf16(h[2], h[3]); *(u32x2*)(Hb + off + bj * HALF + n * 16) = w;
                        ss += (h[0] * h[0] + h[1] * h[1]) + (h[2] * h[2] + h[3] * h[3]); }
                ss += __shfl_xor(ss, 16); ss += __shfl_xor(ss, 32);
                if (fq == 0) unsafeAtomicAdd(sumsq + r, ss); }
    }
};

struct EpiGateUp {
    static constexpr bool PERM = true, AFTER_DRAIN = false;
    const float* sumsq; const float* convw; bf16_t* ACT; float* TAIL; float* FIXG; float* FIXU; float* outFconv; PG8_LAS float* halo;
    __device__ __forceinline__ void operator()(const f32x4 (&acc)[2][2][4][2], const Unit& u, int wr, int wc, int fr, int fq) const {
        const int lane = fr + 16 * fq;
        const int cg = u.pn * HALF + wc * 32 + 8 * fq;
        float w0[8], w1[8], w2[8];
#pragma unroll
        for (int j = 0; j < 8; ++j) { w0[j] = convw[cg + j]; w1[j] = convw[DFF + cg + j]; w2[j] = convw[2 * DFF + cg + j]; }
        float gp[2][4][8], up[2][4][8];
#pragma unroll
        for (int ai = 0; ai < 2; ++ai)
#pragma unroll
            for (int m = 0; m < 4; ++m) { const int r = u.pm * BM + ai * HALF + wr * 64 + m * 16 + fr; const float rs = rsqrtf(sumsq[r] * (1.0f / D) + EPS);
#pragma unroll
                for (int n = 0; n < 2; ++n)
#pragma unroll
                    for (int j = 0; j < 4; ++j) { gp[ai][m][4 * n + j] = acc[ai][0][m][n][j] * rs; up[ai][m][4 * n + j] = acc[ai][1][m][n][j] * rs; } }
        if (fr >= 14) {
#pragma unroll
            for (int ai = 0; ai < 2; ++ai) { PG8_LAS float* hp = halo + ((wc * 4 + (2 * ai + wr)) * 2 + (fr - 14)) * 32 + 8 * fq;
                *(PG8_LAS f32x4*)hp = (f32x4){gp[ai][3][0], gp[ai][3][1], gp[ai][3][2], gp[ai][3][3]}; *(PG8_LAS f32x4*)(hp + 4) = (f32x4){gp[ai][3][4], gp[ai][3][5], gp[ai][3][6], gp[ai][3][7]}; }
        }
        asm volatile("s_waitcnt lgkmcnt(0)" ::: "memory"); __builtin_amdgcn_s_barrier(); asm volatile("" ::: "memory");
        const int src1 = (lane & 48) | ((fr - 1) & 15), src2 = (lane & 48) | ((fr - 2) & 15);
#pragma unroll
        for (int ai = 0; ai < 2; ++ai) {
            const int B = 2 * ai + wr;
            float h62[8], h63[8];
            if (B > 0) { const PG8_LAS float* hp = halo + ((wc * 4 + (B - 1)) * 2) * 32 + 8 * fq;
                const f32x4 a0 = *(const PG8_LAS f32x4*)hp, a1 = *(const PG8_LAS f32x4*)(hp + 4), b0 = *(const PG8_LAS f32x4*)(hp + 32), b1 = *(const PG8_LAS f32x4*)(hp + 36);
#pragma unroll
                for (int j = 0; j < 4; ++j) { h62[j] = a0[j]; h62[4 + j] = a1[j]; h63[j] = b0[j]; h63[4 + j] = b1[j]; } }
            else {
#pragma unroll
                for (int j = 0; j < 8; ++j) { h62[j] = 0.f; h63[j] = 0.f; } }
            float ps1[8], ps2[8];
#pragma unroll
            for (int j = 0; j < 8; ++j) { ps1[j] = h63[j]; ps2[j] = (fr == 0) ? h62[j] : h63[j]; }
#pragma unroll
            for (int m = 0; m < 4; ++m) {
                const int r = u.pm * BM + ai * HALF + wr * 64 + m * 16 + fr;
                float gate[8], a[8];
#pragma unroll
                for (int j = 0; j < 8; ++j) {
                    const float s1 = __shfl(gp[ai][m][j], src1), s2 = __shfl(gp[ai][m][j], src2);
                    const float p1 = (fr >= 1) ? s1 : ps1[j], p2 = (fr >= 2) ? s2 : ps2[j];
                    ps1[j] = s1; ps2[j] = s2;
                    gate[j] = w0[j] * p2 + w1[j] * p1 + w2[j] * gp[ai][m][j];
                    a[j] = silu_f(gate[j]) * up[ai][m][j];
                }
                u32x4 w; w.x = cvt_pk_bf16(a[0], a[1]); w.y = cvt_pk_bf16(a[2], a[3]); w.z = cvt_pk_bf16(a[4], a[5]); w.w = cvt_pk_bf16(a[6], a[7]);
                *(u32x4*)(ACT + (size_t)r * DFF + cg) = w;
                if (B == 0 && m == 0 && fr < 2 && (u.pm & 15) != 0) {
                    float* fg = FIXG + ((size_t)u.pm * 2 + fr) * DFF + cg; float* fu = FIXU + ((size_t)u.pm * 2 + fr) * DFF + cg;
                    *(f32x4*)fg = (f32x4){gate[0], gate[1], gate[2], gate[3]}; *(f32x4*)(fg + 4) = (f32x4){gate[4], gate[5], gate[6], gate[7]};
                    *(f32x4*)fu = (f32x4){up[ai][m][0], up[ai][m][1], up[ai][m][2], up[ai][m][3]}; *(f32x4*)(fu + 4) = (f32x4){up[ai][m][4], up[ai][m][5], up[ai][m][6], up[ai][m][7]};
                }
                if (B == 3 && m == 3 && fr >= 14) {
                    float* tp = TAIL + ((size_t)u.pm * 2 + (fr - 14)) * DFF + cg;
                    *(f32x4*)tp = (f32x4){gp[ai][m][0], gp[ai][m][1], gp[ai][m][2], gp[ai][m][3]}; *(f32x4*)(tp + 4) = (f32x4){gp[ai][m][4], gp[ai][m][5], gp[ai][m][6], gp[ai][m][7]};
                    if ((u.pm & 15) == 15) { float* op = outFconv + ((size_t)(u.pm >> 4) * 2 + (fr - 14)) * DFF + cg;
                        *(f32x4*)op = (f32x4){gp[ai][m][0], gp[ai][m][1], gp[ai][m][2], gp[ai][m][3]}; *(f32x4*)(op + 4) = (f32x4){gp[ai][m][4], gp[ai][m][5], gp[ai][m][6], gp[ai][m][7]}; }
                }
            }
        }
    }
};

struct EpiPle {
    static constexpr bool PERM = false, AFTER_DRAIN = false;
    const float* H2; const float* PP; const float* sumsq2; float* H3; float* sumsq3; int ldc;
    __device__ __forceinline__ void operator()(const f32x4 (&acc)[2][2][4][2], const Unit& u, int wr, int wc, int fr, int fq) const {
        const int row0 = u.pm * BM + wr * 64 + fr, col0 = u.pn * BM + wc * 32 + 4 * fq;
#pragma unroll
        for (int ai = 0; ai < 2; ++ai)
#pragma unroll
            for (int m = 0; m < 4; ++m) { const int r = row0 + ai * HALF + m * 16; const size_t off = (size_t)r * ldc + col0; float ss = 0.f;
                const float rs = rsqrtf(sumsq2[r] * (1.0f / D) + EPS);
#pragma unroll
                for (int bj = 0; bj < 2; ++bj)
#pragma unroll
                    for (int n = 0; n < 2; ++n) { const f32x4 b = *(const f32x4*)(H2 + off + bj * HALF + n * 16), p = *(const f32x4*)(PP + off + bj * HALF + n * 16); const f32x4 a = acc[ai][bj][m][n]; f32x4 h;
#pragma unroll
                        for (int j = 0; j < 4; ++j) h[j] = b[j] + p[j] * sigmoid_f(a[j] * rs);
                        *(f32x4*)(H3 + off + bj * HALF + n * 16) = h; ss += (h[0] * h[0] + h[1] * h[1]) + (h[2] * h[2] + h[3] * h[3]); }
                ss += __shfl_xor(ss, 16); ss += __shfl_xor(ss, 32);
                if (fq == 0) unsafeAtomicAdd(sumsq3 + r, ss); }
    }
};
}

constexpr size_t MiB = 1u << 20;
constexpr size_t WS_CTL = 0, CTL_ZERO_BYTES = 1 * MiB;
constexpr int CW_BAR = 4096;
constexpr int CW_SUMSQ1 = 32768, CW_SUMSQ2 = CW_SUMSQ1 + M, CW_SUMSQ3 = CW_SUMSQ2 + M;
static_assert((CW_SUMSQ3 + M) * 4 <= (int)CTL_ZERO_BYTES, "ctl");
constexpr size_t WS_WIN = 2 * MiB;
constexpr size_t WS_WOUT = WS_WIN + (size_t)NPROJ_PAD * D * 2;
constexpr size_t WS_WGU = WS_WOUT + (size_t)D * D * 2;
constexpr size_t WS_WDN = WS_WGU + (size_t)NGU * D * 2;
constexpr size_t WS_WPG = WS_WDN + (size_t)D * DFF * 2;
constexpr size_t WS_WPP = WS_WPG + (size_t)D * D * 2;
constexpr size_t WS_XN = WS_WPP + (size_t)D * PLE * 2;
constexpr size_t WS_PB = WS_XN + (size_t)M * D * 2;
constexpr size_t WS_Q = WS_PB + (size_t)M * PLE * 2;
constexpr size_t WS_K = WS_Q + (size_t)M * SBW * 2;
constexpr size_t WS_V = WS_K + (size_t)M * SBW * 2;
constexpr size_t WS_CIN = WS_V + (size_t)M * SBW * 2;
constexpr size_t WS_Z = WS_CIN + (size_t)M * CONVCH * 2;
constexpr size_t WS_G = WS_Z + (size_t)M * GW * 2;
constexpr size_t WS_BETA = WS_G + (size_t)M * NH * 4;
constexpr size_t WS_GQ = WS_BETA + (size_t)M * NH * 4;
constexpr size_t WS_GK = WS_GQ + (size_t)M * GW * 4;
constexpr size_t WS_GV = WS_GK + (size_t)M * GW * 4;
constexpr size_t WS_GO = WS_GV + (size_t)M * GW * 4;
constexpr size_t WS_MIX = WS_GO + (size_t)M * GW * 4;
constexpr size_t WS_H1 = WS_MIX + (size_t)M * D * 2;
constexpr size_t WS_H1B = WS_H1 + (size_t)M * D * 4;
constexpr size_t WS_ACT = WS_H1B + (size_t)M * D * 2;
constexpr size_t WS_TAIL = WS_ACT + (size_t)M * DFF * 2;
constexpr size_t WS_FIXG = WS_TAIL + (size_t)32 * 2 * DFF * 4;
constexpr size_t WS_FIXU = WS_FIXG + (size_t)32 * 2 * DFF * 4;
constexpr size_t WS_H2 = WS_FIXU + (size_t)32 * 2 * DFF * 4;
constexpr size_t WS_H2B = WS_H2 + (size_t)M * D * 4;
constexpr size_t WS_PP = WS_H2B + (size_t)M * D * 2;
constexpr size_t WS_S = WS_PP + (size_t)M * D * 4;
constexpr size_t S_A = 0;
constexpr size_t S_PROJ = S_A + MS * D;
constexpr size_t S_GQ = S_PROJ + MS * IN_COLS;
constexpr size_t S_GK = S_GQ + MS * GW;
constexpr size_t S_GV = S_GK + MS * GW;
constexpr size_t S_G = S_GV + MS * GW;
constexpr size_t S_BETA = S_G + 64;
constexpr size_t S_GO = S_BETA + 64;
constexpr size_t S_PART = S_GO + MS * GW;
constexpr int DSEG = 32, DPART = 132;
constexpr size_t S_MIX = S_PART + (size_t)MS * NH * DSEG * DPART;
constexpr size_t S_H1 = S_MIX + MS * D;
constexpr size_t S_GP = S_H1 + MS * D;
constexpr size_t S_UP = S_GP + MS * DFF;
constexpr size_t S_ACT = S_UP + MS * DFF;
constexpr size_t S_H2 = S_ACT + MS * DFF;
constexpr size_t S_PG = S_H2 + MS * D;
constexpr size_t S_PP = S_PG + MS * D;
constexpr size_t S_END = S_PP + MS * D;
constexpr size_t WS_END = WS_S + S_END * 4;

constexpr int RING_OFF = 0, RING_BYTES = 131072;
constexpr int HALO_OFF = RING_BYTES;
constexpr int LDSCTL_OFF = RING_BYTES + 8192, MISC_OFF = LDSCTL_OFF + 320;
constexpr int LDS_BYTES = 147456;
constexpr int NWAVES = 8;

#define GAS __attribute__((address_space(1)))
#define LAS __attribute__((address_space(3)))
typedef unsigned short bf16;
typedef unsigned v4u __attribute__((ext_vector_type(4)));
typedef unsigned v2u __attribute__((ext_vector_type(2)));
typedef float f32x4 __attribute__((ext_vector_type(4)));
typedef float f32x2 __attribute__((ext_vector_type(2)));
typedef GAS unsigned gu32;
#define RLX_AGENT __ATOMIC_RELAXED, __HIP_MEMORY_SCOPE_AGENT
#define LDS_WAIT() asm volatile("s_waitcnt lgkmcnt(0)" ::: "memory")
#define VM_WAIT() asm volatile("s_waitcnt vmcnt(0)" ::: "memory")
__device__ __forceinline__ unsigned f2bf(float f) { unsigned u = __builtin_bit_cast(unsigned, f); return (u + 0x7fffu + ((u >> 16) & 1u)) >> 16; }
__device__ __forceinline__ unsigned pk2(float lo, float hi) { return f2bf(lo) | (f2bf(hi) << 16); }
__device__ __forceinline__ float bf_lo(unsigned w) { return __builtin_bit_cast(float, w << 16); }
__device__ __forceinline__ float bf_hi(unsigned w) { return __builtin_bit_cast(float, w & 0xffff0000u); }
__device__ __forceinline__ float bf2f(bf16 b) { return __builtin_bit_cast(float, (unsigned)b << 16); }
using pg8::silu_f; using pg8::sigmoid_f; using pg8::softplus_f;

#define XB_TMO      128
#define XB_XCNT(j)  (256  + 64 * (j))
#define XB_XSUB(j)  (1280 + 64 * (j))
#define XB_XGEN(j)  (2304 + 64 * (j))
#define XB_TOP      3328
#define XB_TOPGEN   3392
#define XCD_BAR_WORDS 3456
#define XB_SPIN_CAP (1u << 18)
__device__ __forceinline__ unsigned xb_ld(unsigned* p)              { return __hip_atomic_load(p, __ATOMIC_RELAXED, __HIP_MEMORY_SCOPE_AGENT); }
__device__ __forceinline__ unsigned xb_add(unsigned* p, unsigned v) { return __hip_atomic_fetch_add(p, v, __ATOMIC_RELAXED, __HIP_MEMORY_SCOPE_AGENT); }
__device__ __forceinline__ unsigned xb_xcc_id() { return (unsigned)__builtin_amdgcn_s_getreg((3 << 11) | 20) & 0xFu; }
#define XB_SPIN(cond, bar) do { unsigned _sp = 0; while (cond) { __builtin_amdgcn_s_sleep(1); \
    if ((++_sp & 255u) == 0u) { if (xb_ld(&(bar)[XB_TMO])) break; if (_sp > XB_SPIN_CAP) { atomicAdd(&(bar)[XB_TMO], 1u); break; } } } } while (0)
struct XcdBarrier { unsigned* bar; unsigned x; volatile LAS unsigned* st; };
__device__ __forceinline__ XcdBarrier xcd_barrier_post(unsigned* bar, volatile LAS unsigned* st) {
    XcdBarrier b; b.bar = bar; b.x = xb_xcc_id(); b.st = st;
    if (threadIdx.x == 0) (void)xb_add(&bar[XB_XCNT(b.x)], 1u);
    return b;
}
__device__ __forceinline__ void xcd_barrier_complete(unsigned* bar, unsigned x, unsigned& nloc, unsigned& nx) {
    const unsigned G = gridDim.x * gridDim.y * gridDim.z;
    unsigned sum, cnt, mine, sp = 0u;
    for (;;) {
        sum = 0u; cnt = 0u; mine = 0u;
#pragma unroll
        for (unsigned j = 0; j < 16; ++j) { const unsigned c = xb_ld(&bar[XB_XCNT(j)]); sum += c; cnt += (c > 0u) ? 1u : 0u; mine = (j == x) ? c : mine; }
        if (sum == G) break;
        __builtin_amdgcn_s_sleep(1);
        if ((++sp & 255u) == 0u) { if (xb_ld(&bar[XB_TMO])) break; if (sp > XB_SPIN_CAP) { atomicAdd(&bar[XB_TMO], 1u); break; } }
    }
    nloc = mine > 0u ? mine : 1u; nx = cnt > 0u ? cnt : 1u;
}
__device__ __forceinline__ void xcd_barrier(const XcdBarrier& b) {
    asm volatile("s_waitcnt vmcnt(0)" ::: "memory");
    __syncthreads();
    if (threadIdx.x == 0) {
        unsigned* bar = b.bar;
        __builtin_amdgcn_s_waitcnt(0);
        unsigned nloc = b.st[0], nx = b.st[1];
        if (nloc == 0u) { xcd_barrier_complete(bar, b.x, nloc, nx); b.st[0] = nloc; b.st[1] = nx; }
        const unsigned old = xb_add(&bar[XB_XSUB(b.x)], 1u);
        const unsigned gen = old / nloc;
        if (old + 1u == (gen + 1u) * nloc) {
            __builtin_amdgcn_fence(__ATOMIC_RELEASE, "agent");
            asm volatile("s_waitcnt vmcnt(0)" ::: "memory");
            const unsigned og = xb_add(&bar[XB_TOP], 1u);
            const unsigned tg = og / nx;
            if (og + 1u == (tg + 1u) * nx) xb_add(&bar[XB_TOPGEN], 1u);
            else XB_SPIN(xb_ld(&bar[XB_TOPGEN]) == tg, bar);
            __builtin_amdgcn_fence(__ATOMIC_ACQUIRE, "agent");
            xb_add(&bar[XB_XGEN(b.x)], 1u);
            asm volatile("s_waitcnt vmcnt(0)" ::: "memory");
        } else {
            XB_SPIN(xb_ld(&bar[XB_XGEN(b.x)]) == gen, bar);
            __builtin_amdgcn_fence(__ATOMIC_ACQUIRE, "agent");
            asm volatile("s_waitcnt vmcnt(0)" ::: "memory");
        }
    }
    __syncthreads();
}

struct Frame {
    LAS unsigned char* lds;
    volatile LAS unsigned* MISC;
    unsigned* ctl;
    int tid, lane, wave, G, bid;
    const float* in[28];
    float* out;
    unsigned char* ws;
};
#define WSP(T_, off) ((T_*)(F.ws + (off)))
#define SSP(off) ((float*)(F.ws + WS_S) + (off))

__device__ __forceinline__ float wave_sum(float v) {
#pragma unroll
    for (int o = 1; o < 64; o <<= 1) v += __shfl_xor(v, o);
    return v;
}

__device__ __forceinline__ void p0_transpose_item(const float* W, int ldw, int nvalid, int K, bf16* WT, int drow, int k0, int n0, const float* kscale, LAS float* scr, int lane) {
#pragma unroll 8
    for (int i = 0; i < 32; ++i) { const int kk = 2 * i + (lane >> 5); const int n = n0 + (lane & 31);
        float v = (n < nvalid) ? W[(size_t)(k0 + kk) * ldw + n] : 0.f; if (kscale) v *= kscale[k0 + kk]; scr[kk * 33 + (lane & 31)] = v; }
    LDS_WAIT(); asm volatile("" ::: "memory");
    const int c = lane & 7;
#pragma unroll
    for (int j = 0; j < 4; ++j) { const int n = (lane >> 3) + 8 * j; const LAS float* s = scr + (8 * c) * 33 + n;
        v4u o; o.x = pk2(s[0 * 33], s[1 * 33]); o.y = pk2(s[2 * 33], s[3 * 33]); o.z = pk2(s[4 * 33], s[5 * 33]); o.w = pk2(s[6 * 33], s[7 * 33]);
        *(v4u*)(WT + (size_t)(drow + n) * K + k0 + 8 * c) = o; }
    LDS_WAIT(); asm volatile("" ::: "memory");
}
__device__ __forceinline__ void rms_row(const float* xrow, const float* w, bf16* ob, float* of, int lane) {
    const f32x4* xr = (const f32x4*)xrow + lane; const f32x4* wr_ = (const f32x4*)w + lane;
    f32x4 v[8]; float s = 0.f;
#pragma unroll
    for (int j = 0; j < 8; ++j) { v[j] = xr[64 * j]; s += (v[j].x * v[j].x + v[j].y * v[j].y) + (v[j].z * v[j].z + v[j].w * v[j].w); }
    const float rstd = rsqrtf(wave_sum(s) * (1.f / D) + EPS);
#pragma unroll
    for (int j = 0; j < 8; ++j) { const f32x4 g = wr_[64 * j]; const f32x4 y = v[j] * rstd * g;
        if (ob) ((unsigned long long*)ob)[lane + 64 * j] = (unsigned long long)pk2(y.x, y.y) | ((unsigned long long)pk2(y.z, y.w) << 32);
        if (of) ((f32x4*)of)[lane + 64 * j] = y; }
}

__device__ __forceinline__ void p0_prologue(Frame& F) {
    LAS float* scr = (LAS float*)(F.lds + RING_OFF + F.wave * 16384);
    const int gw = F.bid * NWAVES + F.wave, NGW = F.G * NWAVES;
    const float* w_in = F.in[11]; const float* w_out = F.in[18]; const float* w_g = F.in[20]; const float* w_u = F.in[21]; const float* w_d = F.in[23]; const float* w_pg = F.in[25]; const float* w_pp = F.in[26];
    const float* ffn_norm = F.in[19]; const float* ple_norm = F.in[24];
    bf16* Win = WSP(bf16, WS_WIN); bf16* Wout = WSP(bf16, WS_WOUT); bf16* Wgu = WSP(bf16, WS_WGU); bf16* Wdn = WSP(bf16, WS_WDN); bf16* Wpg = WSP(bf16, WS_WPG); bf16* Wpp = WSP(bf16, WS_WPP);
    constexpr int I_IN = (D / 64) * 225;
    constexpr int I_OUT = (D / 64) * (D / 32);
    constexpr int I_G = (D / 64) * (DFF / 32), I_U = I_G;
    constexpr int I_D = (DFF / 64) * (D / 32);
    constexpr int I_PG = I_OUT;
    constexpr int I_PP = (PLE / 64) * (D / 32);
    constexpr int NITEMS = I_IN + I_OUT + I_G + I_U + I_D + I_PG + I_PP;
    for (int it = gw; it < NITEMS; it += NGW) {
        int r = it;
        if (r < I_IN) { const int kb = r / 225, nb = r % 225; p0_transpose_item(w_in, IN_COLS, IN_COLS, D, Win, 32 * nb, 64 * kb, 32 * nb, nullptr, scr, F.lane); continue; } r -= I_IN;
        if (r < I_OUT) { const int kb = r / (D / 32), nb = r % (D / 32); p0_transpose_item(w_out, D, D, D, Wout, 32 * nb, 64 * kb, 32 * nb, nullptr, scr, F.lane); continue; } r -= I_OUT;
        if (r < I_G) { const int kb = r / (DFF / 32), nb = r % (DFF / 32); const int n0 = 32 * nb; p0_transpose_item(w_g, DFF, DFF, D, Wgu, 256 * (n0 >> 7) + (n0 & 127), 64 * kb, n0, ffn_norm, scr, F.lane); continue; } r -= I_G;
        if (r < I_U) { const int kb = r / (DFF / 32), nb = r % (DFF / 32); const int n0 = 32 * nb; p0_transpose_item(w_u, DFF, DFF, D, Wgu, 256 * (n0 >> 7) + 128 + (n0 & 127), 64 * kb, n0, ffn_norm, scr, F.lane); continue; } r -= I_U;
        if (r < I_D) { const int kb = r / (D / 32), nb = r % (D / 32); p0_transpose_item(w_d, D, D, DFF, Wdn, 32 * nb, 64 * kb, 32 * nb, nullptr, scr, F.lane); continue; } r -= I_D;
        if (r < I_PG) { const int kb = r / (D / 32), nb = r % (D / 32); p0_transpose_item(w_pg, D, D, D, Wpg, 32 * nb, 64 * kb, 32 * nb, ple_norm, scr, F.lane); continue; } r -= I_PG;
        { const int kb = r / (D / 32), nb = r % (D / 32); p0_transpose_item(w_pp, D, D, PLE, Wpp, 32 * nb, 64 * kb, 32 * nb, nullptr, scr, F.lane); }
    }
    { const size_t z0 = (size_t)7200 * D * 2, z1 = (size_t)NPROJ_PAD * D * 2; v4u* p = (v4u*)((unsigned char*)Win + z0); const size_t n16 = (z1 - z0) / 16;
      for (size_t i = (size_t)F.bid * 512 + F.tid; i < n16; i += (size_t)F.G * 512) p[i] = (v4u){0u, 0u, 0u, 0u}; }
    bf16* XN = WSP(bf16, WS_XN);
    for (int m = gw; m < M; m += NGW) rms_row(F.in[0] + (size_t)m * D, F.in[10], XN + (size_t)m * D, nullptr, F.lane);
    if (gw < MS) rms_row(F.in[1] + (size_t)gw * D, F.in[10], nullptr, SSP(S_A) + (size_t)gw * D, F.lane);
    { const f32x4* p = (const f32x4*)F.in[8]; v2u* o = (v2u*)WSP(bf16, WS_PB); const size_t n4 = (size_t)M * PLE / 4;
      for (size_t i = (size_t)F.bid * 512 + F.tid; i < n4; i += (size_t)F.G * 512) { const f32x4 v = p[i]; o[i] = (v2u){pk2(v.x, v.y), pk2(v.z, v.w)}; } }
}

template <class Epi>
__device__ __forceinline__ void sample_gemv(Frame& F, const float* A, int K, const float* nw, const float* W, int ldw, int N, const Epi& E) {
    LAS float* As = (LAS float*)(F.lds);
    LAS float* Red = (LAS float*)(F.lds + 65536);
    LAS float* Rs = (LAS float*)(F.lds + 65536 + 16384);
    const int ngroups = (N + 63) / 64;
    const int first = F.G - 1 - F.bid;
    if (first >= ngroups) return;
    __syncthreads();
    if (nw) { float s = 0.f; for (int k = F.lane; k < K; k += 64) { const float v = A[(size_t)F.wave * K + k]; s += v * v; } s = wave_sum(s); if (F.lane == 0) Rs[F.wave] = rsqrtf(s / (float)K + EPS); }
    else if (F.lane == 0) Rs[F.wave] = 1.f;
    __syncthreads();
    for (int g = first; g < ngroups; g += F.G) {
        float acc[8];
#pragma unroll
        for (int r = 0; r < 8; ++r) acc[r] = 0.f;
        const int n = 64 * g + F.lane; const bool nv = n < N;
        for (int kc = 0; kc < K; kc += 2048) {
            const int kn = (K - kc) < 2048 ? (K - kc) : 2048;
            __syncthreads();
            for (int idx = F.tid; idx < 8 * kn; idx += 512) { const int r = idx / kn, k = idx - r * kn; float v = A[(size_t)r * K + kc + k]; if (nw) v *= Rs[r] * nw[kc + k]; As[r * 2048 + k] = v; }
            __syncthreads();
            const int ks = kn / 8;
            for (int k = F.wave * ks; k < (F.wave + 1) * ks; k += 4) {
                float w4[4];
#pragma unroll
                for (int i = 0; i < 4; ++i) w4[i] = nv ? W[(size_t)(kc + k + i) * ldw + n] : 0.f;
#pragma unroll
                for (int r = 0; r < 8; ++r) { const f32x4 a = *(const LAS f32x4*)(As + r * 2048 + k); acc[r] += (a.x * w4[0] + a.y * w4[1]) + (a.z * w4[2] + a.w * w4[3]); }
            }
        }
        __syncthreads();
#pragma unroll
        for (int r = 0; r < 8; ++r) Red[(F.wave * 8 + r) * 64 + F.lane] = acc[r];
        __syncthreads();
        { const int r = F.tid >> 6, c = F.tid & 63; float s = 0.f;
#pragma unroll
          for (int w = 0; w < 8; ++w) s += Red[(w * 8 + r) * 64 + c];
          const int nn = 64 * g + c; if (nn < N) E(r, nn, s); }
    }
    __syncthreads();
}
struct SEpiStore { float* O; int ld; __device__ __forceinline__ void operator()(int r, int n, float v) const { O[(size_t)r * ld + n] = v; } };
struct SEpiAdd { const float* B; float* O; int ld; __device__ __forceinline__ void operator()(int r, int n, float v) const { O[(size_t)r * ld + n] = B[(size_t)r * ld + n] + v; } };

__device__ __forceinline__ void gdn_prep_prompt(Frame& F) {
    const int gw = F.bid * NWAVES + F.wave, NGW = F.G * NWAVES;
    const bf16* CIN = WSP(bf16, WS_CIN); const float* cw = F.in[14];
    float* GQ = WSP(float, WS_GQ); float* GK = WSP(float, WS_GK); float* GV = WSP(float, WS_GV);
    for (int it = gw; it < M * NH; it += NGW) {
        const int row = it >> 3, h = it & 7, t = row & (T - 1);
#pragma unroll
        for (int seg = 0; seg < 3; ++seg) {
            const int ch = seg * GW + h * HD + 2 * F.lane;
            float a0 = 0.f, a1 = 0.f;
#pragma unroll
            for (int j = 0; j < 4; ++j) { const int tt = t - 3 + j; if (tt >= 0) { const unsigned w = *(const unsigned*)(CIN + (size_t)(row - 3 + j) * CONVCH + ch); a0 += bf_lo(w) * cw[j * CONVCH + ch]; a1 += bf_hi(w) * cw[j * CONVCH + ch + 1]; } }
            a0 = silu_f(a0); a1 = silu_f(a1);
            float* dst = (seg == 0 ? GQ : seg == 1 ? GK : GV) + (size_t)row * GW + h * HD + 2 * F.lane;
            if (seg < 2) { const float ss = wave_sum(a0 * a0 + a1 * a1); float sc = rsqrtf(ss + 1e-6f); if (seg == 0) sc *= SB_SCALE; a0 *= sc; a1 *= sc; }
            *(f32x2*)dst = (f32x2){a0, a1};
        }
    }
}
__device__ __forceinline__ void gdn_prep_sample(Frame& F) {
    if (F.bid != 0) return;
    const float* PR = SSP(S_PROJ); const float* hist = F.in[5]; const float* cw = F.in[14];
    for (int i = F.tid; i < MS * SBW; i += 512) { const int b = i >> 10, c = i & 1023; F.out[OUT_KS + i] = PR[(size_t)b * IN_COLS + O_SB_K + c]; F.out[OUT_VS + i] = PR[(size_t)b * IN_COLS + O_SB_V + c]; }
    for (int i = F.tid; i < MS * 3 * CONVCH; i += 512) { const int b = i / (3 * CONVCH), rr = (i / CONVCH) % 3, c = i % CONVCH;
        F.out[OUT_GCONVS + i] = (rr < 2) ? hist[((size_t)b * 3 + rr + 1) * CONVCH + c] : PR[(size_t)b * IN_COLS + O_GQKV + c]; }
    if (F.tid < 64) { const int b = F.tid >> 3, h = F.tid & 7; SSP(S_G)[F.tid] = -__expf(F.in[15][h]) * softplus_f(PR[(size_t)b * IN_COLS + O_GA + h] + F.in[16][h]); SSP(S_BETA)[F.tid] = sigmoid_f(PR[(size_t)b * IN_COLS + O_GB + h]); }
    const int b = F.wave;
    for (int h = 0; h < NH; ++h)
#pragma unroll
        for (int seg = 0; seg < 3; ++seg) {
            const int ch = seg * GW + h * HD + 2 * F.lane; float a[2];
#pragma unroll
            for (int e = 0; e < 2; ++e) { float s = 0.f;
#pragma unroll
                for (int j = 0; j < 3; ++j) s += hist[((size_t)b * 3 + j) * CONVCH + ch + e] * cw[j * CONVCH + ch + e];
                s += PR[(size_t)b * IN_COLS + O_GQKV + ch + e] * cw[3 * CONVCH + ch + e]; a[e] = silu_f(s); }
            float* dst = SSP(seg == 0 ? S_GQ : seg == 1 ? S_GK : S_GV) + (size_t)b * GW + h * HD + 2 * F.lane;
            if (seg < 2) { const float ss = wave_sum(a[0] * a[0] + a[1] * a[1]); float sc = rsqrtf(ss + 1e-6f); if (seg == 0) sc *= SB_SCALE; a[0] *= sc; a[1] *= sc; }
            dst[0] = a[0]; dst[1] = a[1];
        }
}

template <bool PIPE>
__device__ __forceinline__ void gdn_recur_wave(const float* GQ, const float* GK, const float* GV, const float* Gg, const float* Gb, int ld, int gld, size_t row0, int ntok, int h, int slice,
                                               const float* S0, float* Sout, float* GO, int lane) {
    const int e = 4 * slice + (lane >> 4), d0 = 8 * (lane & 15);
    float S[8];
#pragma unroll
    for (int i = 0; i < 8; ++i) S[i] = S0 ? S0[(size_t)(d0 + i) * HD + e] : 0.f;
    constexpr int NT = PIPE ? 4 : 1;
    f32x4 ck0[NT], ck1[NT], cq0[NT], cq1[NT]; float cv[NT], cg[NT], cb[NT];
#define GDN_LOAD(dk0, dk1, dq0, dq1, dv, dg, db, tb) do { _Pragma("unroll") for (int i_ = 0; i_ < NT; ++i_) { const size_t row_ = row0 + (tb) + i_; \
        dk0[i_] = *(const f32x4*)(GK + row_ * ld + h * HD + d0); dk1[i_] = *(const f32x4*)(GK + row_ * ld + h * HD + d0 + 4); \
        dq0[i_] = *(const f32x4*)(GQ + row_ * ld + h * HD + d0); dq1[i_] = *(const f32x4*)(GQ + row_ * ld + h * HD + d0 + 4); \
        dv[i_] = GV[row_ * ld + h * HD + e]; dg[i_] = Gg[row_ * gld + h]; db[i_] = Gb[row_ * gld + h]; } } while (0)
    GDN_LOAD(ck0, ck1, cq0, cq1, cv, cg, cb, 0);
    for (int t = 0; t < ntok; t += NT) {
        f32x4 nk0[NT], nk1[NT], nq0[NT], nq1[NT]; float nv[NT], ng[NT], nb[NT];
        const int tn = (t + NT < ntok) ? t + NT : t;
        GDN_LOAD(nk0, nk1, nq0, nq1, nv, ng, nb, tn);
#pragma unroll
        for (int i = 0; i < NT; ++i) {
            const float kk[8] = {ck0[i].x, ck0[i].y, ck0[i].z, ck0[i].w, ck1[i].x, ck1[i].y, ck1[i].z, ck1[i].w}, qq[8] = {cq0[i].x, cq0[i].y, cq0[i].z, cq0[i].w, cq1[i].x, cq1[i].y, cq1[i].z, cq1[i].w};
            const float eg = __expf(cg[i]);
            float kv = 0.f;
#pragma unroll
            for (int j = 0; j < 8; ++j) kv += S[j] * kk[j];
            kv += __shfl_xor(kv, 1); kv += __shfl_xor(kv, 2); kv += __shfl_xor(kv, 4); kv += __shfl_xor(kv, 8);
            const float u = cb[i] * (cv[i] - eg * kv);
            float o = 0.f;
#pragma unroll
            for (int j = 0; j < 8; ++j) { S[j] = eg * S[j] + kk[j] * u; o += S[j] * qq[j]; }
            o += __shfl_xor(o, 1); o += __shfl_xor(o, 2); o += __shfl_xor(o, 4); o += __shfl_xor(o, 8);
            if ((lane & 15) == 0) GO[(row0 + t + i) * ld + h * HD + e] = o;
        }
#pragma unroll
        for (int i = 0; i < NT; ++i) { ck0[i] = nk0[i]; ck1[i] = nk1[i]; cq0[i] = nq0[i]; cq1[i] = nq1[i]; cv[i] = nv[i]; cg[i] = ng[i]; cb[i] = nb[i]; }
    }
#undef GDN_LOAD
#pragma unroll
    for (int i = 0; i < 8; ++i) Sout[(size_t)(d0 + i) * HD + e] = S[i];
}

__device__ __forceinline__ void sb_query_simple(Frame& F, int b, int h, int t, LAS float* qs) {
    const bf16* Qb = WSP(bf16, WS_Q); const bf16* Kb = WSP(bf16, WS_K); const bf16* Vb = WSP(bf16, WS_V); bf16* MIX = WSP(bf16, WS_MIX);
    const size_t row = (size_t)b * T + t; const int lane = F.lane;
    { const unsigned w = *(const unsigned*)(Qb + row * SBW + h * HD + 2 * lane); qs[2 * lane] = bf_lo(w); qs[2 * lane + 1] = bf_hi(w); }
    LDS_WAIT(); asm volatile("" ::: "memory");
    const float ch = F.in[12][h];
    float o0 = 0.f, o1 = 0.f, R = 0.f;
    const int nblk = (t + 63) >> 6;
    for (int blk = nblk - 1; blk >= 0; --blk) {
        const int k0 = blk * 64, key = k0 + lane; const bool valid = key < t;
        const v4u* kr = (const v4u*)(Kb + ((size_t)b * T + key) * SBW + h * HD);
        float dot = 0.f;
#pragma unroll
        for (int c = 0; c < 16; ++c) { const v4u w = kr[c]; const f32x4 qa = *(const LAS f32x4*)(qs + 8 * c), qb = *(const LAS f32x4*)(qs + 8 * c + 4);
            dot += bf_lo(w.x) * qa.x + bf_hi(w.x) * qa.y + bf_lo(w.y) * qa.z + bf_hi(w.y) * qa.w + bf_lo(w.z) * qb.x + bf_hi(w.z) * qb.y + bf_lo(w.w) * qb.z + bf_hi(w.w) * qb.w; }
        const float z = dot * SB_SCALE + ch;
        const float sp = softplus_f(z);
        const float L = valid ? -sp : 0.f, lb = z - sp;
        float s = L;
#pragma unroll
        for (int o = 1; o < 64; o <<= 1) { const float tmp = __shfl_down(s, o); if (lane + o < 64) s += tmp; }
        const float tot = __shfl(s, 0);
        const float a = valid ? __expf(lb + (s - L) + R) : 0.f;
        R += tot;
        const bf16* vr = Vb + ((size_t)b * T + k0) * SBW + h * HD + 2 * lane;
#pragma unroll 8
        for (int j = 0; j < 64; ++j) { const float aj = __shfl(a, j); const unsigned w = *(const unsigned*)(vr + (size_t)j * SBW); o0 += aj * bf_lo(w); o1 += aj * bf_hi(w); }
    }
    const float ss = wave_sum(o0 * o0 + o1 * o1); const float rs = rsqrtf(ss * (1.f / HD) + EPS);
    const float* nw = F.in[13];
    *(unsigned*)(MIX + row * D + h * HD + 2 * lane) = pk2(o0 * rs * nw[2 * lane], o1 * rs * nw[2 * lane + 1]);
}

__device__ __forceinline__ void sb_decode_segment(Frame& F, int b, int h, int seg) {
    const float* q = SSP(S_PROJ) + (size_t)b * IN_COLS + h * HD;
    const float* CK = F.in[2]; const float* CV = F.in[3]; const int* PT = (const int*)F.in[4];
    const int lane = F.lane, half = lane >> 5, l32 = lane & 31;
    const f32x4 q4 = *(const f32x4*)(q + 4 * l32);
    const float ch = F.in[12][h];
    float o0 = 0.f, o1 = 0.f, R = 0.f;
    for (int blk = 7; blk >= 0; --blk) {
        const int p0 = seg * 512 + blk * 64;
        const int page = PT[b * NPAGES + (p0 >> 7)];
        const size_t base = (((size_t)page * PAGE + (p0 & 127)) * NH + h) * HD;
        float z = 0.f;
#pragma unroll 8
        for (int i = 0; i < 32; ++i) {
            const f32x4 k4 = *(const f32x4*)(CK + base + (size_t)(2 * i + half) * (NH * HD) + 4 * l32);
            float p = (k4.x * q4.x + k4.y * q4.y) + (k4.z * q4.z + k4.w * q4.w);
            p += __shfl_xor(p, 1); p += __shfl_xor(p, 2); p += __shfl_xor(p, 4); p += __shfl_xor(p, 8); p += __shfl_xor(p, 16);
            const float pe = __shfl(p, 0), po = __shfl(p, 32);
            if (lane == 2 * i) z = pe; if (lane == 2 * i + 1) z = po;
        }
        z = z * SB_SCALE + ch;
        const float sp = softplus_f(z);
        const float L = -sp, lb = z - sp;
        float s = L;
#pragma unroll
        for (int o = 1; o < 64; o <<= 1) { const float tmp = __shfl_down(s, o); if (lane + o < 64) s += tmp; }
        const float tot = __shfl(s, 0);
        const float a = __expf(lb + (s - L) + R);
        R += tot;
#pragma unroll 8
        for (int j = 0; j < 64; ++j) { const float aj = __shfl(a, j); const f32x2 v = *(const f32x2*)(CV + base + (size_t)j * (NH * HD) + 2 * lane); o0 += aj * v.x; o1 += aj * v.y; }
    }
    float* P = SSP(S_PART) + ((size_t)(b * NH + h) * DSEG + seg) * DPART;
    P[2 * lane] = o0; P[2 * lane + 1] = o1; if (lane == 0) P[128] = R;
}

typedef short bf16x8 __attribute__((ext_vector_type(8)));
typedef short s16x4 __attribute__((ext_vector_type(4)));
typedef float f32x16 __attribute__((ext_vector_type(16)));
typedef __bf16 bf16x2_t __attribute__((ext_vector_type(2)));
__device__ __forceinline__ unsigned cvt2bf(float lo, float hi) { const f32x2 v = {lo, hi}; return __builtin_bit_cast(unsigned, __builtin_convertvector(v, bf16x2_t)); }
__device__ __forceinline__ unsigned offb(unsigned row, unsigned ch) { return 256u * row + 16u * (ch ^ (((row & 3u) << 2) | ((row >> 2) & 3u))); }
constexpr float LOG2E = 1.4426950408889634f;

__device__ __forceinline__ void sb_attn_unit(Frame& F, int b, int h, int qb) {
    const bf16* Qb = WSP(bf16, WS_Q); const bf16* Kb = WSP(bf16, WS_K); const bf16* Vb = WSP(bf16, WS_V); bf16* MIX = WSP(bf16, WS_MIX);
    const int lane = F.lane, r32 = lane & 31, hh = lane >> 5;
    const int q0w = 256 * qb + 32 * F.wave;
    LAS unsigned char* KB0 = F.lds + RING_OFF; LAS unsigned char* VB0 = F.lds + RING_OFF + 32768;
    bf16x8 qf[8];
    { const bf16* qp = Qb + ((size_t)b * T + q0w + r32) * SBW + h * HD + 8 * hh;
#pragma unroll
      for (int s = 0; s < 8; ++s) qf[s] = *(const bf16x8*)(qp + 16 * s); }
    const float k1 = SB_SCALE * LOG2E, k2 = F.in[12][h] * LOG2E;
    f32x16 oacc[4];
#pragma unroll
    for (int d = 0; d < 4; ++d)
#pragma unroll
        for (int i = 0; i < 16; ++i) oacc[d][i] = 0.f;
    float R = 0.f;
    const int nt = 4 * qb + 4;
    const int srow = F.tid >> 4, sch = F.tid & 15;
    const size_t gbase = ((size_t)b * T) * SBW + h * HD + sch * 8;
    v4u rk[2], rv[2];
#define SB_LOAD(k0_) do { _Pragma("unroll") for (int i_ = 0; i_ < 2; ++i_) { const size_t o_ = gbase + (size_t)((k0_) + srow + 32 * i_) * SBW; rk[i_] = *(const v4u*)(Kb + o_); rv[i_] = *(const v4u*)(Vb + o_); } } while (0)
    const unsigned kwo = (unsigned)((sch >> 1) * 1024 + srow * 32 + (((sch & 1) ^ ((srow >> 3) & 1)) * 16));
    const unsigned vwo = (unsigned)((((srow >> 3) * 4 + (sch >> 2)) * 512) + (srow & 7) * 64 + (sch & 3) * 16);
#define SB_WRITE(buf_) do { _Pragma("unroll") for (int i_ = 0; i_ < 2; ++i_) { *(LAS v4u*)(KB0 + (buf_) * 16384 + kwo + i_ * 8192) = rk[i_]; *(LAS v4u*)(VB0 + (buf_) * 16384 + vwo + i_ * 8192) = rv[i_]; } } while (0)
    SB_LOAD(64 * (nt - 1)); SB_WRITE(0);
    __syncthreads();
    const int tq = (lane & 15) >> 2, tp = lane & 3, tblk = (lane >> 4) & 1;
    const unsigned kro = (unsigned)(r32 * 32 + ((hh ^ ((r32 >> 3) & 1)) * 16));
    const unsigned vro = (unsigned)((4 * hh + tq) * 64 + tblk * 32 + tp * 8);
    for (int it = 0; it < nt; ++it) {
        const int kt = nt - 1 - it, buf = it & 1, k0 = 64 * kt;
        if (it + 1 < nt) SB_LOAD(64 * (kt - 1));
        if (k0 < q0w + 31) {
            const bool diag = (k0 + 63 >= q0w);
            LAS unsigned char* Kt = KB0 + buf * 16384; LAS unsigned char* Vt = VB0 + buf * 16384;
            f32x16 sacc[2];
#pragma unroll
            for (int kb = 0; kb < 2; ++kb) {
#pragma unroll
                for (int i = 0; i < 16; ++i) sacc[kb][i] = 0.f;
#pragma unroll
                for (int s = 0; s < 8; ++s) { const bf16x8 kf = *(const LAS bf16x8*)(Kt + kro + (kb * 8 + s) * 1024); sacc[kb] = __builtin_amdgcn_mfma_f32_32x32x16_bf16(kf, qf[s], sacc[kb], 0, 0, 0); }
            }
            float after = R;
            unsigned pp[2][8];
            const int qabs = q0w + r32;
#pragma unroll
            for (int kb = 1; kb >= 0; --kb)
#pragma unroll
                for (int g = 3; g >= 0; --g) {
                    float L[4], lb[4]; bool vd[4];
#pragma unroll
                    for (int j = 0; j < 4; ++j) {
                        const float z2 = sacc[kb][4 * g + j] * k1 + k2;
                        const float x = __builtin_amdgcn_exp2f(-fabsf(z2));
                        const float t = __builtin_amdgcn_logf(1.0f + x);
                        L[j] = fminf(-z2, 0.f) - t; lb[j] = z2 + L[j];
                        vd[j] = true;
                        if (diag) { vd[j] = (k0 + 32 * kb + 8 * g + 4 * hh + j) < qabs; L[j] = vd[j] ? L[j] : 0.f; }
                    }
                    const float s3 = L[3], s2 = L[2] + s3, s1 = L[1] + s2, s0 = L[0] + s1;
                    const float p4 = __shfl_xor(s0, 32);
                    const float base = after + (hh == 0 ? p4 : 0.f);
                    float a0 = __builtin_amdgcn_exp2f(lb[0] + s1 + base), a1 = __builtin_amdgcn_exp2f(lb[1] + s2 + base), a2 = __builtin_amdgcn_exp2f(lb[2] + s3 + base), a3 = __builtin_amdgcn_exp2f(lb[3] + base);
                    if (diag) { a0 = vd[0] ? a0 : 0.f; a1 = vd[1] ? a1 : 0.f; a2 = vd[2] ? a2 : 0.f; a3 = vd[3] ? a3 : 0.f; }
                    after += s0 + p4;
                    pp[kb][2 * g] = cvt2bf(a0, a1); pp[kb][2 * g + 1] = cvt2bf(a2, a3);
                }
            R = after;
#pragma unroll
            for (int kb = 0; kb < 2; ++kb)
#pragma unroll
                for (int sp = 0; sp < 2; ++sp) {
                    const v4u pw = {pp[kb][4 * sp], pp[kb][4 * sp + 1], pp[kb][4 * sp + 2], pp[kb][4 * sp + 3]};
                    const bf16x8 pf = __builtin_bit_cast(bf16x8, pw);
                    const int keybase = 32 * kb + 16 * sp;
#pragma unroll
                    for (int db = 0; db < 4; ++db) {
                        const s16x4 lo = __builtin_amdgcn_ds_read_tr16_b64_v4i16((LAS s16x4*)(Vt + vro + ((keybase >> 3) * 4 + db) * 512));
                        const s16x4 hi = __builtin_amdgcn_ds_read_tr16_b64_v4i16((LAS s16x4*)(Vt + vro + (((keybase >> 3) + 1) * 4 + db) * 512));
                        const bf16x8 vf = __builtin_shufflevector(lo, hi, 0, 1, 2, 3, 4, 5, 6, 7);
                        oacc[db] = __builtin_amdgcn_mfma_f32_32x32x16_bf16(vf, pf, oacc[db], 0, 0, 0);
                    }
                }
        }
        if (it + 1 < nt) SB_WRITE(buf ^ 1);
        __syncthreads();
    }
#undef SB_LOAD
#undef SB_WRITE
    float ss = 0.f;
#pragma unroll
    for (int d = 0; d < 4; ++d)
#pragma unroll
        for (int i = 0; i < 16; ++i) ss += oacc[d][i] * oacc[d][i];
    ss += __shfl_xor(ss, 32);
    const float rs = rsqrtf(ss * (1.f / HD) + EPS);
    const float* nw = F.in[13];
    bf16* op = MIX + ((size_t)b * T + q0w + r32) * D + h * HD + 4 * hh;
#pragma unroll
    for (int d = 0; d < 4; ++d)
#pragma unroll
        for (int g = 0; g < 4; ++g) { const int dd = 32 * d + 8 * g + 4 * hh; const f32x4 w4 = *(const f32x4*)(nw + dd);
            v2u w; w.x = cvt2bf(oacc[d][4 * g] * rs * w4.x, oacc[d][4 * g + 1] * rs * w4.y); w.y = cvt2bf(oacc[d][4 * g + 2] * rs * w4.z, oacc[d][4 * g + 3] * rs * w4.w);
            *(v2u*)(op + 32 * d + 8 * g) = w; }
}

__device__ __forceinline__ void p2_mixers(Frame& F) {
    const int gw = F.bid * NWAVES + F.wave, NGW = F.G * NWAVES;
    for (int it = gw; it < NB * NH * 32; it += NGW) {
        const int chain = it >> 5, slice = it & 31, b = chain >> 3, h = chain & 7;
        gdn_recur_wave<true>(WSP(float, WS_GQ), WSP(float, WS_GK), WSP(float, WS_GV), WSP(float, WS_G), WSP(float, WS_BETA), GW, NH, (size_t)b * T, T, h, slice,
                             nullptr, F.out + OUT_GREC + (size_t)chain * HD * HD, WSP(float, WS_GO), F.lane);
    }
    for (int it = gw; it < MS * NH * 32; it += NGW) {
        const int chain = it >> 5, slice = it & 31, b = chain >> 3, h = chain & 7;
        gdn_recur_wave<false>(SSP(S_GQ), SSP(S_GK), SSP(S_GV), SSP(S_G), SSP(S_BETA), GW, NH, (size_t)b, 1, h, slice,
                              F.in[6] + (size_t)chain * HD * HD, F.out + OUT_GRECS + (size_t)chain * HD * HD, SSP(S_GO), F.lane);
    }
    for (int it = gw; it < MS * NH * DSEG; it += NGW) { const int bh = it / DSEG, seg = it % DSEG; sb_decode_segment(F, bh >> 3, bh & 7, seg); }
    __syncthreads();
    for (int u = F.bid; u < NB * NH * 16; u += F.G) { const int bh = u & 15, qb = u >> 4; sb_attn_unit(F, bh >> 3, bh & 7, qb); }
}

__device__ __forceinline__ void p2_finish(Frame& F) {
    const int gw = F.bid * NWAVES + F.wave, NGW = F.G * NWAVES;
    const float* GO = WSP(float, WS_GO); const bf16* Zb = WSP(bf16, WS_Z); bf16* MIX = WSP(bf16, WS_MIX); const float* gnw = F.in[17];
    for (int it = gw; it < M * NH; it += NGW) {
        const int row = it >> 3, h = it & 7;
        const f32x2 o = *(const f32x2*)(GO + (size_t)row * GW + h * HD + 2 * F.lane);
        const float rs = rsqrtf(wave_sum(o.x * o.x + o.y * o.y) * (1.f / HD) + EPS);
        const unsigned zw = *(const unsigned*)(Zb + (size_t)row * GW + h * HD + 2 * F.lane);
        *(unsigned*)(MIX + (size_t)row * D + SBW + h * HD + 2 * F.lane) = pk2(o.x * rs * gnw[2 * F.lane] * silu_f(bf_lo(zw)), o.y * rs * gnw[2 * F.lane + 1] * silu_f(bf_hi(zw)));
    }
    if (F.bid == F.G - 1) {
        for (int bh = F.wave; bh < MS * NH; bh += NWAVES) {
            const int b = bh >> 3, h = bh & 7;
            { const f32x2 o = *(const f32x2*)(SSP(S_GO) + (size_t)b * GW + h * HD + 2 * F.lane);
              const float rs = rsqrtf(wave_sum(o.x * o.x + o.y * o.y) * (1.f / HD) + EPS);
              const float* z = SSP(S_PROJ) + (size_t)b * IN_COLS + O_GZ + h * HD + 2 * F.lane;
              float* mo = SSP(S_MIX) + (size_t)b * D + SBW + h * HD + 2 * F.lane;
              mo[0] = o.x * rs * gnw[2 * F.lane] * silu_f(z[0]); mo[1] = o.y * rs * gnw[2 * F.lane + 1] * silu_f(z[1]); }
            { float o0 = 0.f, o1 = 0.f, R = 0.f;
              for (int seg = DSEG - 1; seg >= 0; --seg) { const float* P = SSP(S_PART) + ((size_t)bh * DSEG + seg) * DPART; const float e = __expf(R); o0 += e * P[2 * F.lane]; o1 += e * P[2 * F.lane + 1]; R += P[128]; }
              const float rs = rsqrtf(wave_sum(o0 * o0 + o1 * o1) * (1.f / HD) + EPS); const float* nw = F.in[13];
              float* mo = SSP(S_MIX) + (size_t)b * D + h * HD + 2 * F.lane; mo[0] = o0 * rs * nw[2 * F.lane]; mo[1] = o1 * rs * nw[2 * F.lane + 1]; }
        }
    }
}

__device__ __forceinline__ void p4b_fixup(Frame& F) {
    const float* TAIL = WSP(float, WS_TAIL); const float* FIXG = WSP(float, WS_FIXG); const float* FIXU = WSP(float, WS_FIXU); bf16* ACT = WSP(bf16, WS_ACT); const float* cw = F.in[22];
    const int total = 32 * 2 * DFF;
    for (int i = F.bid * 512 + F.tid; i < total; i += F.G * 512) {
        const int pm = i / (2 * DFF), rr = (i / DFF) & 1, c = i % DFF;
        if ((pm & 15) == 0) continue;
        const float t0 = TAIL[((size_t)(pm - 1) * 2 + 0) * DFF + c], t1 = TAIL[((size_t)(pm - 1) * 2 + 1) * DFF + c];
        float g = FIXG[((size_t)pm * 2 + rr) * DFF + c];
        g += (rr == 0) ? (cw[c] * t0 + cw[DFF + c] * t1) : (cw[c] * t1);
        ACT[(size_t)(pm * 256 + rr) * DFF + c] = (bf16)f2bf(silu_f(g) * FIXU[((size_t)pm * 2 + rr) * DFF + c]);
    }
    const float* st = F.in[7]; const float* GP = SSP(S_GP); const float* UP = SSP(S_UP); float* SACT = SSP(S_ACT);
    for (int i = F.bid * 512 + F.tid; i < MS * DFF; i += F.G * 512) {
        const int b = i / DFF, c = i % DFF;
        const float s0 = st[((size_t)b * 2 + 0) * DFF + c], s1 = st[((size_t)b * 2 + 1) * DFF + c], gp = GP[i];
        const float g = cw[c] * s0 + cw[DFF + c] * s1 + cw[2 * DFF + c] * gp;
        SACT[i] = silu_f(g) * UP[i];
        F.out[OUT_FCONVS + ((size_t)b * 2 + 0) * DFF + c] = s1; F.out[OUT_FCONVS + ((size_t)b * 2 + 1) * DFF + c] = gp;
    }
}

__device__ __forceinline__ void p7_final(Frame& F) {
    const int gw = F.bid * NWAVES + F.wave, NGW = F.G * NWAVES;
    const float* fw = F.in[27]; const float* ss3 = (const float*)(F.ctl + CW_SUMSQ3);
    for (int m = gw; m < M; m += NGW) {
        const float rs = rsqrtf(ss3[m] * (1.f / D) + EPS);
        f32x4* y = (f32x4*)(F.out + OUT_Y + (size_t)m * D) + F.lane; const f32x4* w = (const f32x4*)fw + F.lane;
#pragma unroll
        for (int j = 0; j < 8; ++j) y[64 * j] = y[64 * j] * rs * w[64 * j];
    }
    if (F.bid == 0) {
        const int b = F.wave; float v[32]; float s = 0.f;
#pragma unroll
        for (int j = 0; j < 32; ++j) { const int c = F.lane + 64 * j; const float h = SSP(S_H2)[(size_t)b * D + c] + SSP(S_PP)[(size_t)b * D + c] * sigmoid_f(SSP(S_PG)[(size_t)b * D + c]); v[j] = h; s += h * h; }
        const float rs = rsqrtf(wave_sum(s) * (1.f / D) + EPS);
#pragma unroll
        for (int j = 0; j < 32; ++j) { const int c = F.lane + 64 * j; F.out[OUT_YS + (size_t)b * D + c] = v[j] * rs * fw[c]; }
    }
}

constexpr int NPHASES = 12;
constexpr int N_LAUNCHES = MK_N_LAUNCHES;
struct Args { const float* in[28]; float* out; unsigned char* ws; int ph_lo, ph_hi; };
__global__ void __launch_bounds__(NWAVES * 64, 2) hymba_fwd(Args args) {
    extern __shared__ __attribute__((aligned(16))) unsigned char lds[];
    Frame F;
    F.lds = (LAS unsigned char*)lds;
    F.MISC = (volatile LAS unsigned*)(F.lds + MISC_OFF);
    F.tid = threadIdx.x; F.lane = F.tid & 63; F.wave = __builtin_amdgcn_readfirstlane(F.tid >> 6);
    F.G = gridDim.x; F.bid = blockIdx.x;
    F.ws = args.ws; F.ctl = (unsigned*)(args.ws + WS_CTL); F.out = args.out;
#pragma unroll
    for (int i = 0; i < 28; ++i) F.in[i] = args.in[i];
    for (int u = F.tid; u < (LDS_BYTES - LDSCTL_OFF) / 4; u += NWAVES * 64) ((LAS unsigned*)(F.lds + LDSCTL_OFF))[u] = 0u;
    __syncthreads();
    XcdBarrier bar; bar.bar = F.ctl + CW_BAR; bar.x = 0; bar.st = nullptr;
    if (N_LAUNCHES == 1) bar = xcd_barrier_post(F.ctl + CW_BAR, F.MISC + 8);
#define GRID_BAR() do { if (N_LAUNCHES == 1) xcd_barrier(bar); } while (0)
    const int lo = args.ph_lo, hi = args.ph_hi;
#define IN(k) (lo <= (k) && (k) < hi)
    float* ss1 = (float*)(F.ctl + CW_SUMSQ1); float* ss2 = (float*)(F.ctl + CW_SUMSQ2); float* ss3 = (float*)(F.ctl + CW_SUMSQ3);

    if (IN(0)) { p0_prologue(F); GRID_BAR(); }
    if (IN(1)) {
        { pg8::Gemm g{WSP(bf16, WS_XN), WSP(bf16, WS_WIN), M, NPROJ_PAD, D}; pg8::StaticOrder S; S.init(M, NPROJ_PAD, F.G, F.bid);
          pg8::EpiProj E{WSP(bf16, WS_Q), WSP(bf16, WS_K), WSP(bf16, WS_V), WSP(bf16, WS_CIN), WSP(bf16, WS_Z), F.out + OUT_K, F.out + OUT_V, F.out + OUT_GCONV, WSP(float, WS_G), WSP(float, WS_BETA), F.in[15], F.in[16]};
          pg8::gemm_phase<pg8::EpiProj, pg8::StaticOrder, true, true>(F.lds + RING_OFF, g, S, E); }
        { pg8::Gemm g{WSP(bf16, WS_PB), WSP(bf16, WS_WPP), M, D, PLE}; pg8::StaticOrder S; S.init(M, D, F.G, F.bid);
          pg8::EpiF32 E{WSP(float, WS_PP), D};
          pg8::gemm_phase<pg8::EpiF32, pg8::StaticOrder, true, true>(F.lds + RING_OFF, g, S, E); }
        { SEpiStore E{SSP(S_PROJ), IN_COLS}; sample_gemv(F, SSP(S_A), D, nullptr, F.in[11], IN_COLS, IN_COLS, E); }
        GRID_BAR();
    }
    if (IN(2)) { gdn_prep_prompt(F); gdn_prep_sample(F); GRID_BAR(); }
    if (IN(3)) { p2_mixers(F); GRID_BAR(); }
    if (IN(4)) { p2_finish(F); GRID_BAR(); }
    if (IN(5)) {
        { pg8::Gemm g{WSP(bf16, WS_MIX), WSP(bf16, WS_WOUT), M, D, D}; pg8::StaticOrder S; S.init(M, D, F.G, F.bid);
          pg8::EpiResid E{F.in[0], WSP(float, WS_H1), WSP(bf16, WS_H1B), ss1, D};
          pg8::gemm_phase<pg8::EpiResid, pg8::StaticOrder, true, true>(F.lds + RING_OFF, g, S, E); }
        { SEpiAdd E{F.in[1], SSP(S_H1), D}; sample_gemv(F, SSP(S_MIX), D, nullptr, F.in[18], D, D, E); }
        GRID_BAR();
    }
    if (IN(6)) {
        { pg8::Gemm g{WSP(bf16, WS_H1B), WSP(bf16, WS_WGU), M, NGU, D}; pg8::StaticOrder S; S.init(M, NGU, F.G, F.bid);
          pg8::EpiGateUp E{ss1, F.in[22], WSP(bf16, WS_ACT), WSP(float, WS_TAIL), WSP(float, WS_FIXG), WSP(float, WS_FIXU), F.out + OUT_FCONV, (PG8_LAS float*)(F.lds + HALO_OFF)};
          pg8::gemm_phase<pg8::EpiGateUp, pg8::StaticOrder, true, true>(F.lds + RING_OFF, g, S, E); }
        { SEpiStore E{SSP(S_GP), DFF}; sample_gemv(F, SSP(S_H1), D, F.in[19], F.in[20], DFF, DFF, E); }
        { SEpiStore E{SSP(S_UP), DFF}; sample_gemv(F, SSP(S_H1), D, F.in[19], F.in[21], DFF, DFF, E); }
        GRID_BAR();
    }
    if (IN(7)) { p4b_fixup(F); GRID_BAR(); }
    if (IN(8)) {
        { pg8::Gemm g{WSP(bf16, WS_ACT), WSP(bf16, WS_WDN), M, D, DFF}; pg8::StaticOrder S; S.init(M, D, F.G, F.bid);
          pg8::EpiResid E{WSP(float, WS_H1), WSP(float, WS_H2), WSP(bf16, WS_H2B), ss2, D};
          pg8::gemm_phase<pg8::EpiResid, pg8::StaticOrder, true, true>(F.lds + RING_OFF, g, S, E); }
        { SEpiAdd E{SSP(S_H1), SSP(S_H2), D}; sample_gemv(F, SSP(S_ACT), DFF, nullptr, F.in[23], D, D, E); }
        GRID_BAR();
    }
    if (IN(9)) {
        { pg8::Gemm g{WSP(bf16, WS_H2B), WSP(bf16, WS_WPG), M, D, D}; pg8::StaticOrder S; S.init(M, D, F.G, F.bid);
          pg8::EpiPle E{WSP(float, WS_H2), WSP(float, WS_PP), ss2, F.out + OUT_Y, ss3, D};
          pg8::gemm_phase<pg8::EpiPle, pg8::StaticOrder, true, true>(F.lds + RING_OFF, g, S, E); }
        { SEpiStore E{SSP(S_PG), D}; sample_gemv(F, SSP(S_H2), D, F.in[24], F.in[25], D, D, E); }
        { SEpiStore E{SSP(S_PP), D}; sample_gemv(F, F.in[9], PLE, nullptr, F.in[26], D, D, E); }
        GRID_BAR();
    }
    if (IN(10)) { p7_final(F); }
#undef IN
#undef GRID_BAR
}

extern "C" void kernel_launch(void* const* d_in, const int* in_sizes, int n_in, void* d_out, int out_size, void* d_ws, size_t ws_size, hipStream_t stream) {
    static int grid = 0;
    if (grid == 0) {
        if (n_in != 28 || (size_t)out_size != OUT_END || ws_size < WS_END) { fprintf(stderr, "kernel_launch: unexpected sizes n_in %d out %d ws %zu (need %zu, %zu)\n", n_in, out_size, ws_size, (size_t)OUT_END, (size_t)WS_END); grid = -1; return; }
        int dev = 0, cus = 0, per_cu = 0;
        if (hipGetDevice(&dev) != hipSuccess || hipDeviceGetAttribute(&cus, hipDeviceAttributeMultiprocessorCount, dev) != hipSuccess) { grid = -1; return; }
        if (hipFuncSetAttribute((const void*)hymba_fwd, hipFuncAttributeMaxDynamicSharedMemorySize, LDS_BYTES) != hipSuccess) { fprintf(stderr, "kernel_launch: hipFuncSetAttribute failed\n"); grid = -1; return; }
        if (hipOccupancyMaxActiveBlocksPerMultiprocessor(&per_cu, (const void*)hymba_fwd, NWAVES * 64, LDS_BYTES) != hipSuccess || per_cu < 1) { fprintf(stderr, "kernel_launch: occupancy query says %d\n", per_cu); }
        (void)hipGetLastError();
        grid = cus;
    }
    if (grid < 0) return;
    (void)hipMemsetAsync((char*)d_ws + WS_CTL, 0, CTL_ZERO_BYTES, stream);
    Args a{};
    for (int i = 0; i < 28; ++i) a.in[i] = (const float*)d_in[i];
    a.out = (float*)d_out; a.ws = (unsigned char*)d_ws;
    if (N_LAUNCHES == 1) { a.ph_lo = 0; a.ph_hi = NPHASES; hipLaunchKernelGGL(hymba_fwd, dim3(grid), dim3(NWAVES * 64), LDS_BYTES, stream, a); }
    else for (int p = 0; p < 11; ++p) { a.ph_lo = p; a.ph_hi = p + 1; hipLaunchKernelGGL(hymba_fwd, dim3(grid), dim3(NWAVES * 64), LDS_BYTES, stream, a); }
}
```

```cpp
#include <hip/hip_runtime.h>
#include <cstdio>
#include <cstdint>

#ifndef MK_N_LAUNCHES
#define MK_N_LAUNCHES 1
#endif

namespace pg8 {
#define PG8_LAS __attribute__((address_space(3)))
typedef unsigned short bf16_t;
typedef short bf16x8 __attribute__((ext_vector_type(8)));
typedef float f32x4 __attribute__((ext_vector_type(4)));
typedef unsigned u32x4 __attribute__((ext_vector_type(4)));
constexpr int BM = 256, BK = 64, HALF = 128, HTB = HALF * BK * 2  , STAGE_BYTES = 8 * HTB, NXCD = 8, WGM = 8;

__host__ __device__ __forceinline__ int lds_byte(int r, int c) { const int st = (r >> 4) * 2 + (c >> 5), rr = r & 15, cc = c & 31, ob = rr * 64 + cc * 2; return st * 1024 + (ob ^ (((ob >> 9) & 1) << 5)); }
__host__ __device__ __forceinline__ void stage_rc(int b, int& R, int& C) { const int st = b / 1024, sb = b % 1024, swz = sb ^ (((sb >> 9) & 1) << 5); R = (st >> 1) * 16 + swz / 64; C = (st & 1) * 32 + (swz % 64) / 2; }
__host__ __device__ __forceinline__ int perm32(int rho) { const int n = rho >> 4, i = rho & 15; return 8 * (i >> 2) + 4 * n + (i & 3); }

struct Unit { int pm, pn; };
struct Gemm { const bf16_t* A; const bf16_t* Bt; int M, N, K; };

struct StaticOrder {
    int nM, nN, nwg, G, c;
    __host__ __device__ void init(int M, int N, int G_, int c_) { nM = M / BM; nN = N / BM; nwg = nM * nN; G = G_; c = c_; }
    __host__ __device__ bool next(int i, Unit& u) const {
        const long L = (long)i * G + c; if (L >= nwg) return false;
        int wgid = (int)L; { const int q = nwg / NXCD, r = nwg % NXCD, xcd = wgid % NXCD, off = wgid / NXCD; wgid = (xcd < r ? xcd * (q + 1) : r * (q + 1) + (xcd - r) * q) + off; }
        const int nig = WGM * nN, gid = wgid / nig, fm = gid * WGM, gsz = (nM - fm) < WGM ? (nM - fm) : WGM;
        u.pm = fm + ((wgid % nig) % gsz); u.pn = (wgid % nig) / gsz; return true;
    }
    __device__ __forceinline__ void a_ready(const Unit&) const {}
    __device__ __forceinline__ void done(const Unit&) const {}
};

__device__ __forceinline__ unsigned cvt_pk_bf16(float lo, float hi) { unsigned r; asm volatile("v_cvt_pk_bf16_f32 %0, %1, %2" : "=v"(r) : "v"(lo), "v"(hi)); return r; }
template <class Epi, class Sched, bool ALIGN_EPI = false, bool SP2 = false>
__device__ __forceinline__ void gemm_phase(PG8_LAS unsigned char* lds, const Gemm g, const Sched& S, const Epi& E) {
    const int tid = threadIdx.x, wid = __builtin_amdgcn_readfirstlane(tid >> 6), lane = tid & 63, wr = wid >> 2, wc = wid & 3, fr = lane & 15, fq = lane >> 4;
    const int K = g.K, nt = K / BK;
    unsigned voffA[2], voffB[2];
#pragma unroll
    for (int i = 0; i < 2; ++i) { int R, C; stage_rc(tid * 16 + i * 8192, R, C); const int Rb = Epi::PERM ? ((R & ~31) + perm32(R & 31)) : R;
        voffA[i] = (unsigned)(R * K + C) * 2u; voffB[i] = (unsigned)(Rb * K + C) * 2u; }
    const size_t kstep = (size_t)(BK * 2);
    const size_t hstep = (size_t)HALF * K * 2;
    const size_t tstep = 2 * hstep;
    const unsigned ldsw = (unsigned)wid * 1024u;
    const int aoff = lds_byte(wr * 64 + fr, fq * 8), boff = lds_byte(wc * 32 + fr, fq * 8);
#define PG8_SA(b, h) (((b) * 2 + (h)) * HTB)
#define PG8_SB(b, h) ((4 + (b) * 2 + (h)) * HTB)
#define PG8_STAGE(bufoff, gbase, voff) do { _Pragma("unroll") for (int _i = 0; _i < 2; ++_i) \
        __builtin_amdgcn_global_load_lds((const unsigned*)((const char*)(gbase) + (voff)[_i]), (PG8_LAS unsigned*)(lds + (bufoff) + ldsw + _i * 8192), 16, 0, 0); } while (0)
#define PG8_LDA(dst, b, h) do { _Pragma("unroll") for (int m = 0; m < 4; ++m) _Pragma("unroll") for (int k = 0; k < 2; ++k) dst[m][k] = *(const PG8_LAS bf16x8*)(lds + PG8_SA(b, h) + aoff + m * 2048 + k * 1024); } while (0)
#define PG8_LDB(dst, b, h) do { _Pragma("unroll") for (int n = 0; n < 2; ++n) _Pragma("unroll") for (int k = 0; k < 2; ++k) dst[n][k] = *(const PG8_LAS bf16x8*)(lds + PG8_SB(b, h) + boff + n * 2048 + k * 1024); } while (0)
#define PG8_MMA(ai, bj, At, Bt) do { __builtin_amdgcn_s_setprio(1); _Pragma("unroll") for (int m = 0; m < 4; ++m) _Pragma("unroll") for (int n = 0; n < 2; ++n) _Pragma("unroll") for (int k = 0; k < 2; ++k) \
        acc[ai][bj][m][n] = __builtin_amdgcn_mfma_f32_16x16x32_bf16(Bt[n][k], At[m][k], acc[ai][bj][m][n], 0, 0, 0); __builtin_amdgcn_s_setprio(0); } while (0)
#define PG8_WAIT_V(n) asm volatile("s_waitcnt vmcnt(" #n ")" ::: "memory")
#define PG8_WAIT_L(n) asm volatile("s_waitcnt lgkmcnt(" #n ")" ::: "memory")
#define PG8_BAR __builtin_amdgcn_s_barrier()
#define PG8_SCHED __builtin_amdgcn_sched_barrier(0)
    Unit cur, nxt; int ui = 0;
    if (!S.next(0, cur)) return;
    f32x4 acc[2][2][4][2];
#pragma unroll
    for (int a = 0; a < 2; ++a)
#pragma unroll
        for (int b = 0; b < 2; ++b)
#pragma unroll
            for (int m = 0; m < 4; ++m)
#pragma unroll
                for (int n = 0; n < 2; ++n) acc[a][b][m][n] = (f32x4){0.f, 0.f, 0.f, 0.f};
    bf16x8 At[4][2], B0[2][2], B1[2][2];
    const char* cA = (const char*)g.A + (size_t)cur.pm * tstep; const char* cB = (const char*)g.Bt + (size_t)cur.pn * tstep;
    S.a_ready(cur);
    if constexpr (SP2) {
        PG8_STAGE(PG8_SB(0, 0), cB, voffB); PG8_STAGE(PG8_SB(0, 1), cB + hstep, voffB); PG8_STAGE(PG8_SA(0, 0), cA, voffA); PG8_STAGE(PG8_SA(0, 1), cA + hstep, voffA);
        if (wr == 1) PG8_BAR;
        PG8_WAIT_V(2); PG8_BAR;
        PG8_STAGE(PG8_SB(1, 0), cB + kstep, voffB); PG8_STAGE(PG8_SA(1, 0), cA + kstep, voffA); PG8_STAGE(PG8_SB(1, 1), cB + hstep + kstep, voffB);
        PG8_WAIT_V(6); PG8_BAR;
    } else {
        PG8_STAGE(PG8_SB(0, 0), cB, voffB); PG8_STAGE(PG8_SA(0, 0), cA, voffA); PG8_STAGE(PG8_SB(0, 1), cB + hstep, voffB); PG8_STAGE(PG8_SA(0, 1), cA + hstep, voffA);
        if (wr == 1) PG8_BAR;
        PG8_WAIT_V(4); PG8_BAR;
        PG8_STAGE(PG8_SB(1, 0), cB + kstep, voffB); PG8_STAGE(PG8_SA(1, 0), cA + kstep, voffA); PG8_STAGE(PG8_SB(1, 1), cB + hstep + kstep, voffB);
        PG8_WAIT_V(6); PG8_BAR;
    }
    for (;;) {
        const bool has_next = S.next(ui + 1, nxt);
        const char* nA = has_next ? (const char*)g.A + (size_t)nxt.pm * tstep : cA; const char* nB = has_next ? (const char*)g.Bt + (size_t)nxt.pn * tstep : cB;
        for (int t = 0; t < nt; t += 2) {
            const bool last = (t == nt - 2);
            const char* a1 = cA + (size_t)(t + 1) * kstep;
            const char* a2 = last ? nA : cA + (size_t)(t + 2) * kstep; const char* b2 = last ? nB : cB + (size_t)(t + 2) * kstep;
            const char* a3 = a2 + kstep; const char* b3 = b2 + kstep;
            if (last && has_next) S.a_ready(nxt);
            if constexpr (SP2) {
            PG8_LDB(B0, 0, 0); PG8_LDB(B1, 0, 1); PG8_SCHED; PG8_LDA(At, 0, 0); PG8_STAGE(PG8_SA(1, 1), a1 + hstep, voffA);
            PG8_WAIT_V(8); PG8_WAIT_L(0); PG8_BAR; PG8_MMA(0, 0, At, B0); PG8_MMA(0, 1, At, B1); PG8_BAR; PG8_SCHED;
            PG8_LDA(At, 0, 1); PG8_STAGE(PG8_SB(0, 0), b2, voffB); PG8_STAGE(PG8_SB(0, 1), b2 + hstep, voffB); PG8_STAGE(PG8_SA(0, 0), a2, voffA);
            PG8_WAIT_V(8); PG8_WAIT_L(0); PG8_BAR; PG8_MMA(1, 0, At, B0); PG8_MMA(1, 1, At, B1); PG8_BAR; PG8_SCHED;
            PG8_LDB(B0, 1, 0); PG8_LDB(B1, 1, 1); PG8_SCHED; PG8_LDA(At, 1, 0); PG8_STAGE(PG8_SA(0, 1), a2 + hstep, voffA);
            PG8_WAIT_V(8); PG8_WAIT_L(0); PG8_BAR; PG8_MMA(0, 0, At, B0); PG8_MMA(0, 1, At, B1); PG8_BAR; PG8_SCHED;
            PG8_LDA(At, 1, 1); PG8_STAGE(PG8_SB(1, 0), b3, voffB); PG8_STAGE(PG8_SB(1, 1), b3 + hstep, voffB); PG8_STAGE(PG8_SA(1, 0), a3, voffA);
            PG8_WAIT_V(8); PG8_WAIT_L(0); PG8_BAR; PG8_MMA(1, 0, At, B0); PG8_MMA(1, 1, At, B1); PG8_BAR; PG8_SCHED;
            } else {
            PG8_LDB(B0, 0, 0); PG8_SCHED; PG8_LDA(At, 0, 0); PG8_STAGE(PG8_SA(1, 1), a1 + hstep, voffA);
            PG8_WAIT_L(8); PG8_BAR; PG8_WAIT_L(0); PG8_MMA(0, 0, At, B0); PG8_BAR; PG8_SCHED;
            PG8_LDB(B1, 0, 1); PG8_STAGE(PG8_SB(0, 0), b2, voffB);
            PG8_BAR; PG8_WAIT_L(0); PG8_MMA(0, 1, At, B1); PG8_BAR;
            PG8_LDA(At, 0, 1); PG8_STAGE(PG8_SA(0, 0), a2, voffA);
            PG8_BAR; PG8_WAIT_L(0); PG8_MMA(1, 0, At, B0); PG8_BAR; PG8_SCHED;
            PG8_STAGE(PG8_SB(0, 1), b2 + hstep, voffB);
            PG8_WAIT_V(6); PG8_BAR; PG8_MMA(1, 1, At, B1); PG8_BAR;
            PG8_LDB(B0, 1, 0); PG8_SCHED; PG8_LDA(At, 1, 0); PG8_STAGE(PG8_SA(0, 1), a2 + hstep, voffA);
            PG8_WAIT_L(8); PG8_BAR; PG8_WAIT_L(0); PG8_MMA(0, 0, At, B0); PG8_BAR; PG8_SCHED;
            PG8_LDB(B1, 1, 1); PG8_STAGE(PG8_SB(1, 0), b3, voffB);
            PG8_BAR; PG8_WAIT_L(0); PG8_MMA(0, 1, At, B1); PG8_BAR;
            PG8_LDA(At, 1, 1); PG8_STAGE(PG8_SA(1, 0), a3, voffA);
            PG8_BAR; PG8_WAIT_L(0); PG8_MMA(1, 0, At, B0); PG8_BAR; PG8_SCHED;
            PG8_STAGE(PG8_SB(1, 1), b3 + hstep, voffB);
            PG8_WAIT_V(6); PG8_BAR; PG8_MMA(1, 1, At, B1); PG8_BAR;
            }
        }
        if constexpr (ALIGN_EPI) { if (wr == 0) PG8_BAR; }
        if constexpr (!Epi::AFTER_DRAIN) { E(acc, cur, wr, wc, fr, fq); S.done(cur); }
        if (!has_next) break;
#pragma unroll
        for (int a = 0; a < 2; ++a)
#pragma unroll
            for (int b = 0; b < 2; ++b)
#pragma unroll
                for (int m = 0; m < 4; ++m)
#pragma unroll
                    for (int n = 0; n < 2; ++n) acc[a][b][m][n] = (f32x4){0.f, 0.f, 0.f, 0.f};
        cur = nxt; cA = nA; cB = nB; ++ui;
        if constexpr (ALIGN_EPI) { if (wr == 1) PG8_BAR; }
    }
    PG8_WAIT_V(0);
    if constexpr (!ALIGN_EPI) { if (wr == 0) PG8_BAR; }
    PG8_BAR;
    if constexpr (Epi::AFTER_DRAIN) { E.fused(acc, cur, wr, wc, fr, fq, lds, wid, lane); S.done(cur); }
#undef PG8_SA
#undef PG8_SB
#undef PG8_STAGE
#undef PG8_LDA
#undef PG8_LDB
#undef PG8_MMA
#undef PG8_WAIT_V
#undef PG8_WAIT_L
#undef PG8_BAR
#undef PG8_SCHED
}
}

constexpr int D = 2048, T = 4096, NB = 2, M = NB * T;
constexpr int MS = 8;
constexpr int HD = 128, NH = 8, SBW = NH * HD, GW = NH * HD;
constexpr int CONVCH = 3 * GW;
constexpr int IN_COLS = 7184, NPROJ_PAD = 7424;
constexpr int DFF = 5504, NGU = 2 * DFF;
constexpr int PLE = 256;
constexpr int PAST = 16384, PAGE = 128, NPAGES = PAST / PAGE, NPOOL = 1280;
constexpr float EPS = 1e-6f;
constexpr float SB_SCALE = 0.08838834764831845f;
constexpr int O_SB_K = 1024, O_SB_V = 2048, O_GQKV = 3072, O_GZ = 6144, O_GA = 7168, O_GB = 7176;

constexpr size_t OUT_Y = 0;
constexpr size_t OUT_YS = OUT_Y + (size_t)M * D;
constexpr size_t OUT_K = OUT_YS + (size_t)MS * D;
constexpr size_t OUT_V = OUT_K + (size_t)M * SBW;
constexpr size_t OUT_GCONV = OUT_V + (size_t)M * SBW;
constexpr size_t OUT_GREC = OUT_GCONV + (size_t)NB * 3 * CONVCH;
constexpr size_t OUT_FCONV = OUT_GREC + (size_t)NB * NH * HD * HD;
constexpr size_t OUT_KS = OUT_FCONV + (size_t)NB * 2 * DFF;
constexpr size_t OUT_VS = OUT_KS + (size_t)MS * SBW;
constexpr size_t OUT_GCONVS = OUT_VS + (size_t)MS * SBW;
constexpr size_t OUT_GRECS = OUT_GCONVS + (size_t)MS * 3 * CONVCH;
constexpr size_t OUT_FCONVS = OUT_GRECS + (size_t)MS * NH * HD * HD;
constexpr size_t OUT_END = OUT_FCONVS + (size_t)MS * 2 * DFF;

namespace pg8 {
__device__ __forceinline__ float silu_f(float x) { return x / (1.0f + __expf(-x)); }
__device__ __forceinline__ float sigmoid_f(float x) { return 1.0f / (1.0f + __expf(-x)); }
__device__ __forceinline__ float softplus_f(float x) { return fmaxf(x, 0.f) + log1pf(__expf(-fabsf(x))); }
typedef unsigned u32x2 __attribute__((ext_vector_type(2)));

struct EpiProj {
    static constexpr bool PERM = true, AFTER_DRAIN = false;
    bf16_t *Qb, *Kb, *Vb, *CIN, *Zb; float *outK, *outV, *outGconv; float *G, *BETA; const float *a_log, *dt_bias;
    __device__ __forceinline__ void operator()(const f32x4 (&acc)[2][2][4][2], const Unit& u, int wr, int wc, int fr, int fq) const {
        const int reg = u.pn >> 2;
#pragma unroll
        for (int ai = 0; ai < 2; ++ai)
#pragma unroll
            for (int m = 0; m < 4; ++m) {
                const int r = u.pm * BM + ai * HALF + wr * 64 + m * 16 + fr;
#pragma unroll
                for (int bj = 0; bj < 2; ++bj) {
                    const int c8 = u.pn * BM + bj * HALF + wc * 32 + 8 * fq;
                    const f32x4 v0 = acc[ai][bj][m][0], v1 = acc[ai][bj][m][1];
                    u32x4 w; w.x = cvt_pk_bf16(v0[0], v0[1]); w.y = cvt_pk_bf16(v0[2], v0[3]); w.z = cvt_pk_bf16(v1[0], v1[1]); w.w = cvt_pk_bf16(v1[2], v1[3]);
                    if (reg == 0) { *(u32x4*)(Qb + (size_t)r * SBW + c8) = w; }
                    else if (reg == 1) { const int c = c8 - O_SB_K; *(u32x4*)(Kb + (size_t)r * SBW + c) = w; float* o = outK + (size_t)r * SBW + c; *(f32x4*)o = v0; *(f32x4*)(o + 4) = v1; }
                    else if (reg == 2) { const int c = c8 - O_SB_V; *(u32x4*)(Vb + (size_t)r * SBW + c) = w; float* o = outV + (size_t)r * SBW + c; *(f32x4*)o = v0; *(f32x4*)(o + 4) = v1; }
                    else if (reg < 6) { const int c = c8 - O_GQKV; *(u32x4*)(CIN + (size_t)r * CONVCH + c) = w;
                        const int t = r & (T - 1); if (t >= T - 3) { float* o = outGconv + ((size_t)(r >> 12) * 3 + (t - (T - 3))) * CONVCH + c; *(f32x4*)o = v0; *(f32x4*)(o + 4) = v1; } }
                    else if (reg == 6) { const int c = c8 - O_GZ; *(u32x4*)(Zb + (size_t)r * GW + c) = w; }
                    else if (bj == 0 && wc == 0 && fq < 2 && u.pn == 28) {
                        float x[8] = {v0[0], v0[1], v0[2], v0[3], v1[0], v1[1], v1[2], v1[3]}; float y[8];
#pragma unroll
                        for (int h = 0; h < 8; ++h) y[h] = (fq == 0) ? -__expf(a_log[h]) * softplus_f(x[h] + dt_bias[h]) : sigmoid_f(x[h]);
                        float* o = (fq == 0 ? G : BETA) + (size_t)r * NH; *(f32x4*)o = (f32x4){y[0], y[1], y[2], y[3]}; *(f32x4*)(o + 4) = (f32x4){y[4], y[5], y[6], y[7]};
                    }
                }
            }
    }
};

struct EpiF32 {
    static constexpr bool PERM = false, AFTER_DRAIN = false;
    float* C; int ldc;
    __device__ __forceinline__ void operator()(const f32x4 (&acc)[2][2][4][2], const Unit& u, int wr, int wc, int fr, int fq) const {
        const int row0 = u.pm * BM + wr * 64 + fr, col0 = u.pn * BM + wc * 32 + 4 * fq;
#pragma unroll
        for (int ai = 0; ai < 2; ++ai)
#pragma unroll
            for (int m = 0; m < 4; ++m) { float* rowp = C + (size_t)(row0 + ai * HALF + m * 16) * ldc + col0;
#pragma unroll
                for (int bj = 0; bj < 2; ++bj)
#pragma unroll
                    for (int n = 0; n < 2; ++n) *(f32x4*)(rowp + bj * HALF + n * 16) = acc[ai][bj][m][n]; }
    }
};

struct EpiResid {
    static constexpr bool PERM = false, AFTER_DRAIN = false;
    const float* base; float* Hf; bf16_t* Hb; float* sumsq; int ldc;
    __device__ __forceinline__ void operator()(const f32x4 (&acc)[2][2][4][2], const Unit& u, int wr, int wc, int fr, int fq) const {
        const int row0 = u.pm * BM + wr * 64 + fr, col0 = u.pn * BM + wc * 32 + 4 * fq;
#pragma unroll
        for (int ai = 0; ai < 2; ++ai)
#pragma unroll
            for (int m = 0; m < 4; ++m) { const int r = row0 + ai * HALF + m * 16; const size_t off = (size_t)r * ldc + col0; float ss = 0.f;
#pragma unroll
                for (int bj = 0; bj < 2; ++bj)
#pragma unroll
                    for (int n = 0; n < 2; ++n) { const f32x4 b = *(const f32x4*)(base + off + bj * HALF + n * 16); const f32x4 h = b + acc[ai][bj][m][n];
                        *(f32x4*)(Hf + off + bj * HALF + n * 16) = h; u32x2 w; w.x = cvt_pk_bf16(h[0], h[1]); w.y = cvt_pk_bf16(h[2], h[3]); *(u32x2*)(Hb + off + bj * HALF + n * 16) = w;
                        ss += (h[0] * h[0] + h[1] * h[1]) + (h[2] * h[2] + h[3] * h[3]); }
                ss += __shfl_xor(ss, 16); ss += __shfl_xor(ss, 32);
                if (fq == 0) unsafeAtomicAdd(sumsq + r, ss); }
    }
};

struct EpiGateUp {
    static constexpr bool PERM = true, AFTER_DRAIN = false;
    const float* sumsq; const float* convw; bf16_t* ACT; float* TAIL; float* FIXG; float* FIXU; float* outFconv; PG8_LAS float* halo;
    __device__ __forceinline__ void operator()(const f32x4 (&acc)[2][2][4][2], const Unit& u, int wr, int wc, int fr, int fq) const {
        const int lane = fr + 16 * fq;
        const int cg = u.pn * HALF + wc * 32 + 8 * fq;
        float w0[8], w1[8], w2[8];
#pragma unroll
        for (int j = 0; j < 8; ++j) { w0[j] = convw[cg + j]; w1[j] = convw[DFF + cg + j]; w2[j] = convw[2 * DFF + cg + j]; }
        float gp[2][4][8], up[2][4][8];
#pragma unroll
        for (int ai = 0; ai < 2; ++ai)
#pragma unroll
            for (int m = 0; m < 4; ++m) { const int r = u.pm * BM + ai * HALF + wr * 64 + m * 16 + fr; const float rs = rsqrtf(sumsq[r] * (1.0f / D) + EPS);
#pragma unroll
                for (int n = 0; n < 2; ++n)
#pragma unroll
                    for (int j = 0; j < 4; ++j) { gp[ai][m][4 * n + j] = acc[ai][0][m][n][j] * rs; up[ai][m][4 * n + j] = acc[ai][1][m][n][j] * rs; } }
        if (fr >= 14) {
#pragma unroll
            for (int ai = 0; ai < 2; ++ai) { PG8_LAS float* hp = halo + ((wc * 4 + (2 * ai + wr)) * 2 + (fr - 14)) * 32 + 8 * fq;
                *(PG8_LAS f32x4*)hp = (f32x4){gp[ai][3][0], gp[ai][3][1], gp[ai][3][2], gp[ai][3][3]}; *(PG8_LAS f32x4*)(hp + 4) = (f32x4){gp[ai][3][4], gp[ai][3][5], gp[ai][3][6], gp[ai][3][7]}; }
        }
        asm volatile("s_waitcnt lgkmcnt(0)" ::: "memory"); __builtin_amdgcn_s_barrier(); asm volatile("" ::: "memory");
        const int src1 = (lane & 48) | ((fr - 1) & 15), src2 = (lane & 48) | ((fr - 2) & 15);
#pragma unroll
        for (int ai = 0; ai < 2; ++ai) {
            const int B = 2 * ai + wr;
            float h62[8], h63[8];
            if (B > 0) { const PG8_LAS float* hp = halo + ((wc * 4 + (B - 1)) * 2) * 32 + 8 * fq;
                const f32x4 a0 = *(const PG8_LAS f32x4*)hp, a1 = *(const PG8_LAS f32x4*)(hp + 4), b0 = *(const PG8_LAS f32x4*)(hp + 32), b1 = *(const PG8_LAS f32x4*)(hp + 36);
#pragma unroll
                for (int j = 0; j < 4; ++j) { h62[j] = a0[j]; h62[4 + j] = a1[j]; h63[j] = b0[j]; h63[4 + j] = b1[j]; } }
            else {
#pragma unroll
                for (int j = 0; j < 8; ++j) { h62[j] = 0.f; h63[j] = 0.f; } }
            float ps1[8], ps2[8];
#pragma unroll
            for (int j = 0; j < 8; ++j) { ps1[j] = h63[j]; ps2[j] = (fr == 0) ? h62[j] : h63[j]; }
#pragma unroll
            for (int m = 0; m < 4; ++m) {
                const int r = u.pm * BM + ai * HALF + wr * 64 + m * 16 + fr;
                float gate[8], a[8];
#pragma unroll
                for (int j = 0; j < 8; ++j) {
                    const float s1 = __shfl(gp[ai][m][j], src1), s2 = __shfl(gp[ai][m][j], src2);
                    const float p1 = (fr >= 1) ? s1 : ps1[j], p2 = (fr >= 2) ? s2 : ps2[j];
                    ps1[j] = s1; ps2[j] = s2;
                    gate[j] = w0[j] * p2 + w1[j] * p1 + w2[j] * gp[ai][m][j];
                    a[j] = silu_f(gate[j]) * up[ai][m][j];
                }
                u32x4 w; w.x = cvt_pk_bf16(a[0], a[1]); w.y = cvt_pk_bf16(a[2], a[3]); w.z = cvt_pk_bf16(a[4], a[5]); w.w = cvt_pk_bf16(a[6], a[7]);
                *(u32x4*)(ACT + (size_t)r * DFF + cg) = w;
                if (B == 0 && m == 0 && fr < 2 && (u.pm & 15) != 0) {
                    float* fg = FIXG + ((size_t)u.pm * 2 + fr) * DFF + cg; float* fu = FIXU + ((size_t)u.pm * 2 + fr) * DFF + cg;
                    *(f32x4*)fg = (f32x4){gate[0], gate[1], gate[2], gate[3]}; *(f32x4*)(fg + 4) = (f32x4){gate[4], gate[5], gate[6], gate[7]};
                    *(f32x4*)fu = (f32x4){up[ai][m][0], up[ai][m][1], up[ai][m][2], up[ai][m][3]}; *(f32x4*)(fu + 4) = (f32x4){up[ai][m][4], up[ai][m][5], up[ai][m][6], up[ai][m][7]};
                }
                if (B == 3 && m == 3 && fr >= 14) {
                    float* tp = TAIL + ((size_t)u.pm * 2 + (fr - 14)) * DFF + cg;
                    *(f32x4*)tp = (f32x4){gp[ai][m][0], gp[ai][m][1], gp[ai][m][2], gp[ai][m][3]}; *(f32x4*)(tp + 4) = (f32x4){gp[ai][m][4], gp[ai][m][5], gp[ai][m][6], gp[ai][m][7]};
                    if ((u.pm & 15) == 15) { float* op = outFconv + ((size_t)(u.pm >> 4) * 2 + (fr - 14)) * DFF + cg;
                        *(f32x4*)op = (f32x4){gp[ai][m][0], gp[ai][m][1], gp[ai][m][2], gp[ai][m][3]}; *(f32x4*)(op + 4) = (f32x4){gp[ai][m][4], gp[ai][m][5], gp[ai][m][6], gp[ai][m][7]}; }
                }
            }
        }
    }
};

struct EpiPle {
    static constexpr bool PERM = false, AFTER_DRAIN = false;
    const float* H2; const float* PP; const float* sumsq2; float* H3; float* sumsq3; int ldc;
    __device__ __forceinline__ void operator()(const f32x4 (&acc)[2][2][4][2], const Unit& u, int wr, int wc, int fr, int fq) const {
        const int row0 = u.pm * BM + wr * 64 + fr, col0 = u.pn * BM + wc * 32 + 4 * fq;
#pragma unroll
        for (int ai = 0; ai < 2; ++ai)
#pragma unroll
            for (int m = 0; m < 4; ++m) { const int r = row0 + ai * HALF + m * 16; const size_t off = (size_t)r * ldc + col0; float ss = 0.f;
                const float rs = rsqrtf(sumsq2[r] * (1.0f / D) + EPS);
#pragma unroll
                for (int bj = 0; bj < 2; ++bj)
#pragma unroll
                    for (int n = 0; n < 2; ++n) { const f32x4 b = *(const f32x4*)(H2 + off + bj * HALF + n * 16), p = *(const f32x4*)(PP + off + bj * HALF + n * 16); const f32x4 a = acc[ai][bj][m][n]; f32x4 h;
#pragma unroll
                        for (int j = 0; j < 4; ++j) h[j] = b[j] + p[j] * sigmoid_f(a[j] * rs);
                        *(f32x4*)(H3 + off + bj * HALF + n * 16) = h; ss += (h[0] * h[0] + h[1] * h[1]) + (h[2] * h[2] + h[3] * h[3]); }
                ss += __shfl_xor(ss, 16); ss += __shfl_xor(ss, 32);
                if (fq == 0) unsafeAtomicAdd(sumsq3 + r, ss); }
    }
};
}

constexpr size_t MiB = 1u << 20;
constexpr size_t WS_CTL = 0, CTL_ZERO_BYTES = 1 * MiB;
constexpr int CW_BAR = 4096;
constexpr int CW_SUMSQ1 = 32768, CW_SUMSQ2 = CW_SUMSQ1 + M, CW_SUMSQ3 = CW_SUMSQ2 + M;
static_assert((CW_SUMSQ3 + M) * 4 <= (int)CTL_ZERO_BYTES, "ctl");
constexpr size_t WS_WIN = 2 * MiB;
constexpr size_t WS_WOUT = WS_WIN + (size_t)NPROJ_PAD * D * 2;
constexpr size_t WS_WGU = WS_WOUT + (size_t)D * D * 2;
constexpr size_t WS_WDN = WS_WGU + (size_t)NGU * D * 2;
constexpr size_t WS_WPG = WS_WDN + (size_t)D * DFF * 2;
constexpr size_t WS_WPP = WS_WPG + (size_t)D * D * 2;
constexpr size_t WS_XN = WS_WPP + (size_t)D * PLE * 2;
constexpr size_t WS_PB = WS_XN + (size_t)M * D * 2;
constexpr size_t WS_Q = WS_PB + (size_t)M * PLE * 2;
constexpr size_t WS_K = WS_Q + (size_t)M * SBW * 2;
constexpr size_t WS_V = WS_K + (size_t)M * SBW * 2;
constexpr size_t WS_CIN = WS_V + (size_t)M * SBW * 2;
constexpr size_t WS_Z = WS_CIN + (size_t)M * CONVCH * 2;
constexpr size_t WS_G = WS_Z + (size_t)M * GW * 2;
constexpr size_t WS_BETA = WS_G + (size_t)M * NH * 4;
constexpr size_t WS_GQ = WS_BETA + (size_t)M * NH * 4;
constexpr size_t WS_GK = WS_GQ + (size_t)M * GW * 4;
constexpr size_t WS_GV = WS_GK + (size_t)M * GW * 4;
constexpr size_t WS_GO = WS_GV + (size_t)M * GW * 4;
constexpr size_t WS_MIX = WS_GO + (size_t)M * GW * 4;
constexpr size_t WS_H1 = WS_MIX + (size_t)M * D * 2;
constexpr size_t WS_H1B = WS_H1 + (size_t)M * D * 4;
constexpr size_t WS_ACT = WS_H1B + (size_t)M * D * 2;
constexpr size_t WS_TAIL = WS_ACT + (size_t)M * DFF * 2;
constexpr size_t WS_FIXG = WS_TAIL + (size_t)32 * 2 * DFF * 4;
constexpr size_t WS_FIXU = WS_FIXG + (size_t)32 * 2 * DFF * 4;
constexpr size_t WS_H2 = WS_FIXU + (size_t)32 * 2 * DFF * 4;
constexpr size_t WS_H2B = WS_H2 + (size_t)M * D * 4;
constexpr size_t WS_PP = WS_H2B + (size_t)M * D * 2;
constexpr size_t WS_S = WS_PP + (size_t)M * D * 4;
constexpr size_t S_A = 0;
constexpr size_t S_PROJ = S_A + MS * D;
constexpr size_t S_GQ = S_PROJ + MS * IN_COLS;
constexpr size_t S_GK = S_GQ + MS * GW;
constexpr size_t S_GV = S_GK + MS * GW;
constexpr size_t S_G = S_GV + MS * GW;
constexpr size_t S_BETA = S_G + 64;
constexpr size_t S_GO = S_BETA + 64;
constexpr size_t S_PART = S_GO + MS * GW;
constexpr int DSEG = 32, DPART = 132;
constexpr size_t S_MIX = S_PART + (size_t)MS * NH * DSEG * DPART;
constexpr size_t S_H1 = S_MIX + MS * D;
constexpr size_t S_GP = S_H1 + MS * D;
constexpr size_t S_UP = S_GP + MS * DFF;
constexpr size_t S_ACT = S_UP + MS * DFF;
constexpr size_t S_H2 = S_ACT + MS * DFF;
constexpr size_t S_PG = S_H2 + MS * D;
constexpr size_t S_PP = S_PG + MS * D;
constexpr size_t S_END = S_PP + MS * D;
constexpr size_t WS_GREC = ((WS_S + S_END * 4 + 4095) / 4096) * 4096;
constexpr size_t WS_GEG = WS_GREC + (size_t)16 * 64 * 73728;
constexpr size_t WS_END = WS_GEG + 16 * 64 * 4;

constexpr int RING_OFF = 0, RING_BYTES = 131072;
constexpr int HALO_OFF = RING_BYTES;
constexpr int LDSCTL_OFF = RING_BYTES + 8192, MISC_OFF = LDSCTL_OFF + 320;
constexpr int LDS_BYTES = 147456;
constexpr int NWAVES = 8;

#define GAS __attribute__((address_space(1)))
#define LAS __attribute__((address_space(3)))
typedef unsigned short bf16;
typedef unsigned v4u __attribute__((ext_vector_type(4)));
typedef unsigned v2u __attribute__((ext_vector_type(2)));
typedef float f32x4 __attribute__((ext_vector_type(4)));
typedef float f32x2 __attribute__((ext_vector_type(2)));
typedef GAS unsigned gu32;
#define RLX_AGENT __ATOMIC_RELAXED, __HIP_MEMORY_SCOPE_AGENT
#define LDS_WAIT() asm volatile("s_waitcnt lgkmcnt(0)" ::: "memory")
#define VM_WAIT() asm volatile("s_waitcnt vmcnt(0)" ::: "memory")
__device__ __forceinline__ unsigned f2bf(float f) { unsigned u = __builtin_bit_cast(unsigned, f); return (u + 0x7fffu + ((u >> 16) & 1u)) >> 16; }
__device__ __forceinline__ unsigned pk2(float lo, float hi) { return f2bf(lo) | (f2bf(hi) << 16); }
__device__ __forceinline__ float bf_lo(unsigned w) { return __builtin_bit_cast(float, w << 16); }
__device__ __forceinline__ float bf_hi(unsigned w) { return __builtin_bit_cast(float, w & 0xffff0000u); }
__device__ __forceinline__ float bf2f(bf16 b) { return __builtin_bit_cast(float, (unsigned)b << 16); }
using pg8::silu_f; using pg8::sigmoid_f; using pg8::softplus_f;

#define XB_TMO      128
#define XB_XCNT(j)  (256  + 64 * (j))
#define XB_XSUB(j)  (1280 + 64 * (j))
#define XB_XGEN(j)  (2304 + 64 * (j))
#define XB_TOP      3328
#define XB_TOPGEN   3392
#define XCD_BAR_WORDS 3456
#define XB_SPIN_CAP (1u << 18)
__device__ __forceinline__ unsigned xb_ld(unsigned* p)              { return __hip_atomic_load(p, __ATOMIC_RELAXED, __HIP_MEMORY_SCOPE_AGENT); }
__device__ __forceinline__ unsigned xb_add(unsigned* p, unsigned v) { return __hip_atomic_fetch_add(p, v, __ATOMIC_RELAXED, __HIP_MEMORY_SCOPE_AGENT); }
__device__ __forceinline__ unsigned xb_xcc_id() { return (unsigned)__builtin_amdgcn_s_getreg((3 << 11) | 20) & 0xFu; }
#define XB_SPIN(cond, bar) do { unsigned _sp = 0; while (cond) { __builtin_amdgcn_s_sleep(1); \
    if ((++_sp & 255u) == 0u) { if (xb_ld(&(bar)[XB_TMO])) break; if (_sp > XB_SPIN_CAP) { atomicAdd(&(bar)[XB_TMO], 1u); break; } } } } while (0)
struct XcdBarrier { unsigned* bar; unsigned x; volatile LAS unsigned* st; };
__device__ __forceinline__ XcdBarrier xcd_barrier_post(unsigned* bar, volatile LAS unsigned* st) {
    XcdBarrier b; b.bar = bar; b.x = xb_xcc_id(); b.st = st;
    if (threadIdx.x == 0) (void)xb_add(&bar[XB_XCNT(b.x)], 1u);
    return b;
}
__device__ __forceinline__ void xcd_barrier_complete(unsigned* bar, unsigned x, unsigned& nloc, unsigned& nx) {
    const unsigned G = gridDim.x * gridDim.y * gridDim.z;
    unsigned sum, cnt, mine, sp = 0u;
    for (;;) {
        sum = 0u; cnt = 0u; mine = 0u;
#pragma unroll
        for (unsigned j = 0; j < 16; ++j) { const unsigned c = xb_ld(&bar[XB_XCNT(j)]); sum += c; cnt += (c > 0u) ? 1u : 0u; mine = (j == x) ? c : mine; }
        if (sum == G) break;
        __builtin_amdgcn_s_sleep(1);
        if ((++sp & 255u) == 0u) { if (xb_ld(&bar[XB_TMO])) break; if (sp > XB_SPIN_CAP) { atomicAdd(&bar[XB_TMO], 1u); break; } }
    }
    nloc = mine > 0u ? mine : 1u; nx = cnt > 0u ? cnt : 1u;
}
__device__ __forceinline__ void xcd_barrier(const XcdBarrier& b) {
    asm volatile("s_waitcnt vmcnt(0)" ::: "memory");
    __syncthreads();
    if (threadIdx.x == 0) {
        unsigned* bar = b.bar;
        __builtin_amdgcn_s_waitcnt(0);
        unsigned nloc = b.st[0], nx = b.st[1];
        if (nloc == 0u) { xcd_barrier_complete(bar, b.x, nloc, nx); b.st[0] = nloc; b.st[1] = nx; }
        const unsigned old = xb_add(&bar[XB_XSUB(b.x)], 1u);
        const unsigned gen = old / nloc;
        if (old + 1u == (gen + 1u) * nloc) {
            __builtin_amdgcn_fence(__ATOMIC_RELEASE, "agent");
            asm volatile("s_waitcnt vmcnt(0)" ::: "memory");
            const unsigned og = xb_add(&bar[XB_TOP], 1u);
            const unsigned tg = og / nx;
            if (og + 1u == (tg + 1u) * nx) xb_add(&bar[XB_TOPGEN], 1u);
            else XB_SPIN(xb_ld(&bar[XB_TOPGEN]) == tg, bar);
            __builtin_amdgcn_fence(__ATOMIC_ACQUIRE, "agent");
            xb_add(&bar[XB_XGEN(b.x)], 1u);
            asm volatile("s_waitcnt vmcnt(0)" ::: "memory");
        } else {
            XB_SPIN(xb_ld(&bar[XB_XGEN(b.x)]) == gen, bar);
            __builtin_amdgcn_fence(__ATOMIC_ACQUIRE, "agent");
            asm volatile("s_waitcnt vmcnt(0)" ::: "memory");
        }
    }
    __syncthreads();
}

struct Frame {
    LAS unsigned char* lds;
    volatile LAS unsigned* MISC;
    unsigned* ctl;
    int tid, lane, wave, G, bid;
    const float* in[28];
    float* out;
    unsigned char* ws;
};
#define WSP(T_, off) ((T_*)(F.ws + (off)))
#define SSP(off) ((float*)(F.ws + WS_S) + (off))

__device__ __forceinline__ float wave_sum(float v) {
#pragma unroll
    for (int o = 1; o < 64; o <<= 1) v += __shfl_xor(v, o);
    return v;
}

__device__ __forceinline__ void p0_transpose_item(const float* W, int ldw, int nvalid, int K, bf16* WT, int drow, int k0, int n0, const float* kscale, LAS float* scr, int lane) {
#pragma unroll 8
    for (int i = 0; i < 32; ++i) { const int kk = 2 * i + (lane >> 5); const int n = n0 + (lane & 31);
        float v = (n < nvalid) ? W[(size_t)(k0 + kk) * ldw + n] : 0.f; if (kscale) v *= kscale[k0 + kk]; scr[kk * 33 + (lane & 31)] = v; }
    LDS_WAIT(); asm volatile("" ::: "memory");
    const int c = lane & 7;
#pragma unroll
    for (int j = 0; j < 4; ++j) { const int n = (lane >> 3) + 8 * j; const LAS float* s = scr + (8 * c) * 33 + n;
        v4u o; o.x = pk2(s[0 * 33], s[1 * 33]); o.y = pk2(s[2 * 33], s[3 * 33]); o.z = pk2(s[4 * 33], s[5 * 33]); o.w = pk2(s[6 * 33], s[7 * 33]);
        *(v4u*)(WT + (size_t)(drow + n) * K + k0 + 8 * c) = o; }
    LDS_WAIT(); asm volatile("" ::: "memory");
}
__device__ __forceinline__ void rms_row(const float* xrow, const float* w, bf16* ob, float* of, int lane) {
    const f32x4* xr = (const f32x4*)xrow + lane; const f32x4* wr_ = (const f32x4*)w + lane;
    f32x4 v[8]; float s = 0.f;
#pragma unroll
    for (int j = 0; j < 8; ++j) { v[j] = xr[64 * j]; s += (v[j].x * v[j].x + v[j].y * v[j].y) + (v[j].z * v[j].z + v[j].w * v[j].w); }
    const float rstd = rsqrtf(wave_sum(s) * (1.f / D) + EPS);
#pragma unroll
    for (int j = 0; j < 8; ++j) { const f32x4 g = wr_[64 * j]; const f32x4 y = v[j] * rstd * g;
        if (ob) ((unsigned long long*)ob)[lane + 64 * j] = (unsigned long long)pk2(y.x, y.y) | ((unsigned long long)pk2(y.z, y.w) << 32);
        if (of) ((f32x4*)of)[lane + 64 * j] = y; }
}

__device__ __forceinline__ void p0_prologue(Frame& F) {
    LAS float* scr = (LAS float*)(F.lds + RING_OFF + F.wave * 16384);
    const int gw = F.bid * NWAVES + F.wave, NGW = F.G * NWAVES;
    const float* w_in = F.in[11]; const float* w_out = F.in[18]; const float* w_g = F.in[20]; const float* w_u = F.in[21]; const float* w_d = F.in[23]; const float* w_pg = F.in[25]; const float* w_pp = F.in[26];
    const float* ffn_norm = F.in[19]; const float* ple_norm = F.in[24];
    bf16* Win = WSP(bf16, WS_WIN); bf16* Wout = WSP(bf16, WS_WOUT); bf16* Wgu = WSP(bf16, WS_WGU); bf16* Wdn = WSP(bf16, WS_WDN); bf16* Wpg = WSP(bf16, WS_WPG); bf16* Wpp = WSP(bf16, WS_WPP);
    constexpr int I_IN = (D / 64) * 225;
    constexpr int I_OUT = (D / 64) * (D / 32);
    constexpr int I_G = (D / 64) * (DFF / 32), I_U = I_G;
    constexpr int I_D = (DFF / 64) * (D / 32);
    constexpr int I_PG = I_OUT;
    constexpr int I_PP = (PLE / 64) * (D / 32);
    constexpr int NITEMS = I_IN + I_OUT + I_G + I_U + I_D + I_PG + I_PP;
    for (int it = gw; it < NITEMS; it += NGW) {
        int r = it;
        if (r < I_IN) { const int kb = r / 225, nb = r % 225; p0_transpose_item(w_in, IN_COLS, IN_COLS, D, Win, 32 * nb, 64 * kb, 32 * nb, nullptr, scr, F.lane); continue; } r -= I_IN;
        if (r < I_OUT) { const int kb = r / (D / 32), nb = r % (D / 32); p0_transpose_item(w_out, D, D, D, Wout, 32 * nb, 64 * kb, 32 * nb, nullptr, scr, F.lane); continue; } r -= I_OUT;
        if (r < I_G) { const int kb = r / (DFF / 32), nb = r % (DFF / 32); const int n0 = 32 * nb; p0_transpose_item(w_g, DFF, DFF, D, Wgu, 256 * (n0 >> 7) + (n0 & 127), 64 * kb, n0, ffn_norm, scr, F.lane); continue; } r -= I_G;
        if (r < I_U) { const int kb = r / (DFF / 32), nb = r % (DFF / 32); const int n0 = 32 * nb; p0_transpose_item(w_u, DFF, DFF, D, Wgu, 256 * (n0 >> 7) + 128 + (n0 & 127), 64 * kb, n0, ffn_norm, scr, F.lane); continue; } r -= I_U;
        if (r < I_D) { const int kb = r / (D / 32), nb = r % (D / 32); p0_transpose_item(w_d, D, D, DFF, Wdn, 32 * nb, 64 * kb, 32 * nb, nullptr, scr, F.lane); continue; } r -= I_D;
        if (r < I_PG) { const int kb = r / (D / 32), nb = r % (D / 32); p0_transpose_item(w_pg, D, D, D, Wpg, 32 * nb, 64 * kb, 32 * nb, ple_norm, scr, F.lane); continue; } r -= I_PG;
        { const int kb = r / (D / 32), nb = r % (D / 32); p0_transpose_item(w_pp, D, D, PLE, Wpp, 32 * nb, 64 * kb, 32 * nb, nullptr, scr, F.lane); }
    }
    { const size_t z0 = (size_t)7200 * D * 2, z1 = (size_t)NPROJ_PAD * D * 2; v4u* p = (v4u*)((unsigned char*)Win + z0); const size_t n16 = (z1 - z0) / 16;
      for (size_t i = (size_t)F.bid * 512 + F.tid; i < n16; i += (size_t)F.G * 512) p[i] = (v4u){0u, 0u, 0u, 0u}; }
    bf16* XN = WSP(bf16, WS_XN);
    for (int m = gw; m < M; m += NGW) rms_row(F.in[0] + (size_t)m * D, F.in[10], XN + (size_t)m * D, nullptr, F.lane);
    if (gw < MS) rms_row(F.in[1] + (size_t)gw * D, F.in[10], nullptr, SSP(S_A) + (size_t)gw * D, F.lane);
    { const f32x4* p = (const f32x4*)F.in[8]; v2u* o = (v2u*)WSP(bf16, WS_PB); const size_t n4 = (size_t)M * PLE / 4;
      for (size_t i = (size_t)F.bid * 512 + F.tid; i < n4; i += (size_t)F.G * 512) { const f32x4 v = p[i]; o[i] = (v2u){pk2(v.x, v.y), pk2(v.z, v.w)}; } }
}

template <class Epi>
__device__ __forceinline__ void sample_gemv(Frame& F, const float* A, int K, const float* nw, const float* W, int ldw, int N, const Epi& E) {
    LAS float* As = (LAS float*)(F.lds);
    LAS float* Red = (LAS float*)(F.lds + 65536);
    LAS float* Rs = (LAS float*)(F.lds + 65536 + 16384);
    const int ngroups = (N + 63) / 64;
    const int first = F.G - 1 - F.bid;
    if (first >= ngroups) return;
    __syncthreads();
    if (nw) { float s = 0.f; for (int k = F.lane; k < K; k += 64) { const float v = A[(size_t)F.wave * K + k]; s += v * v; } s = wave_sum(s); if (F.lane == 0) Rs[F.wave] = rsqrtf(s / (float)K + EPS); }
    else if (F.lane == 0) Rs[F.wave] = 1.f;
    __syncthreads();
    for (int g = first; g < ngroups; g += F.G) {
        float acc[8];
#pragma unroll
        for (int r = 0; r < 8; ++r) acc[r] = 0.f;
        const int n = 64 * g + F.lane; const bool nv = n < N;
        for (int kc = 0; kc < K; kc += 2048) {
            const int kn = (K - kc) < 2048 ? (K - kc) : 2048;
            __syncthreads();
            for (int idx = F.tid; idx < 8 * kn; idx += 512) { const int r = idx / kn, k = idx - r * kn; float v = A[(size_t)r * K + kc + k]; if (nw) v *= Rs[r] * nw[kc + k]; As[r * 2048 + k] = v; }
            __syncthreads();
            const int ks = kn / 8;
            for (int k = F.wave * ks; k < (F.wave + 1) * ks; k += 4) {
                float w4[4];
#pragma unroll
                for (int i = 0; i < 4; ++i) w4[i] = nv ? W[(size_t)(kc + k + i) * ldw + n] : 0.f;
#pragma unroll
                for (int r = 0; r < 8; ++r) { const f32x4 a = *(const LAS f32x4*)(As + r * 2048 + k); acc[r] += (a.x * w4[0] + a.y * w4[1]) + (a.z * w4[2] + a.w * w4[3]); }
            }
        }
        __syncthreads();
#pragma unroll
        for (int r = 0; r < 8; ++r) Red[(F.wave * 8 + r) * 64 + F.lane] = acc[r];
        __syncthreads();
        { const int r = F.tid >> 6, c = F.tid & 63; float s = 0.f;
#pragma unroll
          for (int w = 0; w < 8; ++w) s += Red[(w * 8 + r) * 64 + c];
          const int nn = 64 * g + c; if (nn < N) E(r, nn, s); }
    }
    __syncthreads();
}
struct SEpiStore { float* O; int ld; __device__ __forceinline__ void operator()(int r, int n, float v) const { O[(size_t)r * ld + n] = v; } };
struct SEpiAdd { const float* B; float* O; int ld; __device__ __forceinline__ void operator()(int r, int n, float v) const { O[(size_t)r * ld + n] = B[(size_t)r * ld + n] + v; } };

__device__ __forceinline__ void gdn_prep_prompt(Frame& F) {
    const int gw = F.bid * NWAVES + F.wave, NGW = F.G * NWAVES;
    const bf16* CIN = WSP(bf16, WS_CIN); const float* cw = F.in[14];
    float* GQ = WSP(float, WS_GQ); float* GK = WSP(float, WS_GK); float* GV = WSP(float, WS_GV);
    for (int it = gw; it < M * NH; it += NGW) {
        const int row = it >> 3, h = it & 7, t = row & (T - 1);
#pragma unroll
        for (int seg = 0; seg < 3; ++seg) {
            const int ch = seg * GW + h * HD + 2 * F.lane;
            float a0 = 0.f, a1 = 0.f;
#pragma unroll
            for (int j = 0; j < 4; ++j) { const int tt = t - 3 + j; if (tt >= 0) { const unsigned w = *(const unsigned*)(CIN + (size_t)(row - 3 + j) * CONVCH + ch); a0 += bf_lo(w) * cw[j * CONVCH + ch]; a1 += bf_hi(w) * cw[j * CONVCH + ch + 1]; } }
            a0 = silu_f(a0); a1 = silu_f(a1);
            float* dst = (seg == 0 ? GQ : seg == 1 ? GK : GV) + (size_t)row * GW + h * HD + 2 * F.lane;
            if (seg < 2) { const float ss = wave_sum(a0 * a0 + a1 * a1); float sc = rsqrtf(ss + 1e-6f); if (seg == 0) sc *= SB_SCALE; a0 *= sc; a1 *= sc; }
            *(f32x2*)dst = (f32x2){a0, a1};
        }
    }
}
__device__ __forceinline__ void gdn_prep_sample(Frame& F) {
    if (F.bid != 0) return;
    const float* PR = SSP(S_PROJ); const float* hist = F.in[5]; const float* cw = F.in[14];
    for (int i = F.tid; i < MS * SBW; i += 512) { const int b = i >> 10, c = i & 1023; F.out[OUT_KS + i] = PR[(size_t)b * IN_COLS + O_SB_K + c]; F.out[OUT_VS + i] = PR[(size_t)b * IN_COLS + O_SB_V + c]; }
    for (int i = F.tid; i < MS * 3 * CONVCH; i += 512) { const int b = i / (3 * CONVCH), rr = (i / CONVCH) % 3, c = i % CONVCH;
        F.out[OUT_GCONVS + i] = (rr < 2) ? hist[((size_t)b * 3 + rr + 1) * CONVCH + c] : PR[(size_t)b * IN_COLS + O_GQKV + c]; }
    if (F.tid < 64) { const int b = F.tid >> 3, h = F.tid & 7; SSP(S_G)[F.tid] = -__expf(F.in[15][h]) * softplus_f(PR[(size_t)b * IN_COLS + O_GA + h] + F.in[16][h]); SSP(S_BETA)[F.tid] = sigmoid_f(PR[(size_t)b * IN_COLS + O_GB + h]); }
    const int b = F.wave;
    for (int h = 0; h < NH; ++h)
#pragma unroll
        for (int seg = 0; seg < 3; ++seg) {
            const int ch = seg * GW + h * HD + 2 * F.lane; float a[2];
#pragma unroll
            for (int e = 0; e < 2; ++e) { float s = 0.f;
#pragma unroll
                for (int j = 0; j < 3; ++j) s += hist[((size_t)b * 3 + j) * CONVCH + ch + e] * cw[j * CONVCH + ch + e];
                s += PR[(size_t)b * IN_COLS + O_GQKV + ch + e] * cw[3 * CONVCH + ch + e]; a[e] = silu_f(s); }
            float* dst = SSP(seg == 0 ? S_GQ : seg == 1 ? S_GK : S_GV) + (size_t)b * GW + h * HD + 2 * F.lane;
            if (seg < 2) { const float ss = wave_sum(a[0] * a[0] + a[1] * a[1]); float sc = rsqrtf(ss + 1e-6f); if (seg == 0) sc *= SB_SCALE; a[0] *= sc; a[1] *= sc; }
            dst[0] = a[0]; dst[1] = a[1];
        }
}

template <bool PIPE>
__device__ __forceinline__ void gdn_recur_wave(const float* GQ, const float* GK, const float* GV, const float* Gg, const float* Gb, int ld, int gld, size_t row0, int ntok, int h, int slice,
                                               const float* S0, float* Sout, float* GO, int lane) {
    const int e = 4 * slice + (lane >> 4), d0 = 8 * (lane & 15);
    float S[8];
#pragma unroll
    for (int i = 0; i < 8; ++i) S[i] = S0 ? S0[(size_t)(d0 + i) * HD + e] : 0.f;
    constexpr int NT = PIPE ? 4 : 1;
    f32x4 ck0[NT], ck1[NT], cq0[NT], cq1[NT]; float cv[NT], cg[NT], cb[NT];
#define GDN_LOAD(dk0, dk1, dq0, dq1, dv, dg, db, tb) do { _Pragma("unroll") for (int i_ = 0; i_ < NT; ++i_) { const size_t row_ = row0 + (tb) + i_; \
        dk0[i_] = *(const f32x4*)(GK + row_ * ld + h * HD + d0); dk1[i_] = *(const f32x4*)(GK + row_ * ld + h * HD + d0 + 4); \
        dq0[i_] = *(const f32x4*)(GQ + row_ * ld + h * HD + d0); dq1[i_] = *(const f32x4*)(GQ + row_ * ld + h * HD + d0 + 4); \
        dv[i_] = GV[row_ * ld + h * HD + e]; dg[i_] = Gg[row_ * gld + h]; db[i_] = Gb[row_ * gld + h]; } } while (0)
    GDN_LOAD(ck0, ck1, cq0, cq1, cv, cg, cb, 0);
    for (int t = 0; t < ntok; t += NT) {
        f32x4 nk0[NT], nk1[NT], nq0[NT], nq1[NT]; float nv[NT], ng[NT], nb[NT];
        const int tn = (t + NT < ntok) ? t + NT : t;
        GDN_LOAD(nk0, nk1, nq0, nq1, nv, ng, nb, tn);
#pragma unroll
        for (int i = 0; i < NT; ++i) {
            const float kk[8] = {ck0[i].x, ck0[i].y, ck0[i].z, ck0[i].w, ck1[i].x, ck1[i].y, ck1[i].z, ck1[i].w}, qq[8] = {cq0[i].x, cq0[i].y, cq0[i].z, cq0[i].w, cq1[i].x, cq1[i].y, cq1[i].z, cq1[i].w};
            const float eg = __expf(cg[i]);
            float kv = 0.f;
#pragma unroll
            for (int j = 0; j < 8; ++j) kv += S[j] * kk[j];
            kv += __shfl_xor(kv, 1); kv += __shfl_xor(kv, 2); kv += __shfl_xor(kv, 4); kv += __shfl_xor(kv, 8);
            const float u = cb[i] * (cv[i] - eg * kv);
            float o = 0.f;
#pragma unroll
            for (int j = 0; j < 8; ++j) { S[j] = eg * S[j] + kk[j] * u; o += S[j] * qq[j]; }
            o += __shfl_xor(o, 1); o += __shfl_xor(o, 2); o += __shfl_xor(o, 4); o += __shfl_xor(o, 8);
            if ((lane & 15) == 0) GO[(row0 + t + i) * ld + h * HD + e] = o;
        }
#pragma unroll
        for (int i = 0; i < NT; ++i) { ck0[i] = nk0[i]; ck1[i] = nk1[i]; cq0[i] = nq0[i]; cq1[i] = nq1[i]; cv[i] = nv[i]; cg[i] = ng[i]; cb[i] = nb[i]; }
    }
#undef GDN_LOAD
#pragma unroll
    for (int i = 0; i < 8; ++i) Sout[(size_t)(d0 + i) * HD + e] = S[i];
}

__device__ __forceinline__ void sb_query_simple(Frame& F, int b, int h, int t, LAS float* qs) {
    const bf16* Qb = WSP(bf16, WS_Q); const bf16* Kb = WSP(bf16, WS_K); const bf16* Vb = WSP(bf16, WS_V); bf16* MIX = WSP(bf16, WS_MIX);
    const size_t row = (size_t)b * T + t; const int lane = F.lane;
    { const unsigned w = *(const unsigned*)(Qb + row * SBW + h * HD + 2 * lane); qs[2 * lane] = bf_lo(w); qs[2 * lane + 1] = bf_hi(w); }
    LDS_WAIT(); asm volatile("" ::: "memory");
    const float ch = F.in[12][h];
    float o0 = 0.f, o1 = 0.f, R = 0.f;
    const int nblk = (t + 63) >> 6;
    for (int blk = nblk - 1; blk >= 0; --blk) {
        const int k0 = blk * 64, key = k0 + lane; const bool valid = key < t;
        const v4u* kr = (const v4u*)(Kb + ((size_t)b * T + key) * SBW + h * HD);
        float dot = 0.f;
#pragma unroll
        for (int c = 0; c < 16; ++c) { const v4u w = kr[c]; const f32x4 qa = *(const LAS f32x4*)(qs + 8 * c), qb = *(const LAS f32x4*)(qs + 8 * c + 4);
            dot += bf_lo(w.x) * qa.x + bf_hi(w.x) * qa.y + bf_lo(w.y) * qa.z + bf_hi(w.y) * qa.w + bf_lo(w.z) * qb.x + bf_hi(w.z) * qb.y + bf_lo(w.w) * qb.z + bf_hi(w.w) * qb.w; }
        const float z = dot * SB_SCALE + ch;
        const float sp = softplus_f(z);
        const float L = valid ? -sp : 0.f, lb = z - sp;
        float s = L;
#pragma unroll
        for (int o = 1; o < 64; o <<= 1) { const float tmp = __shfl_down(s, o); if (lane + o < 64) s += tmp; }
        const float tot = __shfl(s, 0);
        const float a = valid ? __expf(lb + (s - L) + R) : 0.f;
        R += tot;
        const bf16* vr = Vb + ((size_t)b * T + k0) * SBW + h * HD + 2 * lane;
#pragma unroll 8
        for (int j = 0; j < 64; ++j) { const float aj = __shfl(a, j); const unsigned w = *(const unsigned*)(vr + (size_t)j * SBW); o0 += aj * bf_lo(w); o1 += aj * bf_hi(w); }
    }
    const float ss = wave_sum(o0 * o0 + o1 * o1); const float rs = rsqrtf(ss * (1.f / HD) + EPS);
    const float* nw = F.in[13];
    *(unsigned*)(MIX + row * D + h * HD + 2 * lane) = pk2(o0 * rs * nw[2 * lane], o1 * rs * nw[2 * lane + 1]);
}

__device__ __forceinline__ void sb_decode_segment(Frame& F, int b, int h, int seg) {
    const float* q = SSP(S_PROJ) + (size_t)b * IN_COLS + h * HD;
    const float* CK = F.in[2]; const float* CV = F.in[3]; const int* PT = (const int*)F.in[4];
    const int lane = F.lane, half = lane >> 5, l32 = lane & 31;
    const f32x4 q4 = *(const f32x4*)(q + 4 * l32);
    const float ch = F.in[12][h];
    float o0 = 0.f, o1 = 0.f, R = 0.f;
    for (int blk = 7; blk >= 0; --blk) {
        const int p0 = seg * 512 + blk * 64;
        const int page = PT[b * NPAGES + (p0 >> 7)];
        const size_t base = (((size_t)page * PAGE + (p0 & 127)) * NH + h) * HD;
        float z = 0.f;
#pragma unroll 8
        for (int i = 0; i < 32; ++i) {
            const f32x4 k4 = *(const f32x4*)(CK + base + (size_t)(2 * i + half) * (NH * HD) + 4 * l32);
            float p = (k4.x * q4.x + k4.y * q4.y) + (k4.z * q4.z + k4.w * q4.w);
            p += __shfl_xor(p, 1); p += __shfl_xor(p, 2); p += __shfl_xor(p, 4); p += __shfl_xor(p, 8); p += __shfl_xor(p, 16);
            const float pe = __shfl(p, 0), po = __shfl(p, 32);
            if (lane == 2 * i) z = pe; if (lane == 2 * i + 1) z = po;
        }
        z = z * SB_SCALE + ch;
        const float sp = softplus_f(z);
        const float L = -sp, lb = z - sp;
        float s = L;
#pragma unroll
        for (int o = 1; o < 64; o <<= 1) { const float tmp = __shfl_down(s, o); if (lane + o < 64) s += tmp; }
        const float tot = __shfl(s, 0);
        const float a = __expf(lb + (s - L) + R);
        R += tot;
#pragma unroll 8
        for (int j = 0; j < 64; ++j) { const float aj = __shfl(a, j); const f32x2 v = *(const f32x2*)(CV + base + (size_t)j * (NH * HD) + 2 * lane); o0 += aj * v.x; o1 += aj * v.y; }
    }
    float* P = SSP(S_PART) + ((size_t)(b * NH + h) * DSEG + seg) * DPART;
    P[2 * lane] = o0; P[2 * lane + 1] = o1; if (lane == 0) P[128] = R;
}

typedef short bf16x8 __attribute__((ext_vector_type(8)));
typedef short s16x4 __attribute__((ext_vector_type(4)));
typedef float f32x16 __attribute__((ext_vector_type(16)));
typedef __bf16 bf16x2_t __attribute__((ext_vector_type(2)));
__device__ __forceinline__ unsigned cvt2bf(float lo, float hi) { const f32x2 v = {lo, hi}; return __builtin_bit_cast(unsigned, __builtin_convertvector(v, bf16x2_t)); }
__device__ __forceinline__ unsigned offb(unsigned row, unsigned ch) { return 256u * row + 16u * (ch ^ (((row & 3u) << 2) | ((row >> 2) & 3u))); }
constexpr float LOG2E = 1.4426950408889634f;

__device__ __forceinline__ void sb_attn_unit(Frame& F, int b, int h, int qb) {
    const bf16* Qb = WSP(bf16, WS_Q); const bf16* Kb = WSP(bf16, WS_K); const bf16* Vb = WSP(bf16, WS_V); bf16* MIX = WSP(bf16, WS_MIX);
    const int lane = F.lane, r32 = lane & 31, hh = lane >> 5;
    const int q0w = 256 * qb + 32 * F.wave;
    LAS unsigned char* KB0 = F.lds + RING_OFF; LAS unsigned char* VB0 = F.lds + RING_OFF + 32768;
    bf16x8 qf[8];
    { const bf16* qp = Qb + ((size_t)b * T + q0w + r32) * SBW + h * HD + 8 * hh;
#pragma unroll
      for (int s = 0; s < 8; ++s) qf[s] = *(const bf16x8*)(qp + 16 * s); }
    const float k1 = SB_SCALE * LOG2E, k2 = F.in[12][h] * LOG2E;
    f32x16 oacc[4];
#pragma unroll
    for (int d = 0; d < 4; ++d)
#pragma unroll
        for (int i = 0; i < 16; ++i) oacc[d][i] = 0.f;
    float R = 0.f;
    const int nt = 4 * qb + 4;
    const int srow = F.tid >> 4, sch = F.tid & 15;
    const size_t gbase = ((size_t)b * T) * SBW + h * HD + sch * 8;
    v4u rk[2], rv[2];
#define SB_LOAD(k0_) do { _Pragma("unroll") for (int i_ = 0; i_ < 2; ++i_) { const size_t o_ = gbase + (size_t)((k0_) + srow + 32 * i_) * SBW; rk[i_] = *(const v4u*)(Kb + o_); rv[i_] = *(const v4u*)(Vb + o_); } } while (0)
    const unsigned kwo = (unsigned)((sch >> 1) * 1024 + srow * 32 + (((sch & 1) ^ ((srow >> 3) & 1)) * 16));
    const unsigned vwo = (unsigned)((((srow >> 3) * 4 + (sch >> 2)) * 512) + (srow & 7) * 64 + (sch & 3) * 16);
#define SB_WRITE(buf_) do { _Pragma("unroll") for (int i_ = 0; i_ < 2; ++i_) { *(LAS v4u*)(KB0 + (buf_) * 16384 + kwo + i_ * 8192) = rk[i_]; *(LAS v4u*)(VB0 + (buf_) * 16384 + vwo + i_ * 8192) = rv[i_]; } } while (0)
    SB_LOAD(64 * (nt - 1)); SB_WRITE(0);
    __syncthreads();
    const int tq = (lane & 15) >> 2, tp = lane & 3, tblk = (lane >> 4) & 1;
    const unsigned kro = (unsigned)(r32 * 32 + ((hh ^ ((r32 >> 3) & 1)) * 16));
    const unsigned vro = (unsigned)((4 * hh + tq) * 64 + tblk * 32 + tp * 8);
    for (int it = 0; it < nt; ++it) {
        const int kt = nt - 1 - it, buf = it & 1, k0 = 64 * kt;
        if (it + 1 < nt) SB_LOAD(64 * (kt - 1));
        if (k0 < q0w + 31) {
            const bool diag = (k0 + 63 >= q0w);
            LAS unsigned char* Kt = KB0 + buf * 16384; LAS unsigned char* Vt = VB0 + buf * 16384;
            f32x16 sacc[2];
#pragma unroll
            for (int kb = 0; kb < 2; ++kb) {
#pragma unroll
                for (int i = 0; i < 16; ++i) sacc[kb][i] = 0.f;
#pragma unroll
                for (int s = 0; s < 8; ++s) { const bf16x8 kf = *(const LAS bf16x8*)(Kt + kro + (kb * 8 + s) * 1024); sacc[kb] = __builtin_amdgcn_mfma_f32_32x32x16_bf16(kf, qf[s], sacc[kb], 0, 0, 0); }
            }
            float after = R;
            unsigned pp[2][8];
            const int qabs = q0w + r32;
#pragma unroll
            for (int kb = 1; kb >= 0; --kb)
#pragma unroll
                for (int g = 3; g >= 0; --g) {
                    float L[4], lb[4]; bool vd[4];
#pragma unroll
                    for (int j = 0; j < 4; ++j) {
                        const float z2 = sacc[kb][4 * g + j] * k1 + k2;
                        const float x = __builtin_amdgcn_exp2f(-fabsf(z2));
                        const float t = __builtin_amdgcn_logf(1.0f + x);
                        L[j] = fminf(-z2, 0.f) - t; lb[j] = z2 + L[j];
                        vd[j] = true;
                        if (diag) { vd[j] = (k0 + 32 * kb + 8 * g + 4 * hh + j) < qabs; L[j] = vd[j] ? L[j] : 0.f; }
                    }
                    const float s3 = L[3], s2 = L[2] + s3, s1 = L[1] + s2, s0 = L[0] + s1;
                    const float p4 = __shfl_xor(s0, 32);
                    const float base = after + (hh == 0 ? p4 : 0.f);
                    float a0 = __builtin_amdgcn_exp2f(lb[0] + s1 + base), a1 = __builtin_amdgcn_exp2f(lb[1] + s2 + base), a2 = __builtin_amdgcn_exp2f(lb[2] + s3 + base), a3 = __builtin_amdgcn_exp2f(lb[3] + base);
                    if (diag) { a0 = vd[0] ? a0 : 0.f; a1 = vd[1] ? a1 : 0.f; a2 = vd[2] ? a2 : 0.f; a3 = vd[3] ? a3 : 0.f; }
                    after += s0 + p4;
                    pp[kb][2 * g] = cvt2bf(a0, a1); pp[kb][2 * g + 1] = cvt2bf(a2, a3);
                }
            R = after;
#pragma unroll
            for (int kb = 0; kb < 2; ++kb)
#pragma unroll
                for (int sp = 0; sp < 2; ++sp) {
                    const v4u pw = {pp[kb][4 * sp], pp[kb][4 * sp + 1], pp[kb][4 * sp + 2], pp[kb][4 * sp + 3]};
                    const bf16x8 pf = __builtin_bit_cast(bf16x8, pw);
                    const int keybase = 32 * kb + 16 * sp;
#pragma unroll
                    for (int db = 0; db < 4; ++db) {
                        const s16x4 lo = __builtin_amdgcn_ds_read_tr16_b64_v4i16((LAS s16x4*)(Vt + vro + ((keybase >> 3) * 4 + db) * 512));
                        const s16x4 hi = __builtin_amdgcn_ds_read_tr16_b64_v4i16((LAS s16x4*)(Vt + vro + (((keybase >> 3) + 1) * 4 + db) * 512));
                        const bf16x8 vf = __builtin_shufflevector(lo, hi, 0, 1, 2, 3, 4, 5, 6, 7);
                        oacc[db] = __builtin_amdgcn_mfma_f32_32x32x16_bf16(vf, pf, oacc[db], 0, 0, 0);
                    }
                }
        }
        if (it + 1 < nt) SB_WRITE(buf ^ 1);
        __syncthreads();
    }
#undef SB_LOAD
#undef SB_WRITE
    float ss = 0.f;
#pragma unroll
    for (int d = 0; d < 4; ++d)
#pragma unroll
        for (int i = 0; i < 16; ++i) ss += oacc[d][i] * oacc[d][i];
    ss += __shfl_xor(ss, 32);
    const float rs = rsqrtf(ss * (1.f / HD) + EPS);
    const float* nw = F.in[13];
    bf16* op = MIX + ((size_t)b * T + q0w + r32) * D + h * HD + 4 * hh;
#pragma unroll
    for (int d = 0; d < 4; ++d)
#pragma unroll
        for (int g = 0; g < 4; ++g) { const int dd = 32 * d + 8 * g + 4 * hh; const f32x4 w4 = *(const f32x4*)(nw + dd);
            v2u w; w.x = cvt2bf(oacc[d][4 * g] * rs * w4.x, oacc[d][4 * g + 1] * rs * w4.y); w.y = cvt2bf(oacc[d][4 * g + 2] * rs * w4.z, oacc[d][4 * g + 3] * rs * w4.w);
            *(v2u*)(op + 32 * d + 8 * g) = w; }
}

constexpr int GREC_A = 57344;
constexpr int GREC_WF = 0, GREC_QF = 16384, GREC_QKF = 32768, GREC_KTF = 40960, GREC_UF = GREC_A, GREC_BYTES = GREC_A + 16384;
constexpr int NCHUNK = T / 64;
constexpr int PL_TK = 0, PL_TQ = 16384, PL_TKBG = 32768, PL_TKT = 49152, PL_TVB = 65536, PL_LOW = 81920  , PL_TT = 98304  , PL_GC = 107520  , PL_BETA = 107776;
__device__ __forceinline__ unsigned rowimg(unsigned row, unsigned c16) { return ((row >> 5) * 8 + (c16 >> 1)) * 1024 + (row & 31) * 32 + (((c16 & 1) ^ ((row >> 3) & 1)) * 16); }
__device__ __forceinline__ unsigned trimg(unsigned row, unsigned c16) { return ((row >> 3) * 4 + (c16 >> 2)) * 512 + (row & 7) * 64 + (c16 & 3) * 16; }

__device__ __forceinline__ void gdn_prep_unit(Frame& F, int chain, int ci, unsigned char* rec, float* EGp) {
    int lane = F.lane, tid = F.tid; asm volatile("" : "+v"(lane), "+v"(tid));
    const int b = chain >> 3, h = chain & 7, r32 = lane & 31, hh = lane >> 5;
    const size_t R0 = (size_t)b * T + 64 * ci;
    unsigned lb0 = 0; asm volatile("" : "+v"(lb0));
    LAS unsigned char* L = F.lds + lb0;
    LAS float* GC = (LAS float*)(L + PL_GC); LAS float* BE = (LAS float*)(L + PL_BETA); LAS float* LOW = (LAS float*)(L + PL_LOW);
    const bf16* CIN = WSP(bf16, WS_CIN); const float* cw = F.in[14];
    if (F.wave == 0) { float g = WSP(float, WS_G)[(R0 + lane) * NH + h];
#pragma unroll
        for (int o = 1; o < 64; o <<= 1) { const float t = __shfl_up(g, o); if (lane >= o) g += t; }
        GC[lane] = g; BE[lane] = WSP(float, WS_BETA)[(R0 + lane) * NH + h]; }
    __syncthreads();
    {
        const int t = tid >> 3, sub = tid & 7; const int tseq = 64 * ci + t;
        const float gc = GC[t], gl = GC[63], be = BE[t];
        const float egc = __expf(gc), egl = __expf(gl - gc);
        float val[3][16];
#pragma unroll
        for (int seg = 0; seg < 3; ++seg) {
            const int ch = seg * GW + h * HD + 16 * sub;
            float a[16];
#pragma unroll
            for (int e = 0; e < 16; ++e) a[e] = 0.f;
#pragma unroll
            for (int j = 0; j < 4; ++j) if (tseq - 3 + j >= 0) {
                const v4u w0 = *(const v4u*)(CIN + (R0 + t - 3 + j) * CONVCH + ch), w1 = *(const v4u*)(CIN + (R0 + t - 3 + j) * CONVCH + ch + 8);
                const unsigned ww[8] = {w0.x, w0.y, w0.z, w0.w, w1.x, w1.y, w1.z, w1.w};
#pragma unroll
                for (int e = 0; e < 8; ++e) { a[2 * e] += bf_lo(ww[e]) * cw[j * CONVCH + ch + 2 * e]; a[2 * e + 1] += bf_hi(ww[e]) * cw[j * CONVCH + ch + 2 * e + 1]; }
            }
            float ss = 0.f;
#pragma unroll
            for (int e = 0; e < 16; ++e) { a[e] = silu_f(a[e]); ss += a[e] * a[e]; }
            if (seg < 2) { ss += __shfl_xor(ss, 1); ss += __shfl_xor(ss, 2); ss += __shfl_xor(ss, 4); float sc = rsqrtf(ss + 1e-6f); if (seg == 0) sc *= SB_SCALE;
#pragma unroll
                for (int e = 0; e < 16; ++e) a[e] *= sc; }
#pragma unroll
            for (int e = 0; e < 16; ++e) val[seg][e] = a[e];
        }
#define PK8(dst, src, mul, o) do { dst.x = cvt2bf(src[o] * (mul), src[o + 1] * (mul)); dst.y = cvt2bf(src[o + 2] * (mul), src[o + 3] * (mul)); dst.z = cvt2bf(src[o + 4] * (mul), src[o + 5] * (mul)); dst.w = cvt2bf(src[o + 6] * (mul), src[o + 7] * (mul)); } while (0)
        v4u p0, p1;
        PK8(p0, val[1], 1.0f, 0); PK8(p1, val[1], 1.0f, 8); *(LAS v4u*)(L + PL_TK + rowimg(t, 2 * sub)) = p0; *(LAS v4u*)(L + PL_TK + rowimg(t, 2 * sub + 1)) = p1;
        PK8(p0, val[1], be * egc, 0); PK8(p1, val[1], be * egc, 8); *(LAS v4u*)(L + PL_TKBG + trimg(t, 2 * sub)) = p0; *(LAS v4u*)(L + PL_TKBG + trimg(t, 2 * sub + 1)) = p1;
        PK8(p0, val[1], egl, 0); PK8(p1, val[1], egl, 8); *(LAS v4u*)(L + PL_TKT + trimg(t, 2 * sub)) = p0; *(LAS v4u*)(L + PL_TKT + trimg(t, 2 * sub + 1)) = p1;
        PK8(p0, val[0], 1.0f, 0); PK8(p1, val[0], 1.0f, 8); *(LAS v4u*)(L + PL_TQ + rowimg(t, 2 * sub)) = p0; *(LAS v4u*)(L + PL_TQ + rowimg(t, 2 * sub + 1)) = p1;
        PK8(p0, val[2], be, 0); PK8(p1, val[2], be, 8); *(LAS v4u*)(L + PL_TVB + trimg(t, 2 * sub)) = p0; *(LAS v4u*)(L + PL_TVB + trimg(t, 2 * sub + 1)) = p1;
        { float qg[16];
#pragma unroll
          for (int e = 0; e < 16; ++e) qg[e] = val[0][e] * egc;
          unsigned char* qf = rec + GREC_QF + ((t >> 5) * 8 + sub) * 1024 + (t & 31) * 16;
          v4u f0, f1; f0.x = cvt2bf(qg[0], qg[1]); f0.y = cvt2bf(qg[2], qg[3]); f0.z = cvt2bf(qg[8], qg[9]); f0.w = cvt2bf(qg[10], qg[11]);
          f1.x = cvt2bf(qg[4], qg[5]); f1.y = cvt2bf(qg[6], qg[7]); f1.z = cvt2bf(qg[12], qg[13]); f1.w = cvt2bf(qg[14], qg[15]);
          *(v4u*)qf = f0; *(v4u*)(qf + 512) = f1; }
#undef PK8
        if (tid == 0) *EGp = __expf(gl);
    }
    __syncthreads();
    {
        const int which = F.wave >> 2, ta = (F.wave >> 1) & 1, tb = F.wave & 1;
        const unsigned aro = r32 * 32 + ((hh ^ ((r32 >> 3) & 1)) * 16);
        f32x16 acc;
#pragma unroll
        for (int i = 0; i < 16; ++i) acc[i] = 0.f;
        const bool zero_tile = (which == 0) ? (ta < tb) : (ta > tb);
        if (!zero_tile) {
#pragma unroll
            for (int ks = 0; ks < 8; ++ks) {
                const bf16x8 af = *(const LAS bf16x8*)(L + PL_TK + aro + (ta * 8 + ks) * 1024);
                const bf16x8 bfr = *(const LAS bf16x8*)(L + (which == 0 ? PL_TK : PL_TQ) + aro + (tb * 8 + ks) * 1024);
                acc = __builtin_amdgcn_mfma_f32_32x32x16_bf16(af, bfr, acc, 0, 0, 0);
            }
        }
        if (which == 0) {
            const int s = 32 * tb + r32; const float gs = GC[s];
#pragma unroll
            for (int g = 0; g < 4; ++g) { const int c0 = 32 * ta + 8 * g + 4 * hh; const f32x4 gc4 = *(const LAS f32x4*)(GC + c0), be4 = *(const LAS f32x4*)(BE + c0);
#pragma unroll
                for (int j = 0; j < 4; ++j) { const float e = __expf(fminf(gc4[j] - gs, 0.f)); const float v = be4[j] * acc[4 * g + j] * e; LOW[(c0 + j) * 64 + s] = (c0 + j > s) ? v : 0.f; } }
        } else {
            const int c = 32 * tb + r32; const float gcc = GC[c]; float v[16];
#pragma unroll
            for (int g = 0; g < 4; ++g) { const int s0 = 32 * ta + 8 * g + 4 * hh; const f32x4 gc4 = *(const LAS f32x4*)(GC + s0);
#pragma unroll
                for (int j = 0; j < 4; ++j) { const float e = __expf(fminf(gcc - gc4[j], 0.f)); const float x = acc[4 * g + j] * e; v[4 * g + j] = (c >= s0 + j) ? x : 0.f; } }
#pragma unroll
            for (int s = 0; s < 2; ++s) { v4u f; f.x = cvt2bf(v[8 * s], v[8 * s + 1]); f.y = cvt2bf(v[8 * s + 2], v[8 * s + 3]); f.z = cvt2bf(v[8 * s + 4], v[8 * s + 5]); f.w = cvt2bf(v[8 * s + 6], v[8 * s + 7]);
                *(v4u*)(rec + GREC_QKF + (tb * 4 + 2 * ta + s) * 1024 + lane * 16) = f; }
        }
    }
    __syncthreads();
    if (F.wave == 0) {
        float Tc[64];
#pragma unroll
        for (int c = 0; c < 64; ++c) {
            float a0 = 0.f, a1 = 0.f, a2 = 0.f, a3 = 0.f;
#pragma unroll
            for (int s4 = 0; s4 < (c + 3) / 4; ++s4) { const f32x4 l4 = *(const LAS f32x4*)(LOW + c * 64 + 4 * s4);
                a0 += l4.x * Tc[4 * s4]; if (4 * s4 + 1 < c) a1 += l4.y * Tc[4 * s4 + 1]; if (4 * s4 + 2 < c) a2 += l4.z * Tc[4 * s4 + 2]; if (4 * s4 + 3 < c) a3 += l4.w * Tc[4 * s4 + 3]; }
            Tc[c] = ((c == lane) ? 1.f : 0.f) - ((a0 + a1) + (a2 + a3));
        }
#pragma unroll
        for (int c = 0; c < 64; ++c) *(LAS bf16*)(L + PL_TT + c * 144 + lane * 2) = (bf16)f2bf(Tc[c]);
    }
    __syncthreads();
    {
        const int tq = (lane & 15) >> 2, tp = lane & 3, tblk = (lane >> 4) & 1;
        const unsigned trn = hh * 2048 + tq * 64 + tblk * 32 + tp * 8;
        const unsigned trm = (4 * hh + tq) * 64 + tblk * 32 + tp * 8;
        const unsigned tro = r32 * 144 + hh * 16;
        {
            const int ct = F.wave >> 2, et = F.wave & 3; f32x16 acc;
#pragma unroll
            for (int i = 0; i < 16; ++i) acc[i] = 0.f;
#pragma unroll
            for (int ks = 0; ks < 4; ++ks) {
                const bf16x8 af = *(const LAS bf16x8*)(L + PL_TT + tro + ct * 32 * 144 + ks * 32);
                const s16x4 lo = __builtin_amdgcn_ds_read_tr16_b64_v4i16((LAS s16x4*)(L + PL_TVB + trn + ks * 4096 + et * 512));
                const s16x4 hi = __builtin_amdgcn_ds_read_tr16_b64_v4i16((LAS s16x4*)(L + PL_TVB + trn + ks * 4096 + et * 512 + 256));
                acc = __builtin_amdgcn_mfma_f32_32x32x16_bf16(af, __builtin_shufflevector(lo, hi, 0, 1, 2, 3, 4, 5, 6, 7), acc, 0, 0, 0);
            }
            v4u f0, f1; f0.x = cvt2bf(acc[0], acc[1]); f0.y = cvt2bf(acc[2], acc[3]); f0.z = cvt2bf(acc[4], acc[5]); f0.w = cvt2bf(acc[6], acc[7]);
            f1.x = cvt2bf(acc[8], acc[9]); f1.y = cvt2bf(acc[10], acc[11]); f1.z = cvt2bf(acc[12], acc[13]); f1.w = cvt2bf(acc[14], acc[15]);
            unsigned char* up = rec + GREC_UF + (et * 2 + ct) * 2048 + lane * 32; *(v4u*)up = f0; *(v4u*)(up + 16) = f1;
        }
        {
            const int dt = F.wave >> 1, ct = F.wave & 1; f32x16 acc;
#pragma unroll
            for (int i = 0; i < 16; ++i) acc[i] = 0.f;
#pragma unroll
            for (int ks = 0; ks < 4; ++ks) {
                const s16x4 lo = __builtin_amdgcn_ds_read_tr16_b64_v4i16((LAS s16x4*)(L + PL_TKBG + trn + ks * 4096 + dt * 512));
                const s16x4 hi = __builtin_amdgcn_ds_read_tr16_b64_v4i16((LAS s16x4*)(L + PL_TKBG + trn + ks * 4096 + dt * 512 + 256));
                const bf16x8 bfr = *(const LAS bf16x8*)(L + PL_TT + tro + ct * 32 * 144 + ks * 32);
                acc = __builtin_amdgcn_mfma_f32_32x32x16_bf16(__builtin_shufflevector(lo, hi, 0, 1, 2, 3, 4, 5, 6, 7), bfr, acc, 0, 0, 0);
            }
#pragma unroll
            for (int s = 0; s < 2; ++s) { v4u f; f.x = cvt2bf(-acc[8 * s], -acc[8 * s + 1]); f.y = cvt2bf(-acc[8 * s + 2], -acc[8 * s + 3]); f.z = cvt2bf(-acc[8 * s + 4], -acc[8 * s + 5]); f.w = cvt2bf(-acc[8 * s + 6], -acc[8 * s + 7]);
                *(v4u*)(rec + GREC_WF + (ct * 8 + 2 * dt + s) * 1024 + lane * 16) = f; }
        }
        {
#pragma unroll
            for (int q = 0; q < 2; ++q) { const int f = 2 * F.wave + q, dt = f >> 2, ksp = f & 3;
                const s16x4 lo = __builtin_amdgcn_ds_read_tr16_b64_v4i16((LAS s16x4*)(L + PL_TKT + trm + (2 * ksp) * 2048 + dt * 512));
                const s16x4 hi = __builtin_amdgcn_ds_read_tr16_b64_v4i16((LAS s16x4*)(L + PL_TKT + trm + (2 * ksp + 1) * 2048 + dt * 512));
                const bf16x8 kf = __builtin_shufflevector(lo, hi, 0, 1, 2, 3, 4, 5, 6, 7);
                *(bf16x8*)(rec + GREC_KTF + (dt * 4 + ksp) * 1024 + lane * 16) = kf; }
        }
    }
    __syncthreads();
}

__device__ __forceinline__ void gdn_scan_chain(Frame& F, int chain) {
    const int b = chain >> 3, h = chain & 7, lane = F.lane, r32 = lane & 31, hh = lane >> 5, et = F.wave;
    const unsigned char* recs = F.ws + WS_GREC + (size_t)chain * NCHUNK * GREC_BYTES;
    const float* EG = WSP(float, WS_GEG) + chain * NCHUNK;
    float* GO = WSP(float, WS_GO);
    LAS unsigned char* L = F.lds;
    f32x16 S[4];
#pragma unroll
    for (int d = 0; d < 4; ++d)
#pragma unroll
        for (int i = 0; i < 16; ++i) S[d][i] = 0.f;
#define GS_DMA(ci_, slot_) do { const unsigned char* g_ = recs + (size_t)(ci_) * GREC_BYTES + lane * 16; \
        _Pragma("unroll") for (int p_ = 0; p_ < 7; ++p_) __builtin_amdgcn_global_load_lds((const unsigned*)(g_ + (F.wave + 8 * p_) * 1024), (LAS unsigned*)(L + (slot_) * GREC_A + (F.wave + 8 * p_) * 1024), 16, 0, 0); } while (0)
    v4u un[2][2];
#define GS_ULOAD(ci_) do { if (F.wave < 4) { const unsigned char* u_ = recs + (size_t)(ci_) * GREC_BYTES + GREC_UF + (et * 2) * 2048 + lane * 32; \
        un[0][0] = *(const v4u*)u_; un[0][1] = *(const v4u*)(u_ + 16); un[1][0] = *(const v4u*)(u_ + 2048); un[1][1] = *(const v4u*)(u_ + 2048 + 16); } } while (0)
    GS_DMA(0, 0); GS_ULOAD(0);
    __syncthreads();
    for (int ci = 0; ci < NCHUNK; ++ci) {
        const int slot = ci & 1;
        v4u uc[2][2];
#pragma unroll
        for (int a = 0; a < 2; ++a) { uc[a][0] = un[a][0]; uc[a][1] = un[a][1]; }
        if (ci + 1 < NCHUNK) { GS_DMA(ci + 1, slot ^ 1); GS_ULOAD(ci + 1); }
        if (F.wave < 4) {
            const LAS unsigned char* A = L + slot * GREC_A + lane * 16;
            const float eg = EG[ci];
            bf16x8 sf[8];
#pragma unroll
            for (int ks = 0; ks < 8; ++ks) { const int d = ks >> 1, s = ks & 1; v4u w; w.x = cvt2bf(S[d][8 * s], S[d][8 * s + 1]); w.y = cvt2bf(S[d][8 * s + 2], S[d][8 * s + 3]); w.z = cvt2bf(S[d][8 * s + 4], S[d][8 * s + 5]); w.w = cvt2bf(S[d][8 * s + 6], S[d][8 * s + 7]); sf[ks] = __builtin_bit_cast(bf16x8, w); }
            f32x16 vn[2];
#pragma unroll
            for (int ct = 0; ct < 2; ++ct) {
                const unsigned uw[8] = {uc[ct][0].x, uc[ct][0].y, uc[ct][0].z, uc[ct][0].w, uc[ct][1].x, uc[ct][1].y, uc[ct][1].z, uc[ct][1].w};
#pragma unroll
                for (int i = 0; i < 8; ++i) { vn[ct][2 * i] = bf_lo(uw[i]); vn[ct][2 * i + 1] = bf_hi(uw[i]); }
#pragma unroll
                for (int ks = 0; ks < 8; ++ks) vn[ct] = __builtin_amdgcn_mfma_f32_32x32x16_bf16(*(const LAS bf16x8*)(A + GREC_WF + (ct * 8 + ks) * 1024), sf[ks], vn[ct], 0, 0, 0);
            }
            bf16x8 vf[4];
#pragma unroll
            for (int ks = 0; ks < 4; ++ks) { const int ct = ks >> 1, s = ks & 1; v4u w; w.x = cvt2bf(vn[ct][8 * s], vn[ct][8 * s + 1]); w.y = cvt2bf(vn[ct][8 * s + 2], vn[ct][8 * s + 3]); w.z = cvt2bf(vn[ct][8 * s + 4], vn[ct][8 * s + 5]); w.w = cvt2bf(vn[ct][8 * s + 6], vn[ct][8 * s + 7]); vf[ks] = __builtin_bit_cast(bf16x8, w); }
            float* gop = GO + ((size_t)b * T + 64 * ci + 4 * hh) * GW + h * HD + 32 * et + r32;
#pragma unroll
            for (int ct = 0; ct < 2; ++ct) {
                f32x16 o;
#pragma unroll
                for (int i = 0; i < 16; ++i) o[i] = 0.f;
#pragma unroll
                for (int ks = 0; ks < 8; ++ks) o = __builtin_amdgcn_mfma_f32_32x32x16_bf16(*(const LAS bf16x8*)(A + GREC_QF + (ct * 8 + ks) * 1024), sf[ks], o, 0, 0, 0);
#pragma unroll
                for (int ks = 0; ks < 4; ++ks) o = __builtin_amdgcn_mfma_f32_32x32x16_bf16(*(const LAS bf16x8*)(A + GREC_QKF + (ct * 4 + ks) * 1024), vf[ks], o, 0, 0, 0);
#pragma unroll
                for (int g = 0; g < 4; ++g) { float* gp = gop + (size_t)(32 * ct + 8 * g) * GW; asm volatile("" : "+v"(gp));
                    gp[0] = o[4 * g]; gp[GW] = o[4 * g + 1]; gp[2 * GW] = o[4 * g + 2]; gp[3 * GW] = o[4 * g + 3]; }
            }
#pragma unroll
            for (int d = 0; d < 4; ++d) {
#pragma unroll
                for (int i = 0; i < 16; ++i) S[d][i] *= eg;
#pragma unroll
                for (int ks = 0; ks < 4; ++ks) S[d] = __builtin_amdgcn_mfma_f32_32x32x16_bf16(*(const LAS bf16x8*)(A + GREC_KTF + (d * 4 + ks) * 1024), vf[ks], S[d], 0, 0, 0);
            }
        }
        __syncthreads();
    }
#undef GS_DMA
#undef GS_ULOAD
    if (F.wave < 4) { float* so = F.out + OUT_GREC + (size_t)chain * HD * HD + 32 * et + r32;
#pragma unroll
        for (int d = 0; d < 4; ++d)
#pragma unroll
            for (int i = 0; i < 16; ++i) so[(size_t)(32 * d + (i & 3) + 8 * (i >> 2) + 4 * hh) * HD] = S[d][i]; }
}

__device__ __forceinline__ void p2_mixers(Frame& F) {
    if (F.bid < NB * NH) gdn_scan_chain(F, F.bid);
    const int gw = (F.bid - NB * NH) * NWAVES + F.wave, NGW = (F.G - NB * NH) * NWAVES;
    if (F.bid >= NB * NH) {
    for (int it = gw; it < MS * NH * 32; it += NGW) {
        const int chain = it >> 5, slice = it & 31, b = chain >> 3, h = chain & 7;
        gdn_recur_wave<false>(SSP(S_GQ), SSP(S_GK), SSP(S_GV), SSP(S_G), SSP(S_BETA), GW, NH, (size_t)b, 1, h, slice,
                              F.in[6] + (size_t)chain * HD * HD, F.out + OUT_GRECS + (size_t)chain * HD * HD, SSP(S_GO), F.lane);
    }
    for (int it = gw; it < MS * NH * DSEG; it += NGW) { const int bh = it / DSEG, seg = it % DSEG; sb_decode_segment(F, bh >> 3, bh & 7, seg); }
    }
    __syncthreads();
    for (int u = F.bid; u < NB * NH * 16; u += F.G) { const int bh = u & 15, qb = u >> 4; sb_attn_unit(F, bh >> 3, bh & 7, qb); }
}

__device__ __forceinline__ void p2_finish(Frame& F) {
    const int gw = F.bid * NWAVES + F.wave, NGW = F.G * NWAVES;
    const float* GO = WSP(float, WS_GO); const bf16* Zb = WSP(bf16, WS_Z); bf16* MIX = WSP(bf16, WS_MIX); const float* gnw = F.in[17];
    for (int it = gw; it < M * NH; it += NGW) {
        const int row = it >> 3, h = it & 7;
        const f32x2 o = *(const f32x2*)(GO + (size_t)row * GW + h * HD + 2 * F.lane);
        const float rs = rsqrtf(wave_sum(o.x * o.x + o.y * o.y) * (1.f / HD) + EPS);
        const unsigned zw = *(const unsigned*)(Zb + (size_t)row * GW + h * HD + 2 * F.lane);
        *(unsigned*)(MIX + (size_t)row * D + SBW + h * HD + 2 * F.lane) = pk2(o.x * rs * gnw[2 * F.lane] * silu_f(bf_lo(zw)), o.y * rs * gnw[2 * F.lane + 1] * silu_f(bf_hi(zw)));
    }
    if (F.bid == F.G - 1) {
        for (int bh = F.wave; bh < MS * NH; bh += NWAVES) {
            const int b = bh >> 3, h = bh & 7;
            { const f32x2 o = *(const f32x2*)(SSP(S_GO) + (size_t)b * GW + h * HD + 2 * F.lane);
              const float rs = rsqrtf(wave_sum(o.x * o.x + o.y * o.y) * (1.f / HD) + EPS);
              const float* z = SSP(S_PROJ) + (size_t)b * IN_COLS + O_GZ + h * HD + 2 * F.lane;
              float* mo = SSP(S_MIX) + (size_t)b * D + SBW + h * HD + 2 * F.lane;
              mo[0] = o.x * rs * gnw[2 * F.lane] * silu_f(z[0]); mo[1] = o.y * rs * gnw[2 * F.lane + 1] * silu_f(z[1]); }
            { float o0 = 0.f, o1 = 0.f, R = 0.f;
              for (int seg = DSEG - 1; seg >= 0; --seg) { const float* P = SSP(S_PART) + ((size_t)bh * DSEG + seg) * DPART; const float e = __expf(R); o0 += e * P[2 * F.lane]; o1 += e * P[2 * F.lane + 1]; R += P[128]; }
              const float rs = rsqrtf(wave_sum(o0 * o0 + o1 * o1) * (1.f / HD) + EPS); const float* nw = F.in[13];
              float* mo = SSP(S_MIX) + (size_t)b * D + h * HD + 2 * F.lane; mo[0] = o0 * rs * nw[2 * F.lane]; mo[1] = o1 * rs * nw[2 * F.lane + 1]; }
        }
    }
}

__device__ __forceinline__ void p4b_fixup(Frame& F) {
    const float* TAIL = WSP(float, WS_TAIL); const float* FIXG = WSP(float, WS_FIXG); const float* FIXU = WSP(float, WS_FIXU); bf16* ACT = WSP(bf16, WS_ACT); const float* cw = F.in[22];
    const int total = 32 * 2 * DFF;
    for (int i = F.bid * 512 + F.tid; i < total; i += F.G * 512) {
        const int pm = i / (2 * DFF), rr = (i / DFF) & 1, c = i % DFF;
        if ((pm & 15) == 0) continue;
        const float t0 = TAIL[((size_t)(pm - 1) * 2 + 0) * DFF + c], t1 = TAIL[((size_t)(pm - 1) * 2 + 1) * DFF + c];
        float g = FIXG[((size_t)pm * 2 + rr) * DFF + c];
        g += (rr == 0) ? (cw[c] * t0 + cw[DFF + c] * t1) : (cw[c] * t1);
        ACT[(size_t)(pm * 256 + rr) * DFF + c] = (bf16)f2bf(silu_f(g) * FIXU[((size_t)pm * 2 + rr) * DFF + c]);
    }
    const float* st = F.in[7]; const float* GP = SSP(S_GP); const float* UP = SSP(S_UP); float* SACT = SSP(S_ACT);
    for (int i = F.bid * 512 + F.tid; i < MS * DFF; i += F.G * 512) {
        const int b = i / DFF, c = i % DFF;
        const float s0 = st[((size_t)b * 2 + 0) * DFF + c], s1 = st[((size_t)b * 2 + 1) * DFF + c], gp = GP[i];
        const float g = cw[c] * s0 + cw[DFF + c] * s1 + cw[2 * DFF + c] * gp;
        SACT[i] = silu_f(g) * UP[i];
        F.out[OUT_FCONVS + ((size_t)b * 2 + 0) * DFF + c] = s1; F.out[OUT_FCONVS + ((size_t)b * 2 + 1) * DFF + c] = gp;
    }
}

__device__ __forceinline__ void p7_final(Frame& F) {
    const int gw = F.bid * NWAVES + F.wave, NGW = F.G * NWAVES;
    const float* fw = F.in[27]; const float* ss3 = (const float*)(F.ctl + CW_SUMSQ3);
    for (int m = gw; m < M; m += NGW) {
        const float rs = rsqrtf(ss3[m] * (1.f / D) + EPS);
        f32x4* y = (f32x4*)(F.out + OUT_Y + (size_t)m * D) + F.lane; const f32x4* w = (const f32x4*)fw + F.lane;
#pragma unroll
        for (int j = 0; j < 8; ++j) y[64 * j] = y[64 * j] * rs * w[64 * j];
    }
    if (F.bid == 0) {
        const int b = F.wave; float v[32]; float s = 0.f;
#pragma unroll
        for (int j = 0; j < 32; ++j) { const int c = F.lane + 64 * j; const float h = SSP(S_H2)[(size_t)b * D + c] + SSP(S_PP)[(size_t)b * D + c] * sigmoid_f(SSP(S_PG)[(size_t)b * D + c]); v[j] = h; s += h * h; }
        const float rs = rsqrtf(wave_sum(s) * (1.f / D) + EPS);
#pragma unroll
        for (int j = 0; j < 32; ++j) { const int c = F.lane + 64 * j; F.out[OUT_YS + (size_t)b * D + c] = v[j] * rs * fw[c]; }
    }
}

constexpr int NPHASES = 12;
constexpr int N_LAUNCHES = MK_N_LAUNCHES;
struct Args { const float* in[28]; float* out; unsigned char* ws; int ph_lo, ph_hi; };
__global__ void __launch_bounds__(NWAVES * 64, 2) hymba_fwd(Args args) {
    extern __shared__ __attribute__((aligned(16))) unsigned char lds[];
    Frame F;
    F.lds = (LAS unsigned char*)lds;
    F.MISC = (volatile LAS unsigned*)(F.lds + MISC_OFF);
    F.tid = threadIdx.x; F.lane = F.tid & 63; F.wave = __builtin_amdgcn_readfirstlane(F.tid >> 6);
    F.G = gridDim.x; F.bid = blockIdx.x;
    F.ws = args.ws; F.ctl = (unsigned*)(args.ws + WS_CTL); F.out = args.out;
#pragma unroll
    for (int i = 0; i < 28; ++i) F.in[i] = args.in[i];
    for (int u = F.tid; u < (LDS_BYTES - LDSCTL_OFF) / 4; u += NWAVES * 64) ((LAS unsigned*)(F.lds + LDSCTL_OFF))[u] = 0u;
    __syncthreads();
    XcdBarrier bar; bar.bar = F.ctl + CW_BAR; bar.x = 0; bar.st = nullptr;
    if (N_LAUNCHES == 1) bar = xcd_barrier_post(F.ctl + CW_BAR, F.MISC + 8);
#define GRID_BAR() do { if (N_LAUNCHES == 1) xcd_barrier(bar); } while (0)
    const int lo = args.ph_lo, hi = args.ph_hi;
#define IN(k) (lo <= (k) && (k) < hi)
    float* ss1 = (float*)(F.ctl + CW_SUMSQ1); float* ss2 = (float*)(F.ctl + CW_SUMSQ2); float* ss3 = (float*)(F.ctl + CW_SUMSQ3);

    if (IN(0)) { p0_prologue(F); GRID_BAR(); }
    if (IN(1)) {
        { pg8::Gemm g{WSP(bf16, WS_XN), WSP(bf16, WS_WIN), M, NPROJ_PAD, D}; pg8::StaticOrder S; S.init(M, NPROJ_PAD, F.G, F.bid);
          pg8::EpiProj E{WSP(bf16, WS_Q), WSP(bf16, WS_K), WSP(bf16, WS_V), WSP(bf16, WS_CIN), WSP(bf16, WS_Z), F.out + OUT_K, F.out + OUT_V, F.out + OUT_GCONV, WSP(float, WS_G), WSP(float, WS_BETA), F.in[15], F.in[16]};
          pg8::gemm_phase<pg8::EpiProj, pg8::StaticOrder, true, true>(F.lds + RING_OFF, g, S, E); }
        { pg8::Gemm g{WSP(bf16, WS_PB), WSP(bf16, WS_WPP), M, D, PLE}; pg8::StaticOrder S; S.init(M, D, F.G, F.bid);
          pg8::EpiF32 E{WSP(float, WS_PP), D};
          pg8::gemm_phase<pg8::EpiF32, pg8::StaticOrder, true, true>(F.lds + RING_OFF, g, S, E); }
        { SEpiStore E{SSP(S_PROJ), IN_COLS}; sample_gemv(F, SSP(S_A), D, nullptr, F.in[11], IN_COLS, IN_COLS, E); }
        GRID_BAR();
    }
    if (IN(2)) {
        for (int u = F.bid; u < NB * NH * NCHUNK; u += F.G) { const int chain = u & 15, ci = u >> 4;
            gdn_prep_unit(F, chain, ci, F.ws + WS_GREC + ((size_t)chain * NCHUNK + ci) * GREC_BYTES, WSP(float, WS_GEG) + chain * NCHUNK + ci); }
        gdn_prep_sample(F); GRID_BAR(); }
    if (IN(3)) { p2_mixers(F); GRID_BAR(); }
    if (IN(4)) { p2_finish(F); GRID_BAR(); }
    if (IN(5)) {
        { pg8::Gemm g{WSP(bf16, WS_MIX), WSP(bf16, WS_WOUT), M, D, D}; pg8::StaticOrder S; S.init(M, D, F.G, F.bid);
          pg8::EpiResid E{F.in[0], WSP(float, WS_H1), WSP(bf16, WS_H1B), ss1, D};
          pg8::gemm_phase<pg8::EpiResid, pg8::StaticOrder, true, true>(F.lds + RING_OFF, g, S, E); }
        { SEpiAdd E{F.in[1], SSP(S_H1), D}; sample_gemv(F, SSP(S_MIX), D, nullptr, F.in[18], D, D, E); }
        GRID_BAR();
    }
    if (IN(6)) {
        { pg8::Gemm g{WSP(bf16, WS_H1B), WSP(bf16, WS_WGU), M, NGU, D}; pg8::StaticOrder S; S.init(M, NGU, F.G, F.bid);
          pg8::EpiGateUp E{ss1, F.in[22], WSP(bf16, WS_ACT), WSP(float, WS_TAIL), WSP(float, WS_FIXG), WSP(float, WS_FIXU), F.out + OUT_FCONV, (PG8_LAS float*)(F.lds + HALO_OFF)};
          pg8::gemm_phase<pg8::EpiGateUp, pg8::StaticOrder, true, true>(F.lds + RING_OFF, g, S, E); }
        { SEpiStore E{SSP(S_GP), DFF}; sample_gemv(F, SSP(S_H1), D, F.in[19], F.in[20], DFF, DFF, E); }
        { SEpiStore E{SSP(S_UP), DFF}; sample_gemv(F, SSP(S_H1), D, F.in[19], F.in[21], DFF, DFF, E); }
        GRID_BAR();
    }
    if (IN(7)) { p4b_fixup(F); GRID_BAR(); }
    if (IN(8)) {
        { pg8::Gemm g{WSP(bf16, WS_ACT), WSP(bf16, WS_WDN), M, D, DFF}; pg8::StaticOrder S; S.init(M, D, F.G, F.bid);
          pg8::EpiResid E{WSP(float, WS_H1), WSP(float, WS_H2), WSP(bf16, WS_H2B), ss2, D};
          pg8::gemm_phase<pg8::EpiResid, pg8::StaticOrder, true, true>(F.lds + RING_OFF, g, S, E); }
        { SEpiAdd E{SSP(S_H1), SSP(S_H2), D}; sample_gemv(F, SSP(S_ACT), DFF, nullptr, F.in[23], D, D, E); }
        GRID_BAR();
    }
    if (IN(9)) {
        { pg8::Gemm g{WSP(bf16, WS_H2B), WSP(bf16, WS_WPG), M, D, D}; pg8::StaticOrder S; S.init(M, D, F.G, F.bid);
          pg8::EpiPle E{WSP(float, WS_H2), WSP(float, WS_PP), ss2, F.out + OUT_Y, ss3, D};
          pg8::gemm_phase<pg8::EpiPle, pg8::StaticOrder, true, true>(F.lds + RING_OFF, g, S, E); }
        { SEpiStore E{SSP(S_PG), D}; sample_gemv(F, SSP(S_H2), D, F.in[24], F.in[25], D, D, E); }
        { SEpiStore E{SSP(S_PP), D}; sample_gemv(F, F.in[9], PLE, nullptr, F.in[26], D, D, E); }
        GRID_BAR();
    }
    if (IN(10)) { p7_final(F); }
#undef IN
#undef GRID_BAR
}

extern "C" void kernel_launch(void* const* d_in, const int* in_sizes, int n_in, void* d_out, int out_size, void* d_ws, size_t ws_size, hipStream_t stream) {
    static int grid = 0;
    if (grid == 0) {
        if (n_in != 28 || (size_t)out_size != OUT_END || ws_size < WS_END) { fprintf(stderr, "kernel_launch: unexpected sizes n_in %d out %d ws %zu (need %zu, %zu)\n", n_in, out_size, ws_size, (size_t)OUT_END, (size_t)WS_END); grid = -1; return; }
        int dev = 0, cus = 0, per_cu = 0;
        if (hipGetDevice(&dev) != hipSuccess || hipDeviceGetAttribute(&cus, hipDeviceAttributeMultiprocessorCount, dev) != hipSuccess) { grid = -1; return; }
        if (hipFuncSetAttribute((const void*)hymba_fwd, hipFuncAttributeMaxDynamicSharedMemorySize, LDS_BYTES) != hipSuccess) { fprintf(stderr, "kernel_launch: hipFuncSetAttribute failed\n"); grid = -1; return; }
        if (hipOccupancyMaxActiveBlocksPerMultiprocessor(&per_cu, (const void*)hymba_fwd, NWAVES * 64, LDS_BYTES) != hipSuccess || per_cu < 1) { fprintf(stderr, "kernel_launch: occupancy query says %d\n", per_cu); }
        (void)hipGetLastError();
        grid = cus;
    }
    if (grid < 0) return;
    (void)hipMemsetAsync((char*)d_ws + WS_CTL, 0, CTL_ZERO_BYTES, stream);
    Args a{};
    for (int i = 0; i < 28; ++i) a.in[i] = (const float*)d_in[i];
    a.out = (float*)d_out; a.ws = (unsigned char*)d_ws;
    if (N_LAUNCHES == 1) { a.ph_lo = 0; a.ph_hi = NPHASES; hipLaunchKernelGGL(hymba_fwd, dim3(grid), dim3(NWAVES * 64), LDS_BYTES, stream, a); }
    else for (int p = 0; p < 11; ++p) { a.ph_lo = p; a.ph_hi = p + 1; hipLaunchKernelGGL(hymba_fwd, dim3(grid), dim3(NWAVES * 64), LDS_BYTES, stream, a); }
}
```

```cpp
#include <hip/hip_runtime.h>
#include <cstdio>
#include <cstdint>

#ifndef MK_N_LAUNCHES
#define MK_N_LAUNCHES 1
#endif

namespace pg8 {
#define PG8_LAS __attribute__((address_space(3)))
typedef unsigned short bf16_t;
typedef short bf16x8 __attribute__((ext_vector_type(8)));
typedef float f32x4 __attribute__((ext_vector_type(4)));
typedef unsigned u32x4 __attribute__((ext_vector_type(4)));
constexpr int BM = 256, BK = 64, HALF = 128, HTB = HALF * BK * 2  , STAGE_BYTES = 8 * HTB, NXCD = 8, WGM = 8;

__host__ __device__ __forceinline__ int lds_byte(int r, int c) { const int st = (r >> 4) * 2 + (c >> 5), rr = r & 15, cc = c & 31, ob = rr * 64 + cc * 2; return st * 1024 + (ob ^ (((ob >> 9) & 1) << 5)); }
__host__ __device__ __forceinline__ void stage_rc(int b, int& R, int& C) { const int st = b / 1024, sb = b % 1024, swz = sb ^ (((sb >> 9) & 1) << 5); R = (st >> 1) * 16 + swz / 64; C = (st & 1) * 32 + (swz % 64) / 2; }
__host__ __device__ __forceinline__ int perm32(int rho) { const int n = rho >> 4, i = rho & 15; return 8 * (i >> 2) + 4 * n + (i & 3); }

struct Unit { int pm, pn; };
struct Gemm { const bf16_t* A; const bf16_t* Bt; int M, N, K; };

struct StaticOrder {
    int nM, nN, nwg, G, c;
    __host__ __device__ void init(int M, int N, int G_, int c_) { nM = M / BM; nN = N / BM; nwg = nM * nN; G = G_; c = c_; }
    __host__ __device__ bool next(int i, Unit& u) const {
        const long L = (long)i * G + c; if (L >= nwg) return false;
        int wgid = (int)L; { const int q = nwg / NXCD, r = nwg % NXCD, xcd = wgid % NXCD, off = wgid / NXCD; wgid = (xcd < r ? xcd * (q + 1) : r * (q + 1) + (xcd - r) * q) + off; }
        const int nig = WGM * nN, gid = wgid / nig, fm = gid * WGM, gsz = (nM - fm) < WGM ? (nM - fm) : WGM;
        u.pm = fm + ((wgid % nig) % gsz); u.pn = (wgid % nig) / gsz; return true;
    }
    __device__ __forceinline__ void a_ready(const Unit&) const {}
    __device__ __forceinline__ void done(const Unit&) const {}
};

__device__ __forceinline__ unsigned cvt_pk_bf16(float lo, float hi) { unsigned r; asm volatile("v_cvt_pk_bf16_f32 %0, %1, %2" : "=v"(r) : "v"(lo), "v"(hi)); return r; }
template <class Epi, class Sched, bool ALIGN_EPI = false, bool SP2 = false>
__device__ __forceinline__ void gemm_phase(PG8_LAS unsigned char* lds, const Gemm g, const Sched& S, const Epi& E) {
    const int tid = threadIdx.x, wid = __builtin_amdgcn_readfirstlane(tid >> 6), lane = tid & 63, wr = wid >> 2, wc = wid & 3, fr = lane & 15, fq = lane >> 4;
    const int K = g.K, nt = K / BK;
    unsigned voffA[2], voffB[2];
#pragma unroll
    for (int i = 0; i < 2; ++i) { int R, C; stage_rc(tid * 16 + i * 8192, R, C); const int Rb = Epi::PERM ? ((R & ~31) + perm32(R & 31)) : R;
        voffA[i] = (unsigned)(R * K + C) * 2u; voffB[i] = (unsigned)(Rb * K + C) * 2u; }
    const size_t kstep = (size_t)(BK * 2);
    const size_t hstep = (size_t)HALF * K * 2;
    const size_t tstep = 2 * hstep;
    const unsigned ldsw = (unsigned)wid * 1024u;
    const int aoff = lds_byte(wr * 64 + fr, fq * 8), boff = lds_byte(wc * 32 + fr, fq * 8);
#define PG8_SA(b, h) (((b) * 2 + (h)) * HTB)
#define PG8_SB(b, h) ((4 + (b) * 2 + (h)) * HTB)
#define PG8_STAGE(bufoff, gbase, voff) do { _Pragma("unroll") for (int _i = 0; _i < 2; ++_i) \
        __builtin_amdgcn_global_load_lds((const unsigned*)((const char*)(gbase) + (voff)[_i]), (PG8_LAS unsigned*)(lds + (bufoff) + ldsw + _i * 8192), 16, 0, 0); } while (0)
#define PG8_LDA(dst, b, h) do { _Pragma("unroll") for (int m = 0; m < 4; ++m) _Pragma("unroll") for (int k = 0; k < 2; ++k) dst[m][k] = *(const PG8_LAS bf16x8*)(lds + PG8_SA(b, h) + aoff + m * 2048 + k * 1024); } while (0)
#define PG8_LDB(dst, b, h) do { _Pragma("unroll") for (int n = 0; n < 2; ++n) _Pragma("unroll") for (int k = 0; k < 2; ++k) dst[n][k] = *(const PG8_LAS bf16x8*)(lds + PG8_SB(b, h) + boff + n * 2048 + k * 1024); } while (0)
#define PG8_MMA(ai, bj, At, Bt) do { __builtin_amdgcn_s_setprio(1); _Pragma("unroll") for (int m = 0; m < 4; ++m) _Pragma("unroll") for (int n = 0; n < 2; ++n) _Pragma("unroll") for (int k = 0; k < 2; ++k) \
        acc[ai][bj][m][n] = __builtin_amdgcn_mfma_f32_16x16x32_bf16(Bt[n][k], At[m][k], acc[ai][bj][m][n], 0, 0, 0); __builtin_amdgcn_s_setprio(0); } while (0)
#define PG8_WAIT_V(n) asm volatile("s_waitcnt vmcnt(" #n ")" ::: "memory")
#define PG8_WAIT_L(n) asm volatile("s_waitcnt lgkmcnt(" #n ")" ::: "memory")
#define PG8_BAR __builtin_amdgcn_s_barrier()
#define PG8_SCHED __builtin_amdgcn_sched_barrier(0)
    Unit cur, nxt; int ui = 0;
    if (!S.next(0, cur)) return;
    f32x4 acc[2][2][4][2];
#pragma unroll
    for (int a = 0; a < 2; ++a)
#pragma unroll
        for (int b = 0; b < 2; ++b)
#pragma unroll
            for (int m = 0; m < 4; ++m)
#pragma unroll
                for (int n = 0; n < 2; ++n) acc[a][b][m][n] = (f32x4){0.f, 0.f, 0.f, 0.f};
    bf16x8 At[4][2], B0[2][2], B1[2][2];
    const char* cA = (const char*)g.A + (size_t)cur.pm * tstep; const char* cB = (const char*)g.Bt + (size_t)cur.pn * tstep;
    S.a_ready(cur);
    if constexpr (SP2) {
        PG8_STAGE(PG8_SB(0, 0), cB, voffB); PG8_STAGE(PG8_SB(0, 1), cB + hstep, voffB); PG8_STAGE(PG8_SA(0, 0), cA, voffA); PG8_STAGE(PG8_SA(0, 1), cA + hstep, voffA);
        if (wr == 1) PG8_BAR;
        PG8_WAIT_V(2); PG8_BAR;
        PG8_STAGE(PG8_SB(1, 0), cB + kstep, voffB); PG8_STAGE(PG8_SA(1, 0), cA + kstep, voffA); PG8_STAGE(PG8_SB(1, 1), cB + hstep + kstep, voffB);
        PG8_WAIT_V(6); PG8_BAR;
    } else {
        PG8_STAGE(PG8_SB(0, 0), cB, voffB); PG8_STAGE(PG8_SA(0, 0), cA, voffA); PG8_STAGE(PG8_SB(0, 1), cB + hstep, voffB); PG8_STAGE(PG8_SA(0, 1), cA + hstep, voffA);
        if (wr == 1) PG8_BAR;
        PG8_WAIT_V(4); PG8_BAR;
        PG8_STAGE(PG8_SB(1, 0), cB + kstep, voffB); PG8_STAGE(PG8_SA(1, 0), cA + kstep, voffA); PG8_STAGE(PG8_SB(1, 1), cB + hstep + kstep, voffB);
        PG8_WAIT_V(6); PG8_BAR;
    }
    for (;;) {
        const bool has_next = S.next(ui + 1, nxt);
        const char* nA = has_next ? (const char*)g.A + (size_t)nxt.pm * tstep : cA; const char* nB = has_next ? (const char*)g.Bt + (size_t)nxt.pn * tstep : cB;
        for (int t = 0; t < nt; t += 2) {
            const bool last = (t == nt - 2);
            const char* a1 = cA + (size_t)(t + 1) * kstep;
            const char* a2 = last ? nA : cA + (size_t)(t + 2) * kstep; const char* b2 = last ? nB : cB + (size_t)(t + 2) * kstep;
            const char* a3 = a2 + kstep; const char* b3 = b2 + kstep;
            if (last && has_next) S.a_ready(nxt);
            if constexpr (SP2) {
            PG8_LDB(B0, 0, 0); PG8_LDB(B1, 0, 1); PG8_SCHED; PG8_LDA(At, 0, 0); PG8_STAGE(PG8_SA(1, 1), a1 + hstep, voffA);
            PG8_WAIT_V(8); PG8_WAIT_L(0); PG8_BAR; PG8_MMA(0, 0, At, B0); PG8_MMA(0, 1, At, B1); PG8_BAR; PG8_SCHED;
            PG8_LDA(At, 0, 1); PG8_STAGE(PG8_SB(0, 0), b2, voffB); PG8_STAGE(PG8_SB(0, 1), b2 + hstep, voffB); PG8_STAGE(PG8_SA(0, 0), a2, voffA);
            PG8_WAIT_V(8); PG8_WAIT_L(0); PG8_BAR; PG8_MMA(1, 0, At, B0); PG8_MMA(1, 1, At, B1); PG8_BAR; PG8_SCHED;
            PG8_LDB(B0, 1, 0); PG8_LDB(B1, 1, 1); PG8_SCHED; PG8_LDA(At, 1, 0); PG8_STAGE(PG8_SA(0, 1), a2 + hstep, voffA);
            PG8_WAIT_V(8); PG8_WAIT_L(0); PG8_BAR; PG8_MMA(0, 0, At, B0); PG8_MMA(0, 1, At, B1); PG8_BAR; PG8_SCHED;
            PG8_LDA(At, 1, 1); PG8_STAGE(PG8_SB(1, 0), b3, voffB); PG8_STAGE(PG8_SB(1, 1), b3 + hstep, voffB); PG8_STAGE(PG8_SA(1, 0), a3, voffA);
            PG8_WAIT_V(8); PG8_WAIT_L(0); PG8_BAR; PG8_MMA(1, 0, At, B0); PG8_MMA(1, 1, At, B1); PG8_BAR; PG8_SCHED;
            } else {
            PG8_LDB(B0, 0, 0); PG8_SCHED; PG8_LDA(At, 0, 0); PG8_STAGE(PG8_SA(1, 1), a1 + hstep, voffA);
            PG8_WAIT_L(8); PG8_BAR; PG8_WAIT_L(0); PG8_MMA(0, 0, At, B0); PG8_BAR; PG8_SCHED;
            PG8_LDB(B1, 0, 1); PG8_STAGE(PG8_SB(0, 0), b2, voffB);
            PG8_BAR; PG8_WAIT_L(0); PG8_MMA(0, 1, At, B1); PG8_BAR;
            PG8_LDA(At, 0, 1); PG8_STAGE(PG8_SA(0, 0), a2, voffA);
            PG8_BAR; PG8_WAIT_L(0); PG8_MMA(1, 0, At, B0); PG8_BAR; PG8_SCHED;
            PG8_STAGE(PG8_SB(0, 1), b2 + hstep, voffB);
            PG8_WAIT_V(6); PG8_BAR; PG8_MMA(1, 1, At, B1); PG8_BAR;
            PG8_LDB(B0, 1, 0); PG8_SCHED; PG8_LDA(At, 1, 0); PG8_STAGE(PG8_SA(0, 1), a2 + hstep, voffA);
            PG8_WAIT_L(8); PG8_BAR; PG8_WAIT_L(0); PG8_MMA(0, 0, At, B0); PG8_BAR; PG8_SCHED;
            PG8_LDB(B1, 1, 1); PG8_STAGE(PG8_SB(1, 0), b3, voffB);
            PG8_BAR; PG8_WAIT_L(0); PG8_MMA(0, 1, At, B1); PG8_BAR;
            PG8_LDA(At, 1, 1); PG8_STAGE(PG8_SA(1, 0), a3, voffA);
            PG8_BAR; PG8_WAIT_L(0); PG8_MMA(1, 0, At, B0); PG8_BAR; PG8_SCHED;
            PG8_STAGE(PG8_SB(1, 1), b3 + hstep, voffB);
            PG8_WAIT_V(6); PG8_BAR; PG8_MMA(1, 1, At, B1); PG8_BAR;
            }
        }
        if constexpr (ALIGN_EPI) { if (wr == 0) PG8_BAR; }
        if constexpr (!Epi::AFTER_DRAIN) { E(acc, cur, wr, wc, fr, fq); S.done(cur); }
        if (!has_next) break;
#pragma unroll
        for (int a = 0; a < 2; ++a)
#pragma unroll
            for (int b = 0; b < 2; ++b)
#pragma unroll
                for (int m = 0; m < 4; ++m)
#pragma unroll
                    for (int n = 0; n < 2; ++n) acc[a][b][m][n] = (f32x4){0.f, 0.f, 0.f, 0.f};
        cur = nxt; cA = nA; cB = nB; ++ui;
        if constexpr (ALIGN_EPI) { if (wr == 1) PG8_BAR; }
    }
    PG8_WAIT_V(0);
    if constexpr (!ALIGN_EPI) { if (wr == 0) PG8_BAR; }
    PG8_BAR;
    if constexpr (Epi::AFTER_DRAIN) { E.fused(acc, cur, wr, wc, fr, fq, lds, wid, lane); S.done(cur); }
#undef PG8_SA
#undef PG8_SB
#undef PG8_STAGE
#undef PG8_LDA
#undef PG8_LDB
#undef PG8_MMA
#undef PG8_WAIT_V
#undef PG8_WAIT_L
#undef PG8_BAR
#undef PG8_SCHED
}
}

constexpr int D = 2048, T = 4096, NB = 2, M = NB * T;
constexpr int MS = 8;
constexpr int HD = 128, NH = 8, SBW = NH * HD, GW = NH * HD;
constexpr int CONVCH = 3 * GW;
constexpr int IN_COLS = 7184, NPROJ_PAD = 7424;
constexpr int DFF = 5504, NGU = 2 * DFF;
constexpr int PLE = 256;
constexpr int PAST = 16384, PAGE = 128, NPAGES = PAST / PAGE, NPOOL = 1280;
constexpr float EPS = 1e-6f;
constexpr float SB_SCALE = 0.08838834764831845f;
constexpr int O_SB_K = 1024, O_SB_V = 2048, O_GQKV = 3072, O_GZ = 6144, O_GA = 7168, O_GB = 7176;

constexpr size_t OUT_Y = 0;
constexpr size_t OUT_YS = OUT_Y + (size_t)M * D;
constexpr size_t OUT_K = OUT_YS + (size_t)MS * D;
constexpr size_t OUT_V = OUT_K + (size_t)M * SBW;
constexpr size_t OUT_GCONV = OUT_V + (size_t)M * SBW;
constexpr size_t OUT_GREC = OUT_GCONV + (size_t)NB * 3 * CONVCH;
constexpr size_t OUT_FCONV = OUT_GREC + (size_t)NB * NH * HD * HD;
constexpr size_t OUT_KS = OUT_FCONV + (size_t)NB * 2 * DFF;
constexpr size_t OUT_VS = OUT_KS + (size_t)MS * SBW;
constexpr size_t OUT_GCONVS = OUT_VS + (size_t)MS * SBW;
constexpr size_t OUT_GRECS = OUT_GCONVS + (size_t)MS * 3 * CONVCH;
constexpr size_t OUT_FCONVS = OUT_GRECS + (size_t)MS * NH * HD * HD;
constexpr size_t OUT_END = OUT_FCONVS + (size_t)MS * 2 * DFF;

namespace pg8 {
__device__ __forceinline__ float silu_f(float x) { return x / (1.0f + __expf(-x)); }
__device__ __forceinline__ float sigmoid_f(float x) { return 1.0f / (1.0f + __expf(-x)); }
__device__ __forceinline__ float softplus_f(float x) { return fmaxf(x, 0.f) + log1pf(__expf(-fabsf(x))); }
typedef unsigned u32x2 __attribute__((ext_vector_type(2)));

struct EpiProj {
    static constexpr bool PERM = true, AFTER_DRAIN = false;
    bf16_t *Qb, *Kb, *Vb, *CIN, *Zb; float *outK, *outV, *outGconv; float *G, *BETA; const float *a_log, *dt_bias;
    __device__ __forceinline__ void operator()(const f32x4 (&acc)[2][2][4][2], const Unit& u, int wr, int wc, int fr, int fq) const {
        const int reg = u.pn >> 2;
#pragma unroll
        for (int ai = 0; ai < 2; ++ai)
#pragma unroll
            for (int m = 0; m < 4; ++m) {
                const int r = u.pm * BM + ai * HALF + wr * 64 + m * 16 + fr;
#pragma unroll
                for (int bj = 0; bj < 2; ++bj) {
                    const int c8 = u.pn * BM + bj * HALF + wc * 32 + 8 * fq;
                    const f32x4 v0 = acc[ai][bj][m][0], v1 = acc[ai][bj][m][1];
                    u32x4 w; w.x = cvt_pk_bf16(v0[0], v0[1]); w.y = cvt_pk_bf16(v0[2], v0[3]); w.z = cvt_pk_bf16(v1[0], v1[1]); w.w = cvt_pk_bf16(v1[2], v1[3]);
                    if (reg == 0) { *(u32x4*)(Qb + (size_t)r * SBW + c8) = w; }
                    else if (reg == 1) { const int c = c8 - O_SB_K; *(u32x4*)(Kb + (size_t)r * SBW + c) = w; float* o = outK + (size_t)r * SBW + c; *(f32x4*)o = v0; *(f32x4*)(o + 4) = v1; }
                    else if (reg == 2) { const int c = c8 - O_SB_V; *(u32x4*)(Vb + (size_t)r * SBW + c) = w; float* o = outV + (size_t)r * SBW + c; *(f32x4*)o = v0; *(f32x4*)(o + 4) = v1; }
                    else if (reg < 6) { const int c = c8 - O_GQKV; *(u32x4*)(CIN + (size_t)r * CONVCH + c) = w;
                        const int t = r & (T - 1); if (t >= T - 3) { float* o = outGconv + ((size_t)(r >> 12) * 3 + (t - (T - 3))) * CONVCH + c; *(f32x4*)o = v0; *(f32x4*)(o + 4) = v1; } }
                    else if (reg == 6) { const int c = c8 - O_GZ; *(u32x4*)(Zb + (size_t)r * GW + c) = w; }
                    else if (bj == 0 && wc == 0 && fq < 2 && u.pn == 28) {
                        float x[8] = {v0[0], v0[1], v0[2], v0[3], v1[0], v1[1], v1[2], v1[3]}; float y[8];
#pragma unroll
                        for (int h = 0; h < 8; ++h) y[h] = (fq == 0) ? -__expf(a_log[h]) * softplus_f(x[h] + dt_bias[h]) : sigmoid_f(x[h]);
                        float* o = (fq == 0 ? G : BETA) + (size_t)r * NH; *(f32x4*)o = (f32x4){y[0], y[1], y[2], y[3]}; *(f32x4*)(o + 4) = (f32x4){y[4], y[5], y[6], y[7]};
                    }
                }
            }
    }
};

struct EpiF32 {
    static constexpr bool PERM = false, AFTER_DRAIN = false;
    float* C; int ldc;
    __device__ __forceinline__ void operator()(const f32x4 (&acc)[2][2][4][2], const Unit& u, int wr, int wc, int fr, int fq) const {
        const int row0 = u.pm * BM + wr * 64 + fr, col0 = u.pn * BM + wc * 32 + 4 * fq;
#pragma unroll
        for (int ai = 0; ai < 2; ++ai)
#pragma unroll
            for (int m = 0; m < 4; ++m) { float* rowp = C + (size_t)(row0 + ai * HALF + m * 16) * ldc + col0;
#pragma unroll
                for (int bj = 0; bj < 2; ++bj)
#pragma unroll
                    for (int n = 0; n < 2; ++n) *(f32x4*)(rowp + bj * HALF + n * 16) = acc[ai][bj][m][n]; }
    }
};

struct EpiResid {
    static constexpr bool PERM = false, AFTER_DRAIN = false;
    const float* base; float* Hf; bf16_t* Hb; float* sumsq; int ldc;
    __device__ __forceinline__ void operator()(const f32x4 (&acc)[2][2][4][2], const Unit& u, int wr, int wc, int fr, int fq) const {
        const int row0 = u.pm * BM + wr * 64 + fr, col0 = u.pn * BM + wc * 32 + 4 * fq;
#pragma unroll
        for (int ai = 0; ai < 2; ++ai)
#pragma unroll
            for (int m = 0; m < 4; ++m) { const int r = row0 + ai * HALF + m * 16; const size_t off = (size_t)r * ldc + col0; float ss = 0.f;
#pragma unroll
                for (int bj = 0; bj < 2; ++bj)
#pragma unroll
                    for (int n = 0; n < 2; ++n) { const f32x4 b = *(const f32x4*)(base + off + bj * HALF + n * 16); const f32x4 h = b + acc[ai][bj][m][n];
                        *(f32x4*)(Hf + off + bj * HALF + n * 16) = h; u32x2 w; w.x = cvt_pk_bf16(h[0], h[1]); w.y = cvt_pk_bf16(h[2], h[3]); *(u32x2*)(Hb + off + bj * HALF + n * 16) = w;
                        ss += (h[0] * h[0] + h[1] * h[1]) + (h[2] * h[2] + h[3] * h[3]); }
                ss += __shfl_xor(ss, 16); ss += __shfl_xor(ss, 32);
                if (fq == 0) unsafeAtomicAdd(sumsq + r, ss); }
    }
};

struct EpiGateUp {
    static constexpr bool PERM = true, AFTER_DRAIN = false;
    const float* sumsq; const float* convw; bf16_t* ACT; float* TAIL; float* FIXG; float* FIXU; float* outFconv; PG8_LAS float* halo;
    __device__ __forceinline__ void operator()(const f32x4 (&acc)[2][2][4][2], const Unit& u, int wr, int wc, int fr, int fq) const {
        const int lane = fr + 16 * fq;
        const int cg = u.pn * HALF + wc * 32 + 8 * fq;
        float w0[8], w1[8], w2[8];
#pragma unroll
        for (int j = 0; j < 8; ++j) { w0[j] = convw[cg + j]; w1[j] = convw[DFF + cg + j]; w2[j] = convw[2 * DFF + cg + j]; }
        float gp[2][4][8], up[2][4][8];
#pragma unroll
        for (int ai = 0; ai < 2; ++ai)
#pragma unroll
            for (int m = 0; m < 4; ++m) { const int r = u.pm * BM + ai * HALF + wr * 64 + m * 16 + fr; const float rs = rsqrtf(sumsq[r] * (1.0f / D) + EPS);
#pragma unroll
                for (int n = 0; n < 2; ++n)
#pragma unroll
                    for (int j = 0; j < 4; ++j) { gp[ai][m][4 * n + j] = acc[ai][0][m][n][j] * rs; up[ai][m][4 * n + j] = acc[ai][1][m][n][j] * rs; } }
        if (fr >= 14) {
#pragma unroll
            for (int ai = 0; ai < 2; ++ai) { PG8_LAS float* hp = halo + ((wc * 4 + (2 * ai + wr)) * 2 + (fr - 14)) * 32 + 8 * fq;
                *(PG8_LAS f32x4*)hp = (f32x4){gp[ai][3][0], gp[ai][3][1], gp[ai][3][2], gp[ai][3][3]}; *(PG8_LAS f32x4*)(hp + 4) = (f32x4){gp[ai][3][4], gp[ai][3][5], gp[ai][3][6], gp[ai][3][7]}; }
        }
        asm volatile("s_waitcnt lgkmcnt(0)" ::: "memory"); __builtin_amdgcn_s_barrier(); asm volatile("" ::: "memory");
        const int src1 = (lane & 48) | ((fr - 1) & 15), src2 = (lane & 48) | ((fr - 2) & 15);
#pragma unroll
        for (int ai = 0; ai < 2; ++ai) {
            const int B = 2 * ai + wr;
            float h62[8], h63[8];
            if (B > 0) { const PG8_LAS float* hp = halo + ((wc * 4 + (B - 1)) * 2) * 32 + 8 * fq;
                const f32x4 a0 = *(const PG8_LAS f32x4*)hp, a1 = *(const PG8_LAS f32x4*)(hp + 4), b0 = *(const PG8_LAS f32x4*)(hp + 32), b1 = *(const PG8_LAS f32x4*)(hp + 36);
#pragma unroll
                for (int j = 0; j < 4; ++j) { h62[j] = a0[j]; h62[4 + j] = a1[j]; h63[j] = b0[j]; h63[4 + j] = b1[j]; } }
            else {
#pragma unroll
                for (int j = 0; j < 8; ++j) { h62[j] = 0.f; h63[j] = 0.f; } }
            float ps1[8], ps2[8];
#pragma unroll
            for (int j = 0; j < 8; ++j) { ps1[j] = h63[j]; ps2[j] = (fr == 0) ? h62[j] : h63[j]; }
#pragma unroll
            for (int m = 0; m < 4; ++m) {
                const int r = u.pm * BM + ai * HALF + wr * 64 + m * 16 + fr;
                float gate[8], a[8];
#pragma unroll
                for (int j = 0; j < 8; ++j) {
                    const float s1 = __shfl(gp[ai][m][j], src1), s2 = __shfl(gp[ai][m][j], src2);
                    const float p1 = (fr >= 1) ? s1 : ps1[j], p2 = (fr >= 2) ? s2 : ps2[j];
                    ps1[j] = s1; ps2[j] = s2;
                    gate[j] = w0[j] * p2 + w1[j] * p1 + w2[j] * gp[ai][m][j];
                    a[j] = silu_f(gate[j]) * up[ai][m][j];
                }
                u32x4 w; w.x = cvt_pk_bf16(a[0], a[1]); w.y = cvt_pk_bf16(a[2], a[3]); w.z = cvt_pk_bf16(a[4], a[5]); w.w = cvt_pk_bf16(a[6], a[7]);
                *(u32x4*)(ACT + (size_t)r * DFF + cg) = w;
                if (B == 0 && m == 0 && fr < 2 && (u.pm & 15) != 0) {
                    float* fg = FIXG + ((size_t)u.pm * 2 + fr) * DFF + cg; float* fu = FIXU + ((size_t)u.pm * 2 + fr) * DFF + cg;
                    *(f32x4*)fg = (f32x4){gate[0], gate[1], gate[2], gate[3]}; *(f32x4*)(fg + 4) = (f32x4){gate[4], gate[5], gate[6], gate[7]};
                    *(f32x4*)fu = (f32x4){up[ai][m][0], up[ai][m][1], up[ai][m][2], up[ai][m][3]}; *(f32x4*)(fu + 4) = (f32x4){up[ai][m][4], up[ai][m][5], up[ai][m][6], up[ai][m][7]};
                }
                if (B == 3 && m == 3 && fr >= 14) {
                    float* tp = TAIL + ((size_t)u.pm * 2 + (fr - 14)) * DFF + cg;
                    *(f32x4*)tp = (f32x4){gp[ai][m][0], gp[ai][m][1], gp[ai][m][2], gp[ai][m][3]}; *(f32x4*)(tp + 4) = (f32x4){gp[ai][m][4], gp[ai][m][5], gp[ai][m][6], gp[ai][m][7]};
                    if ((u.pm & 15) == 15) { float* op = outFconv + ((size_t)(u.pm >> 4) * 2 + (fr - 14)) * DFF + cg;
                        *(f32x4*)op = (f32x4){gp[ai][m][0], gp[ai][m][1], gp[ai][m][2], gp[ai][m][3]}; *(f32x4*)(op + 4) = (f32x4){gp[ai][m][4], gp[ai][m][5], gp[ai][m][6], gp[ai][m][7]}; }
                }
            }
        }
    }
};

struct EpiPle {
    static constexpr bool PERM = false, AFTER_DRAIN = false;
    const float* H2; const float* PP; const float* sumsq2; float* H3; float* sumsq3; int ldc;
    __device__ __forceinline__ void operator()(const f32x4 (&acc)[2][2][4][2], const Unit& u, int wr, int wc, int fr, int fq) const {
        const int row0 = u.pm * BM + wr * 64 + fr, col0 = u.pn * BM + wc * 32 + 4 * fq;
#pragma unroll
        for (int ai = 0; ai < 2; ++ai)
#pragma unroll
            for (int m = 0; m < 4; ++m) { const int r = row0 + ai * HALF + m * 16; const size_t off = (size_t)r * ldc + col0; float ss = 0.f;
                const float rs = rsqrtf(sumsq2[r] * (1.0f / D) + EPS);
#pragma unroll
                for (int bj = 0; bj < 2; ++bj)
#pragma unroll
                    for (int n = 0; n < 2; ++n) { const f32x4 b = *(const f32x4*)(H2 + off + bj * HALF + n * 16), p = *(const f32x4*)(PP + off + bj * HALF + n * 16); const f32x4 a = acc[ai][bj][m][n]; f32x4 h;
#pragma unroll
                        for (int j = 0; j < 4; ++j) h[j] = b[j] + p[j] * sigmoid_f(a[j] * rs);
                        *(f32x4*)(H3 + off + bj * HALF + n * 16) = h; ss += (h[0] * h[0] + h[1] * h[1]) + (h[2] * h[2] + h[3] * h[3]); }
                ss += __shfl_xor(ss, 16); ss += __shfl_xor(ss, 32);
                if (fq == 0) unsafeAtomicAdd(sumsq3 + r, ss); }
    }
};
}

constexpr size_t MiB = 1u << 20;
constexpr size_t WS_CTL = 0, CTL_ZERO_BYTES = 1 * MiB;
constexpr int CW_QUEUE = 1024;
constexpr int CW_BAR = 4096;
constexpr int CW_SUMSQ1 = 32768, CW_SUMSQ2 = CW_SUMSQ1 + M, CW_SUMSQ3 = CW_SUMSQ2 + M;
static_assert((CW_SUMSQ3 + M) * 4 <= (int)CTL_ZERO_BYTES, "ctl");
constexpr size_t WS_WIN = 2 * MiB;
constexpr size_t WS_WOUT = WS_WIN + (size_t)NPROJ_PAD * D * 2;
constexpr size_t WS_WGU = WS_WOUT + (size_t)D * D * 2;
constexpr size_t WS_WDN = WS_WGU + (size_t)NGU * D * 2;
constexpr size_t WS_WPG = WS_WDN + (size_t)D * DFF * 2;
constexpr size_t WS_WPP = WS_WPG + (size_t)D * D * 2;
constexpr size_t WS_XN = WS_WPP + (size_t)D * PLE * 2;
constexpr size_t WS_PB = WS_XN + (size_t)M * D * 2;
constexpr size_t WS_Q = WS_PB + (size_t)M * PLE * 2;
constexpr size_t WS_K = WS_Q + (size_t)M * SBW * 2;
constexpr size_t WS_V = WS_K + (size_t)M * SBW * 2;
constexpr size_t WS_CIN = WS_V + (size_t)M * SBW * 2;
constexpr size_t WS_Z = WS_CIN + (size_t)M * CONVCH * 2;
constexpr size_t WS_G = WS_Z + (size_t)M * GW * 2;
constexpr size_t WS_BETA = WS_G + (size_t)M * NH * 4;
constexpr size_t WS_GQ = WS_BETA + (size_t)M * NH * 4;
constexpr size_t WS_GK = WS_GQ + (size_t)M * GW * 4;
constexpr size_t WS_GV = WS_GK + (size_t)M * GW * 4;
constexpr size_t WS_GO = WS_GV + (size_t)M * GW * 4;
constexpr size_t WS_MIX = WS_GO + (size_t)M * GW * 4;
constexpr size_t WS_H1 = WS_MIX + (size_t)M * D * 2;
constexpr size_t WS_H1B = WS_H1 + (size_t)M * D * 4;
constexpr size_t WS_ACT = WS_H1B + (size_t)M * D * 2;
constexpr size_t WS_TAIL = WS_ACT + (size_t)M * DFF * 2;
constexpr size_t WS_FIXG = WS_TAIL + (size_t)32 * 2 * DFF * 4;
constexpr size_t WS_FIXU = WS_FIXG + (size_t)32 * 2 * DFF * 4;
constexpr size_t WS_H2 = WS_FIXU + (size_t)32 * 2 * DFF * 4;
constexpr size_t WS_H2B = WS_H2 + (size_t)M * D * 4;
constexpr size_t WS_PP = WS_H2B + (size_t)M * D * 2;
constexpr size_t WS_S = WS_PP + (size_t)M * D * 4;
constexpr size_t S_A = 0;
constexpr size_t S_PROJ = S_A + MS * D;
constexpr size_t S_GQ = S_PROJ + MS * IN_COLS;
constexpr size_t S_GK = S_GQ + MS * GW;
constexpr size_t S_GV = S_GK + MS * GW;
constexpr size_t S_G = S_GV + MS * GW;
constexpr size_t S_BETA = S_G + 64;
constexpr size_t S_GO = S_BETA + 64;
constexpr size_t S_PART = S_GO + MS * GW;
constexpr int DSEG = 32, DPART = 132;
constexpr size_t S_MIX = S_PART + (size_t)MS * NH * DSEG * DPART;
constexpr size_t S_H1 = S_MIX + MS * D;
constexpr size_t S_GP = S_H1 + MS * D;
constexpr size_t S_UP = S_GP + MS * DFF;
constexpr size_t S_ACT = S_UP + MS * DFF;
constexpr size_t S_H2 = S_ACT + MS * DFF;
constexpr size_t S_PG = S_H2 + MS * D;
constexpr size_t S_PP = S_PG + MS * D;
constexpr size_t S_END = S_PP + MS * D;
constexpr size_t WS_GREC = ((WS_S + S_END * 4 + 4095) / 4096) * 4096;
constexpr size_t WS_GEG = WS_GREC + (size_t)16 * 64 * 73728;
constexpr size_t WS_DUMMY = WS_GEG + 16 * 64 * 4;
constexpr size_t WS_END = WS_DUMMY + (size_t)M * 4;

constexpr int RING_OFF = 0, RING_BYTES = 131072;
constexpr int HALO_OFF = RING_BYTES;
constexpr int LDSCTL_OFF = RING_BYTES + 8192, MISC_OFF = LDSCTL_OFF + 320;
constexpr int LDS_BYTES = 147456;
constexpr int NWAVES = 8;

#define GAS __attribute__((address_space(1)))
#define LAS __attribute__((address_space(3)))
typedef unsigned short bf16;
typedef unsigned v4u __attribute__((ext_vector_type(4)));
typedef unsigned v2u __attribute__((ext_vector_type(2)));
typedef float f32x4 __attribute__((ext_vector_type(4)));
typedef float f32x2 __attribute__((ext_vector_type(2)));
typedef GAS unsigned gu32;
typedef short bf16x8 __attribute__((ext_vector_type(8)));
typedef short s16x4 __attribute__((ext_vector_type(4)));
typedef float f32x16 __attribute__((ext_vector_type(16)));
typedef __bf16 bf16x2_t __attribute__((ext_vector_type(2)));
__device__ __forceinline__ unsigned cvt2bf(float lo, float hi) { const f32x2 v = {lo, hi}; return __builtin_bit_cast(unsigned, __builtin_convertvector(v, bf16x2_t)); }
#define RLX_AGENT __ATOMIC_RELAXED, __HIP_MEMORY_SCOPE_AGENT
#define LDS_WAIT() asm volatile("s_waitcnt lgkmcnt(0)" ::: "memory")
#define VM_WAIT() asm volatile("s_waitcnt vmcnt(0)" ::: "memory")
__device__ __forceinline__ unsigned f2bf(float f) { unsigned u = __builtin_bit_cast(unsigned, f); return (u + 0x7fffu + ((u >> 16) & 1u)) >> 16; }
__device__ __forceinline__ unsigned pk2(float lo, float hi) { return f2bf(lo) | (f2bf(hi) << 16); }
__device__ __forceinline__ float bf_lo(unsigned w) { return __builtin_bit_cast(float, w << 16); }
__device__ __forceinline__ float bf_hi(unsigned w) { return __builtin_bit_cast(float, w & 0xffff0000u); }
__device__ __forceinline__ float bf2f(bf16 b) { return __builtin_bit_cast(float, (unsigned)b << 16); }
using pg8::silu_f; using pg8::sigmoid_f; using pg8::softplus_f;

#define XB_TMO      128
#define XB_XCNT(j)  (256  + 64 * (j))
#define XB_XSUB(j)  (1280 + 64 * (j))
#define XB_XGEN(j)  (2304 + 64 * (j))
#define XB_TOP      3328
#define XB_TOPGEN   3392
#define XCD_BAR_WORDS 3456
#define XB_SPIN_CAP (1u << 18)
__device__ __forceinline__ unsigned xb_ld(unsigned* p)              { return __hip_atomic_load(p, __ATOMIC_RELAXED, __HIP_MEMORY_SCOPE_AGENT); }
__device__ __forceinline__ unsigned xb_add(unsigned* p, unsigned v) { return __hip_atomic_fetch_add(p, v, __ATOMIC_RELAXED, __HIP_MEMORY_SCOPE_AGENT); }
__device__ __forceinline__ unsigned xb_xcc_id() { return (unsigned)__builtin_amdgcn_s_getreg((3 << 11) | 20) & 0xFu; }
#define XB_SPIN(cond, bar) do { unsigned _sp = 0; while (cond) { __builtin_amdgcn_s_sleep(1); \
    if ((++_sp & 255u) == 0u) { if (xb_ld(&(bar)[XB_TMO])) break; if (_sp > XB_SPIN_CAP) { atomicAdd(&(bar)[XB_TMO], 1u); break; } } } } while (0)
struct XcdBarrier { unsigned* bar; unsigned x; volatile LAS unsigned* st; };
__device__ __forceinline__ XcdBarrier xcd_barrier_post(unsigned* bar, volatile LAS unsigned* st) {
    XcdBarrier b; b.bar = bar; b.x = xb_xcc_id(); b.st = st;
    if (threadIdx.x == 0) (void)xb_add(&bar[XB_XCNT(b.x)], 1u);
    return b;
}
__device__ __forceinline__ void xcd_barrier_complete(unsigned* bar, unsigned x, unsigned& nloc, unsigned& nx) {
    const unsigned G = gridDim.x * gridDim.y * gridDim.z;
    unsigned sum, cnt, mine, sp = 0u;
    for (;;) {
        sum = 0u; cnt = 0u; mine = 0u;
#pragma unroll
        for (unsigned j = 0; j < 16; ++j) { const unsigned c = xb_ld(&bar[XB_XCNT(j)]); sum += c; cnt += (c > 0u) ? 1u : 0u; mine = (j == x) ? c : mine; }
        if (sum == G) break;
        __builtin_amdgcn_s_sleep(1);
        if ((++sp & 255u) == 0u) { if (xb_ld(&bar[XB_TMO])) break; if (sp > XB_SPIN_CAP) { atomicAdd(&bar[XB_TMO], 1u); break; } }
    }
    nloc = mine > 0u ? mine : 1u; nx = cnt > 0u ? cnt : 1u;
}
__device__ __forceinline__ void xcd_barrier(const XcdBarrier& b) {
    asm volatile("s_waitcnt vmcnt(0)" ::: "memory");
    __syncthreads();
    if (threadIdx.x == 0) {
        unsigned* bar = b.bar;
        __builtin_amdgcn_s_waitcnt(0);
        unsigned nloc = b.st[0], nx = b.st[1];
        if (nloc == 0u) { xcd_barrier_complete(bar, b.x, nloc, nx); b.st[0] = nloc; b.st[1] = nx; }
        const unsigned old = xb_add(&bar[XB_XSUB(b.x)], 1u);
        const unsigned gen = old / nloc;
        if (old + 1u == (gen + 1u) * nloc) {
            __builtin_amdgcn_fence(__ATOMIC_RELEASE, "agent");
            asm volatile("s_waitcnt vmcnt(0)" ::: "memory");
            const unsigned og = xb_add(&bar[XB_TOP], 1u);
            const unsigned tg = og / nx;
            if (og + 1u == (tg + 1u) * nx) xb_add(&bar[XB_TOPGEN], 1u);
            else XB_SPIN(xb_ld(&bar[XB_TOPGEN]) == tg, bar);
            __builtin_amdgcn_fence(__ATOMIC_ACQUIRE, "agent");
            xb_add(&bar[XB_XGEN(b.x)], 1u);
            asm volatile("s_waitcnt vmcnt(0)" ::: "memory");
        } else {
            XB_SPIN(xb_ld(&bar[XB_XGEN(b.x)]) == gen, bar);
            __builtin_amdgcn_fence(__ATOMIC_ACQUIRE, "agent");
            asm volatile("s_waitcnt vmcnt(0)" ::: "memory");
        }
    }
    __syncthreads();
}

struct Frame {
    LAS unsigned char* lds;
    volatile LAS unsigned* MISC;
    unsigned* ctl;
    int tid, lane, wave, G, bid;
    const float* in[28];
    float* out;
    unsigned char* ws;
};
#define WSP(T_, off) ((T_*)(F.ws + (off)))
#define SSP(off) ((float*)(F.ws + WS_S) + (off))

__device__ __forceinline__ float wave_sum(float v) {
#pragma unroll
    for (int o = 1; o < 64; o <<= 1) v += __shfl_xor(v, o);
    return v;
}

__device__ __forceinline__ void p0_transpose_item(const float* W, int ldw, int nvalid, int K, bf16* WT, int drow, int k0, int n0, const float* kscale, LAS float* scr, int lane) {
    const int n4 = (lane & 15) * 4, kq = lane >> 4;
    const bool nv = (n0 + n4) < nvalid;
#pragma unroll 8
    for (int i = 0; i < 16; ++i) { const int kk = 4 * i + kq;
        f32x4 v = nv ? *(const f32x4*)(W + (size_t)(k0 + kk) * ldw + n0 + n4) : (f32x4){0.f, 0.f, 0.f, 0.f};
        if (kscale) v = v * kscale[k0 + kk];
        LAS float* d = scr + kk * 65 + n4; d[0] = v.x; d[1] = v.y; d[2] = v.z; d[3] = v.w; }
    LDS_WAIT(); asm volatile("" ::: "memory");
    const int c = lane & 7;
#pragma unroll
    for (int j = 0; j < 8; ++j) { const int n = (lane >> 3) + 8 * j; const LAS float* s = scr + (8 * c) * 65 + n;
        v4u o; o.x = pk2(s[0 * 65], s[1 * 65]); o.y = pk2(s[2 * 65], s[3 * 65]); o.z = pk2(s[4 * 65], s[5 * 65]); o.w = pk2(s[6 * 65], s[7 * 65]);
        *(v4u*)(WT + (size_t)(drow + n) * K + k0 + 8 * c) = o; }
    LDS_WAIT(); asm volatile("" ::: "memory");
}
__device__ __forceinline__ void rms_row(const float* xrow, const float* w, bf16* ob, float* of, int lane) {
    const f32x4* xr = (const f32x4*)xrow + lane; const f32x4* wr_ = (const f32x4*)w + lane;
    f32x4 v[8]; float s = 0.f;
#pragma unroll
    for (int j = 0; j < 8; ++j) { v[j] = xr[64 * j]; s += (v[j].x * v[j].x + v[j].y * v[j].y) + (v[j].z * v[j].z + v[j].w * v[j].w); }
    const float rstd = rsqrtf(wave_sum(s) * (1.f / D) + EPS);
#pragma unroll
    for (int j = 0; j < 8; ++j) { const f32x4 g = wr_[64 * j]; const f32x4 y = v[j] * rstd * g;
        if (ob) ((unsigned long long*)ob)[lane + 64 * j] = (unsigned long long)pk2(y.x, y.y) | ((unsigned long long)pk2(y.z, y.w) << 32);
        if (of) ((f32x4*)of)[lane + 64 * j] = y; }
}

__device__ __forceinline__ void p0_prologue(Frame& F) {
    LAS float* scr = (LAS float*)(F.lds + RING_OFF + F.wave * 16640);
    const int gw = F.bid * NWAVES + F.wave, NGW = F.G * NWAVES;
    const float* w_in = F.in[11]; const float* w_out = F.in[18]; const float* w_g = F.in[20]; const float* w_u = F.in[21]; const float* w_d = F.in[23]; const float* w_pg = F.in[25]; const float* w_pp = F.in[26];
    const float* ffn_norm = F.in[19]; const float* ple_norm = F.in[24];
    bf16* Win = WSP(bf16, WS_WIN); bf16* Wout = WSP(bf16, WS_WOUT); bf16* Wgu = WSP(bf16, WS_WGU); bf16* Wdn = WSP(bf16, WS_WDN); bf16* Wpg = WSP(bf16, WS_WPG); bf16* Wpp = WSP(bf16, WS_WPP);
    constexpr int NB_IN = 113;
    constexpr int I_IN = (D / 64) * NB_IN;
    constexpr int I_OUT = (D / 64) * (D / 64);
    constexpr int I_G = (D / 64) * (DFF / 64), I_U = I_G;
    constexpr int I_D = (DFF / 64) * (D / 64);
    constexpr int I_PG = I_OUT;
    constexpr int I_PP = (PLE / 64) * (D / 64);
    constexpr int NITEMS = I_IN + I_OUT + I_G + I_U + I_D + I_PG + I_PP;
    for (int it = gw; it < NITEMS; it += NGW) {
        int r = it;
        if (r < I_IN) { const int kb = r / NB_IN, nb = r % NB_IN; p0_transpose_item(w_in, IN_COLS, IN_COLS, D, Win, 64 * nb, 64 * kb, 64 * nb, nullptr, scr, F.lane); continue; } r -= I_IN;
        if (r < I_OUT) { const int kb = r / (D / 64), nb = r % (D / 64); p0_transpose_item(w_out, D, D, D, Wout, 64 * nb, 64 * kb, 64 * nb, nullptr, scr, F.lane); continue; } r -= I_OUT;
        if (r < I_G) { const int kb = r / (DFF / 64), nb = r % (DFF / 64); const int n0 = 64 * nb; p0_transpose_item(w_g, DFF, DFF, D, Wgu, 256 * (n0 >> 7) + (n0 & 127), 64 * kb, n0, ffn_norm, scr, F.lane); continue; } r -= I_G;
        if (r < I_U) { const int kb = r / (DFF / 64), nb = r % (DFF / 64); const int n0 = 64 * nb; p0_transpose_item(w_u, DFF, DFF, D, Wgu, 256 * (n0 >> 7) + 128 + (n0 & 127), 64 * kb, n0, ffn_norm, scr, F.lane); continue; } r -= I_U;
        if (r < I_D) { const int kb = r / (D / 64), nb = r % (D / 64); p0_transpose_item(w_d, D, D, DFF, Wdn, 64 * nb, 64 * kb, 64 * nb, nullptr, scr, F.lane); continue; } r -= I_D;
        if (r < I_PG) { const int kb = r / (D / 64), nb = r % (D / 64); p0_transpose_item(w_pg, D, D, D, Wpg, 64 * nb, 64 * kb, 64 * nb, ple_norm, scr, F.lane); continue; } r -= I_PG;
        { const int kb = r / (D / 64), nb = r % (D / 64); p0_transpose_item(w_pp, D, D, PLE, Wpp, 64 * nb, 64 * kb, 64 * nb, nullptr, scr, F.lane); }
    }
    { const size_t z0 = (size_t)7232 * D * 2, z1 = (size_t)NPROJ_PAD * D * 2; v4u* p = (v4u*)((unsigned char*)Win + z0); const size_t n16 = (z1 - z0) / 16;
      for (size_t i = (size_t)F.bid * 512 + F.tid; i < n16; i += (size_t)F.G * 512) p[i] = (v4u){0u, 0u, 0u, 0u}; }
    bf16* XN = WSP(bf16, WS_XN);
    for (int m = gw; m < M; m += NGW) rms_row(F.in[0] + (size_t)m * D, F.in[10], XN + (size_t)m * D, nullptr, F.lane);
    if (gw < MS) rms_row(F.in[1] + (size_t)gw * D, F.in[10], nullptr, SSP(S_A) + (size_t)gw * D, F.lane);
    { const f32x4* p = (const f32x4*)F.in[8]; v2u* o = (v2u*)WSP(bf16, WS_PB); const size_t n4 = (size_t)M * PLE / 4;
      for (size_t i = (size_t)F.bid * 512 + F.tid; i < n4; i += (size_t)F.G * 512) { const f32x4 v = p[i]; o[i] = (v2u){pk2(v.x, v.y), pk2(v.z, v.w)}; } }
}

template <class Epi>
__device__ __forceinline__ void sample_gemm(Frame& F, const float* A, int K, bool norm, const bf16* Wt, int ntiles, const Epi& E) {
    const int first = F.G - 1 - F.bid;
    if (first >= ntiles) return;
    LAS bf16* As = (LAS bf16*)(F.lds);
    LAS float* Red = (LAS float*)(F.lds + 98304);
    LAS float* Rs = (LAS float*)(F.lds + 98304 + 8192);
    const int lane = F.lane, r32 = lane & 31, hh = lane >> 5;
    __syncthreads();
    if (norm) { float s = 0.f; for (int k = lane; k < K; k += 64) { const float v = A[(size_t)F.wave * K + k]; s += v * v; } s = wave_sum(s); if (lane == 0) Rs[F.wave] = rsqrtf(s / (float)K + EPS); }
    else if (lane == 0) Rs[F.wave] = 1.f;
    __syncthreads();
    { const float rs = Rs[F.wave]; for (int k = 2 * lane; k < K; k += 128) { const f32x2 v = *(const f32x2*)(A + (size_t)F.wave * K + k); *(LAS unsigned*)(As + F.wave * K + k) = cvt2bf(v.x * rs, v.y * rs); } }
    __syncthreads();
    const int ksteps = K / 128;
    for (int tl = first; tl < ntiles; tl += F.G) {
        f32x16 acc;
#pragma unroll
        for (int i = 0; i < 16; ++i) acc[i] = 0.f;
        const bf16* wp = Wt + (size_t)(32 * tl + r32) * K + F.wave * (K / 8) + 8 * hh;
        const LAS bf16* ap = As + (r32 & 7) * K + F.wave * (K / 8) + 8 * hh;
#pragma unroll 4
        for (int ks = 0; ks < ksteps; ++ks) {
            const bf16x8 bfr = *(const bf16x8*)(wp + 16 * ks);
            bf16x8 af = *(const LAS bf16x8*)(ap + 16 * ks);
            if (r32 >= 8) af = (bf16x8){0, 0, 0, 0, 0, 0, 0, 0};
            acc = __builtin_amdgcn_mfma_f32_32x32x16_bf16(af, bfr, acc, 0, 0, 0);
        }
        __syncthreads();
#pragma unroll
        for (int i = 0; i < 4; ++i) Red[(F.wave * 8 + 4 * hh + i) * 32 + r32] = acc[i];
        __syncthreads();
        if (F.tid < 256) { const int r = F.tid >> 5, c = F.tid & 31; float s = 0.f;
#pragma unroll
            for (int w = 0; w < 8; ++w) s += Red[(w * 8 + r) * 32 + c];
            E(r, 32 * tl + c, s); }
    }
    __syncthreads();
}
struct SEpiStore { float* O; int ld; int nmax; __device__ __forceinline__ void operator()(int r, int n, float v) const { if (n < nmax) O[(size_t)r * ld + n] = v; } };
struct SEpiAdd { const float* B; float* O; int ld; __device__ __forceinline__ void operator()(int r, int n, float v) const { O[(size_t)r * ld + n] = B[(size_t)r * ld + n] + v; } };
struct SEpiGateUp { float* GP; float* UP; __device__ __forceinline__ void operator()(int r, int n, float v) const { const int j = n >> 8, w = n & 255; if (w < 128) GP[(size_t)r * DFF + 128 * j + w] = v; else UP[(size_t)r * DFF + 128 * j + (w - 128)] = v; } };

__device__ __forceinline__ void gdn_prep_prompt(Frame& F) {
    const int gw = F.bid * NWAVES + F.wave, NGW = F.G * NWAVES;
    const bf16* CIN = WSP(bf16, WS_CIN); const float* cw = F.in[14];
    float* GQ = WSP(float, WS_GQ); float* GK = WSP(float, WS_GK); float* GV = WSP(float, WS_GV);
    for (int it = gw; it < M * NH; it += NGW) {
        const int row = it >> 3, h = it & 7, t = row & (T - 1);
#pragma unroll
        for (int seg = 0; seg < 3; ++seg) {
            const int ch = seg * GW + h * HD + 2 * F.lane;
            float a0 = 0.f, a1 = 0.f;
#pragma unroll
            for (int j = 0; j < 4; ++j) { const int tt = t - 3 + j; if (tt >= 0) { const unsigned w = *(const unsigned*)(CIN + (size_t)(row - 3 + j) * CONVCH + ch); a0 += bf_lo(w) * cw[j * CONVCH + ch]; a1 += bf_hi(w) * cw[j * CONVCH + ch + 1]; } }
            a0 = silu_f(a0); a1 = silu_f(a1);
            float* dst = (seg == 0 ? GQ : seg == 1 ? GK : GV) + (size_t)row * GW + h * HD + 2 * F.lane;
            if (seg < 2) { const float ss = wave_sum(a0 * a0 + a1 * a1); float sc = rsqrtf(ss + 1e-6f); if (seg == 0) sc *= SB_SCALE; a0 *= sc; a1 *= sc; }
            *(f32x2*)dst = (f32x2){a0, a1};
        }
    }
}
__device__ __forceinline__ void gdn_prep_sample(Frame& F) {
    if (F.bid != 0) return;
    const float* PR = SSP(S_PROJ); const float* hist = F.in[5]; const float* cw = F.in[14];
    for (int i = F.tid; i < MS * SBW; i += 512) { const int b = i >> 10, c = i & 1023; F.out[OUT_KS + i] = PR[(size_t)b * IN_COLS + O_SB_K + c]; F.out[OUT_VS + i] = PR[(size_t)b * IN_COLS + O_SB_V + c]; }
    for (int i = F.tid; i < MS * 3 * CONVCH; i += 512) { const int b = i / (3 * CONVCH), rr = (i / CONVCH) % 3, c = i % CONVCH;
        F.out[OUT_GCONVS + i] = (rr < 2) ? hist[((size_t)b * 3 + rr + 1) * CONVCH + c] : PR[(size_t)b * IN_COLS + O_GQKV + c]; }
    if (F.tid < 64) { const int b = F.tid >> 3, h = F.tid & 7; SSP(S_G)[F.tid] = -__expf(F.in[15][h]) * softplus_f(PR[(size_t)b * IN_COLS + O_GA + h] + F.in[16][h]); SSP(S_BETA)[F.tid] = sigmoid_f(PR[(size_t)b * IN_COLS + O_GB + h]); }
    const int b = F.wave;
    for (int h = 0; h < NH; ++h)
#pragma unroll
        for (int seg = 0; seg < 3; ++seg) {
            const int ch = seg * GW + h * HD + 2 * F.lane; float a[2];
#pragma unroll
            for (int e = 0; e < 2; ++e) { float s = 0.f;
#pragma unroll
                for (int j = 0; j < 3; ++j) s += hist[((size_t)b * 3 + j) * CONVCH + ch + e] * cw[j * CONVCH + ch + e];
                s += PR[(size_t)b * IN_COLS + O_GQKV + ch + e] * cw[3 * CONVCH + ch + e]; a[e] = silu_f(s); }
            float* dst = SSP(seg == 0 ? S_GQ : seg == 1 ? S_GK : S_GV) + (size_t)b * GW + h * HD + 2 * F.lane;
            if (seg < 2) { const float ss = wave_sum(a[0] * a[0] + a[1] * a[1]); float sc = rsqrtf(ss + 1e-6f); if (seg == 0) sc *= SB_SCALE; a[0] *= sc; a[1] *= sc; }
            dst[0] = a[0]; dst[1] = a[1];
        }
}

template <bool PIPE>
__device__ __forceinline__ void gdn_recur_wave(const float* GQ, const float* GK, const float* GV, const float* Gg, const float* Gb, int ld, int gld, size_t row0, int ntok, int h, int slice,
                                               const float* S0, float* Sout, float* GO, int lane) {
    const int e = 4 * slice + (lane >> 4), d0 = 8 * (lane & 15);
    float S[8];
#pragma unroll
    for (int i = 0; i < 8; ++i) S[i] = S0 ? S0[(size_t)(d0 + i) * HD + e] : 0.f;
    constexpr int NT = PIPE ? 4 : 1;
    f32x4 ck0[NT], ck1[NT], cq0[NT], cq1[NT]; float cv[NT], cg[NT], cb[NT];
#define GDN_LOAD(dk0, dk1, dq0, dq1, dv, dg, db, tb) do { _Pragma("unroll") for (int i_ = 0; i_ < NT; ++i_) { const size_t row_ = row0 + (tb) + i_; \
        dk0[i_] = *(const f32x4*)(GK + row_ * ld + h * HD + d0); dk1[i_] = *(const f32x4*)(GK + row_ * ld + h * HD + d0 + 4); \
        dq0[i_] = *(const f32x4*)(GQ + row_ * ld + h * HD + d0); dq1[i_] = *(const f32x4*)(GQ + row_ * ld + h * HD + d0 + 4); \
        dv[i_] = GV[row_ * ld + h * HD + e]; dg[i_] = Gg[row_ * gld + h]; db[i_] = Gb[row_ * gld + h]; } } while (0)
    GDN_LOAD(ck0, ck1, cq0, cq1, cv, cg, cb, 0);
    for (int t = 0; t < ntok; t += NT) {
        f32x4 nk0[NT], nk1[NT], nq0[NT], nq1[NT]; float nv[NT], ng[NT], nb[NT];
        const int tn = (t + NT < ntok) ? t + NT : t;
        GDN_LOAD(nk0, nk1, nq0, nq1, nv, ng, nb, tn);
#pragma unroll
        for (int i = 0; i < NT; ++i) {
            const float kk[8] = {ck0[i].x, ck0[i].y, ck0[i].z, ck0[i].w, ck1[i].x, ck1[i].y, ck1[i].z, ck1[i].w}, qq[8] = {cq0[i].x, cq0[i].y, cq0[i].z, cq0[i].w, cq1[i].x, cq1[i].y, cq1[i].z, cq1[i].w};
            const float eg = __expf(cg[i]);
            float kv = 0.f;
#pragma unroll
            for (int j = 0; j < 8; ++j) kv += S[j] * kk[j];
            kv += __shfl_xor(kv, 1); kv += __shfl_xor(kv, 2); kv += __shfl_xor(kv, 4); kv += __shfl_xor(kv, 8);
            const float u = cb[i] * (cv[i] - eg * kv);
            float o = 0.f;
#pragma unroll
            for (int j = 0; j < 8; ++j) { S[j] = eg * S[j] + kk[j] * u; o += S[j] * qq[j]; }
            o += __shfl_xor(o, 1); o += __shfl_xor(o, 2); o += __shfl_xor(o, 4); o += __shfl_xor(o, 8);
            if ((lane & 15) == 0) GO[(row0 + t + i) * ld + h * HD + e] = o;
        }
#pragma unroll
        for (int i = 0; i < NT; ++i) { ck0[i] = nk0[i]; ck1[i] = nk1[i]; cq0[i] = nq0[i]; cq1[i] = nq1[i]; cv[i] = nv[i]; cg[i] = ng[i]; cb[i] = nb[i]; }
    }
#undef GDN_LOAD
#pragma unroll
    for (int i = 0; i < 8; ++i) Sout[(size_t)(d0 + i) * HD + e] = S[i];
}

__device__ __forceinline__ void sb_query_simple(Frame& F, int b, int h, int t, LAS float* qs) {
    const bf16* Qb = WSP(bf16, WS_Q); const bf16* Kb = WSP(bf16, WS_K); const bf16* Vb = WSP(bf16, WS_V); bf16* MIX = WSP(bf16, WS_MIX);
    const size_t row = (size_t)b * T + t; const int lane = F.lane;
    { const unsigned w = *(const unsigned*)(Qb + row * SBW + h * HD + 2 * lane); qs[2 * lane] = bf_lo(w); qs[2 * lane + 1] = bf_hi(w); }
    LDS_WAIT(); asm volatile("" ::: "memory");
    const float ch = F.in[12][h];
    float o0 = 0.f, o1 = 0.f, R = 0.f;
    const int nblk = (t + 63) >> 6;
    for (int blk = nblk - 1; blk >= 0; --blk) {
        const int k0 = blk * 64, key = k0 + lane; const bool valid = key < t;
        const v4u* kr = (const v4u*)(Kb + ((size_t)b * T + key) * SBW + h * HD);
        float dot = 0.f;
#pragma unroll
        for (int c = 0; c < 16; ++c) { const v4u w = kr[c]; const f32x4 qa = *(const LAS f32x4*)(qs + 8 * c), qb = *(const LAS f32x4*)(qs + 8 * c + 4);
            dot += bf_lo(w.x) * qa.x + bf_hi(w.x) * qa.y + bf_lo(w.y) * qa.z + bf_hi(w.y) * qa.w + bf_lo(w.z) * qb.x + bf_hi(w.z) * qb.y + bf_lo(w.w) * qb.z + bf_hi(w.w) * qb.w; }
        const float z = dot * SB_SCALE + ch;
        const float sp = softplus_f(z);
        const float L = valid ? -sp : 0.f, lb = z - sp;
        float s = L;
#pragma unroll
        for (int o = 1; o < 64; o <<= 1) { const float tmp = __shfl_down(s, o); if (lane + o < 64) s += tmp; }
        const float tot = __shfl(s, 0);
        const float a = valid ? __expf(lb + (s - L) + R) : 0.f;
        R += tot;
        const bf16* vr = Vb + ((size_t)b * T + k0) * SBW + h * HD + 2 * lane;
#pragma unroll 8
        for (int j = 0; j < 64; ++j) { const float aj = __shfl(a, j); const unsigned w = *(const unsigned*)(vr + (size_t)j * SBW); o0 += aj * bf_lo(w); o1 += aj * bf_hi(w); }
    }
    const float ss = wave_sum(o0 * o0 + o1 * o1); const float rs = rsqrtf(ss * (1.f / HD) + EPS);
    const float* nw = F.in[13];
    *(unsigned*)(MIX + row * D + h * HD + 2 * lane) = pk2(o0 * rs * nw[2 * lane], o1 * rs * nw[2 * lane + 1]);
}

__device__ __forceinline__ void sb_decode_segment(Frame& F, int b, int h, int seg) {
    const float* q = SSP(S_PROJ) + (size_t)b * IN_COLS + h * HD;
    const float* CK = F.in[2]; const float* CV = F.in[3]; const int* PT = (const int*)F.in[4];
    const int lane = F.lane, half = lane >> 5, l32 = lane & 31;
    const f32x4 q4 = *(const f32x4*)(q + 4 * l32);
    const float ch = F.in[12][h];
    f32x4 o4 = {0.f, 0.f, 0.f, 0.f}; float R = 0.f;
    for (int blk = 7; blk >= 0; --blk) {
        const int p0 = seg * 512 + blk * 64;
        const int page = PT[b * NPAGES + (p0 >> 7)];
        const size_t base = (((size_t)page * PAGE + (p0 & 127)) * NH + h) * HD;
        float z = 0.f;
#pragma unroll 16
        for (int i = 0; i < 32; ++i) {
            const f32x4 k4 = *(const f32x4*)(CK + base + (size_t)(2 * i + half) * (NH * HD) + 4 * l32);
            float p = (k4.x * q4.x + k4.y * q4.y) + (k4.z * q4.z + k4.w * q4.w);
            p += __shfl_xor(p, 1); p += __shfl_xor(p, 2); p += __shfl_xor(p, 4); p += __shfl_xor(p, 8); p += __shfl_xor(p, 16);
            const float pe = __shfl(p, 0), po = __shfl(p, 32);
            if (lane == 2 * i) z = pe; if (lane == 2 * i + 1) z = po;
        }
        z = z * SB_SCALE + ch;
        const float sp = softplus_f(z);
        const float L = -sp, lb = z - sp;
        float s = L;
#pragma unroll
        for (int o = 1; o < 64; o <<= 1) { const float tmp = __shfl_down(s, o); if (lane + o < 64) s += tmp; }
        const float tot = __shfl(s, 0);
        const float a = __expf(lb + (s - L) + R);
        R += tot;
#pragma unroll 16
        for (int i = 0; i < 32; ++i) { const float aj = __shfl(a, 2 * i + half); const f32x4 v = *(const f32x4*)(CV + base + (size_t)(2 * i + half) * (NH * HD) + 4 * l32); o4 += aj * v; }
    }
    o4.x += __shfl_xor(o4.x, 32); o4.y += __shfl_xor(o4.y, 32); o4.z += __shfl_xor(o4.z, 32); o4.w += __shfl_xor(o4.w, 32);
    float* P = SSP(S_PART) + ((size_t)(b * NH + h) * DSEG + seg) * DPART;
    if (half == 0) *(f32x4*)(P + 4 * l32) = o4; if (lane == 0) P[128] = R;
}

__device__ __forceinline__ unsigned offb(unsigned row, unsigned ch) { return 256u * row + 16u * (ch ^ (((row & 3u) << 2) | ((row >> 2) & 3u))); }
constexpr float LOG2E = 1.4426950408889634f;

__device__ __forceinline__ void sb_attn_unit(Frame& F, int b, int h, int qb) {
    const bf16* Qb = WSP(bf16, WS_Q); const bf16* Kb = WSP(bf16, WS_K); const bf16* Vb = WSP(bf16, WS_V); bf16* MIX = WSP(bf16, WS_MIX);
    const int lane = F.lane, r32 = lane & 31, hh = lane >> 5;
    const int q0w = 256 * qb + 32 * F.wave;
    LAS unsigned char* KB0 = F.lds + RING_OFF; LAS unsigned char* VB0 = F.lds + RING_OFF + 32768;
    bf16x8 qf[8];
    { const bf16* qp = Qb + ((size_t)b * T + q0w + r32) * SBW + h * HD + 8 * hh;
#pragma unroll
      for (int s = 0; s < 8; ++s) qf[s] = *(const bf16x8*)(qp + 16 * s); }
    const float k1 = SB_SCALE * LOG2E, k2 = F.in[12][h] * LOG2E;
    f32x16 oacc[4];
#pragma unroll
    for (int d = 0; d < 4; ++d)
#pragma unroll
        for (int i = 0; i < 16; ++i) oacc[d][i] = 0.f;
    float R = 1.f;
    const int nt = 4 * qb + 4;
    const int srow = F.tid >> 4, sch = F.tid & 15;
    const size_t gbase = ((size_t)b * T) * SBW + h * HD + sch * 8;
    v4u rk[2], rv[2];
#define SB_LOAD(k0_) do { _Pragma("unroll") for (int i_ = 0; i_ < 2; ++i_) { const size_t o_ = gbase + (size_t)((k0_) + srow + 32 * i_) * SBW; rk[i_] = *(const v4u*)(Kb + o_); rv[i_] = *(const v4u*)(Vb + o_); } } while (0)
    const unsigned kwo = (unsigned)((sch >> 1) * 1024 + srow * 32 + (((sch & 1) ^ ((srow >> 3) & 1)) * 16));
    const unsigned vwo = (unsigned)((((srow >> 3) * 4 + (sch >> 2)) * 512) + (srow & 7) * 64 + (sch & 3) * 16);
#define SB_WRITE(buf_) do { _Pragma("unroll") for (int i_ = 0; i_ < 2; ++i_) { *(LAS v4u*)(KB0 + (buf_) * 16384 + kwo + i_ * 8192) = rk[i_]; *(LAS v4u*)(VB0 + (buf_) * 16384 + vwo + i_ * 8192) = rv[i_]; } } while (0)
    SB_LOAD(64 * (nt - 1)); SB_WRITE(0);
    __syncthreads();
    const int tq = (lane & 15) >> 2, tp = lane & 3, tblk = (lane >> 4) & 1;
    const unsigned kro = (unsigned)(r32 * 32 + ((hh ^ ((r32 >> 3) & 1)) * 16));
    const unsigned vro = (unsigned)((4 * hh + tq) * 64 + tblk * 32 + tp * 8);
    for (int it = 0; it < nt; ++it) {
        const int kt = nt - 1 - it, buf = it & 1, k0 = 64 * kt;
        if (it + 1 < nt) SB_LOAD(64 * (kt - 1));
        if (k0 < q0w + 31) {
            const bool diag = (k0 + 63 >= q0w);
            LAS unsigned char* Kt = KB0 + buf * 16384; LAS unsigned char* Vt = VB0 + buf * 16384;
            f32x16 sacc[2];
#pragma unroll
            for (int kb = 0; kb < 2; ++kb) {
#pragma unroll
                for (int i = 0; i < 16; ++i) sacc[kb][i] = 0.f;
#pragma unroll
                for (int s = 0; s < 8; ++s) { const bf16x8 kf = *(const LAS bf16x8*)(Kt + kro + (kb * 8 + s) * 1024); sacc[kb] = __builtin_amdgcn_mfma_f32_32x32x16_bf16(kf, qf[s], sacc[kb], 0, 0, 0); }
            }
            float after = R;
            unsigned pp[2][8];
            const int qabs = q0w + r32;
#define SB_TILE(DIAG_) do { _Pragma("unroll") for (int kb = 1; kb >= 0; --kb) _Pragma("unroll") for (int g = 3; g >= 0; --g) { \
                    float be[4], m[4]; \
                    _Pragma("unroll") for (int j = 0; j < 4; ++j) { \
                        const float e = __builtin_amdgcn_exp2f(-(sacc[kb][4 * g + j] * k1 + k2)); \
                        be[j] = __builtin_amdgcn_rcpf(1.0f + e); m[j] = 1.0f - be[j]; \
                        if (DIAG_) { const bool vd = (k0 + 32 * kb + 8 * g + 4 * hh + j) < qabs; be[j] = vd ? be[j] : 0.f; m[j] = vd ? m[j] : 1.f; } } \
                    const float s3 = m[3], s2 = m[2] * s3, s1 = m[1] * s2, s0 = m[0] * s1; \
                    const float p4 = __shfl_xor(s0, 32); \
                    const float base = after * (hh == 0 ? p4 : 1.0f); \
                    const float a0 = be[0] * s1 * base, a1 = be[1] * s2 * base, a2 = be[2] * s3 * base, a3 = be[3] * base; \
                    after *= s0 * p4; \
                    pp[kb][2 * g] = cvt2bf(a0, a1); pp[kb][2 * g + 1] = cvt2bf(a2, a3); } } while (0)
            if (diag) SB_TILE(true); else SB_TILE(false);
#undef SB_TILE
            R = after;
#pragma unroll
            for (int kb = 0; kb < 2; ++kb)
#pragma unroll
                for (int sp = 0; sp < 2; ++sp) {
                    const v4u pw = {pp[kb][4 * sp], pp[kb][4 * sp + 1], pp[kb][4 * sp + 2], pp[kb][4 * sp + 3]};
                    const bf16x8 pf = __builtin_bit_cast(bf16x8, pw);
                    const int keybase = 32 * kb + 16 * sp;
#pragma unroll
                    for (int db = 0; db < 4; ++db) {
                        const s16x4 lo = __builtin_amdgcn_ds_read_tr16_b64_v4i16((LAS s16x4*)(Vt + vro + ((keybase >> 3) * 4 + db) * 512));
                        const s16x4 hi = __builtin_amdgcn_ds_read_tr16_b64_v4i16((LAS s16x4*)(Vt + vro + (((keybase >> 3) + 1) * 4 + db) * 512));
                        const bf16x8 vf = __builtin_shufflevector(lo, hi, 0, 1, 2, 3, 4, 5, 6, 7);
                        oacc[db] = __builtin_amdgcn_mfma_f32_32x32x16_bf16(vf, pf, oacc[db], 0, 0, 0);
                    }
                }
        }
        if (it + 1 < nt) SB_WRITE(buf ^ 1);
        __syncthreads();
    }
#undef SB_LOAD
#undef SB_WRITE
    float ss = 0.f;
#pragma unroll
    for (int d = 0; d < 4; ++d)
#pragma unroll
        for (int i = 0; i < 16; ++i) ss += oacc[d][i] * oacc[d][i];
    ss += __shfl_xor(ss, 32);
    const float rs = rsqrtf(ss * (1.f / HD) + EPS);
    const float* nw = F.in[13];
    bf16* op = MIX + ((size_t)b * T + q0w + r32) * D + h * HD + 4 * hh;
#pragma unroll
    for (int d = 0; d < 4; ++d)
#pragma unroll
        for (int g = 0; g < 4; ++g) { const int dd = 32 * d + 8 * g + 4 * hh; const f32x4 w4 = *(const f32x4*)(nw + dd);
            v2u w; w.x = cvt2bf(oacc[d][4 * g] * rs * w4.x, oacc[d][4 * g + 1] * rs * w4.y); w.y = cvt2bf(oacc[d][4 * g + 2] * rs * w4.z, oacc[d][4 * g + 3] * rs * w4.w);
            *(v2u*)(op + 32 * d + 8 * g) = w; }
}

constexpr int GREC_A = 57344;
constexpr int GREC_WF = 0, GREC_QF = 16384, GREC_QKF = 32768, GREC_KTF = 40960, GREC_UF = GREC_A, GREC_BYTES = GREC_A + 16384;
constexpr int NCHUNK = T / 64;
constexpr int PL_TK = 0, PL_TQ = 16384, PL_TKBG = 32768, PL_TKT = 49152, PL_TVB = 65536, PL_LOW = 81920  , PL_TT = 98304  , PL_GC = 107520  , PL_BETA = 107776, PL_CW = 108032  ;
__device__ __forceinline__ unsigned rowimg(unsigned row, unsigned c16) { return ((row >> 5) * 8 + (c16 >> 1)) * 1024 + (row & 31) * 32 + (((c16 & 1) ^ ((row >> 3) & 1)) * 16); }
__device__ __forceinline__ unsigned trimg(unsigned row, unsigned c16) { return ((row >> 3) * 4 + (c16 >> 2)) * 512 + (row & 7) * 64 + (c16 & 3) * 16; }

__device__ __forceinline__ void gdn_prep_unit(Frame& F, int chain, int ci, unsigned char* rec, float* EGp) {
    int lane = F.lane, tid = F.tid; asm volatile("" : "+v"(lane), "+v"(tid));
    const int b = chain >> 3, h = chain & 7, r32 = lane & 31, hh = lane >> 5;
    const size_t R0 = (size_t)b * T + 64 * ci;
    unsigned lb0 = 0; asm volatile("" : "+v"(lb0));
    LAS unsigned char* L = F.lds + lb0;
    LAS float* GC = (LAS float*)(L + PL_GC); LAS float* BE = (LAS float*)(L + PL_BETA); LAS float* LOW = (LAS float*)(L + PL_LOW);
    const bf16* CIN = WSP(bf16, WS_CIN); const float* cw = F.in[14];
    for (int i = tid - 64; i >= 0 && i < 4 * 3 * 128; i += 448) { const int j = i / 384, seg = (i / 128) % 3, c = i & 127; ((LAS float*)(L + PL_CW))[i] = cw[j * CONVCH + seg * GW + h * HD + c]; }
    if (F.wave == 0) { float g = WSP(float, WS_G)[(R0 + lane) * NH + h];
#pragma unroll
        for (int o = 1; o < 64; o <<= 1) { const float t = __shfl_up(g, o); if (lane >= o) g += t; }
        GC[lane] = g; BE[lane] = WSP(float, WS_BETA)[(R0 + lane) * NH + h]; }
    __syncthreads();
    {
        const int t = tid >> 3, sub = tid & 7; const int tseq = 64 * ci + t;
        const float gc = GC[t], gl = GC[63], be = BE[t];
        const float egc = __expf(gc), egl = __expf(gl - gc);
        float val[3][16];
#pragma unroll
        for (int seg = 0; seg < 3; ++seg) {
            const int ch = seg * GW + h * HD + 16 * sub;
            float a[16];
#pragma unroll
            for (int e = 0; e < 16; ++e) a[e] = 0.f;
#pragma unroll
            for (int j = 0; j < 4; ++j) if (tseq - 3 + j >= 0) {
                const v4u w0 = *(const v4u*)(CIN + (R0 + t - 3 + j) * CONVCH + ch), w1 = *(const v4u*)(CIN + (R0 + t - 3 + j) * CONVCH + ch + 8);
                const unsigned ww[8] = {w0.x, w0.y, w0.z, w0.w, w1.x, w1.y, w1.z, w1.w};
                const LAS f32x4* wl = (const LAS f32x4*)(L + PL_CW + ((j * 3 + seg) * 128 + 16 * sub) * 4);
                const f32x4 c0 = wl[0], c1 = wl[1], c2 = wl[2], c3 = wl[3];
                const float cwv[16] = {c0.x, c0.y, c0.z, c0.w, c1.x, c1.y, c1.z, c1.w, c2.x, c2.y, c2.z, c2.w, c3.x, c3.y, c3.z, c3.w};
#pragma unroll
                for (int e = 0; e < 8; ++e) { a[2 * e] += bf_lo(ww[e]) * cwv[2 * e]; a[2 * e + 1] += bf_hi(ww[e]) * cwv[2 * e + 1]; }
            }
            float ss = 0.f;
#pragma unroll
            for (int e = 0; e < 16; ++e) { a[e] = silu_f(a[e]); ss += a[e] * a[e]; }
            if (seg < 2) { ss += __shfl_xor(ss, 1); ss += __shfl_xor(ss, 2); ss += __shfl_xor(ss, 4); float sc = rsqrtf(ss + 1e-6f); if (seg == 0) sc *= SB_SCALE;
#pragma unroll
                for (int e = 0; e < 16; ++e) a[e] *= sc; }
#pragma unroll
            for (int e = 0; e < 16; ++e) val[seg][e] = a[e];
        }
#define PK8(dst, src, mul, o) do { dst.x = cvt2bf(src[o] * (mul), src[o + 1] * (mul)); dst.y = cvt2bf(src[o + 2] * (mul), src[o + 3] * (mul)); dst.z = cvt2bf(src[o + 4] * (mul), src[o + 5] * (mul)); dst.w = cvt2bf(src[o + 6] * (mul), src[o + 7] * (mul)); } while (0)
        v4u p0, p1;
        PK8(p0, val[1], 1.0f, 0); PK8(p1, val[1], 1.0f, 8); *(LAS v4u*)(L + PL_TK + rowimg(t, 2 * sub)) = p0; *(LAS v4u*)(L + PL_TK + rowimg(t, 2 * sub + 1)) = p1;
        PK8(p0, val[1], be * egc, 0); PK8(p1, val[1], be * egc, 8); *(LAS v4u*)(L + PL_TKBG + trimg(t, 2 * sub)) = p0; *(LAS v4u*)(L + PL_TKBG + trimg(t, 2 * sub + 1)) = p1;
        PK8(p0, val[1], egl, 0); PK8(p1, val[1], egl, 8); *(LAS v4u*)(L + PL_TKT + trimg(t, 2 * sub)) = p0; *(LAS v4u*)(L + PL_TKT + trimg(t, 2 * sub + 1)) = p1;
        PK8(p0, val[0], 1.0f, 0); PK8(p1, val[0], 1.0f, 8); *(LAS v4u*)(L + PL_TQ + rowimg(t, 2 * sub)) = p0; *(LAS v4u*)(L + PL_TQ + rowimg(t, 2 * sub + 1)) = p1;
        PK8(p0, val[2], be, 0); PK8(p1, val[2], be, 8); *(LAS v4u*)(L + PL_TVB + trimg(t, 2 * sub)) = p0; *(LAS v4u*)(L + PL_TVB + trimg(t, 2 * sub + 1)) = p1;
        { float qg[16];
#pragma unroll
          for (int e = 0; e < 16; ++e) qg[e] = val[0][e] * egc;
          unsigned char* qf = rec + GREC_QF + ((t >> 5) * 8 + sub) * 1024 + (t & 31) * 16;
          v4u f0, f1; f0.x = cvt2bf(qg[0], qg[1]); f0.y = cvt2bf(qg[2], qg[3]); f0.z = cvt2bf(qg[8], qg[9]); f0.w = cvt2bf(qg[10], qg[11]);
          f1.x = cvt2bf(qg[4], qg[5]); f1.y = cvt2bf(qg[6], qg[7]); f1.z = cvt2bf(qg[12], qg[13]); f1.w = cvt2bf(qg[14], qg[15]);
          *(v4u*)qf = f0; *(v4u*)(qf + 512) = f1; }
#undef PK8
        if (tid == 0) *EGp = __expf(gl);
    }
    __syncthreads();
    {
        const int which = F.wave >> 2, ta = (F.wave >> 1) & 1, tb = F.wave & 1;
        const unsigned aro = r32 * 32 + ((hh ^ ((r32 >> 3) & 1)) * 16);
        f32x16 acc;
#pragma unroll
        for (int i = 0; i < 16; ++i) acc[i] = 0.f;
        const bool zero_tile = (which == 0) ? (ta < tb) : (ta > tb);
        if (!zero_tile) {
#pragma unroll
            for (int ks = 0; ks < 8; ++ks) {
                const bf16x8 af = *(const LAS bf16x8*)(L + PL_TK + aro + (ta * 8 + ks) * 1024);
                const bf16x8 bfr = *(const LAS bf16x8*)(L + (which == 0 ? PL_TK : PL_TQ) + aro + (tb * 8 + ks) * 1024);
                acc = __builtin_amdgcn_mfma_f32_32x32x16_bf16(af, bfr, acc, 0, 0, 0);
            }
        }
        if (which == 0) {
            const int s = 32 * tb + r32; const float gs = GC[s];
#pragma unroll
            for (int g = 0; g < 4; ++g) { const int c0 = 32 * ta + 8 * g + 4 * hh; const f32x4 gc4 = *(const LAS f32x4*)(GC + c0), be4 = *(const LAS f32x4*)(BE + c0);
#pragma unroll
                for (int j = 0; j < 4; ++j) { const float e = __expf(fminf(gc4[j] - gs, 0.f)); const float v = be4[j] * acc[4 * g + j] * e; LOW[(c0 + j) * 64 + s] = (c0 + j > s) ? v : 0.f; } }
        } else {
            const int c = 32 * tb + r32; const float gcc = GC[c]; float v[16];
#pragma unroll
            for (int g = 0; g < 4; ++g) { const int s0 = 32 * ta + 8 * g + 4 * hh; const f32x4 gc4 = *(const LAS f32x4*)(GC + s0);
#pragma unroll
                for (int j = 0; j < 4; ++j) { const float e = __expf(fminf(gcc - gc4[j], 0.f)); const float x = acc[4 * g + j] * e; v[4 * g + j] = (c >= s0 + j) ? x : 0.f; } }
#pragma unroll
            for (int s = 0; s < 2; ++s) { v4u f; f.x = cvt2bf(v[8 * s], v[8 * s + 1]); f.y = cvt2bf(v[8 * s + 2], v[8 * s + 3]); f.z = cvt2bf(v[8 * s + 4], v[8 * s + 5]); f.w = cvt2bf(v[8 * s + 6], v[8 * s + 7]);
                *(v4u*)(rec + GREC_QKF + (tb * 4 + 2 * ta + s) * 1024 + lane * 16) = f; }
        }
    }
    __syncthreads();
    if (F.wave == 0) {
        float Tc[64];
#pragma unroll
        for (int c = 0; c < 64; ++c) {
            float a0 = 0.f, a1 = 0.f, a2 = 0.f, a3 = 0.f;
#pragma unroll
            for (int s4 = 0; s4 < (c + 3) / 4; ++s4) { const f32x4 l4 = *(const LAS f32x4*)(LOW + c * 64 + 4 * s4);
                a0 += l4.x * Tc[4 * s4]; if (4 * s4 + 1 < c) a1 += l4.y * Tc[4 * s4 + 1]; if (4 * s4 + 2 < c) a2 += l4.z * Tc[4 * s4 + 2]; if (4 * s4 + 3 < c) a3 += l4.w * Tc[4 * s4 + 3]; }
            Tc[c] = ((c == lane) ? 1.f : 0.f) - ((a0 + a1) + (a2 + a3));
        }
#pragma unroll
        for (int c = 0; c < 64; ++c) *(LAS bf16*)(L + PL_TT + c * 144 + lane * 2) = (bf16)f2bf(Tc[c]);
    }
    __syncthreads();
    {
        const int tq = (lane & 15) >> 2, tp = lane & 3, tblk = (lane >> 4) & 1;
        const unsigned trn = hh * 2048 + tq * 64 + tblk * 32 + tp * 8;
        const unsigned trm = (4 * hh + tq) * 64 + tblk * 32 + tp * 8;
        const unsigned tro = r32 * 144 + hh * 16;
        {
            const int ct = F.wave >> 2, et = F.wave & 3; f32x16 acc;
#pragma unroll
            for (int i = 0; i < 16; ++i) acc[i] = 0.f;
#pragma unroll
            for (int ks = 0; ks < 4; ++ks) {
                const bf16x8 af = *(const LAS bf16x8*)(L + PL_TT + tro + ct * 32 * 144 + ks * 32);
                const s16x4 lo = __builtin_amdgcn_ds_read_tr16_b64_v4i16((LAS s16x4*)(L + PL_TVB + trn + ks * 4096 + et * 512));
                const s16x4 hi = __builtin_amdgcn_ds_read_tr16_b64_v4i16((LAS s16x4*)(L + PL_TVB + trn + ks * 4096 + et * 512 + 256));
                acc = __builtin_amdgcn_mfma_f32_32x32x16_bf16(af, __builtin_shufflevector(lo, hi, 0, 1, 2, 3, 4, 5, 6, 7), acc, 0, 0, 0);
            }
            v4u f0, f1; f0.x = cvt2bf(acc[0], acc[1]); f0.y = cvt2bf(acc[2], acc[3]); f0.z = cvt2bf(acc[4], acc[5]); f0.w = cvt2bf(acc[6], acc[7]);
            f1.x = cvt2bf(acc[8], acc[9]); f1.y = cvt2bf(acc[10], acc[11]); f1.z = cvt2bf(acc[12], acc[13]); f1.w = cvt2bf(acc[14], acc[15]);
            unsigned char* up = rec + GREC_UF + (et * 2 + ct) * 2048 + lane * 32; *(v4u*)up = f0; *(v4u*)(up + 16) = f1;
        }
        {
            const int dt = F.wave >> 1, ct = F.wave & 1; f32x16 acc;
#pragma unroll
            for (int i = 0; i < 16; ++i) acc[i] = 0.f;
#pragma unroll
            for (int ks = 0; ks < 4; ++ks) {
                const s16x4 lo = __builtin_amdgcn_ds_read_tr16_b64_v4i16((LAS s16x4*)(L + PL_TKBG + trn + ks * 4096 + dt * 512));
                const s16x4 hi = __builtin_amdgcn_ds_read_tr16_b64_v4i16((LAS s16x4*)(L + PL_TKBG + trn + ks * 4096 + dt * 512 + 256));
                const bf16x8 bfr = *(const LAS bf16x8*)(L + PL_TT + tro + ct * 32 * 144 + ks * 32);
                acc = __builtin_amdgcn_mfma_f32_32x32x16_bf16(__builtin_shufflevector(lo, hi, 0, 1, 2, 3, 4, 5, 6, 7), bfr, acc, 0, 0, 0);
            }
#pragma unroll
            for (int s = 0; s < 2; ++s) { v4u f; f.x = cvt2bf(-acc[8 * s], -acc[8 * s + 1]); f.y = cvt2bf(-acc[8 * s + 2], -acc[8 * s + 3]); f.z = cvt2bf(-acc[8 * s + 4], -acc[8 * s + 5]); f.w = cvt2bf(-acc[8 * s + 6], -acc[8 * s + 7]);
                *(v4u*)(rec + GREC_WF + (ct * 8 + 2 * dt + s) * 1024 + lane * 16) = f; }
        }
        {
#pragma unroll
            for (int q = 0; q < 2; ++q) { const int f = 2 * F.wave + q, dt = f >> 2, ksp = f & 3;
                const s16x4 lo = __builtin_amdgcn_ds_read_tr16_b64_v4i16((LAS s16x4*)(L + PL_TKT + trm + (2 * ksp) * 2048 + dt * 512));
                const s16x4 hi = __builtin_amdgcn_ds_read_tr16_b64_v4i16((LAS s16x4*)(L + PL_TKT + trm + (2 * ksp + 1) * 2048 + dt * 512));
                const bf16x8 kf = __builtin_shufflevector(lo, hi, 0, 1, 2, 3, 4, 5, 6, 7);
                *(bf16x8*)(rec + GREC_KTF + (dt * 4 + ksp) * 1024 + lane * 16) = kf; }
        }
    }
    __syncthreads();
}

__device__ __forceinline__ void gdn_scan_chain(Frame& F, int chain) {
    const int b = chain >> 3, h = chain & 7, lane = F.lane, r32 = lane & 31, hh = lane >> 5, et = F.wave;
    const unsigned char* recs = F.ws + WS_GREC + (size_t)chain * NCHUNK * GREC_BYTES;
    const float* EG = WSP(float, WS_GEG) + chain * NCHUNK;
    float* GO = WSP(float, WS_GO);
    LAS unsigned char* L = F.lds;
    f32x16 S[4];
#pragma unroll
    for (int d = 0; d < 4; ++d)
#pragma unroll
        for (int i = 0; i < 16; ++i) S[d][i] = 0.f;
#define GS_DMA(ci_, slot_) do { const unsigned char* g_ = recs + (size_t)(ci_) * GREC_BYTES + lane * 16; \
        _Pragma("unroll") for (int p_ = 0; p_ < 7; ++p_) __builtin_amdgcn_global_load_lds((const unsigned*)(g_ + (F.wave + 8 * p_) * 1024), (LAS unsigned*)(L + (slot_) * GREC_A + (F.wave + 8 * p_) * 1024), 16, 0, 0); } while (0)
    v4u un[2][2];
#define GS_ULOAD(ci_) do { if (F.wave < 4) { const unsigned char* u_ = recs + (size_t)(ci_) * GREC_BYTES + GREC_UF + (et * 2) * 2048 + lane * 32; \
        un[0][0] = *(const v4u*)u_; un[0][1] = *(const v4u*)(u_ + 16); un[1][0] = *(const v4u*)(u_ + 2048); un[1][1] = *(const v4u*)(u_ + 2048 + 16); } } while (0)
    GS_DMA(0, 0); GS_ULOAD(0);
    __syncthreads();
    for (int ci = 0; ci < NCHUNK; ++ci) {
        const int slot = ci & 1;
        v4u uc[2][2];
#pragma unroll
        for (int a = 0; a < 2; ++a) { uc[a][0] = un[a][0]; uc[a][1] = un[a][1]; }
        if (ci + 1 < NCHUNK) { GS_DMA(ci + 1, slot ^ 1); GS_ULOAD(ci + 1); }
        if (F.wave < 4) {
            const LAS unsigned char* A = L + slot * GREC_A + lane * 16;
            const float eg = EG[ci];
            bf16x8 sf[8];
#pragma unroll
            for (int ks = 0; ks < 8; ++ks) { const int d = ks >> 1, s = ks & 1; v4u w; w.x = cvt2bf(S[d][8 * s], S[d][8 * s + 1]); w.y = cvt2bf(S[d][8 * s + 2], S[d][8 * s + 3]); w.z = cvt2bf(S[d][8 * s + 4], S[d][8 * s + 5]); w.w = cvt2bf(S[d][8 * s + 6], S[d][8 * s + 7]); sf[ks] = __builtin_bit_cast(bf16x8, w); }
            f32x16 vn[2];
#pragma unroll
            for (int ct = 0; ct < 2; ++ct) {
                const unsigned uw[8] = {uc[ct][0].x, uc[ct][0].y, uc[ct][0].z, uc[ct][0].w, uc[ct][1].x, uc[ct][1].y, uc[ct][1].z, uc[ct][1].w};
#pragma unroll
                for (int i = 0; i < 8; ++i) { vn[ct][2 * i] = bf_lo(uw[i]); vn[ct][2 * i + 1] = bf_hi(uw[i]); }
#pragma unroll
                for (int ks = 0; ks < 8; ++ks) vn[ct] = __builtin_amdgcn_mfma_f32_32x32x16_bf16(*(const LAS bf16x8*)(A + GREC_WF + (ct * 8 + ks) * 1024), sf[ks], vn[ct], 0, 0, 0);
            }
            bf16x8 vf[4];
#pragma unroll
            for (int ks = 0; ks < 4; ++ks) { const int ct = ks >> 1, s = ks & 1; v4u w; w.x = cvt2bf(vn[ct][8 * s], vn[ct][8 * s + 1]); w.y = cvt2bf(vn[ct][8 * s + 2], vn[ct][8 * s + 3]); w.z = cvt2bf(vn[ct][8 * s + 4], vn[ct][8 * s + 5]); w.w = cvt2bf(vn[ct][8 * s + 6], vn[ct][8 * s + 7]); vf[ks] = __builtin_bit_cast(bf16x8, w); }
            float* gop = GO + ((size_t)b * T + 64 * ci + 4 * hh) * GW + h * HD + 32 * et + r32;
#pragma unroll
            for (int ct = 0; ct < 2; ++ct) {
                f32x16 o;
#pragma unroll
                for (int i = 0; i < 16; ++i) o[i] = 0.f;
#pragma unroll
                for (int ks = 0; ks < 8; ++ks) o = __builtin_amdgcn_mfma_f32_32x32x16_bf16(*(const LAS bf16x8*)(A + GREC_QF + (ct * 8 + ks) * 1024), sf[ks], o, 0, 0, 0);
#pragma unroll
                for (int ks = 0; ks < 4; ++ks) o = __builtin_amdgcn_mfma_f32_32x32x16_bf16(*(const LAS bf16x8*)(A + GREC_QKF + (ct * 4 + ks) * 1024), vf[ks], o, 0, 0, 0);
#pragma unroll
                for (int g = 0; g < 4; ++g) { float* gp = gop + (size_t)(32 * ct + 8 * g) * GW; asm volatile("" : "+v"(gp));
                    gp[0] = o[4 * g]; gp[GW] = o[4 * g + 1]; gp[2 * GW] = o[4 * g + 2]; gp[3 * GW] = o[4 * g + 3]; }
            }
#pragma unroll
            for (int d = 0; d < 4; ++d) {
#pragma unroll
                for (int i = 0; i < 16; ++i) S[d][i] *= eg;
#pragma unroll
                for (int ks = 0; ks < 4; ++ks) S[d] = __builtin_amdgcn_mfma_f32_32x32x16_bf16(*(const LAS bf16x8*)(A + GREC_KTF + (d * 4 + ks) * 1024), vf[ks], S[d], 0, 0, 0);
            }
        }
        __syncthreads();
    }
#undef GS_DMA
#undef GS_ULOAD
    if (F.wave < 4) { float* so = F.out + OUT_GREC + (size_t)chain * HD * HD + 32 * et + r32;
#pragma unroll
        for (int d = 0; d < 4; ++d)
#pragma unroll
            for (int i = 0; i < 16; ++i) so[(size_t)(32 * d + (i & 3) + 8 * (i >> 2) + 4 * hh) * HD] = S[d][i]; }
}

#ifndef REP_PHASE
#define REP_PHASE -1
#endif
#ifndef REP_N
#define REP_N 0
#endif
#ifndef REP_SCAN
#define REP_SCAN 0
#endif
#ifndef REP_ATTN
#define REP_ATTN 0
#endif

__device__ __forceinline__ void p2_mixers(Frame& F, unsigned* qctr) {
    _Pragma("unroll") for (int rs_ = 0; rs_ < 1 + REP_SCAN; ++rs_) if (F.bid < NB * NH) gdn_scan_chain(F, F.bid);
    __syncthreads();
    _Pragma("unroll") for (int ra_ = 0; ra_ < 1 + REP_ATTN; ++ra_)
    for (int u = F.bid; u < NB * NH * 16; u += F.G) { const int bh = u & 15, qb = u >> 4; sb_attn_unit(F, bh >> 3, bh & 7, qb); }
    const int gw = F.bid * NWAVES + F.wave, NGW = F.G * NWAVES;
    for (int it = gw; it < MS * NH * 32; it += NGW) {
        const int chain = it >> 5, slice = it & 31, b = chain >> 3, h = chain & 7;
        gdn_recur_wave<false>(SSP(S_GQ), SSP(S_GK), SSP(S_GV), SSP(S_G), SSP(S_BETA), GW, NH, (size_t)b, 1, h, slice,
                              F.in[6] + (size_t)chain * HD * HD, F.out + OUT_GRECS + (size_t)chain * HD * HD, SSP(S_GO), F.lane);
    }
    for (;;) {
        const unsigned v = __hip_atomic_fetch_add(qctr, 1u, __ATOMIC_RELAXED, __HIP_MEMORY_SCOPE_AGENT);
        const int it = (int)(__builtin_amdgcn_readfirstlane(v) >> 6);
        if (it >= MS * NH * DSEG) break;
        const int bh = it / DSEG, seg = it % DSEG; sb_decode_segment(F, bh >> 3, bh & 7, seg);
    }
}

__device__ __forceinline__ void p2_finish(Frame& F) {
    const int gw = F.bid * NWAVES + F.wave, NGW = F.G * NWAVES;
    const float* GO = WSP(float, WS_GO); const bf16* Zb = WSP(bf16, WS_Z); bf16* MIX = WSP(bf16, WS_MIX); const float* gnw = F.in[17];
    for (int it = gw; it < M * NH; it += NGW) {
        const int row = it >> 3, h = it & 7;
        const f32x2 o = *(const f32x2*)(GO + (size_t)row * GW + h * HD + 2 * F.lane);
        const float rs = rsqrtf(wave_sum(o.x * o.x + o.y * o.y) * (1.f / HD) + EPS);
        const unsigned zw = *(const unsigned*)(Zb + (size_t)row * GW + h * HD + 2 * F.lane);
        *(unsigned*)(MIX + (size_t)row * D + SBW + h * HD + 2 * F.lane) = pk2(o.x * rs * gnw[2 * F.lane] * silu_f(bf_lo(zw)), o.y * rs * gnw[2 * F.lane + 1] * silu_f(bf_hi(zw)));
    }
    if (F.bid == F.G - 1) {
        for (int bh = F.wave; bh < MS * NH; bh += NWAVES) {
            const int b = bh >> 3, h = bh & 7;
            { const f32x2 o = *(const f32x2*)(SSP(S_GO) + (size_t)b * GW + h * HD + 2 * F.lane);
              const float rs = rsqrtf(wave_sum(o.x * o.x + o.y * o.y) * (1.f / HD) + EPS);
              const float* z = SSP(S_PROJ) + (size_t)b * IN_COLS + O_GZ + h * HD + 2 * F.lane;
              float* mo = SSP(S_MIX) + (size_t)b * D + SBW + h * HD + 2 * F.lane;
              mo[0] = o.x * rs * gnw[2 * F.lane] * silu_f(z[0]); mo[1] = o.y * rs * gnw[2 * F.lane + 1] * silu_f(z[1]); }
            { float o0 = 0.f, o1 = 0.f, R = 0.f;
              for (int seg = DSEG - 1; seg >= 0; --seg) { const float* P = SSP(S_PART) + ((size_t)bh * DSEG + seg) * DPART; const float e = __expf(R); o0 += e * P[2 * F.lane]; o1 += e * P[2 * F.lane + 1]; R += P[128]; }
              const float rs = rsqrtf(wave_sum(o0 * o0 + o1 * o1) * (1.f / HD) + EPS); const float* nw = F.in[13];
              float* mo = SSP(S_MIX) + (size_t)b * D + h * HD + 2 * F.lane; mo[0] = o0 * rs * nw[2 * F.lane]; mo[1] = o1 * rs * nw[2 * F.lane + 1]; }
        }
    }
}

__device__ __forceinline__ void p4b_fixup(Frame& F) {
    const float* TAIL = WSP(float, WS_TAIL); const float* FIXG = WSP(float, WS_FIXG); const float* FIXU = WSP(float, WS_FIXU); bf16* ACT = WSP(bf16, WS_ACT); const float* cw = F.in[22];
    const int total = 32 * 2 * DFF;
    for (int i = F.bid * 512 + F.tid; i < total; i += F.G * 512) {
        const int pm = i / (2 * DFF), rr = (i / DFF) & 1, c = i % DFF;
        if ((pm & 15) == 0) continue;
        const float t0 = TAIL[((size_t)(pm - 1) * 2 + 0) * DFF + c], t1 = TAIL[((size_t)(pm - 1) * 2 + 1) * DFF + c];
        float g = FIXG[((size_t)pm * 2 + rr) * DFF + c];
        g += (rr == 0) ? (cw[c] * t0 + cw[DFF + c] * t1) : (cw[c] * t1);
        ACT[(size_t)(pm * 256 + rr) * DFF + c] = (bf16)f2bf(silu_f(g) * FIXU[((size_t)pm * 2 + rr) * DFF + c]);
    }
    const float* st = F.in[7]; const float* GP = SSP(S_GP); const float* UP = SSP(S_UP); float* SACT = SSP(S_ACT);
    for (int i = F.bid * 512 + F.tid; i < MS * DFF; i += F.G * 512) {
        const int b = i / DFF, c = i % DFF;
        const float s0 = st[((size_t)b * 2 + 0) * DFF + c], s1 = st[((size_t)b * 2 + 1) * DFF + c], gp = GP[i];
        const float g = cw[c] * s0 + cw[DFF + c] * s1 + cw[2 * DFF + c] * gp;
        SACT[i] = silu_f(g) * UP[i];
        F.out[OUT_FCONVS + ((size_t)b * 2 + 0) * DFF + c] = s1; F.out[OUT_FCONVS + ((size_t)b * 2 + 1) * DFF + c] = gp;
    }
}

__device__ __forceinline__ void p7_final(Frame& F) {
    const int gw = F.bid * NWAVES + F.wave, NGW = F.G * NWAVES;
    const float* fw = F.in[27]; const float* ss3 = (const float*)(F.ctl + CW_SUMSQ3);
    for (int m = gw; m < M; m += NGW) {
        const float rs = rsqrtf(ss3[m] * (1.f / D) + EPS);
        f32x4* y = (f32x4*)(F.out + OUT_Y + (size_t)m * D) + F.lane; const f32x4* w = (const f32x4*)fw + F.lane;
#pragma unroll
        for (int j = 0; j < 8; ++j) y[64 * j] = y[64 * j] * rs * w[64 * j];
    }
    if (F.bid == 0) {
        const int b = F.wave; float v[32]; float s = 0.f;
#pragma unroll
        for (int j = 0; j < 32; ++j) { const int c = F.lane + 64 * j; const float h = SSP(S_H2)[(size_t)b * D + c] + SSP(S_PP)[(size_t)b * D + c] * sigmoid_f(SSP(S_PG)[(size_t)b * D + c]); v[j] = h; s += h * h; }
        const float rs = rsqrtf(wave_sum(s) * (1.f / D) + EPS);
#pragma unroll
        for (int j = 0; j < 32; ++j) { const int c = F.lane + 64 * j; F.out[OUT_YS + (size_t)b * D + c] = v[j] * rs * fw[c]; }
    }
}

constexpr int NPHASES = 12;

constexpr int WS_DUMMY_WORDS = 3 * M;
constexpr int N_LAUNCHES = MK_N_LAUNCHES;
struct Args { const float* in[28]; float* out; unsigned char* ws; int ph_lo, ph_hi; };
__global__ void __launch_bounds__(NWAVES * 64, 2) hymba_fwd(Args args) {
    extern __shared__ __attribute__((aligned(16))) unsigned char lds[];
    Frame F;
    F.lds = (LAS unsigned char*)lds;
    F.MISC = (volatile LAS unsigned*)(F.lds + MISC_OFF);
    F.tid = threadIdx.x; F.lane = F.tid & 63; F.wave = __builtin_amdgcn_readfirstlane(F.tid >> 6);
    F.G = gridDim.x; F.bid = blockIdx.x;
    F.ws = args.ws; F.ctl = (unsigned*)(args.ws + WS_CTL); F.out = args.out;
#pragma unroll
    for (int i = 0; i < 28; ++i) F.in[i] = args.in[i];
    for (int u = F.tid; u < (LDS_BYTES - LDSCTL_OFF) / 4; u += NWAVES * 64) ((LAS unsigned*)(F.lds + LDSCTL_OFF))[u] = 0u;
    __syncthreads();
    XcdBarrier bar; bar.bar = F.ctl + CW_BAR; bar.x = 0; bar.st = nullptr;
    if (N_LAUNCHES == 1) bar = xcd_barrier_post(F.ctl + CW_BAR, F.MISC + 8);
#define GRID_BAR() do { if (N_LAUNCHES == 1) xcd_barrier(bar); } while (0)
    const int lo = args.ph_lo, hi = args.ph_hi;
#define IN(k) (lo <= (k) && (k) < hi)
#define NREP(k) ((k) == REP_PHASE ? 1 + REP_N : 1)
    float* ss1 = (float*)(F.ctl + CW_SUMSQ1); float* ss2 = (float*)(F.ctl + CW_SUMSQ2); float* ss3 = (float*)(F.ctl + CW_SUMSQ3); float* dummy = WSP(float, WS_DUMMY);

    if (IN(0)) { _Pragma("unroll") for (int rep = 0; rep < NREP(0); ++rep) p0_prologue(F); GRID_BAR(); }
    if (IN(1)) { _Pragma("unroll") for (int rep = 0; rep < NREP(1); ++rep) {
        { pg8::Gemm g{WSP(bf16, WS_XN), WSP(bf16, WS_WIN), M, NPROJ_PAD, D}; pg8::StaticOrder S; S.init(M, NPROJ_PAD, F.G, F.bid);
          pg8::EpiProj E{WSP(bf16, WS_Q), WSP(bf16, WS_K), WSP(bf16, WS_V), WSP(bf16, WS_CIN), WSP(bf16, WS_Z), F.out + OUT_K, F.out + OUT_V, F.out + OUT_GCONV, WSP(float, WS_G), WSP(float, WS_BETA), F.in[15], F.in[16]};
          pg8::gemm_phase<pg8::EpiProj, pg8::StaticOrder, true, true>(F.lds + RING_OFF, g, S, E); }
        { pg8::Gemm g{WSP(bf16, WS_PB), WSP(bf16, WS_WPP), M, D, PLE}; pg8::StaticOrder S; S.init(M, D, F.G, F.bid);
          pg8::EpiF32 E{WSP(float, WS_PP), D};
          pg8::gemm_phase<pg8::EpiF32, pg8::StaticOrder, true, true>(F.lds + RING_OFF, g, S, E); }
        { SEpiStore E{SSP(S_PROJ), IN_COLS, IN_COLS}; sample_gemm(F, SSP(S_A), D, false, WSP(bf16, WS_WIN), 225, E); }
        }
        GRID_BAR();
    }
    if (IN(2)) { _Pragma("unroll") for (int rep = 0; rep < NREP(2); ++rep) {
        for (int u = F.bid; u < NB * NH * NCHUNK; u += F.G) { const int chain = u & 15, ci = u >> 4;
            gdn_prep_unit(F, chain, ci, F.ws + WS_GREC + ((size_t)chain * NCHUNK + ci) * GREC_BYTES, WSP(float, WS_GEG) + chain * NCHUNK + ci); }
        gdn_prep_sample(F); }
        GRID_BAR(); }
    if (IN(3)) { _Pragma("unroll") for (int rep = 0; rep < NREP(3); ++rep) p2_mixers(F, F.ctl + CW_QUEUE + 64 * rep); GRID_BAR(); }
    if (IN(4)) { _Pragma("unroll") for (int rep = 0; rep < NREP(4); ++rep) p2_finish(F); GRID_BAR(); }
    if (IN(5)) { _Pragma("unroll") for (int rep = 0; rep < NREP(5); ++rep) {
        { pg8::Gemm g{WSP(bf16, WS_MIX), WSP(bf16, WS_WOUT), M, D, D}; pg8::StaticOrder S; S.init(M, D, F.G, F.bid);
          pg8::EpiResid E{F.in[0], WSP(float, WS_H1), WSP(bf16, WS_H1B), rep == 0 ? ss1 : dummy, D};
          pg8::gemm_phase<pg8::EpiResid, pg8::StaticOrder, true, true>(F.lds + RING_OFF, g, S, E); }
        { SEpiAdd E{F.in[1], SSP(S_H1), D}; sample_gemm(F, SSP(S_MIX), D, false, WSP(bf16, WS_WOUT), D / 32, E); }
        }
        GRID_BAR();
    }
    if (IN(6)) { _Pragma("unroll") for (int rep = 0; rep < NREP(6); ++rep) {
        { pg8::Gemm g{WSP(bf16, WS_H1B), WSP(bf16, WS_WGU), M, NGU, D}; pg8::StaticOrder S; S.init(M, NGU, F.G, F.bid);
          pg8::EpiGateUp E{ss1, F.in[22], WSP(bf16, WS_ACT), WSP(float, WS_TAIL), WSP(float, WS_FIXG), WSP(float, WS_FIXU), F.out + OUT_FCONV, (PG8_LAS float*)(F.lds + HALO_OFF)};
          pg8::gemm_phase<pg8::EpiGateUp, pg8::StaticOrder, true, true>(F.lds + RING_OFF, g, S, E); }
        { SEpiGateUp E{SSP(S_GP), SSP(S_UP)}; sample_gemm(F, SSP(S_H1), D, true, WSP(bf16, WS_WGU), NGU / 32, E); }
        }
        GRID_BAR();
    }
    if (IN(7)) { _Pragma("unroll") for (int rep = 0; rep < NREP(7); ++rep) p4b_fixup(F); GRID_BAR(); }
    if (IN(8)) { _Pragma("unroll") for (int rep = 0; rep < NREP(8); ++rep) {
        { pg8::Gemm g{WSP(bf16, WS_ACT), WSP(bf16, WS_WDN), M, D, DFF}; pg8::StaticOrder S; S.init(M, D, F.G, F.bid);
          pg8::EpiResid E{WSP(float, WS_H1), WSP(float, WS_H2), WSP(bf16, WS_H2B), rep == 0 ? ss2 : dummy, D};
          pg8::gemm_phase<pg8::EpiResid, pg8::StaticOrder, true, true>(F.lds + RING_OFF, g, S, E); }
        { SEpiAdd E{SSP(S_H1), SSP(S_H2), D}; sample_gemm(F, SSP(S_ACT), DFF, false, WSP(bf16, WS_WDN), D / 32, E); }
        }
        GRID_BAR();
    }
    if (IN(9)) { _Pragma("unroll") for (int rep = 0; rep < NREP(9); ++rep) {
        { pg8::Gemm g{WSP(bf16, WS_H2B), WSP(bf16, WS_WPG), M, D, D}; pg8::StaticOrder S; S.init(M, D, F.G, F.bid);
          pg8::EpiPle E{WSP(float, WS_H2), WSP(float, WS_PP), ss2, F.out + OUT_Y, rep == 0 ? ss3 : dummy, D};
          pg8::gemm_phase<pg8::EpiPle, pg8::StaticOrder, true, true>(F.lds + RING_OFF, g, S, E); }
        { SEpiStore E{SSP(S_PG), D, D}; sample_gemm(F, SSP(S_H2), D, true, WSP(bf16, WS_WPG), D / 32, E); }
        { SEpiStore E{SSP(S_PP), D, D}; sample_gemm(F, F.in[9], PLE, false, WSP(bf16, WS_WPP), D / 32, E); }
        }
        GRID_BAR();
    }
    if (IN(10)) { p7_final(F); }
#undef IN
#undef GRID_BAR
}

extern "C" void kernel_launch(void* const* d_in, const int* in_sizes, int n_in, void* d_out, int out_size, void* d_ws, size_t ws_size, hipStream_t stream) {
    static int grid = 0;
    if (grid == 0) {
        if (n_in != 28 || (size_t)out_size != OUT_END || ws_size < WS_END) { fprintf(stderr, "kernel_launch: unexpected sizes n_in %d out %d ws %zu (need %zu, %zu)\n", n_in, out_size, ws_size, (size_t)OUT_END, (size_t)WS_END); grid = -1; return; }
        int dev = 0, cus = 0, per_cu = 0;
        if (hipGetDevice(&dev) != hipSuccess || hipDeviceGetAttribute(&cus, hipDeviceAttributeMultiprocessorCount, dev) != hipSuccess) { grid = -1; return; }
        if (hipFuncSetAttribute((const void*)hymba_fwd, hipFuncAttributeMaxDynamicSharedMemorySize, LDS_BYTES) != hipSuccess) { fprintf(stderr, "kernel_launch: hipFuncSetAttribute failed\n"); grid = -1; return; }
        if (hipOccupancyMaxActiveBlocksPerMultiprocessor(&per_cu, (const void*)hymba_fwd, NWAVES * 64, LDS_BYTES) != hipSuccess || per_cu < 1) { fprintf(stderr, "kernel_launch: occupancy query says %d\n", per_cu); }
        (void)hipGetLastError();
        grid = cus;
    }
    if (grid < 0) return;
    (void)hipMemsetAsync((char*)d_ws + WS_CTL, 0, CTL_ZERO_BYTES, stream);
    Args a{};
    for (int i = 0; i < 28; ++i) a.in[i] = (const float*)d_in[i];
    a.out = (float*)d_out; a.ws = (unsigned char*)d_ws;
    if (N_LAUNCHES == 1) { a.ph_lo = 0; a.ph_hi = NPHASES; hipLaunchKernelGGL(hymba_fwd, dim3(grid), dim3(NWAVES * 64), LDS_BYTES, stream, a); }
    else for (int p = 0; p < 11; ++p) { a.ph_lo = p; a.ph_hi = p + 1; hipLaunchKernelGGL(hymba_fwd, dim3(grid), dim3(NWAVES * 64), LDS_BYTES, stream, a); }
}
```

```cpp
#include <hip/hip_runtime.h>
#include <cstdio>
#include <cstdint>

#ifndef MK_N_LAUNCHES
#define MK_N_LAUNCHES 1
#endif

namespace pg8 {
#define PG8_LAS __attribute__((address_space(3)))
typedef unsigned short bf16_t;
typedef short bf16x8 __attribute__((ext_vector_type(8)));
typedef float f32x4 __attribute__((ext_vector_type(4)));
typedef unsigned u32x4 __attribute__((ext_vector_type(4)));
constexpr int BM = 256, BK = 64, HALF = 128, HTB = HALF * BK * 2  , STAGE_BYTES = 8 * HTB, NXCD = 8, WGM = 8;

__host__ __device__ __forceinline__ int lds_byte(int r, int c) { const int st = (r >> 4) * 2 + (c >> 5), rr = r & 15, cc = c & 31, ob = rr * 64 + cc * 2; return st * 1024 + (ob ^ (((ob >> 9) & 1) << 5)); }
__host__ __device__ __forceinline__ void stage_rc(int b, int& R, int& C) { const int st = b / 1024, sb = b % 1024, swz = sb ^ (((sb >> 9) & 1) << 5); R = (st >> 1) * 16 + swz / 64; C = (st & 1) * 32 + (swz % 64) / 2; }
__host__ __device__ __forceinline__ int perm32(int rho) { const int n = rho >> 4, i = rho & 15; return 8 * (i >> 2) + 4 * n + (i & 3); }

struct Unit { int pm, pn; };
struct Gemm { const bf16_t* A; const bf16_t* Bt; int M, N, K; };

struct StaticOrder {
    int nM, nN, nwg, G, c;
    __host__ __device__ void init(int M, int N, int G_, int c_) { nM = M / BM; nN = N / BM; nwg = nM * nN; G = G_; c = c_; }
    __host__ __device__ bool next(int i, Unit& u) const {
        const long L = (long)i * G + c; if (L >= nwg) return false;
        int wgid = (int)L; { const int q = nwg / NXCD, r = nwg % NXCD, xcd = wgid % NXCD, off = wgid / NXCD; wgid = (xcd < r ? xcd * (q + 1) : r * (q + 1) + (xcd - r) * q) + off; }
        const int nig = WGM * nN, gid = wgid / nig, fm = gid * WGM, gsz = (nM - fm) < WGM ? (nM - fm) : WGM;
        u.pm = fm + ((wgid % nig) % gsz); u.pn = (wgid % nig) / gsz; return true;
    }
    __device__ __forceinline__ void a_ready(const Unit&) const {}
    __device__ __forceinline__ void done(const Unit&) const {}
};

__device__ __forceinline__ unsigned cvt_pk_bf16(float lo, float hi) { unsigned r; asm volatile("v_cvt_pk_bf16_f32 %0, %1, %2" : "=v"(r) : "v"(lo), "v"(hi)); return r; }
template <class Epi, class Sched, bool ALIGN_EPI = false, bool SP2 = false>
__device__ __forceinline__ void gemm_phase(PG8_LAS unsigned char* lds, const Gemm g, const Sched& S, const Epi& E) {
    int tid = threadIdx.x; asm volatile("" : "+v"(tid));
    const int wid = __builtin_amdgcn_readfirstlane(tid >> 6), lane = tid & 63, wr = wid >> 2, wc = wid & 3, fr = lane & 15, fq = lane >> 4;
    int K = g.K; asm volatile("" : "+s"(K));
    const int nt = K / BK;
    unsigned voffA[2], voffB[2];
#pragma unroll
    for (int i = 0; i < 2; ++i) { int R, C; stage_rc(tid * 16 + i * 8192, R, C); const int Rb = Epi::PERM ? ((R & ~31) + perm32(R & 31)) : R;
        voffA[i] = (unsigned)(R * K + C) * 2u; voffB[i] = (unsigned)(Rb * K + C) * 2u; }
    const size_t kstep = (size_t)(BK * 2);
    const size_t hstep = (size_t)HALF * K * 2;
    const size_t tstep = 2 * hstep;
    const unsigned ldsw = (unsigned)wid * 1024u;
    const int aoff = lds_byte(wr * 64 + fr, fq * 8), boff = lds_byte(wc * 32 + fr, fq * 8);
#define PG8_SA(b, h) (((b) * 2 + (h)) * HTB)
#define PG8_SB(b, h) ((4 + (b) * 2 + (h)) * HTB)
#define PG8_STAGE(bufoff, gbase, voff) do { _Pragma("unroll") for (int _i = 0; _i < 2; ++_i) \
        __builtin_amdgcn_global_load_lds((const unsigned*)((const char*)(gbase) + (voff)[_i]), (PG8_LAS unsigned*)(lds + (bufoff) + ldsw + _i * 8192), 16, 0, 0); } while (0)
#define PG8_LDA(dst, b, h) do { _Pragma("unroll") for (int m = 0; m < 4; ++m) _Pragma("unroll") for (int k = 0; k < 2; ++k) dst[m][k] = *(const PG8_LAS bf16x8*)(lds + PG8_SA(b, h) + aoff + m * 2048 + k * 1024); } while (0)
#define PG8_LDB(dst, b, h) do { _Pragma("unroll") for (int n = 0; n < 2; ++n) _Pragma("unroll") for (int k = 0; k < 2; ++k) dst[n][k] = *(const PG8_LAS bf16x8*)(lds + PG8_SB(b, h) + boff + n * 2048 + k * 1024); } while (0)
#define PG8_MMA(ai, bj, At, Bt) do { __builtin_amdgcn_s_setprio(1); _Pragma("unroll") for (int m = 0; m < 4; ++m) _Pragma("unroll") for (int n = 0; n < 2; ++n) _Pragma("unroll") for (int k = 0; k < 2; ++k) \
        acc[ai][bj][m][n] = __builtin_amdgcn_mfma_f32_16x16x32_bf16(Bt[n][k], At[m][k], acc[ai][bj][m][n], 0, 0, 0); __builtin_amdgcn_s_setprio(0); } while (0)
#define PG8_WAIT_V(n) asm volatile("s_waitcnt vmcnt(" #n ")" ::: "memory")
#define PG8_WAIT_L(n) asm volatile("s_waitcnt lgkmcnt(" #n ")" ::: "memory")
#define PG8_BAR __builtin_amdgcn_s_barrier()
#define PG8_SCHED __builtin_amdgcn_sched_barrier(0)
    Unit cur, nxt; int ui = 0;
    if (!S.next(0, cur)) return;
    f32x4 acc[2][2][4][2];
#pragma unroll
    for (int a = 0; a < 2; ++a)
#pragma unroll
        for (int b = 0; b < 2; ++b)
#pragma unroll
            for (int m = 0; m < 4; ++m)
#pragma unroll
                for (int n = 0; n < 2; ++n) acc[a][b][m][n] = (f32x4){0.f, 0.f, 0.f, 0.f};
    bf16x8 At[4][2], B0[2][2], B1[2][2];
    const char* cA = (const char*)g.A + (size_t)cur.pm * tstep; const char* cB = (const char*)g.Bt + (size_t)cur.pn * tstep;
    S.a_ready(cur);
    if constexpr (SP2) {
        PG8_STAGE(PG8_SB(0, 0), cB, voffB); PG8_STAGE(PG8_SB(0, 1), cB + hstep, voffB); PG8_STAGE(PG8_SA(0, 0), cA, voffA); PG8_STAGE(PG8_SA(0, 1), cA + hstep, voffA);
        if (wr == 1) PG8_BAR;
        PG8_WAIT_V(2); PG8_BAR;
        PG8_STAGE(PG8_SB(1, 0), cB + kstep, voffB); PG8_STAGE(PG8_SA(1, 0), cA + kstep, voffA); PG8_STAGE(PG8_SB(1, 1), cB + hstep + kstep, voffB);
        PG8_WAIT_V(6); PG8_BAR;
    } else {
        PG8_STAGE(PG8_SB(0, 0), cB, voffB); PG8_STAGE(PG8_SA(0, 0), cA, voffA); PG8_STAGE(PG8_SB(0, 1), cB + hstep, voffB); PG8_STAGE(PG8_SA(0, 1), cA + hstep, voffA);
        if (wr == 1) PG8_BAR;
        PG8_WAIT_V(4); PG8_BAR;
        PG8_STAGE(PG8_SB(1, 0), cB + kstep, voffB); PG8_STAGE(PG8_SA(1, 0), cA + kstep, voffA); PG8_STAGE(PG8_SB(1, 1), cB + hstep + kstep, voffB);
        PG8_WAIT_V(6); PG8_BAR;
    }
    for (;;) {
        const bool has_next = S.next(ui + 1, nxt);
        const char* nA = has_next ? (const char*)g.A + (size_t)nxt.pm * tstep : cA; const char* nB = has_next ? (const char*)g.Bt + (size_t)nxt.pn * tstep : cB;
        for (int t = 0; t < nt; t += 2) {
            const bool last = (t == nt - 2);
            const char* a1 = cA + (size_t)(t + 1) * kstep;
            const char* a2 = last ? nA : cA + (size_t)(t + 2) * kstep; const char* b2 = last ? nB : cB + (size_t)(t + 2) * kstep;
            const char* a3 = a2 + kstep; const char* b3 = b2 + kstep;
            if (last && has_next) S.a_ready(nxt);
            if constexpr (SP2) {
            PG8_LDB(B0, 0, 0); PG8_LDB(B1, 0, 1); PG8_SCHED; PG8_LDA(At, 0, 0); PG8_STAGE(PG8_SA(1, 1), a1 + hstep, voffA);
            PG8_WAIT_V(8); PG8_WAIT_L(0); PG8_BAR; PG8_MMA(0, 0, At, B0); PG8_MMA(0, 1, At, B1); PG8_BAR; PG8_SCHED;
            PG8_LDA(At, 0, 1); PG8_STAGE(PG8_SB(0, 0), b2, voffB); PG8_STAGE(PG8_SB(0, 1), b2 + hstep, voffB); PG8_STAGE(PG8_SA(0, 0), a2, voffA);
            PG8_WAIT_V(8); PG8_WAIT_L(0); PG8_BAR; PG8_MMA(1, 0, At, B0); PG8_MMA(1, 1, At, B1); PG8_BAR; PG8_SCHED;
            PG8_LDB(B0, 1, 0); PG8_LDB(B1, 1, 1); PG8_SCHED; PG8_LDA(At, 1, 0); PG8_STAGE(PG8_SA(0, 1), a2 + hstep, voffA);
            PG8_WAIT_V(8); PG8_WAIT_L(0); PG8_BAR; PG8_MMA(0, 0, At, B0); PG8_MMA(0, 1, At, B1); PG8_BAR; PG8_SCHED;
            PG8_LDA(At, 1, 1); PG8_STAGE(PG8_SB(1, 0), b3, voffB); PG8_STAGE(PG8_SB(1, 1), b3 + hstep, voffB); PG8_STAGE(PG8_SA(1, 0), a3, voffA);
            PG8_WAIT_V(8); PG8_WAIT_L(0); PG8_BAR; PG8_MMA(1, 0, At, B0); PG8_MMA(1, 1, At, B1); PG8_BAR; PG8_SCHED;
            } else {
            PG8_LDB(B0, 0, 0); PG8_SCHED; PG8_LDA(At, 0, 0); PG8_STAGE(PG8_SA(1, 1), a1 + hstep, voffA);
            PG8_WAIT_L(8); PG8_BAR; PG8_WAIT_L(0); PG8_MMA(0, 0, At, B0); PG8_BAR; PG8_SCHED;
            PG8_LDB(B1, 0, 1); PG8_STAGE(PG8_SB(0, 0), b2, voffB);
            PG8_BAR; PG8_WAIT_L(0); PG8_MMA(0, 1, At, B1); PG8_BAR;
            PG8_LDA(At, 0, 1); PG8_STAGE(PG8_SA(0, 0), a2, voffA);
            PG8_BAR; PG8_WAIT_L(0); PG8_MMA(1, 0, At, B0); PG8_BAR; PG8_SCHED;
            PG8_STAGE(PG8_SB(0, 1), b2 + hstep, voffB);
            PG8_WAIT_V(6); PG8_BAR; PG8_MMA(1, 1, At, B1); PG8_BAR;
            PG8_LDB(B0, 1, 0); PG8_SCHED; PG8_LDA(At, 1, 0); PG8_STAGE(PG8_SA(0, 1), a2 + hstep, voffA);
            PG8_WAIT_L(8); PG8_BAR; PG8_WAIT_L(0); PG8_MMA(0, 0, At, B0); PG8_BAR; PG8_SCHED;
            PG8_LDB(B1, 1, 1); PG8_STAGE(PG8_SB(1, 0), b3, voffB);
            PG8_BAR; PG8_WAIT_L(0); PG8_MMA(0, 1, At, B1); PG8_BAR;
            PG8_LDA(At, 1, 1); PG8_STAGE(PG8_SA(1, 0), a3, voffA);
            PG8_BAR; PG8_WAIT_L(0); PG8_MMA(1, 0, At, B0); PG8_BAR; PG8_SCHED;
            PG8_STAGE(PG8_SB(1, 1), b3 + hstep, voffB);
            PG8_WAIT_V(6); PG8_BAR; PG8_MMA(1, 1, At, B1); PG8_BAR;
            }
        }
        if constexpr (ALIGN_EPI) { if (wr == 0) PG8_BAR; }
        if constexpr (!Epi::AFTER_DRAIN) { int fr_e = fr, fq_e = fq; asm volatile("" : "+v"(fr_e), "+v"(fq_e));
            E(acc, cur, wr, wc, fr_e, fq_e); S.done(cur); }
        if (!has_next) break;
#pragma unroll
        for (int a = 0; a < 2; ++a)
#pragma unroll
            for (int b = 0; b < 2; ++b)
#pragma unroll
                for (int m = 0; m < 4; ++m)
#pragma unroll
                    for (int n = 0; n < 2; ++n) acc[a][b][m][n] = (f32x4){0.f, 0.f, 0.f, 0.f};
        cur = nxt; cA = nA; cB = nB; ++ui;
        if constexpr (ALIGN_EPI) { if (wr == 1) PG8_BAR; }
    }
    PG8_WAIT_V(0);
    if constexpr (!ALIGN_EPI) { if (wr == 0) PG8_BAR; }
    PG8_BAR;
    if constexpr (Epi::AFTER_DRAIN) { E.fused(acc, cur, wr, wc, fr, fq, lds, wid, lane); S.done(cur); }
#undef PG8_SA
#undef PG8_SB
#undef PG8_STAGE
#undef PG8_LDA
#undef PG8_LDB
#undef PG8_MMA
#undef PG8_WAIT_V
#undef PG8_WAIT_L
#undef PG8_BAR
#undef PG8_SCHED
}
}

constexpr int D = 2048, T = 4096, NB = 2, M = NB * T;
constexpr int MS = 8;
constexpr int HD = 128, NH = 8, SBW = NH * HD, GW = NH * HD;
constexpr int CONVCH = 3 * GW;
constexpr int IN_COLS = 7184, NPROJ_PAD = 7424;
constexpr int DFF = 5504, NGU = 2 * DFF;
constexpr int PLE = 256;
constexpr int PAST = 16384, PAGE = 128, NPAGES = PAST / PAGE, NPOOL = 1280;
constexpr float EPS = 1e-6f;
constexpr float SB_SCALE = 0.08838834764831845f;
constexpr int O_SB_K = 1024, O_SB_V = 2048, O_GQKV = 3072, O_GZ = 6144, O_GA = 7168, O_GB = 7176;

constexpr size_t OUT_Y = 0;
constexpr size_t OUT_YS = OUT_Y + (size_t)M * D;
constexpr size_t OUT_K = OUT_YS + (size_t)MS * D;
constexpr size_t OUT_V = OUT_K + (size_t)M * SBW;
constexpr size_t OUT_GCONV = OUT_V + (size_t)M * SBW;
constexpr size_t OUT_GREC = OUT_GCONV + (size_t)NB * 3 * CONVCH;
constexpr size_t OUT_FCONV = OUT_GREC + (size_t)NB * NH * HD * HD;
constexpr size_t OUT_KS = OUT_FCONV + (size_t)NB * 2 * DFF;
constexpr size_t OUT_VS = OUT_KS + (size_t)MS * SBW;
constexpr size_t OUT_GCONVS = OUT_VS + (size_t)MS * SBW;
constexpr size_t OUT_GRECS = OUT_GCONVS + (size_t)MS * 3 * CONVCH;
constexpr size_t OUT_FCONVS = OUT_GRECS + (size_t)MS * NH * HD * HD;
constexpr size_t OUT_END = OUT_FCONVS + (size_t)MS * 2 * DFF;

namespace pg8 {
__device__ __forceinline__ float silu_f(float x) { return x * __builtin_amdgcn_rcpf(1.0f + __expf(-x)); }
__device__ __forceinline__ float sigmoid_f(float x) { return __builtin_amdgcn_rcpf(1.0f + __expf(-x)); }
__device__ __forceinline__ float softplus_f(float x) { return fmaxf(x, 0.f) + log1pf(__expf(-fabsf(x))); }
typedef unsigned u32x2 __attribute__((ext_vector_type(2)));

struct EpiProj {
    static constexpr bool PERM = true, AFTER_DRAIN = false;
    bf16_t *Qb, *Kb, *Vb, *CIN, *Zb; float *outK, *outV, *outGconv; float *G, *BETA; const float *a_log, *dt_bias;
    __device__ __forceinline__ void operator()(const f32x4 (&acc)[2][2][4][2], const Unit& u, int wr, int wc, int fr, int fq) const {
        const int reg = u.pn >> 2;
#pragma unroll
        for (int ai = 0; ai < 2; ++ai)
#pragma unroll
            for (int m = 0; m < 4; ++m) {
                const int r = u.pm * BM + ai * HALF + wr * 64 + m * 16 + fr;
#pragma unroll
                for (int bj = 0; bj < 2; ++bj) {
                    const int c8 = u.pn * BM + bj * HALF + wc * 32 + 8 * fq;
                    const f32x4 v0 = acc[ai][bj][m][0], v1 = acc[ai][bj][m][1];
                    u32x4 w; w.x = cvt_pk_bf16(v0[0], v0[1]); w.y = cvt_pk_bf16(v0[2], v0[3]); w.z = cvt_pk_bf16(v1[0], v1[1]); w.w = cvt_pk_bf16(v1[2], v1[3]);
                    if (reg == 0) { *(u32x4*)(Qb + (size_t)r * SBW + c8) = w; }
                    else if (reg == 1) { const int c = c8 - O_SB_K; *(u32x4*)(Kb + (size_t)r * SBW + c) = w; float* o = outK + (size_t)r * SBW + c; *(f32x4*)o = v0; *(f32x4*)(o + 4) = v1; }
                    else if (reg == 2) { const int c = c8 - O_SB_V; *(u32x4*)(Vb + (size_t)r * SBW + c) = w; float* o = outV + (size_t)r * SBW + c; *(f32x4*)o = v0; *(f32x4*)(o + 4) = v1; }
                    else if (reg < 6) { const int c = c8 - O_GQKV; *(u32x4*)(CIN + (size_t)r * CONVCH + c) = w;
                        const int t = r & (T - 1); if (t >= T - 3) { float* o = outGconv + ((size_t)(r >> 12) * 3 + (t - (T - 3))) * CONVCH + c; *(f32x4*)o = v0; *(f32x4*)(o + 4) = v1; } }
                    else if (reg == 6) { const int c = c8 - O_GZ; *(u32x4*)(Zb + (size_t)r * GW + c) = w; }
                    else if (bj == 0 && wc == 0 && fq < 2 && u.pn == 28) {
                        float x[8] = {v0[0], v0[1], v0[2], v0[3], v1[0], v1[1], v1[2], v1[3]}; float y[8];
#pragma unroll
                        for (int h = 0; h < 8; ++h) y[h] = (fq == 0) ? -__expf(a_log[h]) * softplus_f(x[h] + dt_bias[h]) : sigmoid_f(x[h]);
                        float* o = (fq == 0 ? G : BETA) + (size_t)r * NH; *(f32x4*)o = (f32x4){y[0], y[1], y[2], y[3]}; *(f32x4*)(o + 4) = (f32x4){y[4], y[5], y[6], y[7]};
                    }
                }
            }
    }
};

struct EpiBf16 {
    static constexpr bool PERM = true, AFTER_DRAIN = false;
    bf16_t* O; int ldc;
    __device__ __forceinline__ void operator()(const f32x4 (&acc)[2][2][4][2], const Unit& u, int wr, int wc, int fr, int fq) const {
#pragma unroll
        for (int ai = 0; ai < 2; ++ai)
#pragma unroll
            for (int m = 0; m < 4; ++m) { const int r = u.pm * BM + ai * HALF + wr * 64 + m * 16 + fr;
#pragma unroll
                for (int bj = 0; bj < 2; ++bj) { const int c8 = u.pn * BM + bj * HALF + wc * 32 + 8 * fq; const f32x4 v0 = acc[ai][bj][m][0], v1 = acc[ai][bj][m][1];
                    u32x4 w; w.x = cvt_pk_bf16(v0[0], v0[1]); w.y = cvt_pk_bf16(v0[2], v0[3]); w.z = cvt_pk_bf16(v1[0], v1[1]); w.w = cvt_pk_bf16(v1[2], v1[3]);
                    *(u32x4*)(O + (size_t)r * ldc + c8) = w; } }
    }
};

__device__ __forceinline__ float bflo(unsigned w) { return __builtin_bit_cast(float, w << 16); }
__device__ __forceinline__ float bfhi(unsigned w) { return __builtin_bit_cast(float, w & 0xffff0000u); }
template <bool BF> struct EpiResid {
    static constexpr bool PERM = true, AFTER_DRAIN = false;
    const void* base; bf16_t* Hb; float* sumsq; int ldc;
    __device__ __forceinline__ void operator()(const f32x4 (&acc)[2][2][4][2], const Unit& u, int wr, int wc, int fr, int fq) const {
#pragma unroll
        for (int ai = 0; ai < 2; ++ai)
#pragma unroll
            for (int m = 0; m < 4; ++m) { const int r = u.pm * BM + ai * HALF + wr * 64 + m * 16 + fr; float ss = 0.f;
#pragma unroll
                for (int bj = 0; bj < 2; ++bj) { const int c8 = u.pn * BM + bj * HALF + wc * 32 + 8 * fq; const size_t off = (size_t)r * ldc + c8;
                    float b[8];
                    if (BF) { const u32x4 w = *(const u32x4*)((const bf16_t*)base + off); b[0] = bflo(w.x); b[1] = bfhi(w.x); b[2] = bflo(w.y); b[3] = bfhi(w.y); b[4] = bflo(w.z); b[5] = bfhi(w.z); b[6] = bflo(w.w); b[7] = bfhi(w.w); }
                    else { const f32x4 b0 = *(const f32x4*)((const float*)base + off), b1 = *(const f32x4*)((const float*)base + off + 4); b[0] = b0[0]; b[1] = b0[1]; b[2] = b0[2]; b[3] = b0[3]; b[4] = b1[0]; b[5] = b1[1]; b[6] = b1[2]; b[7] = b1[3]; }
                    float h[8];
#pragma unroll
                    for (int j = 0; j < 4; ++j) { h[j] = b[j] + acc[ai][bj][m][0][j]; h[4 + j] = b[4 + j] + acc[ai][bj][m][1][j]; }
#pragma unroll
                    for (int j = 0; j < 8; ++j) ss += h[j] * h[j];
                    u32x4 w; w.x = cvt_pk_bf16(h[0], h[1]); w.y = cvt_pk_bf16(h[2], h[3]); w.z = cvt_pk_bf16(h[4], h[5]); w.w = cvt_pk_bf16(h[6], h[7]);
                    *(u32x4*)(Hb + off) = w; }
                ss += __shfl_xor(ss, 16); ss += __shfl_xor(ss, 32);
                if (fq == 0) unsafeAtomicAdd(sumsq + r, ss); }
    }
};

struct EpiGateUp {
    static constexpr bool PERM = true, AFTER_DRAIN = false;
    const float* sumsq; const float* convw; bf16_t* ACT; float* TAIL; float* FIXG; float* FIXU; float* outFconv; PG8_LAS float* halo;
    __device__ __forceinline__ void operator()(const f32x4 (&acc)[2][2][4][2], const Unit& u, int wr, int wc, int fr, int fq) const {
        const int lane = fr + 16 * fq;
        const int cg = u.pn * HALF + wc * 32 + 8 * fq;
        float w0[8], w1[8], w2[8];
#pragma unroll
        for (int j = 0; j < 8; ++j) { w0[j] = convw[cg + j]; w1[j] = convw[DFF + cg + j]; w2[j] = convw[2 * DFF + cg + j]; }
        float gp[2][4][8], up[2][4][8];
#pragma unroll
        for (int ai = 0; ai < 2; ++ai)
#pragma unroll
            for (int m = 0; m < 4; ++m) { const int r = u.pm * BM + ai * HALF + wr * 64 + m * 16 + fr; const float rs = rsqrtf(sumsq[r] * (1.0f / D) + EPS);
#pragma unroll
                for (int n = 0; n < 2; ++n)
#pragma unroll
                    for (int j = 0; j < 4; ++j) { gp[ai][m][4 * n + j] = acc[ai][0][m][n][j] * rs; up[ai][m][4 * n + j] = acc[ai][1][m][n][j] * rs; } }
        if (fr >= 14) {
#pragma unroll
            for (int ai = 0; ai < 2; ++ai) { PG8_LAS float* hp = halo + ((wc * 4 + (2 * ai + wr)) * 2 + (fr - 14)) * 32 + 8 * fq;
                *(PG8_LAS f32x4*)hp = (f32x4){gp[ai][3][0], gp[ai][3][1], gp[ai][3][2], gp[ai][3][3]}; *(PG8_LAS f32x4*)(hp + 4) = (f32x4){gp[ai][3][4], gp[ai][3][5], gp[ai][3][6], gp[ai][3][7]}; }
        }
        asm volatile("s_waitcnt lgkmcnt(0)" ::: "memory"); __builtin_amdgcn_s_barrier(); asm volatile("" ::: "memory");
        const int src1 = (lane & 48) | ((fr - 1) & 15), src2 = (lane & 48) | ((fr - 2) & 15);
#pragma unroll
        for (int ai = 0; ai < 2; ++ai) {
            const int B = 2 * ai + wr;
            float h62[8], h63[8];
            if (B > 0) { const PG8_LAS float* hp = halo + ((wc * 4 + (B - 1)) * 2) * 32 + 8 * fq;
                const f32x4 a0 = *(const PG8_LAS f32x4*)hp, a1 = *(const PG8_LAS f32x4*)(hp + 4), b0 = *(const PG8_LAS f32x4*)(hp + 32), b1 = *(const PG8_LAS f32x4*)(hp + 36);
#pragma unroll
                for (int j = 0; j < 4; ++j) { h62[j] = a0[j]; h62[4 + j] = a1[j]; h63[j] = b0[j]; h63[4 + j] = b1[j]; } }
            else {
#pragma unroll
                for (int j = 0; j < 8; ++j) { h62[j] = 0.f; h63[j] = 0.f; } }
            float ps1[8], ps2[8];
#pragma unroll
            for (int j = 0; j < 8; ++j) { ps1[j] = h63[j]; ps2[j] = (fr == 0) ? h62[j] : h63[j]; }
#pragma unroll
            for (int m = 0; m < 4; ++m) {
                const int r = u.pm * BM + ai * HALF + wr * 64 + m * 16 + fr;
                float gate[8], a[8];
#pragma unroll
                for (int j = 0; j < 8; ++j) {
                    const float s1 = __shfl(gp[ai][m][j], src1), s2 = __shfl(gp[ai][m][j], src2);
                    const float p1 = (fr >= 1) ? s1 : ps1[j], p2 = (fr >= 2) ? s2 : ps2[j];
                    ps1[j] = s1; ps2[j] = s2;
                    gate[j] = w0[j] * p2 + w1[j] * p1 + w2[j] * gp[ai][m][j];
                    a[j] = silu_f(gate[j]) * up[ai][m][j];
                }
                u32x4 w; w.x = cvt_pk_bf16(a[0], a[1]); w.y = cvt_pk_bf16(a[2], a[3]); w.z = cvt_pk_bf16(a[4], a[5]); w.w = cvt_pk_bf16(a[6], a[7]);
                *(u32x4*)(ACT + (size_t)r * DFF + cg) = w;
                if (B == 0 && m == 0 && fr < 2 && (u.pm & 15) != 0) {
                    float* fg = FIXG + ((size_t)u.pm * 2 + fr) * DFF + cg; float* fu = FIXU + ((size_t)u.pm * 2 + fr) * DFF + cg;
                    *(f32x4*)fg = (f32x4){gate[0], gate[1], gate[2], gate[3]}; *(f32x4*)(fg + 4) = (f32x4){gate[4], gate[5], gate[6], gate[7]};
                    *(f32x4*)fu = (f32x4){up[ai][m][0], up[ai][m][1], up[ai][m][2], up[ai][m][3]}; *(f32x4*)(fu + 4) = (f32x4){up[ai][m][4], up[ai][m][5], up[ai][m][6], up[ai][m][7]};
                }
                if (B == 3 && m == 3 && fr >= 14) {
                    float* tp = TAIL + ((size_t)u.pm * 2 + (fr - 14)) * DFF + cg;
                    *(f32x4*)tp = (f32x4){gp[ai][m][0], gp[ai][m][1], gp[ai][m][2], gp[ai][m][3]}; *(f32x4*)(tp + 4) = (f32x4){gp[ai][m][4], gp[ai][m][5], gp[ai][m][6], gp[ai][m][7]};
                    if ((u.pm & 15) == 15) { float* op = outFconv + ((size_t)(u.pm >> 4) * 2 + (fr - 14)) * DFF + cg;
                        *(f32x4*)op = (f32x4){gp[ai][m][0], gp[ai][m][1], gp[ai][m][2], gp[ai][m][3]}; *(f32x4*)(op + 4) = (f32x4){gp[ai][m][4], gp[ai][m][5], gp[ai][m][6], gp[ai][m][7]}; }
                }
            }
        }
    }
};

struct EpiPle {
    static constexpr bool PERM = true, AFTER_DRAIN = false;
    const bf16_t* H2; const bf16_t* PP; const float* sumsq2; float* H3; float* sumsq3; int ldc;
    __device__ __forceinline__ void operator()(const f32x4 (&acc)[2][2][4][2], const Unit& u, int wr, int wc, int fr, int fq) const {
#pragma unroll
        for (int ai = 0; ai < 2; ++ai)
#pragma unroll
            for (int m = 0; m < 4; ++m) { const int r = u.pm * BM + ai * HALF + wr * 64 + m * 16 + fr; float ss = 0.f;
                const float rs = rsqrtf(sumsq2[r] * (1.0f / D) + EPS);
#pragma unroll
                for (int bj = 0; bj < 2; ++bj) { const int c8 = u.pn * BM + bj * HALF + wc * 32 + 8 * fq; const size_t off = (size_t)r * ldc + c8;
                    const u32x4 hw = *(const u32x4*)(H2 + off), pw = *(const u32x4*)(PP + off);
                    const float hb[8] = {bflo(hw.x), bfhi(hw.x), bflo(hw.y), bfhi(hw.y), bflo(hw.z), bfhi(hw.z), bflo(hw.w), bfhi(hw.w)};
                    const float pb[8] = {bflo(pw.x), bfhi(pw.x), bflo(pw.y), bfhi(pw.y), bflo(pw.z), bfhi(pw.z), bflo(pw.w), bfhi(pw.w)};
                    float h[8];
#pragma unroll
                    for (int j = 0; j < 4; ++j) { h[j] = hb[j] + pb[j] * sigmoid_f(acc[ai][bj][m][0][j] * rs); h[4 + j] = hb[4 + j] + pb[4 + j] * sigmoid_f(acc[ai][bj][m][1][j] * rs); }
#pragma unroll
                    for (int j = 0; j < 8; ++j) ss += h[j] * h[j];
                    *(f32x4*)(H3 + off) = (f32x4){h[0], h[1], h[2], h[3]}; *(f32x4*)(H3 + off + 4) = (f32x4){h[4], h[5], h[6], h[7]}; }
                ss += __shfl_xor(ss, 16); ss += __shfl_xor(ss, 32);
                if (fq == 0) unsafeAtomicAdd(sumsq3 + r, ss); }
    }
};
}

constexpr size_t MiB = 1u << 20;
constexpr size_t WS_CTL = 0, CTL_ZERO_BYTES = 1 * MiB;
constexpr int CW_QUEUE = 1024;
constexpr int CW_BAR = 4096;
constexpr int CW_SUMSQ1 = 32768, CW_SUMSQ2 = CW_SUMSQ1 + M, CW_SUMSQ3 = CW_SUMSQ2 + M;
static_assert((CW_SUMSQ3 + M) * 4 <= (int)CTL_ZERO_BYTES, "ctl");
constexpr size_t WS_WIN = 2 * MiB;
constexpr size_t WS_WOUT = WS_WIN + (size_t)NPROJ_PAD * D * 2;
constexpr size_t WS_WGU = WS_WOUT + (size_t)D * D * 2;
constexpr size_t WS_WDN = WS_WGU + (size_t)NGU * D * 2;
constexpr size_t WS_WPG = WS_WDN + (size_t)D * DFF * 2;
constexpr size_t WS_WPP = WS_WPG + (size_t)D * D * 2;
constexpr size_t WS_XN = WS_WPP + (size_t)D * PLE * 2;
constexpr size_t WS_PB = WS_XN + (size_t)M * D * 2;
constexpr size_t WS_Q = WS_PB + (size_t)M * PLE * 2;
constexpr size_t WS_K = WS_Q + (size_t)M * SBW * 2;
constexpr size_t WS_V = WS_K + (size_t)M * SBW * 2;
constexpr size_t WS_CIN = WS_V + (size_t)M * SBW * 2;
constexpr size_t WS_Z = WS_CIN + (size_t)M * CONVCH * 2;
constexpr size_t WS_G = WS_Z + (size_t)M * GW * 2;
constexpr size_t WS_BETA = WS_G + (size_t)M * NH * 4;
constexpr size_t WS_GQ = WS_BETA + (size_t)M * NH * 4;
constexpr size_t WS_GK = WS_GQ + (size_t)M * GW * 4;
constexpr size_t WS_GV = WS_GK + (size_t)M * GW * 4;
constexpr size_t WS_GO = WS_GV + (size_t)M * GW * 4;
constexpr size_t WS_GSF = WS_GO;
constexpr size_t WS_MIX = WS_GO + (size_t)M * GW * 4;
constexpr size_t WS_H1 = WS_MIX + (size_t)M * D * 2;
constexpr size_t WS_H1B = WS_H1 + (size_t)M * D * 4;
constexpr size_t WS_ACT = WS_H1B + (size_t)M * D * 2;
constexpr size_t WS_TAIL = WS_ACT + (size_t)M * DFF * 2;
constexpr size_t WS_FIXG = WS_TAIL + (size_t)32 * 2 * DFF * 4;
constexpr size_t WS_FIXU = WS_FIXG + (size_t)32 * 2 * DFF * 4;
constexpr size_t WS_H2 = WS_FIXU + (size_t)32 * 2 * DFF * 4;
constexpr size_t WS_H2B = WS_H2 + (size_t)M * D * 4;
constexpr size_t WS_PP = WS_H2B + (size_t)M * D * 2;
constexpr size_t WS_S = WS_PP + (size_t)M * D * 4;
constexpr size_t S_A = 0;
constexpr size_t S_PROJ = S_A + MS * D;
constexpr size_t S_GQ = S_PROJ + MS * IN_COLS;
constexpr size_t S_GK = S_GQ + MS * GW;
constexpr size_t S_GV = S_GK + MS * GW;
constexpr size_t S_G = S_GV + MS * GW;
constexpr size_t S_BETA = S_G + 64;
constexpr size_t S_GO = S_BETA + 64;
constexpr size_t S_PART = S_GO + MS * GW;
constexpr int DSEG = 32, DPART = 132;
constexpr size_t S_MIX = S_PART + (size_t)MS * NH * DSEG * DPART;
constexpr size_t S_H1 = S_MIX + MS * D;
constexpr size_t S_GP = S_H1 + MS * D;
constexpr size_t S_UP = S_GP + MS * DFF;
constexpr size_t S_ACT = S_UP + MS * DFF;
constexpr size_t S_H2 = S_ACT + MS * DFF;
constexpr size_t S_PG = S_H2 + MS * D;
constexpr size_t S_PP = S_PG + MS * D;
constexpr size_t S_END = S_PP + MS * D;
constexpr size_t WS_GREC = ((WS_S + S_END * 4 + 4095) / 4096) * 4096;
constexpr size_t WS_GEG = WS_GREC + (size_t)16 * 64 * 73728;
constexpr size_t WS_DUMMY = WS_GEG + 16 * 64 * 4;
constexpr size_t WS_END = WS_DUMMY + (size_t)M * 4;

constexpr int RING_OFF = 0, RING_BYTES = 131072;
constexpr int HALO_OFF = RING_BYTES;
constexpr int LDSCTL_OFF = 151552, MISC_OFF = LDSCTL_OFF + 320;
constexpr int LDS_BYTES = 155648;
constexpr int NWAVES = 8;

#define GAS __attribute__((address_space(1)))
#define LAS __attribute__((address_space(3)))
typedef unsigned short bf16;
typedef unsigned v4u __attribute__((ext_vector_type(4)));
typedef unsigned v2u __attribute__((ext_vector_type(2)));
typedef float f32x4 __attribute__((ext_vector_type(4)));
typedef float f32x2 __attribute__((ext_vector_type(2)));
typedef GAS unsigned gu32;
typedef short bf16x8 __attribute__((ext_vector_type(8)));
typedef short s16x4 __attribute__((ext_vector_type(4)));
typedef float f32x16 __attribute__((ext_vector_type(16)));
typedef __bf16 bf16x2_t __attribute__((ext_vector_type(2)));
__device__ __forceinline__ unsigned cvt2bf(float lo, float hi) { const f32x2 v = {lo, hi}; return __builtin_bit_cast(unsigned, __builtin_convertvector(v, bf16x2_t)); }
#define RLX_AGENT __ATOMIC_RELAXED, __HIP_MEMORY_SCOPE_AGENT
#define LDS_WAIT() asm volatile("s_waitcnt lgkmcnt(0)" ::: "memory")
#define VM_WAIT() asm volatile("s_waitcnt vmcnt(0)" ::: "memory")
__device__ __forceinline__ unsigned f2bf(float f) { unsigned u = __builtin_bit_cast(unsigned, f); return (u + 0x7fffu + ((u >> 16) & 1u)) >> 16; }
__device__ __forceinline__ unsigned pk2(float lo, float hi) { return f2bf(lo) | (f2bf(hi) << 16); }
__device__ __forceinline__ float bf_lo(unsigned w) { return __builtin_bit_cast(float, w << 16); }
__device__ __forceinline__ float bf_hi(unsigned w) { return __builtin_bit_cast(float, w & 0xffff0000u); }
__device__ __forceinline__ float bf2f(bf16 b) { return __builtin_bit_cast(float, (unsigned)b << 16); }
using pg8::silu_f; using pg8::sigmoid_f; using pg8::softplus_f;

#define XB_TMO      128
#define XB_XCNT(j)  (256  + 64 * (j))
#define XB_XSUB(j)  (1280 + 64 * (j))
#define XB_XGEN(j)  (2304 + 64 * (j))
#define XB_TOP      3328
#define XB_TOPGEN   3392
#define XCD_BAR_WORDS 3456
#define XB_SPIN_CAP (1u << 18)
__device__ __forceinline__ unsigned xb_ld(unsigned* p)              { return __hip_atomic_load(p, __ATOMIC_RELAXED, __HIP_MEMORY_SCOPE_AGENT); }
__device__ __forceinline__ unsigned xb_add(unsigned* p, unsigned v) { return __hip_atomic_fetch_add(p, v, __ATOMIC_RELAXED, __HIP_MEMORY_SCOPE_AGENT); }
__device__ __forceinline__ unsigned xb_xcc_id() { return (unsigned)__builtin_amdgcn_s_getreg((3 << 11) | 20) & 0xFu; }
#define XB_SPIN(cond, bar) do { unsigned _sp = 0; while (cond) { __builtin_amdgcn_s_sleep(1); \
    if ((++_sp & 255u) == 0u) { if (xb_ld(&(bar)[XB_TMO])) break; if (_sp > XB_SPIN_CAP) { atomicAdd(&(bar)[XB_TMO], 1u); break; } } } } while (0)
struct XcdBarrier { unsigned* bar; unsigned x; volatile LAS unsigned* st; };
__device__ __forceinline__ XcdBarrier xcd_barrier_post(unsigned* bar, volatile LAS unsigned* st) {
    XcdBarrier b; b.bar = bar; b.x = xb_xcc_id(); b.st = st;
    if (threadIdx.x == 0) (void)xb_add(&bar[XB_XCNT(b.x)], 1u);
    return b;
}
__device__ __forceinline__ void xcd_barrier_complete(unsigned* bar, unsigned x, unsigned& nloc, unsigned& nx) {
    const unsigned G = gridDim.x * gridDim.y * gridDim.z;
    unsigned sum, cnt, mine, sp = 0u;
    for (;;) {
        sum = 0u; cnt = 0u; mine = 0u;
#pragma unroll
        for (unsigned j = 0; j < 16; ++j) { const unsigned c = xb_ld(&bar[XB_XCNT(j)]); sum += c; cnt += (c > 0u) ? 1u : 0u; mine = (j == x) ? c : mine; }
        if (sum == G) break;
        __builtin_amdgcn_s_sleep(1);
        if ((++sp & 255u) == 0u) { if (xb_ld(&bar[XB_TMO])) break; if (sp > XB_SPIN_CAP) { atomicAdd(&bar[XB_TMO], 1u); break; } }
    }
    nloc = mine > 0u ? mine : 1u; nx = cnt > 0u ? cnt : 1u;
}
__device__ __forceinline__ void xcd_barrier(const XcdBarrier& b) {
    asm volatile("s_waitcnt vmcnt(0)" ::: "memory");
    __syncthreads();
    if (threadIdx.x == 0) {
        unsigned* bar = b.bar;
        __builtin_amdgcn_s_waitcnt(0);
        unsigned nloc = b.st[0], nx = b.st[1];
        if (nloc == 0u) { xcd_barrier_complete(bar, b.x, nloc, nx); b.st[0] = nloc; b.st[1] = nx; }
        const unsigned old = xb_add(&bar[XB_XSUB(b.x)], 1u);
        const unsigned gen = old / nloc;
        if (old + 1u == (gen + 1u) * nloc) {
            __builtin_amdgcn_fence(__ATOMIC_RELEASE, "agent");
            asm volatile("s_waitcnt vmcnt(0)" ::: "memory");
            const unsigned og = xb_add(&bar[XB_TOP], 1u);
            const unsigned tg = og / nx;
            if (og + 1u == (tg + 1u) * nx) xb_add(&bar[XB_TOPGEN], 1u);
            else XB_SPIN(xb_ld(&bar[XB_TOPGEN]) == tg, bar);
            __builtin_amdgcn_fence(__ATOMIC_ACQUIRE, "agent");
            xb_add(&bar[XB_XGEN(b.x)], 1u);
            asm volatile("s_waitcnt vmcnt(0)" ::: "memory");
        } else {
            XB_SPIN(xb_ld(&bar[XB_XGEN(b.x)]) == gen, bar);
            __builtin_amdgcn_fence(__ATOMIC_ACQUIRE, "agent");
            asm volatile("s_waitcnt vmcnt(0)" ::: "memory");
        }
    }
    __syncthreads();
}

struct Frame {
    LAS unsigned char* lds;
    volatile LAS unsigned* MISC;
    unsigned* ctl;
    int tid, lane, wave, G, bid;
    float* out;
    unsigned char* ws;
};
__device__ __forceinline__ const float* kin(int i) {
    const unsigned char __attribute__((address_space(4)))* ka = (const unsigned char __attribute__((address_space(4)))*)__builtin_amdgcn_kernarg_segment_ptr();
    unsigned off = (unsigned)i * 8u; asm volatile("" : "+s"(off));
    return *(const float* const __attribute__((address_space(4)))*)(ka + off);
}
#define WSP(T_, off) ((T_*)(F.ws + (off)))
#define SSP(off) ((float*)(F.ws + WS_S) + (off))

__device__ __forceinline__ float wave_sum(float v) {
#pragma unroll
    for (int o = 1; o < 64; o <<= 1) v += __shfl_xor(v, o);
    return v;
}

struct TItem { const float* W; const float* ks; bf16* WT; int ldw, nvalid, K, drow, k0, n0; };
constexpr int TI_NB_IN = 113;
constexpr int TI_IN = (D / 64) * TI_NB_IN, TI_OUT = (D / 64) * (D / 64), TI_G = (D / 64) * (DFF / 64), TI_D = (DFF / 64) * (D / 64), TI_PG = TI_OUT, TI_PP = (PLE / 64) * (D / 64);
__device__ __forceinline__ int ti_count(int set) { return set == 0 ? TI_IN + TI_PP + TI_OUT : set == 1 ? 2 * TI_G : TI_D + TI_PG; }
__device__ __forceinline__ void ti_decode(Frame& F, int set, int r, TItem& t) {
    t.ks = nullptr;
    if (set == 0) {
        if (r < TI_IN) { const int kb = r / TI_NB_IN, nb = r % TI_NB_IN; t.W = kin(11); t.ldw = IN_COLS; t.nvalid = IN_COLS; t.K = D; t.WT = WSP(bf16, WS_WIN); t.drow = 64 * nb; t.k0 = 64 * kb; t.n0 = 64 * nb; return; } r -= TI_IN;
        if (r < TI_PP) { const int kb = r / (D / 64), nb = r % (D / 64); t.W = kin(26); t.ldw = D; t.nvalid = D; t.K = PLE; t.WT = WSP(bf16, WS_WPP); t.drow = 64 * nb; t.k0 = 64 * kb; t.n0 = 64 * nb; return; } r -= TI_PP;
        { const int kb = r / (D / 64), nb = r % (D / 64); t.W = kin(18); t.ldw = D; t.nvalid = D; t.K = D; t.WT = WSP(bf16, WS_WOUT); t.drow = 64 * nb; t.k0 = 64 * kb; t.n0 = 64 * nb; return; }
    } else if (set == 1) {
        const int up = r >= TI_G; if (up) r -= TI_G;
        const int kb = r / (DFF / 64), nb = r % (DFF / 64), n0 = 64 * nb;
        t.W = up ? kin(21) : kin(20); t.ks = kin(19); t.ldw = DFF; t.nvalid = DFF; t.K = D; t.WT = WSP(bf16, WS_WGU); t.drow = 256 * (n0 >> 7) + 128 * up + (n0 & 127); t.k0 = 64 * kb; t.n0 = n0; return;
    } else {
        if (r < TI_D) { const int kb = r / (D / 64), nb = r % (D / 64); t.W = kin(23); t.ldw = D; t.nvalid = D; t.K = DFF; t.WT = WSP(bf16, WS_WDN); t.drow = 64 * nb; t.k0 = 64 * kb; t.n0 = 64 * nb; return; } r -= TI_D;
        { const int kb = r / (D / 64), nb = r % (D / 64); t.W = kin(25); t.ks = kin(24); t.ldw = D; t.nvalid = D; t.K = D; t.WT = WSP(bf16, WS_WPG); t.drow = 64 * nb; t.k0 = 64 * kb; t.n0 = 64 * nb; return; }
    }
}
__device__ __forceinline__ void ti_load(const TItem& t, f32x4 (&v)[16], float (&sc)[16], int lane) {
    const int n4 = (lane & 15) * 4, kq = lane >> 4; const bool nv = (t.n0 + n4) < t.nvalid;
#pragma unroll
    for (int i = 0; i < 16; ++i) { const int kk = 4 * i + kq;
        v[i] = nv ? *(const f32x4*)(t.W + (size_t)(t.k0 + kk) * t.ldw + t.n0 + n4) : (f32x4){0.f, 0.f, 0.f, 0.f};
        sc[i] = t.ks ? t.ks[t.k0 + kk] : 1.f; }
}
__device__ __forceinline__ void ti_store(const TItem& t, const f32x4 (&v)[16], const float (&sc)[16], LAS float* scr, int lane) {
    const int n4 = (lane & 15) * 4, kq = lane >> 4;
#pragma unroll
    for (int i = 0; i < 16; ++i) { const int kk = 4 * i + kq; const f32x4 x = v[i] * sc[i]; LAS float* d = scr + kk * 65 + n4; d[0] = x.x; d[1] = x.y; d[2] = x.z; d[3] = x.w; }
    LDS_WAIT(); asm volatile("" ::: "memory");
    const int c = lane & 7;
#pragma unroll
    for (int j = 0; j < 8; ++j) { const int n = (lane >> 3) + 8 * j; const LAS float* s = scr + (8 * c) * 65 + n;
        v4u o; o.x = pk2(s[0 * 65], s[1 * 65]); o.y = pk2(s[2 * 65], s[3 * 65]); o.z = pk2(s[4 * 65], s[5 * 65]); o.w = pk2(s[6 * 65], s[7 * 65]);
        *(v4u*)(t.WT + (size_t)(t.drow + n) * t.K + t.k0 + 8 * c) = o; }
    LDS_WAIT(); asm volatile("" ::: "memory");
}
__device__ __forceinline__ void convert_set(Frame& F, int set, int wv, int nw) {
    if (wv < 0 || wv >= nw) return;
    LAS float* scr = (LAS float*)(F.lds + RING_OFF + F.wave * 16640);
    const int n = ti_count(set);
    int it = wv; if (it >= n) return;
    TItem cur, nxt; f32x4 vc[16], vn[16]; float sc[16], sn[16];
    ti_decode(F, set, it, cur); ti_load(cur, vc, sc, F.lane);
    for (;;) {
        const int itn = it + nw; const bool hn = itn < n;
        if (hn) { ti_decode(F, set, itn, nxt); ti_load(nxt, vn, sn, F.lane); }
        ti_store(cur, vc, sc, scr, F.lane);
        if (!hn) break;
        cur = nxt; it = itn;
#pragma unroll
        for (int i = 0; i < 16; ++i) { vc[i] = vn[i]; sc[i] = sn[i]; }
    }
}
__device__ __forceinline__ void rms_row(const float* xrow, const float* w, bf16* ob, float* of, int lane) {
    const f32x4* xr = (const f32x4*)xrow + lane; const f32x4* wr_ = (const f32x4*)w + lane;
    f32x4 v[8]; float s = 0.f;
#pragma unroll
    for (int j = 0; j < 8; ++j) { v[j] = xr[64 * j]; s += (v[j].x * v[j].x + v[j].y * v[j].y) + (v[j].z * v[j].z + v[j].w * v[j].w); }
    const float rstd = rsqrtf(wave_sum(s) * (1.f / D) + EPS);
#pragma unroll
    for (int j = 0; j < 8; ++j) { const f32x4 g = wr_[64 * j]; const f32x4 y = v[j] * rstd * g;
        if (ob) ((unsigned long long*)ob)[lane + 64 * j] = (unsigned long long)pk2(y.x, y.y) | ((unsigned long long)pk2(y.z, y.w) << 32);
        if (of) ((f32x4*)of)[lane + 64 * j] = y; }
}

__device__ __forceinline__ void p0_prologue(Frame& F) {
    const int gw = F.bid * NWAVES + F.wave, NGW = F.G * NWAVES;
    bf16* Win = WSP(bf16, WS_WIN);
    convert_set(F, 0, gw, NGW);
    { const size_t z0 = (size_t)7232 * D * 2, z1 = (size_t)NPROJ_PAD * D * 2; v4u* p = (v4u*)((unsigned char*)Win + z0); const size_t n16 = (z1 - z0) / 16;
      for (size_t i = (size_t)F.bid * 512 + F.tid; i < n16; i += (size_t)F.G * 512) p[i] = (v4u){0u, 0u, 0u, 0u}; }
    bf16* XN = WSP(bf16, WS_XN);
    for (int m = gw; m < M; m += NGW) rms_row(kin(0) + (size_t)m * D, kin(10), XN + (size_t)m * D, nullptr, F.lane);
    if (gw < MS) rms_row(kin(1) + (size_t)gw * D, kin(10), nullptr, SSP(S_A) + (size_t)gw * D, F.lane);
    { const f32x4* p = (const f32x4*)kin(8); v2u* o = (v2u*)WSP(bf16, WS_PB); const size_t n4 = (size_t)M * PLE / 4;
      for (size_t i = (size_t)F.bid * 512 + F.tid; i < n4; i += (size_t)F.G * 512) { const f32x4 v = p[i]; o[i] = (v2u){pk2(v.x, v.y), pk2(v.z, v.w)}; } }
}

template <class Epi>
__device__ __forceinline__ void sample_gemm(Frame& F, const float* A, int K, bool norm, const bf16* Wt, int ntiles, const Epi& E) {
    const int first = F.G - 1 - F.bid;
    if (first >= ntiles) return;
    LAS bf16* As = (LAS bf16*)(F.lds);
    LAS float* Red = (LAS float*)(F.lds + 98304);
    LAS float* Rs = (LAS float*)(F.lds + 98304 + 8192);
    const int lane = F.lane, r32 = lane & 31, hh = lane >> 5;
    __syncthreads();
    if (norm) { float s = 0.f; for (int k = lane; k < K; k += 64) { const float v = A[(size_t)F.wave * K + k]; s += v * v; } s = wave_sum(s); if (lane == 0) Rs[F.wave] = rsqrtf(s / (float)K + EPS); }
    else if (lane == 0) Rs[F.wave] = 1.f;
    __syncthreads();
    { const float rs = Rs[F.wave]; for (int k = 2 * lane; k < K; k += 128) { const f32x2 v = *(const f32x2*)(A + (size_t)F.wave * K + k); *(LAS unsigned*)(As + F.wave * K + k) = cvt2bf(v.x * rs, v.y * rs); } }
    __syncthreads();
    const int ksteps = K / 128;
    for (int tl = first; tl < ntiles; tl += F.G) {
        f32x16 acc;
#pragma unroll
        for (int i = 0; i < 16; ++i) acc[i] = 0.f;
        const bf16* wp = Wt + (size_t)(32 * tl + r32) * K + F.wave * (K / 8) + 8 * hh;
        const LAS bf16* ap = As + (r32 & 7) * K + F.wave * (K / 8) + 8 * hh;
#pragma unroll 4
        for (int ks = 0; ks < ksteps; ++ks) {
            const bf16x8 bfr = *(const bf16x8*)(wp + 16 * ks);
            bf16x8 af = *(const LAS bf16x8*)(ap + 16 * ks);
            if (r32 >= 8) af = (bf16x8){0, 0, 0, 0, 0, 0, 0, 0};
            acc = __builtin_amdgcn_mfma_f32_32x32x16_bf16(af, bfr, acc, 0, 0, 0);
        }
        __syncthreads();
#pragma unroll
        for (int i = 0; i < 4; ++i) Red[(F.wave * 8 + 4 * hh + i) * 32 + r32] = acc[i];
        __syncthreads();
        if (F.tid < 256) { const int r = F.tid >> 5, c = F.tid & 31; float s = 0.f;
#pragma unroll
            for (int w = 0; w < 8; ++w) s += Red[(w * 8 + r) * 32 + c];
            E(r, 32 * tl + c, s); }
    }
    __syncthreads();
}
struct SEpiStore { float* O; int ld; int nmax; __device__ __forceinline__ void operator()(int r, int n, float v) const { if (n < nmax) O[(size_t)r * ld + n] = v; } };
struct SEpiAdd { const float* B; float* O; int ld; __device__ __forceinline__ void operator()(int r, int n, float v) const { O[(size_t)r * ld + n] = B[(size_t)r * ld + n] + v; } };
struct SEpiGateUp { float* GP; float* UP; __device__ __forceinline__ void operator()(int r, int n, float v) const { const int j = n >> 8, w = n & 255; if (w < 128) GP[(size_t)r * DFF + 128 * j + w] = v; else UP[(size_t)r * DFF + 128 * j + (w - 128)] = v; } };

__device__ __forceinline__ void gdn_prep_prompt(Frame& F) {
    const int gw = F.bid * NWAVES + F.wave, NGW = F.G * NWAVES;
    const bf16* CIN = WSP(bf16, WS_CIN); const float* cw = kin(14);
    float* GQ = WSP(float, WS_GQ); float* GK = WSP(float, WS_GK); float* GV = WSP(float, WS_GV);
    for (int it = gw; it < M * NH; it += NGW) {
        const int row = it >> 3, h = it & 7, t = row & (T - 1);
#pragma unroll
        for (int seg = 0; seg < 3; ++seg) {
            const int ch = seg * GW + h * HD + 2 * F.lane;
            float a0 = 0.f, a1 = 0.f;
#pragma unroll
            for (int j = 0; j < 4; ++j) { const int tt = t - 3 + j; if (tt >= 0) { const unsigned w = *(const unsigned*)(CIN + (size_t)(row - 3 + j) * CONVCH + ch); a0 += bf_lo(w) * cw[j * CONVCH + ch]; a1 += bf_hi(w) * cw[j * CONVCH + ch + 1]; } }
            a0 = silu_f(a0); a1 = silu_f(a1);
            float* dst = (seg == 0 ? GQ : seg == 1 ? GK : GV) + (size_t)row * GW + h * HD + 2 * F.lane;
            if (seg < 2) { const float ss = wave_sum(a0 * a0 + a1 * a1); float sc = rsqrtf(ss + 1e-6f); if (seg == 0) sc *= SB_SCALE; a0 *= sc; a1 *= sc; }
            *(f32x2*)dst = (f32x2){a0, a1};
        }
    }
}
__device__ __forceinline__ void gdn_prep_sample(Frame& F) {
    if (F.bid != 0) return;
    const float* PR = SSP(S_PROJ); const float* hist = kin(5); const float* cw = kin(14);
    for (int i = F.tid; i < MS * SBW; i += 512) { const int b = i >> 10, c = i & 1023; F.out[OUT_KS + i] = PR[(size_t)b * IN_COLS + O_SB_K + c]; F.out[OUT_VS + i] = PR[(size_t)b * IN_COLS + O_SB_V + c]; }
    for (int i = F.tid; i < MS * 3 * CONVCH; i += 512) { const int b = i / (3 * CONVCH), rr = (i / CONVCH) % 3, c = i % CONVCH;
        F.out[OUT_GCONVS + i] = (rr < 2) ? hist[((size_t)b * 3 + rr + 1) * CONVCH + c] : PR[(size_t)b * IN_COLS + O_GQKV + c]; }
    if (F.tid < 64) { const int b = F.tid >> 3, h = F.tid & 7; SSP(S_G)[F.tid] = -__expf(kin(15)[h]) * softplus_f(PR[(size_t)b * IN_COLS + O_GA + h] + kin(16)[h]); SSP(S_BETA)[F.tid] = sigmoid_f(PR[(size_t)b * IN_COLS + O_GB + h]); }
    const int b = F.wave;
    for (int h = 0; h < NH; ++h)
#pragma unroll
        for (int seg = 0; seg < 3; ++seg) {
            const int ch = seg * GW + h * HD + 2 * F.lane; float a[2];
#pragma unroll
            for (int e = 0; e < 2; ++e) { float s = 0.f;
#pragma unroll
                for (int j = 0; j < 3; ++j) s += hist[((size_t)b * 3 + j) * CONVCH + ch + e] * cw[j * CONVCH + ch + e];
                s += PR[(size_t)b * IN_COLS + O_GQKV + ch + e] * cw[3 * CONVCH + ch + e]; a[e] = silu_f(s); }
            float* dst = SSP(seg == 0 ? S_GQ : seg == 1 ? S_GK : S_GV) + (size_t)b * GW + h * HD + 2 * F.lane;
            if (seg < 2) { const float ss = wave_sum(a[0] * a[0] + a[1] * a[1]); float sc = rsqrtf(ss + 1e-6f); if (seg == 0) sc *= SB_SCALE; a[0] *= sc; a[1] *= sc; }
            dst[0] = a[0]; dst[1] = a[1];
        }
}

template <bool PIPE>
__device__ __forceinline__ void gdn_recur_wave(const float* GQ, const float* GK, const float* GV, const float* Gg, const float* Gb, int ld, int gld, size_t row0, int ntok, int h, int slice,
                                               const float* S0, float* Sout, float* GO, int lane) {
    const int e = 4 * slice + (lane >> 4), d0 = 8 * (lane & 15);
    float S[8];
#pragma unroll
    for (int i = 0; i < 8; ++i) S[i] = S0 ? S0[(size_t)(d0 + i) * HD + e] : 0.f;
    constexpr int NT = PIPE ? 4 : 1;
    f32x4 ck0[NT], ck1[NT], cq0[NT], cq1[NT]; float cv[NT], cg[NT], cb[NT];
#define GDN_LOAD(dk0, dk1, dq0, dq1, dv, dg, db, tb) do { _Pragma("unroll") for (int i_ = 0; i_ < NT; ++i_) { const size_t row_ = row0 + (tb) + i_; \
        dk0[i_] = *(const f32x4*)(GK + row_ * ld + h * HD + d0); dk1[i_] = *(const f32x4*)(GK + row_ * ld + h * HD + d0 + 4); \
        dq0[i_] = *(const f32x4*)(GQ + row_ * ld + h * HD + d0); dq1[i_] = *(const f32x4*)(GQ + row_ * ld + h * HD + d0 + 4); \
        dv[i_] = GV[row_ * ld + h * HD + e]; dg[i_] = Gg[row_ * gld + h]; db[i_] = Gb[row_ * gld + h]; } } while (0)
    GDN_LOAD(ck0, ck1, cq0, cq1, cv, cg, cb, 0);
    for (int t = 0; t < ntok; t += NT) {
        f32x4 nk0[NT], nk1[NT], nq0[NT], nq1[NT]; float nv[NT], ng[NT], nb[NT];
        const int tn = (t + NT < ntok) ? t + NT : t;
        GDN_LOAD(nk0, nk1, nq0, nq1, nv, ng, nb, tn);
#pragma unroll
        for (int i = 0; i < NT; ++i) {
            const float kk[8] = {ck0[i].x, ck0[i].y, ck0[i].z, ck0[i].w, ck1[i].x, ck1[i].y, ck1[i].z, ck1[i].w}, qq[8] = {cq0[i].x, cq0[i].y, cq0[i].z, cq0[i].w, cq1[i].x, cq1[i].y, cq1[i].z, cq1[i].w};
            const float eg = __expf(cg[i]);
            float kv = 0.f;
#pragma unroll
            for (int j = 0; j < 8; ++j) kv += S[j] * kk[j];
            kv += __shfl_xor(kv, 1); kv += __shfl_xor(kv, 2); kv += __shfl_xor(kv, 4); kv += __shfl_xor(kv, 8);
            const float u = cb[i] * (cv[i] - eg * kv);
            float o = 0.f;
#pragma unroll
            for (int j = 0; j < 8; ++j) { S[j] = eg * S[j] + kk[j] * u; o += S[j] * qq[j]; }
            o += __shfl_xor(o, 1); o += __shfl_xor(o, 2); o += __shfl_xor(o, 4); o += __shfl_xor(o, 8);
            if ((lane & 15) == 0) GO[(row0 + t + i) * ld + h * HD + e] = o;
        }
#pragma unroll
        for (int i = 0; i < NT; ++i) { ck0[i] = nk0[i]; ck1[i] = nk1[i]; cq0[i] = nq0[i]; cq1[i] = nq1[i]; cv[i] = nv[i]; cg[i] = ng[i]; cb[i] = nb[i]; }
    }
#undef GDN_LOAD
#pragma unroll
    for (int i = 0; i < 8; ++i) Sout[(size_t)(d0 + i) * HD + e] = S[i];
}

__device__ __forceinline__ void sb_query_simple(Frame& F, int b, int h, int t, LAS float* qs) {
    const bf16* Qb = WSP(bf16, WS_Q); const bf16* Kb = WSP(bf16, WS_K); const bf16* Vb = WSP(bf16, WS_V); bf16* MIX = WSP(bf16, WS_MIX);
    const size_t row = (size_t)b * T + t; const int lane = F.lane;
    { const unsigned w = *(const unsigned*)(Qb + row * SBW + h * HD + 2 * lane); qs[2 * lane] = bf_lo(w); qs[2 * lane + 1] = bf_hi(w); }
    LDS_WAIT(); asm volatile("" ::: "memory");
    const float ch = kin(12)[h];
    float o0 = 0.f, o1 = 0.f, R = 0.f;
    const int nblk = (t + 63) >> 6;
    for (int blk = nblk - 1; blk >= 0; --blk) {
        const int k0 = blk * 64, key = k0 + lane; const bool valid = key < t;
        const v4u* kr = (const v4u*)(Kb + ((size_t)b * T + key) * SBW + h * HD);
        float dot = 0.f;
#pragma unroll
        for (int c = 0; c < 16; ++c) { const v4u w = kr[c]; const f32x4 qa = *(const LAS f32x4*)(qs + 8 * c), qb = *(const LAS f32x4*)(qs + 8 * c + 4);
            dot += bf_lo(w.x) * qa.x + bf_hi(w.x) * qa.y + bf_lo(w.y) * qa.z + bf_hi(w.y) * qa.w + bf_lo(w.z) * qb.x + bf_hi(w.z) * qb.y + bf_lo(w.w) * qb.z + bf_hi(w.w) * qb.w; }
        const float z = dot * SB_SCALE + ch;
        const float sp = softplus_f(z);
        const float L = valid ? -sp : 0.f, lb = z - sp;
        float s = L;
#pragma unroll
        for (int o = 1; o < 64; o <<= 1) { const float tmp = __shfl_down(s, o); if (lane + o < 64) s += tmp; }
        const float tot = __shfl(s, 0);
        const float a = valid ? __expf(lb + (s - L) + R) : 0.f;
        R += tot;
        const bf16* vr = Vb + ((size_t)b * T + k0) * SBW + h * HD + 2 * lane;
#pragma unroll 8
        for (int j = 0; j < 64; ++j) { const float aj = __shfl(a, j); const unsigned w = *(const unsigned*)(vr + (size_t)j * SBW); o0 += aj * bf_lo(w); o1 += aj * bf_hi(w); }
    }
    const float ss = wave_sum(o0 * o0 + o1 * o1); const float rs = rsqrtf(ss * (1.f / HD) + EPS);
    const float* nw = kin(13);
    *(unsigned*)(MIX + row * D + h * HD + 2 * lane) = pk2(o0 * rs * nw[2 * lane], o1 * rs * nw[2 * lane + 1]);
}

__device__ __forceinline__ void sb_decode_segment(Frame& F, int b, int h, int seg) {
    const float* q = SSP(S_PROJ) + (size_t)b * IN_COLS + h * HD;
    const float* CK = kin(2); const float* CV = kin(3); const int* PT = (const int*)kin(4);
    const int lane = F.lane, half = lane >> 5, l32 = lane & 31;
    const f32x4 q4 = *(const f32x4*)(q + 4 * l32);
    const float ch = kin(12)[h];
    f32x4 o4 = {0.f, 0.f, 0.f, 0.f}; float R = 0.f;
    for (int blk = 7; blk >= 0; --blk) {
        const int p0 = seg * 512 + blk * 64;
        const int page = PT[b * NPAGES + (p0 >> 7)];
        const size_t base = (((size_t)page * PAGE + (p0 & 127)) * NH + h) * HD;
        float z = 0.f;
#pragma unroll 16
        for (int i = 0; i < 32; ++i) {
            const f32x4 k4 = *(const f32x4*)(CK + base + (size_t)(2 * i + half) * (NH * HD) + 4 * l32);
            float p = (k4.x * q4.x + k4.y * q4.y) + (k4.z * q4.z + k4.w * q4.w);
            p += __shfl_xor(p, 1); p += __shfl_xor(p, 2); p += __shfl_xor(p, 4); p += __shfl_xor(p, 8); p += __shfl_xor(p, 16);
            const float pe = __shfl(p, 0), po = __shfl(p, 32);
            if (lane == 2 * i) z = pe; if (lane == 2 * i + 1) z = po;
        }
        z = z * SB_SCALE + ch;
        const float sp = softplus_f(z);
        const float L = -sp, lb = z - sp;
        float s = L;
#pragma unroll
        for (int o = 1; o < 64; o <<= 1) { const float tmp = __shfl_down(s, o); if (lane + o < 64) s += tmp; }
        const float tot = __shfl(s, 0);
        const float a = __expf(lb + (s - L) + R);
        R += tot;
#pragma unroll 16
        for (int i = 0; i < 32; ++i) { const float aj = __shfl(a, 2 * i + half); const f32x4 v = *(const f32x4*)(CV + base + (size_t)(2 * i + half) * (NH * HD) + 4 * l32); o4 += aj * v; }
    }
    o4.x += __shfl_xor(o4.x, 32); o4.y += __shfl_xor(o4.y, 32); o4.z += __shfl_xor(o4.z, 32); o4.w += __shfl_xor(o4.w, 32);
    float* P = SSP(S_PART) + ((size_t)(b * NH + h) * DSEG + seg) * DPART;
    if (half == 0) *(f32x4*)(P + 4 * l32) = o4; if (lane == 0) P[128] = R;
}

__device__ __forceinline__ unsigned offb(unsigned row, unsigned ch) { return 256u * row + 16u * (ch ^ (((row & 3u) << 2) | ((row >> 2) & 3u))); }
constexpr float LOG2E = 1.4426950408889634f;

__device__ __forceinline__ void sb_attn_unit(Frame& F, int b, int h, int qb) {
    const bf16* Qb = WSP(bf16, WS_Q); const bf16* Kb = WSP(bf16, WS_K); const bf16* Vb = WSP(bf16, WS_V); bf16* MIX = WSP(bf16, WS_MIX);
    const int lane = F.lane, r32 = lane & 31, hh = lane >> 5;
    const int q0w = 256 * qb + 32 * F.wave;
    LAS unsigned char* KB0 = F.lds + RING_OFF; LAS unsigned char* VB0 = F.lds + RING_OFF + 32768;
    bf16x8 qf[8];
    { const bf16* qp = Qb + ((size_t)b * T + q0w + r32) * SBW + h * HD + 8 * hh;
#pragma unroll
      for (int s = 0; s < 8; ++s) qf[s] = *(const bf16x8*)(qp + 16 * s); }
    const float k1 = SB_SCALE * LOG2E, k2 = kin(12)[h] * LOG2E;
    f32x16 oacc[4];
#pragma unroll
    for (int d = 0; d < 4; ++d)
#pragma unroll
        for (int i = 0; i < 16; ++i) oacc[d][i] = 0.f;
    float R = 1.f;
    const int nt = 4 * qb + 4;
    const int srow = F.tid >> 4, sch = F.tid & 15;
    const size_t gbase = ((size_t)b * T) * SBW + h * HD + sch * 8;
    v4u rk[2], rv[2];
#define SB_LOAD(k0_) do { _Pragma("unroll") for (int i_ = 0; i_ < 2; ++i_) { const size_t o_ = gbase + (size_t)((k0_) + srow + 32 * i_) * SBW; rk[i_] = *(const v4u*)(Kb + o_); rv[i_] = *(const v4u*)(Vb + o_); } } while (0)
    const unsigned kwo = (unsigned)((sch >> 1) * 1024 + srow * 32 + (((sch & 1) ^ ((srow >> 3) & 1)) * 16));
    const unsigned vwo = (unsigned)((((srow >> 3) * 4 + (sch >> 2)) * 512) + (srow & 7) * 64 + (sch & 3) * 16);
#define SB_WRITE(buf_) do { _Pragma("unroll") for (int i_ = 0; i_ < 2; ++i_) { *(LAS v4u*)(KB0 + (buf_) * 16384 + kwo + i_ * 8192) = rk[i_]; *(LAS v4u*)(VB0 + (buf_) * 16384 + vwo + i_ * 8192) = rv[i_]; } } while (0)
    SB_LOAD(64 * (nt - 1)); SB_WRITE(0);
    __syncthreads();
    const int tq = (lane & 15) >> 2, tp = lane & 3, tblk = (lane >> 4) & 1;
    const unsigned kro = (unsigned)(r32 * 32 + ((hh ^ ((r32 >> 3) & 1)) * 16));
    const unsigned vro = (unsigned)((4 * hh + tq) * 64 + tblk * 32 + tp * 8);
    for (int it = 0; it < nt; ++it) {
        const int kt = nt - 1 - it, buf = it & 1, k0 = 64 * kt;
        if (it + 1 < nt) SB_LOAD(64 * (kt - 1));
        if (k0 < q0w + 31) {
            const bool diag = (k0 + 63 >= q0w);
            LAS unsigned char* Kt = KB0 + buf * 16384; LAS unsigned char* Vt = VB0 + buf * 16384;
            f32x16 sacc[2];
#pragma unroll
            for (int kb = 0; kb < 2; ++kb) {
#pragma unroll
                for (int i = 0; i < 16; ++i) sacc[kb][i] = 0.f;
#pragma unroll
                for (int s = 0; s < 8; ++s) { const bf16x8 kf = *(const LAS bf16x8*)(Kt + kro + (kb * 8 + s) * 1024); sacc[kb] = __builtin_amdgcn_mfma_f32_32x32x16_bf16(kf, qf[s], sacc[kb], 0, 0, 0); }
            }
            float after = R;
            unsigned pp[2][8];
            const int qabs = q0w + r32;
#define SB_TILE(DIAG_) do { _Pragma("unroll") for (int kb = 1; kb >= 0; --kb) _Pragma("unroll") for (int g = 3; g >= 0; --g) { \
                    float be[4], m[4]; \
                    _Pragma("unroll") for (int j = 0; j < 4; ++j) { \
                        const float e = __builtin_amdgcn_exp2f(-(sacc[kb][4 * g + j] * k1 + k2)); \
                        be[j] = __builtin_amdgcn_rcpf(1.0f + e); m[j] = 1.0f - be[j]; \
                        if (DIAG_) { const bool vd = (k0 + 32 * kb + 8 * g + 4 * hh + j) < qabs; be[j] = vd ? be[j] : 0.f; m[j] = vd ? m[j] : 1.f; } } \
                    const float s3 = m[3], s2 = m[2] * s3, s1 = m[1] * s2, s0 = m[0] * s1; \
                    const float p4 = __shfl_xor(s0, 32); \
                    const float base = after * (hh == 0 ? p4 : 1.0f); \
                    const float a0 = be[0] * s1 * base, a1 = be[1] * s2 * base, a2 = be[2] * s3 * base, a3 = be[3] * base; \
                    after *= s0 * p4; \
                    pp[kb][2 * g] = cvt2bf(a0, a1); pp[kb][2 * g + 1] = cvt2bf(a2, a3); } } while (0)
            if (diag) SB_TILE(true); else SB_TILE(false);
#undef SB_TILE
            R = after;
#pragma unroll
            for (int kb = 0; kb < 2; ++kb)
#pragma unroll
                for (int sp = 0; sp < 2; ++sp) {
                    const v4u pw = {pp[kb][4 * sp], pp[kb][4 * sp + 1], pp[kb][4 * sp + 2], pp[kb][4 * sp + 3]};
                    const bf16x8 pf = __builtin_bit_cast(bf16x8, pw);
                    const int keybase = 32 * kb + 16 * sp;
#pragma unroll
                    for (int db = 0; db < 4; ++db) {
                        const s16x4 lo = __builtin_amdgcn_ds_read_tr16_b64_v4i16((LAS s16x4*)(Vt + vro + ((keybase >> 3) * 4 + db) * 512));
                        const s16x4 hi = __builtin_amdgcn_ds_read_tr16_b64_v4i16((LAS s16x4*)(Vt + vro + (((keybase >> 3) + 1) * 4 + db) * 512));
                        const bf16x8 vf = __builtin_shufflevector(lo, hi, 0, 1, 2, 3, 4, 5, 6, 7);
                        oacc[db] = __builtin_amdgcn_mfma_f32_32x32x16_bf16(vf, pf, oacc[db], 0, 0, 0);
                    }
                }
        }
        if (it + 1 < nt) SB_WRITE(buf ^ 1);
        __syncthreads();
    }
#undef SB_LOAD
#undef SB_WRITE
    float ss = 0.f;
#pragma unroll
    for (int d = 0; d < 4; ++d)
#pragma unroll
        for (int i = 0; i < 16; ++i) ss += oacc[d][i] * oacc[d][i];
    ss += __shfl_xor(ss, 32);
    const float rs = rsqrtf(ss * (1.f / HD) + EPS);
    const float* nw = kin(13);
    bf16* op = MIX + ((size_t)b * T + q0w + r32) * D + h * HD + 4 * hh;
#pragma unroll
    for (int d = 0; d < 4; ++d)
#pragma unroll
        for (int g = 0; g < 4; ++g) { const int dd = 32 * d + 8 * g + 4 * hh; const f32x4 w4 = *(const f32x4*)(nw + dd);
            v2u w; w.x = cvt2bf(oacc[d][4 * g] * rs * w4.x, oacc[d][4 * g + 1] * rs * w4.y); w.y = cvt2bf(oacc[d][4 * g + 2] * rs * w4.z, oacc[d][4 * g + 3] * rs * w4.w);
            *(v2u*)(op + 32 * d + 8 * g) = w; }
}

constexpr int GREC_WF = 0, GREC_KTF = 16384, GREC_UF = 32768, GREC_SCAN = 49152  , GREC_QF = 49152, GREC_QKF = 65536, GREC_BYTES = 73728;
constexpr int NCHUNK = T / 64;
constexpr int PL_LOW = 0  , PL_TK = 16384, PL_TQ = 32768, PL_TKBG = 49152, PL_TKT = 65536, PL_TVB = 81920, PL_TT = 98304  , PL_GC = 107520  , PL_BETA = 107776, PL_CW = 108032  ;
__device__ __forceinline__ unsigned rowimg(unsigned row, unsigned c16) { return ((row >> 5) * 8 + (c16 >> 1)) * 1024 + (row & 31) * 32 + (((c16 & 1) ^ ((row >> 3) & 1)) * 16); }
__device__ __forceinline__ unsigned trimg(unsigned row, unsigned c16) { return ((row >> 3) * 4 + (c16 >> 2)) * 512 + (row & 7) * 64 + (c16 & 3) * 16; }

__device__ __forceinline__ void gdn_prep_unit(Frame& F, int chain, int ci, unsigned char* rec, float* EGp) {
    int lane = F.lane, tid = F.tid; asm volatile("" : "+v"(lane), "+v"(tid));
    const int b = chain >> 3, h = chain & 7, r32 = lane & 31, hh = lane >> 5;
    const size_t R0 = (size_t)b * T + 64 * ci;
    unsigned lb0 = 0; asm volatile("" : "+v"(lb0));
    LAS unsigned char* L = F.lds + lb0;
    LAS float* GC = (LAS float*)(L + PL_GC); LAS float* BE = (LAS float*)(L + PL_BETA); LAS float* LOW = (LAS float*)(L + PL_LOW);
    const bf16* CIN = WSP(bf16, WS_CIN); const float* cw = kin(14);
    for (int i = tid - 64; i >= 0 && i < 4 * 3 * 128; i += 448) { const int j = i / 384, seg = (i / 128) % 3, c = i & 127; ((LAS float*)(L + PL_CW))[i] = cw[j * CONVCH + seg * GW + h * HD + c]; }
    if (F.wave == 0) { float g = WSP(float, WS_G)[(R0 + lane) * NH + h];
#pragma unroll
        for (int o = 1; o < 64; o <<= 1) { const float t = __shfl_up(g, o); if (lane >= o) g += t; }
        GC[lane] = g; BE[lane] = WSP(float, WS_BETA)[(R0 + lane) * NH + h]; }
    __syncthreads();
    {
        const int t = tid >> 3, sub = tid & 7; const int tseq = 64 * ci + t;
        const float gc = GC[t], gl = GC[63], be = BE[t];
        const float egc = __expf(gc), egl = __expf(gl - gc);
        float val[3][16];
        v4u cin[4][3][2]; float tmask[4];
#pragma unroll
        for (int j = 0; j < 4; ++j) { const bool ok = (tseq - 3 + j) >= 0; tmask[j] = ok ? 1.f : 0.f; const size_t rr = ok ? (R0 + t - 3 + j) : R0;
#pragma unroll
            for (int seg = 0; seg < 3; ++seg) { const bf16* p = CIN + rr * CONVCH + seg * GW + h * HD + 16 * sub; cin[j][seg][0] = *(const v4u*)p; cin[j][seg][1] = *(const v4u*)(p + 8); } }
#pragma unroll
        for (int seg = 0; seg < 3; ++seg) {
            float a[16];
#pragma unroll
            for (int e = 0; e < 16; ++e) a[e] = 0.f;
#pragma unroll
            for (int j = 0; j < 4; ++j) {
                const v4u w0 = cin[j][seg][0], w1 = cin[j][seg][1];
                const unsigned ww[8] = {w0.x, w0.y, w0.z, w0.w, w1.x, w1.y, w1.z, w1.w};
                const LAS f32x4* wl = (const LAS f32x4*)(L + PL_CW + ((j * 3 + seg) * 128 + 16 * sub) * 4);
                const f32x4 c0 = wl[0] * tmask[j], c1 = wl[1] * tmask[j], c2 = wl[2] * tmask[j], c3 = wl[3] * tmask[j];
                const float cwv[16] = {c0.x, c0.y, c0.z, c0.w, c1.x, c1.y, c1.z, c1.w, c2.x, c2.y, c2.z, c2.w, c3.x, c3.y, c3.z, c3.w};
#pragma unroll
                for (int e = 0; e < 8; ++e) { a[2 * e] += bf_lo(ww[e]) * cwv[2 * e]; a[2 * e + 1] += bf_hi(ww[e]) * cwv[2 * e + 1]; }
            }
            float ss = 0.f;
#pragma unroll
            for (int e = 0; e < 16; ++e) { a[e] = silu_f(a[e]); ss += a[e] * a[e]; }
            if (seg < 2) { ss += __shfl_xor(ss, 1); ss += __shfl_xor(ss, 2); ss += __shfl_xor(ss, 4); float sc = rsqrtf(ss + 1e-6f); if (seg == 0) sc *= SB_SCALE;
#pragma unroll
                for (int e = 0; e < 16; ++e) a[e] *= sc; }
#pragma unroll
            for (int e = 0; e < 16; ++e) val[seg][e] = a[e];
        }
#define PK8(dst, src, mul, o) do { dst.x = cvt2bf(src[o] * (mul), src[o + 1] * (mul)); dst.y = cvt2bf(src[o + 2] * (mul), src[o + 3] * (mul)); dst.z = cvt2bf(src[o + 4] * (mul), src[o + 5] * (mul)); dst.w = cvt2bf(src[o + 6] * (mul), src[o + 7] * (mul)); } while (0)
        v4u p0, p1;
        PK8(p0, val[1], 1.0f, 0); PK8(p1, val[1], 1.0f, 8); *(LAS v4u*)(L + PL_TK + rowimg(t, 2 * sub)) = p0; *(LAS v4u*)(L + PL_TK + rowimg(t, 2 * sub + 1)) = p1;
        PK8(p0, val[1], be * egc, 0); PK8(p1, val[1], be * egc, 8); *(LAS v4u*)(L + PL_TKBG + trimg(t, 2 * sub)) = p0; *(LAS v4u*)(L + PL_TKBG + trimg(t, 2 * sub + 1)) = p1;
        PK8(p0, val[1], egl, 0); PK8(p1, val[1], egl, 8); *(LAS v4u*)(L + PL_TKT + trimg(t, 2 * sub)) = p0; *(LAS v4u*)(L + PL_TKT + trimg(t, 2 * sub + 1)) = p1;
        PK8(p0, val[0], 1.0f, 0); PK8(p1, val[0], 1.0f, 8); *(LAS v4u*)(L + PL_TQ + rowimg(t, 2 * sub)) = p0; *(LAS v4u*)(L + PL_TQ + rowimg(t, 2 * sub + 1)) = p1;
        PK8(p0, val[2], be, 0); PK8(p1, val[2], be, 8); *(LAS v4u*)(L + PL_TVB + trimg(t, 2 * sub)) = p0; *(LAS v4u*)(L + PL_TVB + trimg(t, 2 * sub + 1)) = p1;
        { float qg[16];
#pragma unroll
          for (int e = 0; e < 16; ++e) qg[e] = val[0][e] * egc;
          unsigned char* qf = rec + GREC_QF + ((t >> 5) * 8 + sub) * 1024 + (t & 31) * 16;
          v4u f0, f1; f0.x = cvt2bf(qg[0], qg[1]); f0.y = cvt2bf(qg[2], qg[3]); f0.z = cvt2bf(qg[8], qg[9]); f0.w = cvt2bf(qg[10], qg[11]);
          f1.x = cvt2bf(qg[4], qg[5]); f1.y = cvt2bf(qg[6], qg[7]); f1.z = cvt2bf(qg[12], qg[13]); f1.w = cvt2bf(qg[14], qg[15]);
          *(v4u*)qf = f0; *(v4u*)(qf + 512) = f1; }
#undef PK8
        if (tid == 0) *EGp = __expf(gl);
    }
    __syncthreads();
    {
        const int which = F.wave >> 2, ta = (F.wave >> 1) & 1, tb = F.wave & 1;
        const unsigned aro = r32 * 32 + ((hh ^ ((r32 >> 3) & 1)) * 16);
        f32x16 acc;
#pragma unroll
        for (int i = 0; i < 16; ++i) acc[i] = 0.f;
        const bool zero_tile = (which == 0) ? (ta < tb) : (ta > tb);
        if (!zero_tile) {
#pragma unroll
            for (int ks = 0; ks < 8; ++ks) {
                const bf16x8 af = *(const LAS bf16x8*)(L + PL_TK + aro + (ta * 8 + ks) * 1024);
                const bf16x8 bfr = *(const LAS bf16x8*)(L + (which == 0 ? PL_TK : PL_TQ) + aro + (tb * 8 + ks) * 1024);
                acc = __builtin_amdgcn_mfma_f32_32x32x16_bf16(af, bfr, acc, 0, 0, 0);
            }
        }
        if (which == 0) {
            const int s = 32 * tb + r32; const float gs = GC[s];
#pragma unroll
            for (int g = 0; g < 4; ++g) { const int c0 = 32 * ta + 8 * g + 4 * hh; const f32x4 gc4 = *(const LAS f32x4*)(GC + c0), be4 = *(const LAS f32x4*)(BE + c0);
#pragma unroll
                for (int j = 0; j < 4; ++j) { const float e = __expf(fminf(gc4[j] - gs, 0.f)); const float v = be4[j] * acc[4 * g + j] * e; LOW[(c0 + j) * 64 + s] = (c0 + j > s) ? v : 0.f; } }
        } else {
            const int c = 32 * tb + r32; const float gcc = GC[c]; float v[16];
#pragma unroll
            for (int g = 0; g < 4; ++g) { const int s0 = 32 * ta + 8 * g + 4 * hh; const f32x4 gc4 = *(const LAS f32x4*)(GC + s0);
#pragma unroll
                for (int j = 0; j < 4; ++j) { const float e = __expf(fminf(gcc - gc4[j], 0.f)); const float x = acc[4 * g + j] * e; v[4 * g + j] = (c >= s0 + j) ? x : 0.f; } }
#pragma unroll
            for (int s = 0; s < 2; ++s) { v4u f; f.x = cvt2bf(v[8 * s], v[8 * s + 1]); f.y = cvt2bf(v[8 * s + 2], v[8 * s + 3]); f.z = cvt2bf(v[8 * s + 4], v[8 * s + 5]); f.w = cvt2bf(v[8 * s + 6], v[8 * s + 7]);
                *(v4u*)(rec + GREC_QKF + (tb * 4 + 2 * ta + s) * 1024 + lane * 16) = f; }
        }
    }
    __syncthreads();
    if (F.wave == 0) {
        float Tc[64];
#pragma unroll
        for (int c = 0; c < 64; ++c) {
            float a0 = 0.f, a1 = 0.f, a2 = 0.f, a3 = 0.f;
#pragma unroll
            for (int s4 = 0; s4 < (c + 3) / 4; ++s4) { const f32x4 l4 = *(const LAS f32x4*)(LOW + c * 64 + 4 * s4);
                a0 += l4.x * Tc[4 * s4]; if (4 * s4 + 1 < c) a1 += l4.y * Tc[4 * s4 + 1]; if (4 * s4 + 2 < c) a2 += l4.z * Tc[4 * s4 + 2]; if (4 * s4 + 3 < c) a3 += l4.w * Tc[4 * s4 + 3]; }
            Tc[c] = ((c == lane) ? 1.f : 0.f) - ((a0 + a1) + (a2 + a3));
        }
#pragma unroll
        for (int c = 0; c < 64; ++c) *(LAS bf16*)(L + PL_TT + c * 144 + lane * 2) = (bf16)f2bf(Tc[c]);
    }
    __syncthreads();
    {
        const int tq = (lane & 15) >> 2, tp = lane & 3, tblk = (lane >> 4) & 1;
        const unsigned trn = hh * 2048 + tq * 64 + tblk * 32 + tp * 8;
        const unsigned trm = (4 * hh + tq) * 64 + tblk * 32 + tp * 8;
        const unsigned tro = r32 * 144 + hh * 16;
        {
            const int ct = F.wave >> 2, et = F.wave & 3; f32x16 acc;
#pragma unroll
            for (int i = 0; i < 16; ++i) acc[i] = 0.f;
#pragma unroll
            for (int ks = 0; ks < 4; ++ks) {
                const bf16x8 af = *(const LAS bf16x8*)(L + PL_TT + tro + ct * 32 * 144 + ks * 32);
                const s16x4 lo = __builtin_amdgcn_ds_read_tr16_b64_v4i16((LAS s16x4*)(L + PL_TVB + trn + ks * 4096 + et * 512));
                const s16x4 hi = __builtin_amdgcn_ds_read_tr16_b64_v4i16((LAS s16x4*)(L + PL_TVB + trn + ks * 4096 + et * 512 + 256));
                acc = __builtin_amdgcn_mfma_f32_32x32x16_bf16(af, __builtin_shufflevector(lo, hi, 0, 1, 2, 3, 4, 5, 6, 7), acc, 0, 0, 0);
            }
            v4u f0, f1; f0.x = cvt2bf(acc[0], acc[1]); f0.y = cvt2bf(acc[2], acc[3]); f0.z = cvt2bf(acc[4], acc[5]); f0.w = cvt2bf(acc[6], acc[7]);
            f1.x = cvt2bf(acc[8], acc[9]); f1.y = cvt2bf(acc[10], acc[11]); f1.z = cvt2bf(acc[12], acc[13]); f1.w = cvt2bf(acc[14], acc[15]);
            unsigned char* up = rec + GREC_UF + (et * 2 + ct) * 2048 + lane * 32; *(v4u*)up = f0; *(v4u*)(up + 16) = f1;
        }
        {
            const int dt = F.wave >> 1, ct = F.wave & 1; f32x16 acc;
#pragma unroll
            for (int i = 0; i < 16; ++i) acc[i] = 0.f;
#pragma unroll
            for (int ks = 0; ks < 4; ++ks) {
                const s16x4 lo = __builtin_amdgcn_ds_read_tr16_b64_v4i16((LAS s16x4*)(L + PL_TKBG + trn + ks * 4096 + dt * 512));
                const s16x4 hi = __builtin_amdgcn_ds_read_tr16_b64_v4i16((LAS s16x4*)(L + PL_TKBG + trn + ks * 4096 + dt * 512 + 256));
                const bf16x8 bfr = *(const LAS bf16x8*)(L + PL_TT + tro + ct * 32 * 144 + ks * 32);
                acc = __builtin_amdgcn_mfma_f32_32x32x16_bf16(__builtin_shufflevector(lo, hi, 0, 1, 2, 3, 4, 5, 6, 7), bfr, acc, 0, 0, 0);
            }
#pragma unroll
            for (int s = 0; s < 2; ++s) { v4u f; f.x = cvt2bf(-acc[8 * s], -acc[8 * s + 1]); f.y = cvt2bf(-acc[8 * s + 2], -acc[8 * s + 3]); f.z = cvt2bf(-acc[8 * s + 4], -acc[8 * s + 5]); f.w = cvt2bf(-acc[8 * s + 6], -acc[8 * s + 7]);
                *(v4u*)(rec + GREC_WF + (ct * 8 + 2 * dt + s) * 1024 + lane * 16) = f; }
        }
        {
#pragma unroll
            for (int q = 0; q < 2; ++q) { const int f = 2 * F.wave + q, dt = f >> 2, ksp = f & 3;
                const s16x4 lo = __builtin_amdgcn_ds_read_tr16_b64_v4i16((LAS s16x4*)(L + PL_TKT + trm + (2 * ksp) * 2048 + dt * 512));
                const s16x4 hi = __builtin_amdgcn_ds_read_tr16_b64_v4i16((LAS s16x4*)(L + PL_TKT + trm + (2 * ksp + 1) * 2048 + dt * 512));
                const bf16x8 kf = __builtin_shufflevector(lo, hi, 0, 1, 2, 3, 4, 5, 6, 7);
                *(bf16x8*)(rec + GREC_KTF + (dt * 4 + ksp) * 1024 + lane * 16) = kf; }
        }
    }
    __syncthreads();
}

__device__ __forceinline__ void gdn_scan_chain(Frame& F, int chain) {
    const int lane = F.lane, r32 = lane & 31, hh = lane >> 5, et = F.wave;
    const unsigned char* recs = F.ws + WS_GREC + (size_t)chain * NCHUNK * GREC_BYTES;
    const float* EG = WSP(float, WS_GEG) + chain * NCHUNK;
    unsigned char* sfr = F.ws + WS_GSF + ((size_t)chain * NCHUNK * 4 + et) * 8192 + lane * 16;
    LAS unsigned char* L = F.lds;
    f32x16 S[4];
#pragma unroll
    for (int d = 0; d < 4; ++d)
#pragma unroll
        for (int i = 0; i < 16; ++i) S[d][i] = 0.f;
#define GS_DMA(ci_, slot_) do { const unsigned char* g_ = recs + (size_t)(ci_) * GREC_BYTES + lane * 16; \
        _Pragma("unroll") for (int p_ = 0; p_ < 6; ++p_) __builtin_amdgcn_global_load_lds((const unsigned*)(g_ + (F.wave + 8 * p_) * 1024), (LAS unsigned*)(L + (slot_) * GREC_SCAN + (F.wave + 8 * p_) * 1024), 16, 0, 0); } while (0)
    const float egv = EG[lane];
    asm volatile("s_waitcnt vmcnt(0)" ::: "memory");
    GS_DMA(0, 0); GS_DMA(1, 1);
    asm volatile("s_waitcnt vmcnt(6)" ::: "memory"); __builtin_amdgcn_s_barrier(); asm volatile("" ::: "memory");
    for (int ci = 0; ci < NCHUNK; ++ci) {
        const int slot = ci % 3;
        { const int cn = (ci + 2 < NCHUNK) ? ci + 2 : ci; GS_DMA(cn, (ci + 2) % 3); }
        if (F.wave < 4) {
            const LAS unsigned char* A = L + slot * GREC_SCAN + lane * 16;
            const float eg = __builtin_bit_cast(float, __builtin_amdgcn_readlane(__builtin_bit_cast(int, egv), ci));
            bf16x8 sf[8];
#pragma unroll
            for (int ks = 0; ks < 8; ++ks) { const int d = ks >> 1, s = ks & 1; v4u w; w.x = cvt2bf(S[d][8 * s], S[d][8 * s + 1]); w.y = cvt2bf(S[d][8 * s + 2], S[d][8 * s + 3]); w.z = cvt2bf(S[d][8 * s + 4], S[d][8 * s + 5]); w.w = cvt2bf(S[d][8 * s + 6], S[d][8 * s + 7]); sf[ks] = __builtin_bit_cast(bf16x8, w);
                *(v4u*)(sfr + (size_t)ci * 32768 + ks * 1024) = w; }
            f32x16 vn[2];
#pragma unroll
            for (int ct = 0; ct < 2; ++ct) {
                const LAS unsigned char* up = L + slot * GREC_SCAN + GREC_UF + (et * 2 + ct) * 2048 + lane * 32;
                const v4u u0 = *(const LAS v4u*)up, u1 = *(const LAS v4u*)(up + 16);
                const unsigned uw[8] = {u0.x, u0.y, u0.z, u0.w, u1.x, u1.y, u1.z, u1.w};
#pragma unroll
                for (int i = 0; i < 8; ++i) { vn[ct][2 * i] = bf_lo(uw[i]); vn[ct][2 * i + 1] = bf_hi(uw[i]); }
#pragma unroll
                for (int ks = 0; ks < 8; ++ks) vn[ct] = __builtin_amdgcn_mfma_f32_32x32x16_bf16(*(const LAS bf16x8*)(A + GREC_WF + (ct * 8 + ks) * 1024), sf[ks], vn[ct], 0, 0, 0);
            }
            bf16x8 vf[4];
#pragma unroll
            for (int ks = 0; ks < 4; ++ks) { const int ct = ks >> 1, s = ks & 1; v4u w; w.x = cvt2bf(vn[ct][8 * s], vn[ct][8 * s + 1]); w.y = cvt2bf(vn[ct][8 * s + 2], vn[ct][8 * s + 3]); w.z = cvt2bf(vn[ct][8 * s + 4], vn[ct][8 * s + 5]); w.w = cvt2bf(vn[ct][8 * s + 6], vn[ct][8 * s + 7]); vf[ks] = __builtin_bit_cast(bf16x8, w); }
#pragma unroll
            for (int d = 0; d < 4; ++d) {
#pragma unroll
                for (int i = 0; i < 16; ++i) S[d][i] *= eg;
#pragma unroll
                for (int ks = 0; ks < 4; ++ks) S[d] = __builtin_amdgcn_mfma_f32_32x32x16_bf16(*(const LAS bf16x8*)(A + GREC_KTF + (d * 4 + ks) * 1024), vf[ks], S[d], 0, 0, 0);
            }
            asm volatile("s_waitcnt vmcnt(14) lgkmcnt(0)" ::: "memory");
        } else {
            asm volatile("s_waitcnt vmcnt(6)" ::: "memory");
        }
        __builtin_amdgcn_s_barrier(); asm volatile("" ::: "memory");
    }
#undef GS_DMA
    asm volatile("s_waitcnt vmcnt(0)" ::: "memory"); __syncthreads();
    if (F.wave < 4) { float* so = F.out + OUT_GREC + (size_t)chain * HD * HD + 32 * et + r32;
#pragma unroll
        for (int d = 0; d < 4; ++d)
#pragma unroll
            for (int i = 0; i < 16; ++i) so[(size_t)(32 * d + (i & 3) + 8 * (i >> 2) + 4 * hh) * HD] = S[d][i]; }
}

__device__ __forceinline__ void gdn_out_unit(Frame& F, int chain, int ci) {
    int lane = F.lane, tid = F.tid; asm volatile("" : "+v"(lane), "+v"(tid));
    const int b = chain >> 3, h = chain & 7, r32 = lane & 31, hh = lane >> 5, et = F.wave & 3, ct = F.wave >> 2;
    const unsigned char* rec = F.ws + WS_GREC + ((size_t)chain * NCHUNK + ci) * GREC_BYTES + lane * 16;
    const unsigned char* sfp = F.ws + WS_GSF + (((size_t)chain * NCHUNK + ci) * 4 + et) * 8192 + lane * 16;
    LAS float* OT = (LAS float*)(F.lds);
    bf16x8 sf[8];
#pragma unroll
    for (int ks = 0; ks < 8; ++ks) sf[ks] = *(const bf16x8*)(sfp + ks * 1024);
    f32x16 vn[2], o;
#pragma unroll
    for (int c2 = 0; c2 < 2; ++c2) {
        const unsigned char* up = F.ws + WS_GREC + ((size_t)chain * NCHUNK + ci) * GREC_BYTES + GREC_UF + (et * 2 + c2) * 2048 + lane * 32;
        const v4u u0 = *(const v4u*)up, u1 = *(const v4u*)(up + 16);
        const unsigned uw[8] = {u0.x, u0.y, u0.z, u0.w, u1.x, u1.y, u1.z, u1.w};
#pragma unroll
        for (int i = 0; i < 8; ++i) { vn[c2][2 * i] = bf_lo(uw[i]); vn[c2][2 * i + 1] = bf_hi(uw[i]); }
#pragma unroll
        for (int ks = 0; ks < 8; ++ks) vn[c2] = __builtin_amdgcn_mfma_f32_32x32x16_bf16(*(const bf16x8*)(rec + GREC_WF + (c2 * 8 + ks) * 1024), sf[ks], vn[c2], 0, 0, 0);
    }
#pragma unroll
    for (int i = 0; i < 16; ++i) o[i] = 0.f;
#pragma unroll
    for (int ks = 0; ks < 8; ++ks) o = __builtin_amdgcn_mfma_f32_32x32x16_bf16(*(const bf16x8*)(rec + GREC_QF + (ct * 8 + ks) * 1024), sf[ks], o, 0, 0, 0);
#pragma unroll
    for (int ks = 0; ks < 4; ++ks) { const int c2 = ks >> 1, s = ks & 1; v4u w; w.x = cvt2bf(vn[c2][8 * s], vn[c2][8 * s + 1]); w.y = cvt2bf(vn[c2][8 * s + 2], vn[c2][8 * s + 3]); w.z = cvt2bf(vn[c2][8 * s + 4], vn[c2][8 * s + 5]); w.w = cvt2bf(vn[c2][8 * s + 6], vn[c2][8 * s + 7]);
        o = __builtin_amdgcn_mfma_f32_32x32x16_bf16(*(const bf16x8*)(rec + GREC_QKF + (ct * 4 + ks) * 1024), __builtin_bit_cast(bf16x8, w), o, 0, 0, 0); }
#pragma unroll
    for (int i = 0; i < 16; ++i) OT[(32 * ct + (i & 3) + 8 * (i >> 2) + 4 * hh) * 132 + 32 * et + r32] = o[i];
    __syncthreads();
    {
        const int c = tid >> 3, sub = tid & 7; const size_t row = (size_t)b * T + 64 * ci + c;
        const LAS f32x4* op = (const LAS f32x4*)(OT + c * 132 + 16 * sub);
        const f32x4 a0 = op[0], a1 = op[1], a2 = op[2], a3 = op[3];
        float x[16] = {a0.x, a0.y, a0.z, a0.w, a1.x, a1.y, a1.z, a1.w, a2.x, a2.y, a2.z, a2.w, a3.x, a3.y, a3.z, a3.w};
        float ss = 0.f;
#pragma unroll
        for (int e = 0; e < 16; ++e) ss += x[e] * x[e];
        ss += __shfl_xor(ss, 1); ss += __shfl_xor(ss, 2); ss += __shfl_xor(ss, 4);
        const float rs = rsqrtf(ss * (1.f / HD) + EPS);
        const bf16* zp = WSP(bf16, WS_Z) + row * GW + h * HD + 16 * sub; const v4u z0 = *(const v4u*)zp, z1 = *(const v4u*)(zp + 8);
        const unsigned zw[8] = {z0.x, z0.y, z0.z, z0.w, z1.x, z1.y, z1.z, z1.w};
        const float* gn = kin(17) + 16 * sub;
        unsigned ow[8];
#pragma unroll
        for (int e = 0; e < 8; ++e) ow[e] = cvt2bf(x[2 * e] * rs * gn[2 * e] * silu_f(bf_lo(zw[e])), x[2 * e + 1] * rs * gn[2 * e + 1] * silu_f(bf_hi(zw[e])));
        bf16* mp = WSP(bf16, WS_MIX) + row * D + SBW + h * HD + 16 * sub;
        *(v4u*)mp = (v4u){ow[0], ow[1], ow[2], ow[3]}; *(v4u*)(mp + 8) = (v4u){ow[4], ow[5], ow[6], ow[7]};
    }
    __syncthreads();
}

#ifndef REP_PHASE
#define REP_PHASE -1
#endif
#ifndef REP_N
#define REP_N 0
#endif
#ifndef REP_SCAN
#define REP_SCAN 0
#endif
#ifndef REP_ATTN
#define REP_ATTN 0
#endif

__device__ __forceinline__ void p2_mixers(Frame& F, unsigned* qctr) {
    _Pragma("unroll") for (int rs_ = 0; rs_ < 1 + REP_SCAN; ++rs_) if (F.bid < NB * NH) gdn_scan_chain(F, F.bid);
    __syncthreads();
    _Pragma("unroll") for (int ra_ = 0; ra_ < 1 + REP_ATTN; ++ra_)
    for (int u = F.bid; u < NB * NH * 16; u += F.G) { const int bh = u & 15, qb = u >> 4; sb_attn_unit(F, bh >> 3, bh & 7, qb); }
    const int gw = F.bid * NWAVES + F.wave, NGW = F.G * NWAVES;
    for (int it = gw; it < MS * NH * 32; it += NGW) {
        const int chain = it >> 5, slice = it & 31, b = chain >> 3, h = chain & 7;
        gdn_recur_wave<false>(SSP(S_GQ), SSP(S_GK), SSP(S_GV), SSP(S_G), SSP(S_BETA), GW, NH, (size_t)b, 1, h, slice,
                              kin(6) + (size_t)chain * HD * HD, F.out + OUT_GRECS + (size_t)chain * HD * HD, SSP(S_GO), F.lane);
    }
    for (;;) {
        const unsigned v = __hip_atomic_fetch_add(qctr, 1u, __ATOMIC_RELAXED, __HIP_MEMORY_SCOPE_AGENT);
        const int it = (int)(__builtin_amdgcn_readfirstlane(v) >> 6);
        if (it >= MS * NH * DSEG) break;
        const int bh = it / DSEG, seg = it % DSEG; sb_decode_segment(F, bh >> 3, bh & 7, seg);
    }
}

__device__ __forceinline__ void p2_finish(Frame& F) {
    const int gw = F.bid * NWAVES + F.wave, NGW = F.G * NWAVES;
    const float* gnw = kin(17);
    for (int u = F.bid; u < NB * NH * NCHUNK; u += F.G) gdn_out_unit(F, u & 15, u >> 4);
    if (F.bid == F.G - 1) {
        for (int bh = F.wave; bh < MS * NH; bh += NWAVES) {
            const int b = bh >> 3, h = bh & 7;
            { const f32x2 o = *(const f32x2*)(SSP(S_GO) + (size_t)b * GW + h * HD + 2 * F.lane);
              const float rs = rsqrtf(wave_sum(o.x * o.x + o.y * o.y) * (1.f / HD) + EPS);
              const float* z = SSP(S_PROJ) + (size_t)b * IN_COLS + O_GZ + h * HD + 2 * F.lane;
              float* mo = SSP(S_MIX) + (size_t)b * D + SBW + h * HD + 2 * F.lane;
              mo[0] = o.x * rs * gnw[2 * F.lane] * silu_f(z[0]); mo[1] = o.y * rs * gnw[2 * F.lane + 1] * silu_f(z[1]); }
            { float o0 = 0.f, o1 = 0.f, R = 0.f;
              for (int seg = DSEG - 1; seg >= 0; --seg) { const float* P = SSP(S_PART) + ((size_t)bh * DSEG + seg) * DPART; const float e = __expf(R); o0 += e * P[2 * F.lane]; o1 += e * P[2 * F.lane + 1]; R += P[128]; }
              const float rs = rsqrtf(wave_sum(o0 * o0 + o1 * o1) * (1.f / HD) + EPS); const float* nw = kin(13);
              float* mo = SSP(S_MIX) + (size_t)b * D + h * HD + 2 * F.lane; mo[0] = o0 * rs * nw[2 * F.lane]; mo[1] = o1 * rs * nw[2 * F.lane + 1]; }
        }
    }
}

__device__ __forceinline__ void p4b_fixup(Frame& F) {
    const float* TAIL = WSP(float, WS_TAIL); const float* FIXG = WSP(float, WS_FIXG); const float* FIXU = WSP(float, WS_FIXU); bf16* ACT = WSP(bf16, WS_ACT); const float* cw = kin(22);
    const int total = 32 * 2 * DFF;
    for (int i = F.bid * 512 + F.tid; i < total; i += F.G * 512) {
        const int pm = i / (2 * DFF), rr = (i / DFF) & 1, c = i % DFF;
        if ((pm & 15) == 0) continue;
        const float t0 = TAIL[((size_t)(pm - 1) * 2 + 0) * DFF + c], t1 = TAIL[((size_t)(pm - 1) * 2 + 1) * DFF + c];
        float g = FIXG[((size_t)pm * 2 + rr) * DFF + c];
        g += (rr == 0) ? (cw[c] * t0 + cw[DFF + c] * t1) : (cw[c] * t1);
        ACT[(size_t)(pm * 256 + rr) * DFF + c] = (bf16)f2bf(silu_f(g) * FIXU[((size_t)pm * 2 + rr) * DFF + c]);
    }
    const float* st = kin(7); const float* GP = SSP(S_GP); const float* UP = SSP(S_UP); float* SACT = SSP(S_ACT);
    for (int i = F.bid * 512 + F.tid; i < MS * DFF; i += F.G * 512) {
        const int b = i / DFF, c = i % DFF;
        const float s0 = st[((size_t)b * 2 + 0) * DFF + c], s1 = st[((size_t)b * 2 + 1) * DFF + c], gp = GP[i];
        const float g = cw[c] * s0 + cw[DFF + c] * s1 + cw[2 * DFF + c] * gp;
        SACT[i] = silu_f(g) * UP[i];
        F.out[OUT_FCONVS + ((size_t)b * 2 + 0) * DFF + c] = s1; F.out[OUT_FCONVS + ((size_t)b * 2 + 1) * DFF + c] = gp;
    }
}

__device__ __forceinline__ void p7_final(Frame& F) {
    const int gw = F.bid * NWAVES + F.wave, NGW = F.G * NWAVES;
    const float* fw = kin(27); const float* ss3 = (const float*)(F.ctl + CW_SUMSQ3);
    for (int m = gw; m < M; m += NGW) {
        const float rs = rsqrtf(ss3[m] * (1.f / D) + EPS);
        f32x4* y = (f32x4*)(F.out + OUT_Y + (size_t)m * D) + F.lane; const f32x4* w = (const f32x4*)fw + F.lane;
#pragma unroll
        for (int j = 0; j < 8; ++j) y[64 * j] = y[64 * j] * rs * w[64 * j];
    }
    if (F.bid == 0) {
        const int b = F.wave; float v[32]; float s = 0.f;
#pragma unroll
        for (int j = 0; j < 32; ++j) { const int c = F.lane + 64 * j; const float h = SSP(S_H2)[(size_t)b * D + c] + SSP(S_PP)[(size_t)b * D + c] * sigmoid_f(SSP(S_PG)[(size_t)b * D + c]); v[j] = h; s += h * h; }
        const float rs = rsqrtf(wave_sum(s) * (1.f / D) + EPS);
#pragma unroll
        for (int j = 0; j < 32; ++j) { const int c = F.lane + 64 * j; F.out[OUT_YS + (size_t)b * D + c] = v[j] * rs * fw[c]; }
    }
}

constexpr int NPHASES = 12;

constexpr int WS_DUMMY_WORDS = 3 * M;
constexpr int N_LAUNCHES = MK_N_LAUNCHES;
struct Args { const float* in[28]; float* out; unsigned char* ws; int ph_lo, ph_hi; };
__global__ void __launch_bounds__(NWAVES * 64, 2) hymba_fwd(Args args) {
    extern __shared__ __attribute__((aligned(16))) unsigned char lds[];
    Frame F;
    F.lds = (LAS unsigned char*)lds;
    F.MISC = (volatile LAS unsigned*)(F.lds + MISC_OFF);
    F.tid = threadIdx.x; F.lane = F.tid & 63; F.wave = __builtin_amdgcn_readfirstlane(F.tid >> 6);
    F.G = gridDim.x; F.bid = blockIdx.x;
    F.ws = args.ws; F.ctl = (unsigned*)(args.ws + WS_CTL); F.out = args.out;
    for (int u = F.tid; u < (LDS_BYTES - LDSCTL_OFF) / 4; u += NWAVES * 64) ((LAS unsigned*)(F.lds + LDSCTL_OFF))[u] = 0u;
    __syncthreads();
    XcdBarrier bar; bar.bar = F.ctl + CW_BAR; bar.x = 0; bar.st = nullptr;
    if (N_LAUNCHES == 1) bar = xcd_barrier_post(F.ctl + CW_BAR, F.MISC + 8);
#define GRID_BAR() do { if (N_LAUNCHES == 1) xcd_barrier(bar); } while (0)
    const int lo = args.ph_lo, hi = args.ph_hi;
#define IN(k) (lo <= (k) && (k) < hi)
#define NREP(k) ((k) == REP_PHASE ? 1 + REP_N : 1)
    float* ss1 = (float*)(F.ctl + CW_SUMSQ1); float* ss2 = (float*)(F.ctl + CW_SUMSQ2); float* ss3 = (float*)(F.ctl + CW_SUMSQ3); float* dummy = WSP(float, WS_DUMMY);

    if (IN(0)) { _Pragma("unroll") for (int rep = 0; rep < NREP(0); ++rep) p0_prologue(F); GRID_BAR(); }
    if (IN(1)) { _Pragma("unroll") for (int rep = 0; rep < NREP(1); ++rep) {
        { pg8::Gemm g{WSP(bf16, WS_XN), WSP(bf16, WS_WIN), M, NPROJ_PAD, D}; pg8::StaticOrder S; S.init(M, NPROJ_PAD, F.G, F.bid);
          pg8::EpiProj E{WSP(bf16, WS_Q), WSP(bf16, WS_K), WSP(bf16, WS_V), WSP(bf16, WS_CIN), WSP(bf16, WS_Z), F.out + OUT_K, F.out + OUT_V, F.out + OUT_GCONV, WSP(float, WS_G), WSP(float, WS_BETA), kin(15), kin(16)};
          pg8::gemm_phase<pg8::EpiProj, pg8::StaticOrder, true, true>(F.lds + RING_OFF, g, S, E); }
        { pg8::Gemm g{WSP(bf16, WS_PB), WSP(bf16, WS_WPP), M, D, PLE}; pg8::StaticOrder S; S.init(M, D, F.G, F.bid);
          pg8::EpiBf16 E{WSP(bf16, WS_PP), D};
          pg8::gemm_phase<pg8::EpiBf16, pg8::StaticOrder, true, true>(F.lds + RING_OFF, g, S, E); }
        { SEpiStore E{SSP(S_PROJ), IN_COLS, IN_COLS}; sample_gemm(F, SSP(S_A), D, false, WSP(bf16, WS_WIN), 225, E); }
        if (rep == 0) { constexpr int T0 = (29 * 32) % 256; convert_set(F, 1, (F.bid - T0) * NWAVES + F.wave, (F.G - T0) * NWAVES); }
        }
        GRID_BAR();
    }
    if (IN(2)) { _Pragma("unroll") for (int rep = 0; rep < NREP(2); ++rep) {
        for (int u = F.bid; u < NB * NH * NCHUNK; u += F.G) { const int chain = u & 15, ci = u >> 4;
            gdn_prep_unit(F, chain, ci, F.ws + WS_GREC + ((size_t)chain * NCHUNK + ci) * GREC_BYTES, WSP(float, WS_GEG) + chain * NCHUNK + ci); }
        gdn_prep_sample(F); }
        GRID_BAR(); }
    if (IN(3)) { _Pragma("unroll") for (int rep = 0; rep < NREP(3); ++rep) p2_mixers(F, F.ctl + CW_QUEUE + 64 * rep); GRID_BAR(); }
    if (IN(4)) { _Pragma("unroll") for (int rep = 0; rep < NREP(4); ++rep) p2_finish(F); GRID_BAR(); }
    if (IN(5)) { _Pragma("unroll") for (int rep = 0; rep < NREP(5); ++rep) {
        { pg8::Gemm g{WSP(bf16, WS_MIX), WSP(bf16, WS_WOUT), M, D, D}; pg8::StaticOrder S; S.init(M, D, F.G, F.bid);
          pg8::EpiResid<false> E{kin(0), WSP(bf16, WS_H1B), rep == 0 ? ss1 : dummy, D};
          pg8::gemm_phase<pg8::EpiResid<false>, pg8::StaticOrder, true, true>(F.lds + RING_OFF, g, S, E); }
        { SEpiAdd E{kin(1), SSP(S_H1), D}; sample_gemm(F, SSP(S_MIX), D, false, WSP(bf16, WS_WOUT), D / 32, E); }
        }
        GRID_BAR();
    }
    if (IN(6)) { _Pragma("unroll") for (int rep = 0; rep < NREP(6); ++rep) {
        { pg8::Gemm g{WSP(bf16, WS_H1B), WSP(bf16, WS_WGU), M, NGU, D}; pg8::StaticOrder S; S.init(M, NGU, F.G, F.bid);
          pg8::EpiGateUp E{ss1, kin(22), WSP(bf16, WS_ACT), WSP(float, WS_TAIL), WSP(float, WS_FIXG), WSP(float, WS_FIXU), F.out + OUT_FCONV, (PG8_LAS float*)(F.lds + HALO_OFF)};
          pg8::gemm_phase<pg8::EpiGateUp, pg8::StaticOrder, true, true>(F.lds + RING_OFF, g, S, E); }
        { SEpiGateUp E{SSP(S_GP), SSP(S_UP)}; sample_gemm(F, SSP(S_H1), D, true, WSP(bf16, WS_WGU), NGU / 32, E); }
        if (rep == 0) { constexpr int T1 = (43 * 32) % 256; convert_set(F, 2, (F.bid - T1) * NWAVES + F.wave, (F.G - T1) * NWAVES); }
        }
        GRID_BAR();
    }
    if (IN(7)) { _Pragma("unroll") for (int rep = 0; rep < NREP(7); ++rep) p4b_fixup(F); GRID_BAR(); }
    if (IN(8)) { _Pragma("unroll") for (int rep = 0; rep < NREP(8); ++rep) {
        { pg8::Gemm g{WSP(bf16, WS_ACT), WSP(bf16, WS_WDN), M, D, DFF}; pg8::StaticOrder S; S.init(M, D, F.G, F.bid);
          pg8::EpiResid<true> E{WSP(bf16, WS_H1B), WSP(bf16, WS_H2B), rep == 0 ? ss2 : dummy, D};
          pg8::gemm_phase<pg8::EpiResid<true>, pg8::StaticOrder, true, true>(F.lds + RING_OFF, g, S, E); }
        { SEpiAdd E{SSP(S_H1), SSP(S_H2), D}; sample_gemm(F, SSP(S_ACT), DFF, false, WSP(bf16, WS_WDN), D / 32, E); }
        }
        GRID_BAR();
    }
    if (IN(9)) { _Pragma("unroll") for (int rep = 0; rep < NREP(9); ++rep) {
        { pg8::Gemm g{WSP(bf16, WS_H2B), WSP(bf16, WS_WPG), M, D, D}; pg8::StaticOrder S; S.init(M, D, F.G, F.bid);
          pg8::EpiPle E{WSP(bf16, WS_H2B), WSP(bf16, WS_PP), ss2, F.out + OUT_Y, rep == 0 ? ss3 : dummy, D};
          pg8::gemm_phase<pg8::EpiPle, pg8::StaticOrder, true, true>(F.lds + RING_OFF, g, S, E); }
        { SEpiStore E{SSP(S_PG), D, D}; sample_gemm(F, SSP(S_H2), D, true, WSP(bf16, WS_WPG), D / 32, E); }
        { SEpiStore E{SSP(S_PP), D, D}; sample_gemm(F, kin(9), PLE, false, WSP(bf16, WS_WPP), D / 32, E); }
        }
        GRID_BAR();
    }
    if (IN(10)) { p7_final(F); }
#undef IN
#undef GRID_BAR
}

extern "C" void kernel_launch(void* const* d_in, const int* in_sizes, int n_in, void* d_out, int out_size, void* d_ws, size_t ws_size, hipStream_t stream) {
    static int grid = 0;
    if (grid == 0) {
        if (n_in != 28 || (size_t)out_size != OUT_END || ws_size < WS_END) { fprintf(stderr, "kernel_launch: unexpected sizes n_in %d out %d ws %zu (need %zu, %zu)\n", n_in, out_size, ws_size, (size_t)OUT_END, (size_t)WS_END); grid = -1; return; }
        int dev = 0, cus = 0, per_cu = 0;
        if (hipGetDevice(&dev) != hipSuccess || hipDeviceGetAttribute(&cus, hipDeviceAttributeMultiprocessorCount, dev) != hipSuccess) { grid = -1; return; }
        if (hipFuncSetAttribute((const void*)hymba_fwd, hipFuncAttributeMaxDynamicSharedMemorySize, LDS_BYTES) != hipSuccess) { fprintf(stderr, "kernel_launch: hipFuncSetAttribute failed\n"); grid = -1; return; }
        if (hipOccupancyMaxActiveBlocksPerMultiprocessor(&per_cu, (const void*)hymba_fwd, NWAVES * 64, LDS_BYTES) != hipSuccess || per_cu < 1) { fprintf(stderr, "kernel_launch: occupancy query says %d\n", per_cu); }
        (void)hipGetLastError();
        grid = cus;
    }
    if (grid < 0) return;
    (void)hipMemsetAsync((char*)d_ws + WS_CTL, 0, CTL_ZERO_BYTES, stream);
    Args a{};
    for (int i = 0; i < 28; ++i) a.in[i] = (const float*)d_in[i];
    a.out = (float*)d_out; a.ws = (unsigned char*)d_ws;
    if (N_LAUNCHES == 1) { a.ph_lo = 0; a.ph_hi = NPHASES; hipLaunchKernelGGL(hymba_fwd, dim3(grid), dim3(NWAVES * 64), LDS_BYTES, stream, a); }
    else for (int p = 0; p < 11; ++p) { a.ph_lo = p; a.ph_hi = p + 1; hipLaunchKernelGGL(hymba_fwd, dim3(grid), dim3(NWAVES * 64), LDS_BYTES, stream, a); }
}
```

```cpp
#include <hip/hip_runtime.h>
#include <cstdio>
#include <cstdint>

#ifndef MK_N_LAUNCHES
#define MK_N_LAUNCHES 1
#endif

namespace pg8 {
#define PG8_LAS __attribute__((address_space(3)))
typedef unsigned short bf16_t;
typedef short bf16x8 __attribute__((ext_vector_type(8)));
typedef float f32x4 __attribute__((ext_vector_type(4)));
typedef unsigned u32x4 __attribute__((ext_vector_type(4)));
constexpr int BM = 256, BK = 64, HALF = 128, HTB = HALF * BK * 2  , STAGE_BYTES = 8 * HTB, NXCD = 8, WGM = 8;

__host__ __device__ __forceinline__ int lds_byte(int r, int c) { const int st = (r >> 4) * 2 + (c >> 5), rr = r & 15, cc = c & 31, ob = rr * 64 + cc * 2; return st * 1024 + (ob ^ (((ob >> 9) & 1) << 5)); }
__host__ __device__ __forceinline__ void stage_rc(int b, int& R, int& C) { const int st = b / 1024, sb = b % 1024, swz = sb ^ (((sb >> 9) & 1) << 5); R = (st >> 1) * 16 + swz / 64; C = (st & 1) * 32 + (swz % 64) / 2; }
__host__ __device__ __forceinline__ int perm32(int rho) { const int n = rho >> 4, i = rho & 15; return 8 * (i >> 2) + 4 * n + (i & 3); }

struct Unit { int pm, pn; };
struct Gemm { const bf16_t* A; const bf16_t* Bt; int M, N, K; };

struct StaticOrder {
    int nM, nN, nwg, G, c;
    __host__ __device__ void init(int M, int N, int G_, int c_) { nM = M / BM; nN = N / BM; nwg = nM * nN; G = G_; c = c_; }
    __host__ __device__ bool next(int i, Unit& u) const {
        const long L = (long)i * G + c; if (L >= nwg) return false;
        int wgid = (int)L; { const int q = nwg / NXCD, r = nwg % NXCD, xcd = wgid % NXCD, off = wgid / NXCD; wgid = (xcd < r ? xcd * (q + 1) : r * (q + 1) + (xcd - r) * q) + off; }
        const int nig = WGM * nN, gid = wgid / nig, fm = gid * WGM, gsz = (nM - fm) < WGM ? (nM - fm) : WGM;
        u.pm = fm + ((wgid % nig) % gsz); u.pn = (wgid % nig) / gsz; return true;
    }
    __device__ __forceinline__ void a_ready(const Unit&) const {}
    __device__ __forceinline__ void done(const Unit&) const {}
};

__device__ __forceinline__ unsigned cvt_pk_bf16(float lo, float hi) { unsigned r; asm volatile("v_cvt_pk_bf16_f32 %0, %1, %2" : "=v"(r) : "v"(lo), "v"(hi)); return r; }
template <class Epi, class Sched, bool ALIGN_EPI = false, bool SP2 = false>
__device__ __forceinline__ void gemm_phase(PG8_LAS unsigned char* lds, const Gemm g, const Sched& S, const Epi& E) {
    int tid = threadIdx.x; asm volatile("" : "+v"(tid));
    const int wid = __builtin_amdgcn_readfirstlane(tid >> 6), lane = tid & 63, wr = wid >> 2, wc = wid & 3, fr = lane & 15, fq = lane >> 4;
    int K = g.K; asm volatile("" : "+s"(K));
    const int nt = K / BK;
    unsigned voffA[2], voffB[2];
#pragma unroll
    for (int i = 0; i < 2; ++i) { int R, C; stage_rc(tid * 16 + i * 8192, R, C); const int Rb = Epi::PERM ? ((R & ~31) + perm32(R & 31)) : R;
        voffA[i] = (unsigned)(R * K + C) * 2u; voffB[i] = (unsigned)(Rb * K + C) * 2u; }
    const size_t kstep = (size_t)(BK * 2);
    const size_t hstep = (size_t)HALF * K * 2;
    const size_t tstep = 2 * hstep;
    const unsigned ldsw = (unsigned)wid * 1024u;
    const int aoff = lds_byte(wr * 64 + fr, fq * 8), boff = lds_byte(wc * 32 + fr, fq * 8);
#define PG8_SA(b, h) (((b) * 2 + (h)) * HTB)
#define PG8_SB(b, h) ((4 + (b) * 2 + (h)) * HTB)
#define PG8_STAGE(bufoff, gbase, voff) do { _Pragma("unroll") for (int _i = 0; _i < 2; ++_i) \
        __builtin_amdgcn_global_load_lds((const unsigned*)((const char*)(gbase) + (voff)[_i]), (PG8_LAS unsigned*)(lds + (bufoff) + ldsw + _i * 8192), 16, 0, 0); } while (0)
#define PG8_LDA(dst, b, h) do { _Pragma("unroll") for (int m = 0; m < 4; ++m) _Pragma("unroll") for (int k = 0; k < 2; ++k) dst[m][k] = *(const PG8_LAS bf16x8*)(lds + PG8_SA(b, h) + aoff + m * 2048 + k * 1024); } while (0)
#define PG8_LDB(dst, b, h) do { _Pragma("unroll") for (int n = 0; n < 2; ++n) _Pragma("unroll") for (int k = 0; k < 2; ++k) dst[n][k] = *(const PG8_LAS bf16x8*)(lds + PG8_SB(b, h) + boff + n * 2048 + k * 1024); } while (0)
#define PG8_MMA(ai, bj, At, Bt) do { __builtin_amdgcn_s_setprio(1); _Pragma("unroll") for (int m = 0; m < 4; ++m) _Pragma("unroll") for (int n = 0; n < 2; ++n) _Pragma("unroll") for (int k = 0; k < 2; ++k) \
        acc[ai][bj][m][n] = __builtin_amdgcn_mfma_f32_16x16x32_bf16(Bt[n][k], At[m][k], acc[ai][bj][m][n], 0, 0, 0); __builtin_amdgcn_s_setprio(0); } while (0)
#define PG8_WAIT_V(n) asm volatile("s_waitcnt vmcnt(" #n ")" ::: "memory")
#define PG8_WAIT_L(n) asm volatile("s_waitcnt lgkmcnt(" #n ")" ::: "memory")
#define PG8_BAR __builtin_amdgcn_s_barrier()
#define PG8_SCHED __builtin_amdgcn_sched_barrier(0)
    Unit cur, nxt; int ui = 0;
    if (!S.next(0, cur)) return;
    f32x4 acc[2][2][4][2];
#pragma unroll
    for (int a = 0; a < 2; ++a)
#pragma unroll
        for (int b = 0; b < 2; ++b)
#pragma unroll
            for (int m = 0; m < 4; ++m)
#pragma unroll
                for (int n = 0; n < 2; ++n) acc[a][b][m][n] = (f32x4){0.f, 0.f, 0.f, 0.f};
    bf16x8 At[4][2], B0[2][2], B1[2][2];
    const char* cA = (const char*)g.A + (size_t)cur.pm * tstep; const char* cB = (const char*)g.Bt + (size_t)cur.pn * tstep;
    S.a_ready(cur);
    if constexpr (SP2) {
        PG8_STAGE(PG8_SB(0, 0), cB, voffB); PG8_STAGE(PG8_SB(0, 1), cB + hstep, voffB); PG8_STAGE(PG8_SA(0, 0), cA, voffA); PG8_STAGE(PG8_SA(0, 1), cA + hstep, voffA);
        if (wr == 1) PG8_BAR;
        PG8_WAIT_V(2); PG8_BAR;
        PG8_STAGE(PG8_SB(1, 0), cB + kstep, voffB); PG8_STAGE(PG8_SA(1, 0), cA + kstep, voffA); PG8_STAGE(PG8_SB(1, 1), cB + hstep + kstep, voffB);
        PG8_WAIT_V(6); PG8_BAR;
    } else {
        PG8_STAGE(PG8_SB(0, 0), cB, voffB); PG8_STAGE(PG8_SA(0, 0), cA, voffA); PG8_STAGE(PG8_SB(0, 1), cB + hstep, voffB); PG8_STAGE(PG8_SA(0, 1), cA + hstep, voffA);
        if (wr == 1) PG8_BAR;
        PG8_WAIT_V(4); PG8_BAR;
        PG8_STAGE(PG8_SB(1, 0), cB + kstep, voffB); PG8_STAGE(PG8_SA(1, 0), cA + kstep, voffA); PG8_STAGE(PG8_SB(1, 1), cB + hstep + kstep, voffB);
        PG8_WAIT_V(6); PG8_BAR;
    }
    for (;;) {
        const bool has_next = S.next(ui + 1, nxt);
        const char* nA = has_next ? (const char*)g.A + (size_t)nxt.pm * tstep : cA; const char* nB = has_next ? (const char*)g.Bt + (size_t)nxt.pn * tstep : cB;
        for (int t = 0; t < nt; t += 2) {
            const bool last = (t == nt - 2);
            const char* a1 = cA + (size_t)(t + 1) * kstep;
            const char* a2 = last ? nA : cA + (size_t)(t + 2) * kstep; const char* b2 = last ? nB : cB + (size_t)(t + 2) * kstep;
            const char* a3 = a2 + kstep; const char* b3 = b2 + kstep;
            if (last && has_next) S.a_ready(nxt);
            if constexpr (SP2) {
            PG8_LDB(B0, 0, 0); PG8_LDB(B1, 0, 1); PG8_SCHED; PG8_LDA(At, 0, 0); PG8_STAGE(PG8_SA(1, 1), a1 + hstep, voffA);
            PG8_WAIT_V(8); PG8_WAIT_L(0); PG8_BAR; PG8_MMA(0, 0, At, B0); PG8_MMA(0, 1, At, B1); PG8_BAR; PG8_SCHED;
            PG8_LDA(At, 0, 1); PG8_STAGE(PG8_SB(0, 0), b2, voffB); PG8_STAGE(PG8_SB(0, 1), b2 + hstep, voffB); PG8_STAGE(PG8_SA(0, 0), a2, voffA);
            PG8_WAIT_V(8); PG8_WAIT_L(0); PG8_BAR; PG8_MMA(1, 0, At, B0); PG8_MMA(1, 1, At, B1); PG8_BAR; PG8_SCHED;
            PG8_LDB(B0, 1, 0); PG8_LDB(B1, 1, 1); PG8_SCHED; PG8_LDA(At, 1, 0); PG8_STAGE(PG8_SA(0, 1), a2 + hstep, voffA);
            PG8_WAIT_V(8); PG8_WAIT_L(0); PG8_BAR; PG8_MMA(0, 0, At, B0); PG8_MMA(0, 1, At, B1); PG8_BAR; PG8_SCHED;
            PG8_LDA(At, 1, 1); PG8_STAGE(PG8_SB(1, 0), b3, voffB); PG8_STAGE(PG8_SB(1, 1), b3 + hstep, voffB); PG8_STAGE(PG8_SA(1, 0), a3, voffA);
            PG8_WAIT_V(8); PG8_WAIT_L(0); PG8_BAR; PG8_MMA(1, 0, At, B0); PG8_MMA(1, 1, At, B1); PG8_BAR; PG8_SCHED;
            } else {
            PG8_LDB(B0, 0, 0); PG8_SCHED; PG8_LDA(At, 0, 0); PG8_STAGE(PG8_SA(1, 1), a1 + hstep, voffA);
            PG8_WAIT_L(8); PG8_BAR; PG8_WAIT_L(0); PG8_MMA(0, 0, At, B0); PG8_BAR; PG8_SCHED;
            PG8_LDB(B1, 0, 1); PG8_STAGE(PG8_SB(0, 0), b2, voffB);
            PG8_BAR; PG8_WAIT_L(0); PG8_MMA(0, 1, At, B1); PG8_BAR;
            PG8_LDA(At, 0, 1); PG8_STAGE(PG8_SA(0, 0), a2, voffA);
            PG8_BAR; PG8_WAIT_L(0); PG8_MMA(1, 0, At, B0); PG8_BAR; PG8_SCHED;
            PG8_STAGE(PG8_SB(0, 1), b2 + hstep, voffB);
            PG8_WAIT_V(6); PG8_BAR; PG8_MMA(1, 1, At, B1); PG8_BAR;
            PG8_LDB(B0, 1, 0); PG8_SCHED; PG8_LDA(At, 1, 0); PG8_STAGE(PG8_SA(0, 1), a2 + hstep, voffA);
            PG8_WAIT_L(8); PG8_BAR; PG8_WAIT_L(0); PG8_MMA(0, 0, At, B0); PG8_BAR; PG8_SCHED;
            PG8_LDB(B1, 1, 1); PG8_STAGE(PG8_SB(1, 0), b3, voffB);
            PG8_BAR; PG8_WAIT_L(0); PG8_MMA(0, 1, At, B1); PG8_BAR;
            PG8_LDA(At, 1, 1); PG8_STAGE(PG8_SA(1, 0), a3, voffA);
            PG8_BAR; PG8_WAIT_L(0); PG8_MMA(1, 0, At, B0); PG8_BAR; PG8_SCHED;
            PG8_STAGE(PG8_SB(1, 1), b3 + hstep, voffB);
            PG8_WAIT_V(6); PG8_BAR; PG8_MMA(1, 1, At, B1); PG8_BAR;
            }
        }
        if constexpr (ALIGN_EPI) { if (wr == 0) PG8_BAR; }
        if constexpr (!Epi::AFTER_DRAIN) { int fr_e = fr, fq_e = fq; asm volatile("" : "+v"(fr_e), "+v"(fq_e));
            E(acc, cur, wr, wc, fr_e, fq_e); S.done(cur); }
        if (!has_next) break;
#pragma unroll
        for (int a = 0; a < 2; ++a)
#pragma unroll
            for (int b = 0; b < 2; ++b)
#pragma unroll
                for (int m = 0; m < 4; ++m)
#pragma unroll
                    for (int n = 0; n < 2; ++n) acc[a][b][m][n] = (f32x4){0.f, 0.f, 0.f, 0.f};
        cur = nxt; cA = nA; cB = nB; ++ui;
        if constexpr (ALIGN_EPI) { if (wr == 1) PG8_BAR; }
    }
    PG8_WAIT_V(0);
    if constexpr (!ALIGN_EPI) { if (wr == 0) PG8_BAR; }
    PG8_BAR;
    if constexpr (Epi::AFTER_DRAIN) { E.fused(acc, cur, wr, wc, fr, fq, lds, wid, lane); S.done(cur); }
#undef PG8_SA
#undef PG8_SB
#undef PG8_STAGE
#undef PG8_LDA
#undef PG8_LDB
#undef PG8_MMA
#undef PG8_WAIT_V
#undef PG8_WAIT_L
#undef PG8_BAR
#undef PG8_SCHED
}
}

constexpr int D = 2048, T = 4096, NB = 2, M = NB * T;
constexpr int MS = 8;
constexpr int HD = 128, NH = 8, SBW = NH * HD, GW = NH * HD;
constexpr int CONVCH = 3 * GW;
constexpr int IN_COLS = 7184, NPROJ_PAD = 7424;
constexpr int DFF = 5504, NGU = 2 * DFF;
constexpr int PLE = 256;
constexpr int PAST = 16384, PAGE = 128, NPAGES = PAST / PAGE, NPOOL = 1280;
constexpr float EPS = 1e-6f;
constexpr float SB_SCALE = 0.08838834764831845f;
constexpr int O_SB_K = 1024, O_SB_V = 2048, O_GQKV = 3072, O_GZ = 6144, O_GA = 7168, O_GB = 7176;

constexpr size_t OUT_Y = 0;
constexpr size_t OUT_YS = OUT_Y + (size_t)M * D;
constexpr size_t OUT_K = OUT_YS + (size_t)MS * D;
constexpr size_t OUT_V = OUT_K + (size_t)M * SBW;
constexpr size_t OUT_GCONV = OUT_V + (size_t)M * SBW;
constexpr size_t OUT_GREC = OUT_GCONV + (size_t)NB * 3 * CONVCH;
constexpr size_t OUT_FCONV = OUT_GREC + (size_t)NB * NH * HD * HD;
constexpr size_t OUT_KS = OUT_FCONV + (size_t)NB * 2 * DFF;
constexpr size_t OUT_VS = OUT_KS + (size_t)MS * SBW;
constexpr size_t OUT_GCONVS = OUT_VS + (size_t)MS * SBW;
constexpr size_t OUT_GRECS = OUT_GCONVS + (size_t)MS * 3 * CONVCH;
constexpr size_t OUT_FCONVS = OUT_GRECS + (size_t)MS * NH * HD * HD;
constexpr size_t OUT_END = OUT_FCONVS + (size_t)MS * 2 * DFF;

namespace pg8 {
__device__ __forceinline__ float silu_f(float x) { return x * __builtin_amdgcn_rcpf(1.0f + __expf(-x)); }
__device__ __forceinline__ float sigmoid_f(float x) { return __builtin_amdgcn_rcpf(1.0f + __expf(-x)); }
__device__ __forceinline__ float softplus_f(float x) { return fmaxf(x, 0.f) + log1pf(__expf(-fabsf(x))); }
typedef unsigned u32x2 __attribute__((ext_vector_type(2)));

struct EpiProj {
    static constexpr bool PERM = true, AFTER_DRAIN = false;
    bf16_t *Qb, *Kb, *Vb, *CIN, *Zb; float *outK, *outV, *outGconv; float *G, *BETA; const float *a_log, *dt_bias;
    __device__ __forceinline__ void operator()(const f32x4 (&acc)[2][2][4][2], const Unit& u, int wr, int wc, int fr, int fq) const {
        const int reg = u.pn >> 2;
#pragma unroll
        for (int ai = 0; ai < 2; ++ai)
#pragma unroll
            for (int m = 0; m < 4; ++m) {
                const int r = u.pm * BM + ai * HALF + wr * 64 + m * 16 + fr;
#pragma unroll
                for (int bj = 0; bj < 2; ++bj) {
                    const int c8 = u.pn * BM + bj * HALF + wc * 32 + 8 * fq;
                    const f32x4 v0 = acc[ai][bj][m][0], v1 = acc[ai][bj][m][1];
                    u32x4 w; w.x = cvt_pk_bf16(v0[0], v0[1]); w.y = cvt_pk_bf16(v0[2], v0[3]); w.z = cvt_pk_bf16(v1[0], v1[1]); w.w = cvt_pk_bf16(v1[2], v1[3]);
                    if (reg == 0) { *(u32x4*)(Qb + (size_t)r * SBW + c8) = w; }
                    else if (reg == 1) { const int c = c8 - O_SB_K; *(u32x4*)(Kb + (size_t)r * SBW + c) = w; float* o = outK + (size_t)r * SBW + c; *(f32x4*)o = v0; *(f32x4*)(o + 4) = v1; }
                    else if (reg == 2) { const int c = c8 - O_SB_V; *(u32x4*)(Vb + (size_t)r * SBW + c) = w; float* o = outV + (size_t)r * SBW + c; *(f32x4*)o = v0; *(f32x4*)(o + 4) = v1; }
                    else if (reg < 6) { const int c = c8 - O_GQKV; *(u32x4*)(CIN + (size_t)r * CONVCH + c) = w;
                        const int t = r & (T - 1); if (t >= T - 3) { float* o = outGconv + ((size_t)(r >> 12) * 3 + (t - (T - 3))) * CONVCH + c; *(f32x4*)o = v0; *(f32x4*)(o + 4) = v1; } }
                    else if (reg == 6) { const int c = c8 - O_GZ; *(u32x4*)(Zb + (size_t)r * GW + c) = w; }
                    else if (bj == 0 && wc == 0 && fq < 2 && u.pn == 28) {
                        float x[8] = {v0[0], v0[1], v0[2], v0[3], v1[0], v1[1], v1[2], v1[3]}; float y[8];
#pragma unroll
                        for (int h = 0; h < 8; ++h) y[h] = (fq == 0) ? -__expf(a_log[h]) * softplus_f(x[h] + dt_bias[h]) : sigmoid_f(x[h]);
                        float* o = (fq == 0 ? G : BETA) + (size_t)r * NH; *(f32x4*)o = (f32x4){y[0], y[1], y[2], y[3]}; *(f32x4*)(o + 4) = (f32x4){y[4], y[5], y[6], y[7]};
                    }
                }
            }
    }
};

struct EpiBf16 {
    static constexpr bool PERM = true, AFTER_DRAIN = false;
    bf16_t* O; int ldc;
    __device__ __forceinline__ void operator()(const f32x4 (&acc)[2][2][4][2], const Unit& u, int wr, int wc, int fr, int fq) const {
#pragma unroll
        for (int ai = 0; ai < 2; ++ai)
#pragma unroll
            for (int m = 0; m < 4; ++m) { const int r = u.pm * BM + ai * HALF + wr * 64 + m * 16 + fr;
#pragma unroll
                for (int bj = 0; bj < 2; ++bj) { const int c8 = u.pn * BM + bj * HALF + wc * 32 + 8 * fq; const f32x4 v0 = acc[ai][bj][m][0], v1 = acc[ai][bj][m][1];
                    u32x4 w; w.x = cvt_pk_bf16(v0[0], v0[1]); w.y = cvt_pk_bf16(v0[2], v0[3]); w.z = cvt_pk_bf16(v1[0], v1[1]); w.w = cvt_pk_bf16(v1[2], v1[3]);
                    *(u32x4*)(O + (size_t)r * ldc + c8) = w; } }
    }
};

__device__ __forceinline__ float bflo(unsigned w) { return __builtin_bit_cast(float, w << 16); }
__device__ __forceinline__ float bfhi(unsigned w) { return __builtin_bit_cast(float, w & 0xffff0000u); }
template <bool BF> struct EpiResid {
    static constexpr bool PERM = true, AFTER_DRAIN = false;
    const void* base; bf16_t* Hb; float* sumsq; int ldc;
    __device__ __forceinline__ void operator()(const f32x4 (&acc)[2][2][4][2], const Unit& u, int wr, int wc, int fr, int fq) const {
#pragma unroll
        for (int ai = 0; ai < 2; ++ai)
#pragma unroll
            for (int m = 0; m < 4; ++m) { const int r = u.pm * BM + ai * HALF + wr * 64 + m * 16 + fr; float ss = 0.f;
#pragma unroll
                for (int bj = 0; bj < 2; ++bj) { const int c8 = u.pn * BM + bj * HALF + wc * 32 + 8 * fq; const size_t off = (size_t)r * ldc + c8;
                    float b[8];
                    if (BF) { const u32x4 w = *(const u32x4*)((const bf16_t*)base + off); b[0] = bflo(w.x); b[1] = bfhi(w.x); b[2] = bflo(w.y); b[3] = bfhi(w.y); b[4] = bflo(w.z); b[5] = bfhi(w.z); b[6] = bflo(w.w); b[7] = bfhi(w.w); }
                    else { const f32x4 b0 = *(const f32x4*)((const float*)base + off), b1 = *(const f32x4*)((const float*)base + off + 4); b[0] = b0[0]; b[1] = b0[1]; b[2] = b0[2]; b[3] = b0[3]; b[4] = b1[0]; b[5] = b1[1]; b[6] = b1[2]; b[7] = b1[3]; }
                    float h[8];
#pragma unroll
                    for (int j = 0; j < 4; ++j) { h[j] = b[j] + acc[ai][bj][m][0][j]; h[4 + j] = b[4 + j] + acc[ai][bj][m][1][j]; }
#pragma unroll
                    for (int j = 0; j < 8; ++j) ss += h[j] * h[j];
                    u32x4 w; w.x = cvt_pk_bf16(h[0], h[1]); w.y = cvt_pk_bf16(h[2], h[3]); w.z = cvt_pk_bf16(h[4], h[5]); w.w = cvt_pk_bf16(h[6], h[7]);
                    *(u32x4*)(Hb + off) = w; }
                ss += __shfl_xor(ss, 16); ss += __shfl_xor(ss, 32);
                if (fq == 0) unsafeAtomicAdd(sumsq + r, ss); }
    }
};

struct EpiGateUp {
    static constexpr bool PERM = true, AFTER_DRAIN = false;
    const float* sumsq; const float* convw; bf16_t* ACT; float* TAIL; float* FIXG; float* FIXU; float* outFconv; PG8_LAS float* halo;
    __device__ __forceinline__ void operator()(const f32x4 (&acc)[2][2][4][2], const Unit& u, int wr, int wc, int fr, int fq) const {
        const int lane = fr + 16 * fq;
        const int cg = u.pn * HALF + wc * 32 + 8 * fq;
        float w0[8], w1[8], w2[8];
#pragma unroll
        for (int j = 0; j < 8; ++j) { w0[j] = convw[cg + j]; w1[j] = convw[DFF + cg + j]; w2[j] = convw[2 * DFF + cg + j]; }
        float gp[2][4][8], up[2][4][8];
#pragma unroll
        for (int ai = 0; ai < 2; ++ai)
#pragma unroll
            for (int m = 0; m < 4; ++m) { const int r = u.pm * BM + ai * HALF + wr * 64 + m * 16 + fr; const float rs = rsqrtf(sumsq[r] * (1.0f / D) + EPS);
#pragma unroll
                for (int n = 0; n < 2; ++n)
#pragma unroll
                    for (int j = 0; j < 4; ++j) { gp[ai][m][4 * n + j] = acc[ai][0][m][n][j] * rs; up[ai][m][4 * n + j] = acc[ai][1][m][n][j] * rs; } }
        if (fr >= 14) {
#pragma unroll
            for (int ai = 0; ai < 2; ++ai) { PG8_LAS float* hp = halo + ((wc * 4 + (2 * ai + wr)) * 2 + (fr - 14)) * 32 + 8 * fq;
                *(PG8_LAS f32x4*)hp = (f32x4){gp[ai][3][0], gp[ai][3][1], gp[ai][3][2], gp[ai][3][3]}; *(PG8_LAS f32x4*)(hp + 4) = (f32x4){gp[ai][3][4], gp[ai][3][5], gp[ai][3][6], gp[ai][3][7]}; }
        }
        asm volatile("s_waitcnt lgkmcnt(0)" ::: "memory"); __builtin_amdgcn_s_barrier(); asm volatile("" ::: "memory");
        const int src1 = (lane & 48) | ((fr - 1) & 15), src2 = (lane & 48) | ((fr - 2) & 15);
#pragma unroll
        for (int ai = 0; ai < 2; ++ai) {
            const int B = 2 * ai + wr;
            float h62[8], h63[8];
            if (B > 0) { const PG8_LAS float* hp = halo + ((wc * 4 + (B - 1)) * 2) * 32 + 8 * fq;
                const f32x4 a0 = *(const PG8_LAS f32x4*)hp, a1 = *(const PG8_LAS f32x4*)(hp + 4), b0 = *(const PG8_LAS f32x4*)(hp + 32), b1 = *(const PG8_LAS f32x4*)(hp + 36);
#pragma unroll
                for (int j = 0; j < 4; ++j) { h62[j] = a0[j]; h62[4 + j] = a1[j]; h63[j] = b0[j]; h63[4 + j] = b1[j]; } }
            else {
#pragma unroll
                for (int j = 0; j < 8; ++j) { h62[j] = 0.f; h63[j] = 0.f; } }
            float ps1[8], ps2[8];
#pragma unroll
            for (int j = 0; j < 8; ++j) { ps1[j] = h63[j]; ps2[j] = (fr == 0) ? h62[j] : h63[j]; }
#pragma unroll
            for (int m = 0; m < 4; ++m) {
                const int r = u.pm * BM + ai * HALF + wr * 64 + m * 16 + fr;
                float gate[8], a[8];
#pragma unroll
                for (int j = 0; j < 8; ++j) {
                    const float s1 = __shfl(gp[ai][m][j], src1), s2 = __shfl(gp[ai][m][j], src2);
                    const float p1 = (fr >= 1) ? s1 : ps1[j], p2 = (fr >= 2) ? s2 : ps2[j];
                    ps1[j] = s1; ps2[j] = s2;
                    gate[j] = w0[j] * p2 + w1[j] * p1 + w2[j] * gp[ai][m][j];
                    a[j] = silu_f(gate[j]) * up[ai][m][j];
                }
                u32x4 w; w.x = cvt_pk_bf16(a[0], a[1]); w.y = cvt_pk_bf16(a[2], a[3]); w.z = cvt_pk_bf16(a[4], a[5]); w.w = cvt_pk_bf16(a[6], a[7]);
                *(u32x4*)(ACT + (size_t)r * DFF + cg) = w;
                if (B == 0 && m == 0 && fr < 2 && (u.pm & 15) != 0) {
                    float* fg = FIXG + ((size_t)u.pm * 2 + fr) * DFF + cg; float* fu = FIXU + ((size_t)u.pm * 2 + fr) * DFF + cg;
                    *(f32x4*)fg = (f32x4){gate[0], gate[1], gate[2], gate[3]}; *(f32x4*)(fg + 4) = (f32x4){gate[4], gate[5], gate[6], gate[7]};
                    *(f32x4*)fu = (f32x4){up[ai][m][0], up[ai][m][1], up[ai][m][2], up[ai][m][3]}; *(f32x4*)(fu + 4) = (f32x4){up[ai][m][4], up[ai][m][5], up[ai][m][6], up[ai][m][7]};
                }
                if (B == 3 && m == 3 && fr >= 14) {
                    float* tp = TAIL + ((size_t)u.pm * 2 + (fr - 14)) * DFF + cg;
                    *(f32x4*)tp = (f32x4){gp[ai][m][0], gp[ai][m][1], gp[ai][m][2], gp[ai][m][3]}; *(f32x4*)(tp + 4) = (f32x4){gp[ai][m][4], gp[ai][m][5], gp[ai][m][6], gp[ai][m][7]};
                    if ((u.pm & 15) == 15) { float* op = outFconv + ((size_t)(u.pm >> 4) * 2 + (fr - 14)) * DFF + cg;
                        *(f32x4*)op = (f32x4){gp[ai][m][0], gp[ai][m][1], gp[ai][m][2], gp[ai][m][3]}; *(f32x4*)(op + 4) = (f32x4){gp[ai][m][4], gp[ai][m][5], gp[ai][m][6], gp[ai][m][7]}; }
                }
            }
        }
    }
};

struct EpiPle {
    static constexpr bool PERM = true, AFTER_DRAIN = false;
    const bf16_t* H2; const bf16_t* PP; const float* sumsq2; float* H3; float* sumsq3; int ldc;
    __device__ __forceinline__ void operator()(const f32x4 (&acc)[2][2][4][2], const Unit& u, int wr, int wc, int fr, int fq) const {
#pragma unroll
        for (int ai = 0; ai < 2; ++ai)
#pragma unroll
            for (int m = 0; m < 4; ++m) { const int r = u.pm * BM + ai * HALF + wr * 64 + m * 16 + fr; float ss = 0.f;
                const float rs = rsqrtf(sumsq2[r] * (1.0f / D) + EPS);
#pragma unroll
                for (int bj = 0; bj < 2; ++bj) { const int c8 = u.pn * BM + bj * HALF + wc * 32 + 8 * fq; const size_t off = (size_t)r * ldc + c8;
                    const u32x4 hw = *(const u32x4*)(H2 + off), pw = *(const u32x4*)(PP + off);
                    const float hb[8] = {bflo(hw.x), bfhi(hw.x), bflo(hw.y), bfhi(hw.y), bflo(hw.z), bfhi(hw.z), bflo(hw.w), bfhi(hw.w)};
                    const float pb[8] = {bflo(pw.x), bfhi(pw.x), bflo(pw.y), bfhi(pw.y), bflo(pw.z), bfhi(pw.z), bflo(pw.w), bfhi(pw.w)};
                    float h[8];
#pragma unroll
                    for (int j = 0; j < 4; ++j) { h[j] = hb[j] + pb[j] * sigmoid_f(acc[ai][bj][m][0][j] * rs); h[4 + j] = hb[4 + j] + pb[4 + j] * sigmoid_f(acc[ai][bj][m][1][j] * rs); }
#pragma unroll
                    for (int j = 0; j < 8; ++j) ss += h[j] * h[j];
                    *(f32x4*)(H3 + off) = (f32x4){h[0], h[1], h[2], h[3]}; *(f32x4*)(H3 + off + 4) = (f32x4){h[4], h[5], h[6], h[7]}; }
                ss += __shfl_xor(ss, 16); ss += __shfl_xor(ss, 32);
                if (fq == 0) unsafeAtomicAdd(sumsq3 + r, ss); }
    }
};
}

constexpr size_t MiB = 1u << 20;
constexpr size_t WS_CTL = 0, CTL_ZERO_BYTES = 1 * MiB;
constexpr int CW_QUEUE = 1024;
constexpr int CW_BAR = 4096;
constexpr int CW_SUMSQ1 = 32768, CW_SUMSQ2 = CW_SUMSQ1 + M, CW_SUMSQ3 = CW_SUMSQ2 + M;
static_assert((CW_SUMSQ3 + M) * 4 <= (int)CTL_ZERO_BYTES, "ctl");
constexpr size_t WS_WIN = 2 * MiB;
constexpr size_t WS_WOUT = WS_WIN + (size_t)NPROJ_PAD * D * 2;
constexpr size_t WS_WGU = WS_WOUT + (size_t)D * D * 2;
constexpr size_t WS_WDN = WS_WGU + (size_t)NGU * D * 2;
constexpr size_t WS_WPG = WS_WDN + (size_t)D * DFF * 2;
constexpr size_t WS_WPP = WS_WPG + (size_t)D * D * 2;
constexpr size_t WS_XN = WS_WPP + (size_t)D * PLE * 2;
constexpr size_t WS_PB = WS_XN + (size_t)M * D * 2;
constexpr size_t WS_Q = WS_PB + (size_t)M * PLE * 2;
constexpr size_t WS_K = WS_Q + (size_t)M * SBW * 2;
constexpr size_t WS_V = WS_K + (size_t)M * SBW * 2;
constexpr size_t WS_CIN = WS_V + (size_t)M * SBW * 2;
constexpr size_t WS_Z = WS_CIN + (size_t)M * CONVCH * 2;
constexpr size_t WS_G = WS_Z + (size_t)M * GW * 2;
constexpr size_t WS_BETA = WS_G + (size_t)M * NH * 4;
constexpr size_t WS_GQ = WS_BETA + (size_t)M * NH * 4;
constexpr size_t WS_GK = WS_GQ + (size_t)M * GW * 4;
constexpr size_t WS_GV = WS_GK + (size_t)M * GW * 4;
constexpr size_t WS_GO = WS_GV + (size_t)M * GW * 4;
constexpr size_t WS_GSF = WS_GO;
constexpr size_t WS_MIX = WS_GO + (size_t)M * GW * 4;
constexpr size_t WS_H1 = WS_MIX + (size_t)M * D * 2;
constexpr size_t WS_H1B = WS_H1 + (size_t)M * D * 4;
constexpr size_t WS_ACT = WS_H1B + (size_t)M * D * 2;
constexpr size_t WS_TAIL = WS_ACT + (size_t)M * DFF * 2;
constexpr size_t WS_FIXG = WS_TAIL + (size_t)32 * 2 * DFF * 4;
constexpr size_t WS_FIXU = WS_FIXG + (size_t)32 * 2 * DFF * 4;
constexpr size_t WS_H2 = WS_FIXU + (size_t)32 * 2 * DFF * 4;
constexpr size_t WS_H2B = WS_H2 + (size_t)M * D * 4;
constexpr size_t WS_PP = WS_H2B + (size_t)M * D * 2;
constexpr size_t WS_S = WS_PP + (size_t)M * D * 4;
constexpr size_t S_A = 0;
constexpr size_t S_PROJ = S_A + MS * D;
constexpr size_t S_GQ = S_PROJ + MS * IN_COLS;
constexpr size_t S_GK = S_GQ + MS * GW;
constexpr size_t S_GV = S_GK + MS * GW;
constexpr size_t S_G = S_GV + MS * GW;
constexpr size_t S_BETA = S_G + 64;
constexpr size_t S_GO = S_BETA + 64;
constexpr size_t S_PART = S_GO + MS * GW;
constexpr int DSEG = 256, DPART = 132;
constexpr size_t S_MIX = S_PART + (size_t)MS * NH * DSEG * DPART;
constexpr size_t S_H1 = S_MIX + MS * D;
constexpr size_t S_GP = S_H1 + MS * D;
constexpr size_t S_UP = S_GP + MS * DFF;
constexpr size_t S_ACT = S_UP + MS * DFF;
constexpr size_t S_H2 = S_ACT + MS * DFF;
constexpr size_t S_PG = S_H2 + MS * D;
constexpr size_t S_PP = S_PG + MS * D;
constexpr size_t S_END = S_PP + MS * D;
constexpr size_t WS_GREC = ((WS_S + S_END * 4 + 4095) / 4096) * 4096;
constexpr size_t WS_GEG = WS_GREC + (size_t)16 * 64 * 73728;
constexpr size_t WS_DUMMY = WS_GEG + 16 * 64 * 4;
constexpr size_t WS_END = WS_DUMMY + (size_t)M * 4;

constexpr int RING_OFF = 0, RING_BYTES = 131072;
constexpr int HALO_OFF = RING_BYTES;
constexpr int LDSCTL_OFF = 151552, MISC_OFF = LDSCTL_OFF + 320;
constexpr int LDS_BYTES = 155648;
constexpr int NWAVES = 8;

#define GAS __attribute__((address_space(1)))
#define LAS __attribute__((address_space(3)))
typedef unsigned short bf16;
typedef unsigned v4u __attribute__((ext_vector_type(4)));
typedef unsigned v2u __attribute__((ext_vector_type(2)));
typedef float f32x4 __attribute__((ext_vector_type(4)));
typedef float f32x2 __attribute__((ext_vector_type(2)));
typedef GAS unsigned gu32;
typedef short bf16x8 __attribute__((ext_vector_type(8)));
typedef short s16x4 __attribute__((ext_vector_type(4)));
typedef float f32x16 __attribute__((ext_vector_type(16)));
typedef __bf16 bf16x2_t __attribute__((ext_vector_type(2)));
__device__ __forceinline__ unsigned cvt2bf(float lo, float hi) { const f32x2 v = {lo, hi}; return __builtin_bit_cast(unsigned, __builtin_convertvector(v, bf16x2_t)); }
#define RLX_AGENT __ATOMIC_RELAXED, __HIP_MEMORY_SCOPE_AGENT
#define LDS_WAIT() asm volatile("s_waitcnt lgkmcnt(0)" ::: "memory")
#define VM_WAIT() asm volatile("s_waitcnt vmcnt(0)" ::: "memory")
__device__ __forceinline__ unsigned f2bf(float f) { unsigned u = __builtin_bit_cast(unsigned, f); return (u + 0x7fffu + ((u >> 16) & 1u)) >> 16; }
__device__ __forceinline__ unsigned pk2(float lo, float hi) { return f2bf(lo) | (f2bf(hi) << 16); }
__device__ __forceinline__ float bf_lo(unsigned w) { return __builtin_bit_cast(float, w << 16); }
__device__ __forceinline__ float bf_hi(unsigned w) { return __builtin_bit_cast(float, w & 0xffff0000u); }
__device__ __forceinline__ float bf2f(bf16 b) { return __builtin_bit_cast(float, (unsigned)b << 16); }
using pg8::silu_f; using pg8::sigmoid_f; using pg8::softplus_f;

#define XB_TMO      128
#define XB_XCNT(j)  (256  + 64 * (j))
#define XB_XSUB(j)  (1280 + 64 * (j))
#define XB_XGEN(j)  (2304 + 64 * (j))
#define XB_TOP      3328
#define XB_TOPGEN   3392
#define XCD_BAR_WORDS 3456
#define XB_SPIN_CAP (1u << 18)
__device__ __forceinline__ unsigned xb_ld(unsigned* p)              { return __hip_atomic_load(p, __ATOMIC_RELAXED, __HIP_MEMORY_SCOPE_AGENT); }
__device__ __forceinline__ unsigned xb_add(unsigned* p, unsigned v) { return __hip_atomic_fetch_add(p, v, __ATOMIC_RELAXED, __HIP_MEMORY_SCOPE_AGENT); }
__device__ __forceinline__ unsigned xb_xcc_id() { return (unsigned)__builtin_amdgcn_s_getreg((3 << 11) | 20) & 0xFu; }
#define XB_SPIN(cond, bar) do { unsigned _sp = 0; while (cond) { __builtin_amdgcn_s_sleep(1); \
    if ((++_sp & 255u) == 0u) { if (xb_ld(&(bar)[XB_TMO])) break; if (_sp > XB_SPIN_CAP) { atomicAdd(&(bar)[XB_TMO], 1u); break; } } } } while (0)
struct XcdBarrier { unsigned* bar; unsigned x; volatile LAS unsigned* st; };
__device__ __forceinline__ XcdBarrier xcd_barrier_post(unsigned* bar, volatile LAS unsigned* st) {
    XcdBarrier b; b.bar = bar; b.x = xb_xcc_id(); b.st = st;
    if (threadIdx.x == 0) (void)xb_add(&bar[XB_XCNT(b.x)], 1u);
    return b;
}
__device__ __forceinline__ void xcd_barrier_complete(unsigned* bar, unsigned x, unsigned& nloc, unsigned& nx) {
    const unsigned G = gridDim.x * gridDim.y * gridDim.z;
    unsigned sum, cnt, mine, sp = 0u;
    for (;;) {
        sum = 0u; cnt = 0u; mine = 0u;
#pragma unroll
        for (unsigned j = 0; j < 16; ++j) { const unsigned c = xb_ld(&bar[XB_XCNT(j)]); sum += c; cnt += (c > 0u) ? 1u : 0u; mine = (j == x) ? c : mine; }
        if (sum == G) break;
        __builtin_amdgcn_s_sleep(1);
        if ((++sp & 255u) == 0u) { if (xb_ld(&bar[XB_TMO])) break; if (sp > XB_SPIN_CAP) { atomicAdd(&bar[XB_TMO], 1u); break; } }
    }
    nloc = mine > 0u ? mine : 1u; nx = cnt > 0u ? cnt : 1u;
}
__device__ __forceinline__ void xcd_barrier(const XcdBarrier& b) {
    asm volatile("s_waitcnt vmcnt(0)" ::: "memory");
    __syncthreads();
    if (threadIdx.x == 0) {
        unsigned* bar = b.bar;
        __builtin_amdgcn_s_waitcnt(0);
        unsigned nloc = b.st[0], nx = b.st[1];
        if (nloc == 0u) { xcd_barrier_complete(bar, b.x, nloc, nx); b.st[0] = nloc; b.st[1] = nx; }
        const unsigned old = xb_add(&bar[XB_XSUB(b.x)], 1u);
        const unsigned gen = old / nloc;
        if (old + 1u == (gen + 1u) * nloc) {
            __builtin_amdgcn_fence(__ATOMIC_RELEASE, "agent");
            asm volatile("s_waitcnt vmcnt(0)" ::: "memory");
            const unsigned og = xb_add(&bar[XB_TOP], 1u);
            const unsigned tg = og / nx;
            if (og + 1u == (tg + 1u) * nx) xb_add(&bar[XB_TOPGEN], 1u);
            else XB_SPIN(xb_ld(&bar[XB_TOPGEN]) == tg, bar);
            __builtin_amdgcn_fence(__ATOMIC_ACQUIRE, "agent");
            xb_add(&bar[XB_XGEN(b.x)], 1u);
            asm volatile("s_waitcnt vmcnt(0)" ::: "memory");
        } else {
            XB_SPIN(xb_ld(&bar[XB_XGEN(b.x)]) == gen, bar);
            __builtin_amdgcn_fence(__ATOMIC_ACQUIRE, "agent");
            asm volatile("s_waitcnt vmcnt(0)" ::: "memory");
        }
    }
    __syncthreads();
}

struct Frame {
    LAS unsigned char* lds;
    volatile LAS unsigned* MISC;
    unsigned* ctl;
    int tid, lane, wave, G, bid;
    float* out;
    unsigned char* ws;
};
__device__ __forceinline__ const float* kin(int i) {
    const unsigned char __attribute__((address_space(4)))* ka = (const unsigned char __attribute__((address_space(4)))*)__builtin_amdgcn_kernarg_segment_ptr();
    unsigned off = (unsigned)i * 8u; asm volatile("" : "+s"(off));
    return *(const float* const __attribute__((address_space(4)))*)(ka + off);
}
#define WSP(T_, off) ((T_*)(F.ws + (off)))
#define SSP(off) ((float*)(F.ws + WS_S) + (off))

__device__ __forceinline__ float wave_sum(float v) {
#pragma unroll
    for (int o = 1; o < 64; o <<= 1) v += __shfl_xor(v, o);
    return v;
}

struct TItem { const float* W; const float* ks; bf16* WT; int ldw, nvalid, K, drow, k0, n0; };
constexpr int TI_NB_IN = 113;
constexpr int TI_IN = (D / 64) * TI_NB_IN, TI_OUT = (D / 64) * (D / 64), TI_G = (D / 64) * (DFF / 64), TI_D = (DFF / 64) * (D / 64), TI_PG = TI_OUT, TI_PP = (PLE / 64) * (D / 64);
__device__ __forceinline__ int ti_count(int set) { return set == 0 ? TI_IN + TI_PP + TI_OUT : set == 1 ? 2 * TI_G : TI_D + TI_PG; }
__device__ __forceinline__ void ti_decode(Frame& F, int set, int r, TItem& t) {
    t.ks = nullptr;
    if (set == 0) {
        if (r < TI_IN) { const int kb = r / TI_NB_IN, nb = r % TI_NB_IN; t.W = kin(11); t.ldw = IN_COLS; t.nvalid = IN_COLS; t.K = D; t.WT = WSP(bf16, WS_WIN); t.drow = 64 * nb; t.k0 = 64 * kb; t.n0 = 64 * nb; return; } r -= TI_IN;
        if (r < TI_PP) { const int kb = r / (D / 64), nb = r % (D / 64); t.W = kin(26); t.ldw = D; t.nvalid = D; t.K = PLE; t.WT = WSP(bf16, WS_WPP); t.drow = 64 * nb; t.k0 = 64 * kb; t.n0 = 64 * nb; return; } r -= TI_PP;
        { const int kb = r / (D / 64), nb = r % (D / 64); t.W = kin(18); t.ldw = D; t.nvalid = D; t.K = D; t.WT = WSP(bf16, WS_WOUT); t.drow = 64 * nb; t.k0 = 64 * kb; t.n0 = 64 * nb; return; }
    } else if (set == 1) {
        const int up = r >= TI_G; if (up) r -= TI_G;
        const int kb = r / (DFF / 64), nb = r % (DFF / 64), n0 = 64 * nb;
        t.W = up ? kin(21) : kin(20); t.ks = kin(19); t.ldw = DFF; t.nvalid = DFF; t.K = D; t.WT = WSP(bf16, WS_WGU); t.drow = 256 * (n0 >> 7) + 128 * up + (n0 & 127); t.k0 = 64 * kb; t.n0 = n0; return;
    } else {
        if (r < TI_D) { const int kb = r / (D / 64), nb = r % (D / 64); t.W = kin(23); t.ldw = D; t.nvalid = D; t.K = DFF; t.WT = WSP(bf16, WS_WDN); t.drow = 64 * nb; t.k0 = 64 * kb; t.n0 = 64 * nb; return; } r -= TI_D;
        { const int kb = r / (D / 64), nb = r % (D / 64); t.W = kin(25); t.ks = kin(24); t.ldw = D; t.nvalid = D; t.K = D; t.WT = WSP(bf16, WS_WPG); t.drow = 64 * nb; t.k0 = 64 * kb; t.n0 = 64 * nb; return; }
    }
}
__device__ __forceinline__ void ti_load(const TItem& t, f32x4 (&v)[16], float (&sc)[16], int lane) {
    const int n4 = (lane & 15) * 4, kq = lane >> 4; const bool nv = (t.n0 + n4) < t.nvalid;
#pragma unroll
    for (int i = 0; i < 16; ++i) { const int kk = 4 * i + kq;
        v[i] = nv ? *(const f32x4*)(t.W + (size_t)(t.k0 + kk) * t.ldw + t.n0 + n4) : (f32x4){0.f, 0.f, 0.f, 0.f};
        sc[i] = t.ks ? t.ks[t.k0 + kk] : 1.f; }
}
__device__ __forceinline__ void ti_store(const TItem& t, const f32x4 (&v)[16], const float (&sc)[16], LAS float* scr, int lane) {
    const int n4 = (lane & 15) * 4, kq = lane >> 4;
#pragma unroll
    for (int i = 0; i < 16; ++i) { const int kk = 4 * i + kq; const f32x4 x = v[i] * sc[i]; LAS float* d = scr + kk * 65 + n4; d[0] = x.x; d[1] = x.y; d[2] = x.z; d[3] = x.w; }
    LDS_WAIT(); asm volatile("" ::: "memory");
    const int c = lane & 7;
#pragma unroll
    for (int j = 0; j < 8; ++j) { const int n = (lane >> 3) + 8 * j; const LAS float* s = scr + (8 * c) * 65 + n;
        v4u o; o.x = pk2(s[0 * 65], s[1 * 65]); o.y = pk2(s[2 * 65], s[3 * 65]); o.z = pk2(s[4 * 65], s[5 * 65]); o.w = pk2(s[6 * 65], s[7 * 65]);
        *(v4u*)(t.WT + (size_t)(t.drow + n) * t.K + t.k0 + 8 * c) = o; }
    LDS_WAIT(); asm volatile("" ::: "memory");
}
__device__ __forceinline__ void convert_set(Frame& F, int set, int wv, int nw) {
    if (wv < 0 || wv >= nw) return;
    LAS float* scr = (LAS float*)(F.lds + RING_OFF + F.wave * 16640);
    const int n = ti_count(set);
    int it = wv; if (it >= n) return;
    TItem cur, nxt; f32x4 vc[16], vn[16]; float sc[16], sn[16];
    ti_decode(F, set, it, cur); ti_load(cur, vc, sc, F.lane);
    for (;;) {
        const int itn = it + nw; const bool hn = itn < n;
        if (hn) { ti_decode(F, set, itn, nxt); ti_load(nxt, vn, sn, F.lane); }
        ti_store(cur, vc, sc, scr, F.lane);
        if (!hn) break;
        cur = nxt; it = itn;
#pragma unroll
        for (int i = 0; i < 16; ++i) { vc[i] = vn[i]; sc[i] = sn[i]; }
    }
}
__device__ __forceinline__ void rms_row(const float* xrow, const float* w, bf16* ob, float* of, int lane) {
    const f32x4* xr = (const f32x4*)xrow + lane; const f32x4* wr_ = (const f32x4*)w + lane;
    f32x4 v[8]; float s = 0.f;
#pragma unroll
    for (int j = 0; j < 8; ++j) { v[j] = xr[64 * j]; s += (v[j].x * v[j].x + v[j].y * v[j].y) + (v[j].z * v[j].z + v[j].w * v[j].w); }
    const float rstd = rsqrtf(wave_sum(s) * (1.f / D) + EPS);
#pragma unroll
    for (int j = 0; j < 8; ++j) { const f32x4 g = wr_[64 * j]; const f32x4 y = v[j] * rstd * g;
        if (ob) ((unsigned long long*)ob)[lane + 64 * j] = (unsigned long long)pk2(y.x, y.y) | ((unsigned long long)pk2(y.z, y.w) << 32);
        if (of) ((f32x4*)of)[lane + 64 * j] = y; }
}

__device__ __forceinline__ void p0_prologue(Frame& F) {
    const int gw = F.bid * NWAVES + F.wave, NGW = F.G * NWAVES;
    bf16* Win = WSP(bf16, WS_WIN);
    convert_set(F, 0, gw, NGW);
    { const size_t z0 = (size_t)7232 * D * 2, z1 = (size_t)NPROJ_PAD * D * 2; v4u* p = (v4u*)((unsigned char*)Win + z0); const size_t n16 = (z1 - z0) / 16;
      for (size_t i = (size_t)F.bid * 512 + F.tid; i < n16; i += (size_t)F.G * 512) p[i] = (v4u){0u, 0u, 0u, 0u}; }
    bf16* XN = WSP(bf16, WS_XN);
    for (int m = gw; m < M; m += NGW) rms_row(kin(0) + (size_t)m * D, kin(10), XN + (size_t)m * D, nullptr, F.lane);
    if (gw < MS) rms_row(kin(1) + (size_t)gw * D, kin(10), nullptr, SSP(S_A) + (size_t)gw * D, F.lane);
    { const f32x4* p = (const f32x4*)kin(8); v2u* o = (v2u*)WSP(bf16, WS_PB); const size_t n4 = (size_t)M * PLE / 4;
      for (size_t i = (size_t)F.bid * 512 + F.tid; i < n4; i += (size_t)F.G * 512) { const f32x4 v = p[i]; o[i] = (v2u){pk2(v.x, v.y), pk2(v.z, v.w)}; } }
}

template <class Epi>
__device__ __forceinline__ void sample_gemm(Frame& F, const float* A, int K, bool norm, const bf16* Wt, int ntiles, const Epi& E) {
    const int first = F.G - 1 - F.bid;
    if (first >= ntiles) return;
    LAS bf16* As = (LAS bf16*)(F.lds);
    LAS float* Red = (LAS float*)(F.lds + 98304);
    LAS float* Rs = (LAS float*)(F.lds + 98304 + 8192);
    const int lane = F.lane, r32 = lane & 31, hh = lane >> 5;
    __syncthreads();
    if (norm) { float s = 0.f; for (int k = lane; k < K; k += 64) { const float v = A[(size_t)F.wave * K + k]; s += v * v; } s = wave_sum(s); if (lane == 0) Rs[F.wave] = rsqrtf(s / (float)K + EPS); }
    else if (lane == 0) Rs[F.wave] = 1.f;
    __syncthreads();
    { const float rs = Rs[F.wave]; for (int k = 2 * lane; k < K; k += 128) { const f32x2 v = *(const f32x2*)(A + (size_t)F.wave * K + k); *(LAS unsigned*)(As + F.wave * K + k) = cvt2bf(v.x * rs, v.y * rs); } }
    __syncthreads();
    const int ksteps = K / 128;
    for (int tl = first; tl < ntiles; tl += F.G) {
        f32x16 acc;
#pragma unroll
        for (int i = 0; i < 16; ++i) acc[i] = 0.f;
        const bf16* wp = Wt + (size_t)(32 * tl + r32) * K + F.wave * (K / 8) + 8 * hh;
        const LAS bf16* ap = As + (r32 & 7) * K + F.wave * (K / 8) + 8 * hh;
#pragma unroll 4
        for (int ks = 0; ks < ksteps; ++ks) {
            const bf16x8 bfr = *(const bf16x8*)(wp + 16 * ks);
            bf16x8 af = *(const LAS bf16x8*)(ap + 16 * ks);
            if (r32 >= 8) af = (bf16x8){0, 0, 0, 0, 0, 0, 0, 0};
            acc = __builtin_amdgcn_mfma_f32_32x32x16_bf16(af, bfr, acc, 0, 0, 0);
        }
        __syncthreads();
#pragma unroll
        for (int i = 0; i < 4; ++i) Red[(F.wave * 8 + 4 * hh + i) * 32 + r32] = acc[i];
        __syncthreads();
        if (F.tid < 256) { const int r = F.tid >> 5, c = F.tid & 31; float s = 0.f;
#pragma unroll
            for (int w = 0; w < 8; ++w) s += Red[(w * 8 + r) * 32 + c];
            E(r, 32 * tl + c, s); }
    }
    __syncthreads();
}
struct SEpiStore { float* O; int ld; int nmax; __device__ __forceinline__ void operator()(int r, int n, float v) const { if (n < nmax) O[(size_t)r * ld + n] = v; } };
struct SEpiAdd { const float* B; float* O; int ld; __device__ __forceinline__ void operator()(int r, int n, float v) const { O[(size_t)r * ld + n] = B[(size_t)r * ld + n] + v; } };
struct SEpiGateUp { float* GP; float* UP; __device__ __forceinline__ void operator()(int r, int n, float v) const { const int j = n >> 8, w = n & 255; if (w < 128) GP[(size_t)r * DFF + 128 * j + w] = v; else UP[(size_t)r * DFF + 128 * j + (w - 128)] = v; } };

__device__ __forceinline__ void gdn_prep_prompt(Frame& F) {
    const int gw = F.bid * NWAVES + F.wave, NGW = F.G * NWAVES;
    const bf16* CIN = WSP(bf16, WS_CIN); const float* cw = kin(14);
    float* GQ = WSP(float, WS_GQ); float* GK = WSP(float, WS_GK); float* GV = WSP(float, WS_GV);
    for (int it = gw; it < M * NH; it += NGW) {
        const int row = it >> 3, h = it & 7, t = row & (T - 1);
#pragma unroll
        for (int seg = 0; seg < 3; ++seg) {
            const int ch = seg * GW + h * HD + 2 * F.lane;
            float a0 = 0.f, a1 = 0.f;
#pragma unroll
            for (int j = 0; j < 4; ++j) { const int tt = t - 3 + j; if (tt >= 0) { const unsigned w = *(const unsigned*)(CIN + (size_t)(row - 3 + j) * CONVCH + ch); a0 += bf_lo(w) * cw[j * CONVCH + ch]; a1 += bf_hi(w) * cw[j * CONVCH + ch + 1]; } }
            a0 = silu_f(a0); a1 = silu_f(a1);
            float* dst = (seg == 0 ? GQ : seg == 1 ? GK : GV) + (size_t)row * GW + h * HD + 2 * F.lane;
            if (seg < 2) { const float ss = wave_sum(a0 * a0 + a1 * a1); float sc = rsqrtf(ss + 1e-6f); if (seg == 0) sc *= SB_SCALE; a0 *= sc; a1 *= sc; }
            *(f32x2*)dst = (f32x2){a0, a1};
        }
    }
}
__device__ __forceinline__ void gdn_prep_sample(Frame& F) {
    if (F.bid != 0) return;
    const float* PR = SSP(S_PROJ); const float* hist = kin(5); const float* cw = kin(14);
    for (int i = F.tid; i < MS * SBW; i += 512) { const int b = i >> 10, c = i & 1023; F.out[OUT_KS + i] = PR[(size_t)b * IN_COLS + O_SB_K + c]; F.out[OUT_VS + i] = PR[(size_t)b * IN_COLS + O_SB_V + c]; }
    for (int i = F.tid; i < MS * 3 * CONVCH; i += 512) { const int b = i / (3 * CONVCH), rr = (i / CONVCH) % 3, c = i % CONVCH;
        F.out[OUT_GCONVS + i] = (rr < 2) ? hist[((size_t)b * 3 + rr + 1) * CONVCH + c] : PR[(size_t)b * IN_COLS + O_GQKV + c]; }
    if (F.tid < 64) { const int b = F.tid >> 3, h = F.tid & 7; SSP(S_G)[F.tid] = -__expf(kin(15)[h]) * softplus_f(PR[(size_t)b * IN_COLS + O_GA + h] + kin(16)[h]); SSP(S_BETA)[F.tid] = sigmoid_f(PR[(size_t)b * IN_COLS + O_GB + h]); }
    const int b = F.wave;
    for (int h = 0; h < NH; ++h)
#pragma unroll
        for (int seg = 0; seg < 3; ++seg) {
            const int ch = seg * GW + h * HD + 2 * F.lane; float a[2];
#pragma unroll
            for (int e = 0; e < 2; ++e) { float s = 0.f;
#pragma unroll
                for (int j = 0; j < 3; ++j) s += hist[((size_t)b * 3 + j) * CONVCH + ch + e] * cw[j * CONVCH + ch + e];
                s += PR[(size_t)b * IN_COLS + O_GQKV + ch + e] * cw[3 * CONVCH + ch + e]; a[e] = silu_f(s); }
            float* dst = SSP(seg == 0 ? S_GQ : seg == 1 ? S_GK : S_GV) + (size_t)b * GW + h * HD + 2 * F.lane;
            if (seg < 2) { const float ss = wave_sum(a[0] * a[0] + a[1] * a[1]); float sc = rsqrtf(ss + 1e-6f); if (seg == 0) sc *= SB_SCALE; a[0] *= sc; a[1] *= sc; }
            dst[0] = a[0]; dst[1] = a[1];
        }
}

template <bool PIPE>
__device__ __forceinline__ void gdn_recur_wave(const float* GQ, const float* GK, const float* GV, const float* Gg, const float* Gb, int ld, int gld, size_t row0, int ntok, int h, int slice,
                                               const float* S0, float* Sout, float* GO, int lane) {
    const int e = 4 * slice + (lane >> 4), d0 = 8 * (lane & 15);
    float S[8];
#pragma unroll
    for (int i = 0; i < 8; ++i) S[i] = S0 ? S0[(size_t)(d0 + i) * HD + e] : 0.f;
    constexpr int NT = PIPE ? 4 : 1;
    f32x4 ck0[NT], ck1[NT], cq0[NT], cq1[NT]; float cv[NT], cg[NT], cb[NT];
#define GDN_LOAD(dk0, dk1, dq0, dq1, dv, dg, db, tb) do { _Pragma("unroll") for (int i_ = 0; i_ < NT; ++i_) { const size_t row_ = row0 + (tb) + i_; \
        dk0[i_] = *(const f32x4*)(GK + row_ * ld + h * HD + d0); dk1[i_] = *(const f32x4*)(GK + row_ * ld + h * HD + d0 + 4); \
        dq0[i_] = *(const f32x4*)(GQ + row_ * ld + h * HD + d0); dq1[i_] = *(const f32x4*)(GQ + row_ * ld + h * HD + d0 + 4); \
        dv[i_] = GV[row_ * ld + h * HD + e]; dg[i_] = Gg[row_ * gld + h]; db[i_] = Gb[row_ * gld + h]; } } while (0)
    GDN_LOAD(ck0, ck1, cq0, cq1, cv, cg, cb, 0);
    for (int t = 0; t < ntok; t += NT) {
        f32x4 nk0[NT], nk1[NT], nq0[NT], nq1[NT]; float nv[NT], ng[NT], nb[NT];
        const int tn = (t + NT < ntok) ? t + NT : t;
        GDN_LOAD(nk0, nk1, nq0, nq1, nv, ng, nb, tn);
#pragma unroll
        for (int i = 0; i < NT; ++i) {
            const float kk[8] = {ck0[i].x, ck0[i].y, ck0[i].z, ck0[i].w, ck1[i].x, ck1[i].y, ck1[i].z, ck1[i].w}, qq[8] = {cq0[i].x, cq0[i].y, cq0[i].z, cq0[i].w, cq1[i].x, cq1[i].y, cq1[i].z, cq1[i].w};
            const float eg = __expf(cg[i]);
            float kv = 0.f;
#pragma unroll
            for (int j = 0; j < 8; ++j) kv += S[j] * kk[j];
            kv += __shfl_xor(kv, 1); kv += __shfl_xor(kv, 2); kv += __shfl_xor(kv, 4); kv += __shfl_xor(kv, 8);
            const float u = cb[i] * (cv[i] - eg * kv);
            float o = 0.f;
#pragma unroll
            for (int j = 0; j < 8; ++j) { S[j] = eg * S[j] + kk[j] * u; o += S[j] * qq[j]; }
            o += __shfl_xor(o, 1); o += __shfl_xor(o, 2); o += __shfl_xor(o, 4); o += __shfl_xor(o, 8);
            if ((lane & 15) == 0) GO[(row0 + t + i) * ld + h * HD + e] = o;
        }
#pragma unroll
        for (int i = 0; i < NT; ++i) { ck0[i] = nk0[i]; ck1[i] = nk1[i]; cq0[i] = nq0[i]; cq1[i] = nq1[i]; cv[i] = nv[i]; cg[i] = ng[i]; cb[i] = nb[i]; }
    }
#undef GDN_LOAD
#pragma unroll
    for (int i = 0; i < 8; ++i) Sout[(size_t)(d0 + i) * HD + e] = S[i];
}

__device__ __forceinline__ void sb_query_simple(Frame& F, int b, int h, int t, LAS float* qs) {
    const bf16* Qb = WSP(bf16, WS_Q); const bf16* Kb = WSP(bf16, WS_K); const bf16* Vb = WSP(bf16, WS_V); bf16* MIX = WSP(bf16, WS_MIX);
    const size_t row = (size_t)b * T + t; const int lane = F.lane;
    { const unsigned w = *(const unsigned*)(Qb + row * SBW + h * HD + 2 * lane); qs[2 * lane] = bf_lo(w); qs[2 * lane + 1] = bf_hi(w); }
    LDS_WAIT(); asm volatile("" ::: "memory");
    const float ch = kin(12)[h];
    float o0 = 0.f, o1 = 0.f, R = 0.f;
    const int nblk = (t + 63) >> 6;
    for (int blk = nblk - 1; blk >= 0; --blk) {
        const int k0 = blk * 64, key = k0 + lane; const bool valid = key < t;
        const v4u* kr = (const v4u*)(Kb + ((size_t)b * T + key) * SBW + h * HD);
        float dot = 0.f;
#pragma unroll
        for (int c = 0; c < 16; ++c) { const v4u w = kr[c]; const f32x4 qa = *(const LAS f32x4*)(qs + 8 * c), qb = *(const LAS f32x4*)(qs + 8 * c + 4);
            dot += bf_lo(w.x) * qa.x + bf_hi(w.x) * qa.y + bf_lo(w.y) * qa.z + bf_hi(w.y) * qa.w + bf_lo(w.z) * qb.x + bf_hi(w.z) * qb.y + bf_lo(w.w) * qb.z + bf_hi(w.w) * qb.w; }
        const float z = dot * SB_SCALE + ch;
        const float sp = softplus_f(z);
        const float L = valid ? -sp : 0.f, lb = z - sp;
        float s = L;
#pragma unroll
        for (int o = 1; o < 64; o <<= 1) { const float tmp = __shfl_down(s, o); if (lane + o < 64) s += tmp; }
        const float tot = __shfl(s, 0);
        const float a = valid ? __expf(lb + (s - L) + R) : 0.f;
        R += tot;
        const bf16* vr = Vb + ((size_t)b * T + k0) * SBW + h * HD + 2 * lane;
#pragma unroll 8
        for (int j = 0; j < 64; ++j) { const float aj = __shfl(a, j); const unsigned w = *(const unsigned*)(vr + (size_t)j * SBW); o0 += aj * bf_lo(w); o1 += aj * bf_hi(w); }
    }
    const float ss = wave_sum(o0 * o0 + o1 * o1); const float rs = rsqrtf(ss * (1.f / HD) + EPS);
    const float* nw = kin(13);
    *(unsigned*)(MIX + row * D + h * HD + 2 * lane) = pk2(o0 * rs * nw[2 * lane], o1 * rs * nw[2 * lane + 1]);
}

__device__ __forceinline__ void sb_decode_block(Frame& F, int bh, int blk) {
    const int b = bh >> 3, h = bh & 7;
    const float* q = SSP(S_PROJ) + (size_t)b * IN_COLS + h * HD;
    const float* CK = kin(2); const float* CV = kin(3); const int* PT = (const int*)kin(4);
    int lane = F.lane; asm volatile("" : "+v"(lane));
    const int half = lane >> 5, l32 = lane & 31;
    const f32x4 q4 = *(const f32x4*)(q + 4 * l32);
    const float k2 = kin(12)[h] * 1.4426950408889634f, k1 = SB_SCALE * 1.4426950408889634f;
    const int p0 = blk * 64;
    const int page = PT[b * NPAGES + (p0 >> 7)];
    const size_t base = (((size_t)page * PAGE + (p0 & 127)) * NH + h) * HD;
    int zi = 0;
#pragma unroll
    for (int hb = 0; hb < 2; ++hb) {
        f32x4 kv[16];
#pragma unroll
        for (int i = 0; i < 16; ++i) kv[i] = *(const f32x4*)(CK + base + (size_t)(32 * hb + 2 * i + half) * (NH * HD) + 4 * l32);
#pragma unroll
        for (int i = 0; i < 16; ++i) {
            float p = (kv[i].x * q4.x + kv[i].y * q4.y) + (kv[i].z * q4.z + kv[i].w * q4.w);
            p += __shfl_xor(p, 1); p += __shfl_xor(p, 2); p += __shfl_xor(p, 4); p += __shfl_xor(p, 8); p += __shfl_xor(p, 16);
            const int pe = __builtin_amdgcn_readlane(__builtin_bit_cast(int, p), 0), po = __builtin_amdgcn_readlane(__builtin_bit_cast(int, p), 32);
            asm volatile("s_nop 3\n\tv_writelane_b32 %0, %1, %2" : "+v"(zi) : "s"(pe), "i"(32 * hb + 2 * i)); asm volatile("v_writelane_b32 %0, %1, %2" : "+v"(zi) : "s"(po), "i"(32 * hb + 2 * i + 1));
        }
    }
    const float z = __builtin_bit_cast(float, zi);
    const float e = __builtin_amdgcn_exp2f(-(z * k1 + k2));
    const float be = __builtin_amdgcn_rcpf(1.0f + e), m = 1.0f - be;
    float s = m;
#pragma unroll
    for (int o = 1; o < 64; o <<= 1) { const float t = __shfl_down(s, o); if (lane + o < 64) s *= t; }
    const float tot = __shfl(s, 0);
    const float sx = __shfl_down(s, 1);
    const float a = be * (lane < 63 ? sx : 1.0f);
    f32x4 o4 = {0.f, 0.f, 0.f, 0.f};
#pragma unroll
    for (int hb = 0; hb < 2; ++hb) {
        f32x4 vv[16];
#pragma unroll
        for (int i = 0; i < 16; ++i) vv[i] = *(const f32x4*)(CV + base + (size_t)(32 * hb + 2 * i + half) * (NH * HD) + 4 * l32);
#pragma unroll
        for (int i = 0; i < 16; ++i) { const float aj = __shfl(a, 32 * hb + 2 * i + half); o4 += aj * vv[i]; }
    }
    o4.x += __shfl_xor(o4.x, 32); o4.y += __shfl_xor(o4.y, 32); o4.z += __shfl_xor(o4.z, 32); o4.w += __shfl_xor(o4.w, 32);
    float* P = SSP(S_PART) + ((size_t)bh * DSEG + blk) * DPART;
    if (half == 0) *(f32x4*)(P + 4 * l32) = o4; if (lane == 0) P[128] = tot;
}
__device__ __forceinline__ void sb_decode_pull(Frame& F, unsigned* qctr, volatile LAS unsigned* stop) {
    for (;;) {
        if (stop && __builtin_amdgcn_readfirstlane(*stop) != 0u) break;
        const unsigned v = __hip_atomic_fetch_add(qctr, 1u, __ATOMIC_RELAXED, __HIP_MEMORY_SCOPE_AGENT);
        const int it = (int)(__builtin_amdgcn_readfirstlane(v) >> 6);
        if (it >= MS * NH * DSEG) break;
        sb_decode_block(F, it >> 8, it & 255);
    }
}

__device__ __forceinline__ unsigned offb(unsigned row, unsigned ch) { return 256u * row + 16u * (ch ^ (((row & 3u) << 2) | ((row >> 2) & 3u))); }
constexpr float LOG2E = 1.4426950408889634f;

__device__ __forceinline__ void sb_attn_unit(Frame& F, int b, int h, int qb) {
    const bf16* Qb = WSP(bf16, WS_Q); const bf16* Kb = WSP(bf16, WS_K); const bf16* Vb = WSP(bf16, WS_V); bf16* MIX = WSP(bf16, WS_MIX);
    const int lane = F.lane, r32 = lane & 31, hh = lane >> 5;
    const int q0w = 256 * qb + 32 * F.wave;
    LAS unsigned char* KB0 = F.lds + RING_OFF; LAS unsigned char* VB0 = F.lds + RING_OFF + 32768;
    bf16x8 qf[8];
    { const bf16* qp = Qb + ((size_t)b * T + q0w + r32) * SBW + h * HD + 8 * hh;
#pragma unroll
      for (int s = 0; s < 8; ++s) qf[s] = *(const bf16x8*)(qp + 16 * s); }
    const float k1 = SB_SCALE * LOG2E, k2 = kin(12)[h] * LOG2E;
    f32x16 oacc[4];
#pragma unroll
    for (int d = 0; d < 4; ++d)
#pragma unroll
        for (int i = 0; i < 16; ++i) oacc[d][i] = 0.f;
    float R = 1.f;
    const int nt = 4 * qb + 4;
    const int srow = F.tid >> 4, sch = F.tid & 15;
    const size_t gbase = ((size_t)b * T) * SBW + h * HD + sch * 8;
    v4u rk[2], rv[2];
#define SB_LOAD(k0_) do { _Pragma("unroll") for (int i_ = 0; i_ < 2; ++i_) { const size_t o_ = gbase + (size_t)((k0_) + srow + 32 * i_) * SBW; rk[i_] = *(const v4u*)(Kb + o_); rv[i_] = *(const v4u*)(Vb + o_); } } while (0)
    const unsigned kwo = (unsigned)((sch >> 1) * 1024 + srow * 32 + (((sch & 1) ^ ((srow >> 3) & 1)) * 16));
    const unsigned vwo = (unsigned)((((srow >> 3) * 4 + (sch >> 2)) * 512) + (srow & 7) * 64 + (sch & 3) * 16);
#define SB_WRITE(buf_) do { _Pragma("unroll") for (int i_ = 0; i_ < 2; ++i_) { *(LAS v4u*)(KB0 + (buf_) * 16384 + kwo + i_ * 8192) = rk[i_]; *(LAS v4u*)(VB0 + (buf_) * 16384 + vwo + i_ * 8192) = rv[i_]; } } while (0)
    SB_LOAD(64 * (nt - 1)); SB_WRITE(0);
    __syncthreads();
    const int tq = (lane & 15) >> 2, tp = lane & 3, tblk = (lane >> 4) & 1;
    const unsigned kro = (unsigned)(r32 * 32 + ((hh ^ ((r32 >> 3) & 1)) * 16));
    const unsigned vro = (unsigned)((4 * hh + tq) * 64 + tblk * 32 + tp * 8);
    for (int it = 0; it < nt; ++it) {
        const int kt = nt - 1 - it, buf = it & 1, k0 = 64 * kt;
        if (it + 1 < nt) SB_LOAD(64 * (kt - 1));
        if (k0 < q0w + 31) {
            const bool diag = (k0 + 63 >= q0w);
            LAS unsigned char* Kt = KB0 + buf * 16384; LAS unsigned char* Vt = VB0 + buf * 16384;
            f32x16 sacc[2];
#pragma unroll
            for (int kb = 0; kb < 2; ++kb) {
#pragma unroll
                for (int i = 0; i < 16; ++i) sacc[kb][i] = 0.f;
#pragma unroll
                for (int s = 0; s < 8; ++s) { const bf16x8 kf = *(const LAS bf16x8*)(Kt + kro + (kb * 8 + s) * 1024); sacc[kb] = __builtin_amdgcn_mfma_f32_32x32x16_bf16(kf, qf[s], sacc[kb], 0, 0, 0); }
            }
            float after = R;
            unsigned pp[2][8];
            const int qabs = q0w + r32;
#define SB_TILE(DIAG_) do { _Pragma("unroll") for (int kb = 1; kb >= 0; --kb) _Pragma("unroll") for (int g = 3; g >= 0; --g) { \
                    float be[4], m[4]; \
                    _Pragma("unroll") for (int j = 0; j < 4; ++j) { \
                        const float e = __builtin_amdgcn_exp2f(-(sacc[kb][4 * g + j] * k1 + k2)); \
                        be[j] = __builtin_amdgcn_rcpf(1.0f + e); m[j] = 1.0f - be[j]; \
                        if (DIAG_) { const bool vd = (k0 + 32 * kb + 8 * g + 4 * hh + j) < qabs; be[j] = vd ? be[j] : 0.f; m[j] = vd ? m[j] : 1.f; } } \
                    const float s3 = m[3], s2 = m[2] * s3, s1 = m[1] * s2, s0 = m[0] * s1; \
                    const float p4 = __shfl_xor(s0, 32); \
                    const float base = after * (hh == 0 ? p4 : 1.0f); \
                    const float a0 = be[0] * s1 * base, a1 = be[1] * s2 * base, a2 = be[2] * s3 * base, a3 = be[3] * base; \
                    after *= s0 * p4; \
                    pp[kb][2 * g] = cvt2bf(a0, a1); pp[kb][2 * g + 1] = cvt2bf(a2, a3); } } while (0)
            if (diag) SB_TILE(true); else SB_TILE(false);
#undef SB_TILE
            R = after;
#pragma unroll
            for (int kb = 0; kb < 2; ++kb)
#pragma unroll
                for (int sp = 0; sp < 2; ++sp) {
                    const v4u pw = {pp[kb][4 * sp], pp[kb][4 * sp + 1], pp[kb][4 * sp + 2], pp[kb][4 * sp + 3]};
                    const bf16x8 pf = __builtin_bit_cast(bf16x8, pw);
                    const int keybase = 32 * kb + 16 * sp;
#pragma unroll
                    for (int db = 0; db < 4; ++db) {
                        const s16x4 lo = __builtin_amdgcn_ds_read_tr16_b64_v4i16((LAS s16x4*)(Vt + vro + ((keybase >> 3) * 4 + db) * 512));
                        const s16x4 hi = __builtin_amdgcn_ds_read_tr16_b64_v4i16((LAS s16x4*)(Vt + vro + (((keybase >> 3) + 1) * 4 + db) * 512));
                        const bf16x8 vf = __builtin_shufflevector(lo, hi, 0, 1, 2, 3, 4, 5, 6, 7);
                        oacc[db] = __builtin_amdgcn_mfma_f32_32x32x16_bf16(vf, pf, oacc[db], 0, 0, 0);
                    }
                }
        }
        if (it + 1 < nt) SB_WRITE(buf ^ 1);
        __syncthreads();
    }
#undef SB_LOAD
#undef SB_WRITE
    float ss = 0.f;
#pragma unroll
    for (int d = 0; d < 4; ++d)
#pragma unroll
        for (int i = 0; i < 16; ++i) ss += oacc[d][i] * oacc[d][i];
    ss += __shfl_xor(ss, 32);
    const float rs = rsqrtf(ss * (1.f / HD) + EPS);
    const float* nw = kin(13);
    bf16* op = MIX + ((size_t)b * T + q0w + r32) * D + h * HD + 4 * hh;
#pragma unroll
    for (int d = 0; d < 4; ++d)
#pragma unroll
        for (int g = 0; g < 4; ++g) { const int dd = 32 * d + 8 * g + 4 * hh; const f32x4 w4 = *(const f32x4*)(nw + dd);
            v2u w; w.x = cvt2bf(oacc[d][4 * g] * rs * w4.x, oacc[d][4 * g + 1] * rs * w4.y); w.y = cvt2bf(oacc[d][4 * g + 2] * rs * w4.z, oacc[d][4 * g + 3] * rs * w4.w);
            *(v2u*)(op + 32 * d + 8 * g) = w; }
}

constexpr int GREC_WF = 0, GREC_KTF = 16384, GREC_UF = 32768, GREC_SCAN = 49152  , GREC_QF = 49152, GREC_QKF = 65536, GREC_BYTES = 73728;
constexpr int NCHUNK = T / 64;
constexpr int PL_LOW = 0  , PL_TK = 16384, PL_TQ = 32768, PL_TKBG = 49152, PL_TKT = 65536, PL_TVB = 81920, PL_TT = 98304  , PL_GC = 107520  , PL_BETA = 107776, PL_CW = 108032  ;
__device__ __forceinline__ unsigned rowimg(unsigned row, unsigned c16) { return ((row >> 5) * 8 + (c16 >> 1)) * 1024 + (row & 31) * 32 + (((c16 & 1) ^ ((row >> 3) & 1)) * 16); }
__device__ __forceinline__ unsigned trimg(unsigned row, unsigned c16) { return ((row >> 3) * 4 + (c16 >> 2)) * 512 + (row & 7) * 64 + (c16 & 3) * 16; }

__device__ __forceinline__ void gdn_prep_unit(Frame& F, int chain, int ci, unsigned char* rec, float* EGp, unsigned* qctr) {
    int lane = F.lane, tid = F.tid; asm volatile("" : "+v"(lane), "+v"(tid));
    const int b = chain >> 3, h = chain & 7, r32 = lane & 31, hh = lane >> 5;
    const size_t R0 = (size_t)b * T + 64 * ci;
    unsigned lb0 = 0; asm volatile("" : "+v"(lb0));
    LAS unsigned char* L = F.lds + lb0;
    LAS float* GC = (LAS float*)(L + PL_GC); LAS float* BE = (LAS float*)(L + PL_BETA); LAS float* LOW = (LAS float*)(L + PL_LOW);
    const bf16* CIN = WSP(bf16, WS_CIN); const float* cw = kin(14);
    for (int i = tid - 64; i >= 0 && i < 4 * 3 * 128; i += 448) { const int j = i / 384, seg = (i / 128) % 3, c = i & 127; ((LAS float*)(L + PL_CW))[i] = cw[j * CONVCH + seg * GW + h * HD + c]; }
    if (tid == 0) F.MISC[16] = 0u;
    if (F.wave == 0) { float g = WSP(float, WS_G)[(R0 + lane) * NH + h];
#pragma unroll
        for (int o = 1; o < 64; o <<= 1) { const float t = __shfl_up(g, o); if (lane >= o) g += t; }
        GC[lane] = g; BE[lane] = WSP(float, WS_BETA)[(R0 + lane) * NH + h]; }
    __syncthreads();
    {
        const int t = tid >> 3, sub = tid & 7; const int tseq = 64 * ci + t;
        const float gc = GC[t], gl = GC[63], be = BE[t];
        const float egc = __expf(gc), egl = __expf(gl - gc);
        float val[3][16];
        v4u cin[4][3][2]; float tmask[4];
#pragma unroll
        for (int j = 0; j < 4; ++j) { const bool ok = (tseq - 3 + j) >= 0; tmask[j] = ok ? 1.f : 0.f; const size_t rr = ok ? (R0 + t - 3 + j) : R0;
#pragma unroll
            for (int seg = 0; seg < 3; ++seg) { const bf16* p = CIN + rr * CONVCH + seg * GW + h * HD + 16 * sub; cin[j][seg][0] = *(const v4u*)p; cin[j][seg][1] = *(const v4u*)(p + 8); } }
#pragma unroll
        for (int seg = 0; seg < 3; ++seg) {
            float a[16];
#pragma unroll
            for (int e = 0; e < 16; ++e) a[e] = 0.f;
#pragma unroll
            for (int j = 0; j < 4; ++j) {
                const v4u w0 = cin[j][seg][0], w1 = cin[j][seg][1];
                const unsigned ww[8] = {w0.x, w0.y, w0.z, w0.w, w1.x, w1.y, w1.z, w1.w};
                const LAS f32x4* wl = (const LAS f32x4*)(L + PL_CW + ((j * 3 + seg) * 128 + 16 * sub) * 4);
                const f32x4 c0 = wl[0] * tmask[j], c1 = wl[1] * tmask[j], c2 = wl[2] * tmask[j], c3 = wl[3] * tmask[j];
                const float cwv[16] = {c0.x, c0.y, c0.z, c0.w, c1.x, c1.y, c1.z, c1.w, c2.x, c2.y, c2.z, c2.w, c3.x, c3.y, c3.z, c3.w};
#pragma unroll
                for (int e = 0; e < 8; ++e) { a[2 * e] += bf_lo(ww[e]) * cwv[2 * e]; a[2 * e + 1] += bf_hi(ww[e]) * cwv[2 * e + 1]; }
            }
            float ss = 0.f;
#pragma unroll
            for (int e = 0; e < 16; ++e) { a[e] = silu_f(a[e]); ss += a[e] * a[e]; }
            if (seg < 2) { ss += __shfl_xor(ss, 1); ss += __shfl_xor(ss, 2); ss += __shfl_xor(ss, 4); float sc = rsqrtf(ss + 1e-6f); if (seg == 0) sc *= SB_SCALE;
#pragma unroll
                for (int e = 0; e < 16; ++e) a[e] *= sc; }
#pragma unroll
            for (int e = 0; e < 16; ++e) val[seg][e] = a[e];
        }
#define PK8(dst, src, mul, o) do { dst.x = cvt2bf(src[o] * (mul), src[o + 1] * (mul)); dst.y = cvt2bf(src[o + 2] * (mul), src[o + 3] * (mul)); dst.z = cvt2bf(src[o + 4] * (mul), src[o + 5] * (mul)); dst.w = cvt2bf(src[o + 6] * (mul), src[o + 7] * (mul)); } while (0)
        v4u p0, p1;
        PK8(p0, val[1], 1.0f, 0); PK8(p1, val[1], 1.0f, 8); *(LAS v4u*)(L + PL_TK + rowimg(t, 2 * sub)) = p0; *(LAS v4u*)(L + PL_TK + rowimg(t, 2 * sub + 1)) = p1;
        PK8(p0, val[1], be * egc, 0); PK8(p1, val[1], be * egc, 8); *(LAS v4u*)(L + PL_TKBG + trimg(t, 2 * sub)) = p0; *(LAS v4u*)(L + PL_TKBG + trimg(t, 2 * sub + 1)) = p1;
        PK8(p0, val[1], egl, 0); PK8(p1, val[1], egl, 8); *(LAS v4u*)(L + PL_TKT + trimg(t, 2 * sub)) = p0; *(LAS v4u*)(L + PL_TKT + trimg(t, 2 * sub + 1)) = p1;
        PK8(p0, val[0], 1.0f, 0); PK8(p1, val[0], 1.0f, 8); *(LAS v4u*)(L + PL_TQ + rowimg(t, 2 * sub)) = p0; *(LAS v4u*)(L + PL_TQ + rowimg(t, 2 * sub + 1)) = p1;
        PK8(p0, val[2], be, 0); PK8(p1, val[2], be, 8); *(LAS v4u*)(L + PL_TVB + trimg(t, 2 * sub)) = p0; *(LAS v4u*)(L + PL_TVB + trimg(t, 2 * sub + 1)) = p1;
        { float qg[16];
#pragma unroll
          for (int e = 0; e < 16; ++e) qg[e] = val[0][e] * egc;
          unsigned char* qf = rec + GREC_QF + ((t >> 5) * 8 + sub) * 1024 + (t & 31) * 16;
          v4u f0, f1; f0.x = cvt2bf(qg[0], qg[1]); f0.y = cvt2bf(qg[2], qg[3]); f0.z = cvt2bf(qg[8], qg[9]); f0.w = cvt2bf(qg[10], qg[11]);
          f1.x = cvt2bf(qg[4], qg[5]); f1.y = cvt2bf(qg[6], qg[7]); f1.z = cvt2bf(qg[12], qg[13]); f1.w = cvt2bf(qg[14], qg[15]);
          *(v4u*)qf = f0; *(v4u*)(qf + 512) = f1; }
#undef PK8
        if (tid == 0) *EGp = __expf(gl);
    }
    __syncthreads();
    {
        const int which = F.wave >> 2, ta = (F.wave >> 1) & 1, tb = F.wave & 1;
        const unsigned aro = r32 * 32 + ((hh ^ ((r32 >> 3) & 1)) * 16);
        f32x16 acc;
#pragma unroll
        for (int i = 0; i < 16; ++i) acc[i] = 0.f;
        const bool zero_tile = (which == 0) ? (ta < tb) : (ta > tb);
        if (!zero_tile) {
#pragma unroll
            for (int ks = 0; ks < 8; ++ks) {
                const bf16x8 af = *(const LAS bf16x8*)(L + PL_TK + aro + (ta * 8 + ks) * 1024);
                const bf16x8 bfr = *(const LAS bf16x8*)(L + (which == 0 ? PL_TK : PL_TQ) + aro + (tb * 8 + ks) * 1024);
                acc = __builtin_amdgcn_mfma_f32_32x32x16_bf16(af, bfr, acc, 0, 0, 0);
            }
        }
        if (which == 0) {
            const int s = 32 * tb + r32; const float gs = GC[s];
#pragma unroll
            for (int g = 0; g < 4; ++g) { const int c0 = 32 * ta + 8 * g + 4 * hh; const f32x4 gc4 = *(const LAS f32x4*)(GC + c0), be4 = *(const LAS f32x4*)(BE + c0);
#pragma unroll
                for (int j = 0; j < 4; ++j) { const float e = __expf(fminf(gc4[j] - gs, 0.f)); const float v = be4[j] * acc[4 * g + j] * e; LOW[(c0 + j) * 64 + s] = (c0 + j > s) ? v : 0.f; } }
        } else {
            const int c = 32 * tb + r32; const float gcc = GC[c]; float v[16];
#pragma unroll
            for (int g = 0; g < 4; ++g) { const int s0 = 32 * ta + 8 * g + 4 * hh; const f32x4 gc4 = *(const LAS f32x4*)(GC + s0);
#pragma unroll
                for (int j = 0; j < 4; ++j) { const float e = __expf(fminf(gcc - gc4[j], 0.f)); const float x = acc[4 * g + j] * e; v[4 * g + j] = (c >= s0 + j) ? x : 0.f; } }
#pragma unroll
            for (int s = 0; s < 2; ++s) { v4u f; f.x = cvt2bf(v[8 * s], v[8 * s + 1]); f.y = cvt2bf(v[8 * s + 2], v[8 * s + 3]); f.z = cvt2bf(v[8 * s + 4], v[8 * s + 5]); f.w = cvt2bf(v[8 * s + 6], v[8 * s + 7]);
                *(v4u*)(rec + GREC_QKF + (tb * 4 + 2 * ta + s) * 1024 + lane * 16) = f; }
        }
    }
    __syncthreads();
    if (F.wave != 0) sb_decode_pull(F, qctr, F.MISC + 16);
    if (F.wave == 0) {
        float Tc[64];
#pragma unroll
        for (int c = 0; c < 64; ++c) {
            float a0 = 0.f, a1 = 0.f, a2 = 0.f, a3 = 0.f;
#pragma unroll
            for (int s4 = 0; s4 < (c + 3) / 4; ++s4) { const f32x4 l4 = *(const LAS f32x4*)(LOW + c * 64 + 4 * s4);
                a0 += l4.x * Tc[4 * s4]; if (4 * s4 + 1 < c) a1 += l4.y * Tc[4 * s4 + 1]; if (4 * s4 + 2 < c) a2 += l4.z * Tc[4 * s4 + 2]; if (4 * s4 + 3 < c) a3 += l4.w * Tc[4 * s4 + 3]; }
            Tc[c] = ((c == lane) ? 1.f : 0.f) - ((a0 + a1) + (a2 + a3));
        }
#pragma unroll
        for (int c = 0; c < 64; ++c) *(LAS bf16*)(L + PL_TT + c * 144 + lane * 2) = (bf16)f2bf(Tc[c]);
        F.MISC[16] = 1u;
    }
    __syncthreads();
    {
        const int tq = (lane & 15) >> 2, tp = lane & 3, tblk = (lane >> 4) & 1;
        const unsigned trn = hh * 2048 + tq * 64 + tblk * 32 + tp * 8;
        const unsigned trm = (4 * hh + tq) * 64 + tblk * 32 + tp * 8;
        const unsigned tro = r32 * 144 + hh * 16;
        {
            const int ct = F.wave >> 2, et = F.wave & 3; f32x16 acc;
#pragma unroll
            for (int i = 0; i < 16; ++i) acc[i] = 0.f;
#pragma unroll
            for (int ks = 0; ks < 4; ++ks) {
                const bf16x8 af = *(const LAS bf16x8*)(L + PL_TT + tro + ct * 32 * 144 + ks * 32);
                const s16x4 lo = __builtin_amdgcn_ds_read_tr16_b64_v4i16((LAS s16x4*)(L + PL_TVB + trn + ks * 4096 + et * 512));
                const s16x4 hi = __builtin_amdgcn_ds_read_tr16_b64_v4i16((LAS s16x4*)(L + PL_TVB + trn + ks * 4096 + et * 512 + 256));
                acc = __builtin_amdgcn_mfma_f32_32x32x16_bf16(af, __builtin_shufflevector(lo, hi, 0, 1, 2, 3, 4, 5, 6, 7), acc, 0, 0, 0);
            }
            v4u f0, f1; f0.x = cvt2bf(acc[0], acc[1]); f0.y = cvt2bf(acc[2], acc[3]); f0.z = cvt2bf(acc[4], acc[5]); f0.w = cvt2bf(acc[6], acc[7]);
            f1.x = cvt2bf(acc[8], acc[9]); f1.y = cvt2bf(acc[10], acc[11]); f1.z = cvt2bf(acc[12], acc[13]); f1.w = cvt2bf(acc[14], acc[15]);
            unsigned char* up = rec + GREC_UF + (et * 2 + ct) * 2048 + lane * 32; *(v4u*)up = f0; *(v4u*)(up + 16) = f1;
        }
        {
            const int dt = F.wave >> 1, ct = F.wave & 1; f32x16 acc;
#pragma unroll
            for (int i = 0; i < 16; ++i) acc[i] = 0.f;
#pragma unroll
            for (int ks = 0; ks < 4; ++ks) {
                const s16x4 lo = __builtin_amdgcn_ds_read_tr16_b64_v4i16((LAS s16x4*)(L + PL_TKBG + trn + ks * 4096 + dt * 512));
                const s16x4 hi = __builtin_amdgcn_ds_read_tr16_b64_v4i16((LAS s16x4*)(L + PL_TKBG + trn + ks * 4096 + dt * 512 + 256));
                const bf16x8 bfr = *(const LAS bf16x8*)(L + PL_TT + tro + ct * 32 * 144 + ks * 32);
                acc = __builtin_amdgcn_mfma_f32_32x32x16_bf16(__builtin_shufflevector(lo, hi, 0, 1, 2, 3, 4, 5, 6, 7), bfr, acc, 0, 0, 0);
            }
#pragma unroll
            for (int s = 0; s < 2; ++s) { v4u f; f.x = cvt2bf(-acc[8 * s], -acc[8 * s + 1]); f.y = cvt2bf(-acc[8 * s + 2], -acc[8 * s + 3]); f.z = cvt2bf(-acc[8 * s + 4], -acc[8 * s + 5]); f.w = cvt2bf(-acc[8 * s + 6], -acc[8 * s + 7]);
                *(v4u*)(rec + GREC_WF + (ct * 8 + 2 * dt + s) * 1024 + lane * 16) = f; }
        }
        {
#pragma unroll
            for (int q = 0; q < 2; ++q) { const int f = 2 * F.wave + q, dt = f >> 2, ksp = f & 3;
                const s16x4 lo = __builtin_amdgcn_ds_read_tr16_b64_v4i16((LAS s16x4*)(L + PL_TKT + trm + (2 * ksp) * 2048 + dt * 512));
                const s16x4 hi = __builtin_amdgcn_ds_read_tr16_b64_v4i16((LAS s16x4*)(L + PL_TKT + trm + (2 * ksp + 1) * 2048 + dt * 512));
                const bf16x8 kf = __builtin_shufflevector(lo, hi, 0, 1, 2, 3, 4, 5, 6, 7);
                *(bf16x8*)(rec + GREC_KTF + (dt * 4 + ksp) * 1024 + lane * 16) = kf; }
        }
    }
    __syncthreads();
}

__device__ __forceinline__ void gdn_scan_chain(Frame& F, int chain) {
    const int lane = F.lane, r32 = lane & 31, hh = lane >> 5, et = F.wave;
    const unsigned char* recs = F.ws + WS_GREC + (size_t)chain * NCHUNK * GREC_BYTES;
    const float* EG = WSP(float, WS_GEG) + chain * NCHUNK;
    unsigned char* sfr = F.ws + WS_GSF + ((size_t)chain * NCHUNK * 4 + et) * 8192 + lane * 16;
    LAS unsigned char* L = F.lds;
    f32x16 S[4];
#pragma unroll
    for (int d = 0; d < 4; ++d)
#pragma unroll
        for (int i = 0; i < 16; ++i) S[d][i] = 0.f;
#define GS_DMA(ci_, slot_) do { const unsigned char* g_ = recs + (size_t)(ci_) * GREC_BYTES + lane * 16; \
        _Pragma("unroll") for (int p_ = 0; p_ < 6; ++p_) __builtin_amdgcn_global_load_lds((const unsigned*)(g_ + (F.wave + 8 * p_) * 1024), (LAS unsigned*)(L + (slot_) * GREC_SCAN + (F.wave + 8 * p_) * 1024), 16, 0, 0); } while (0)
    const float egv = EG[lane];
    asm volatile("s_waitcnt vmcnt(0)" ::: "memory");
    GS_DMA(0, 0); GS_DMA(1, 1);
    asm volatile("s_waitcnt vmcnt(6)" ::: "memory"); __builtin_amdgcn_s_barrier(); asm volatile("" ::: "memory");
    for (int ci = 0; ci < NCHUNK; ++ci) {
        const int slot = ci % 3;
        { const int cn = (ci + 2 < NCHUNK) ? ci + 2 : ci; GS_DMA(cn, (ci + 2) % 3); }
        if (F.wave < 4) {
            const LAS unsigned char* A = L + slot * GREC_SCAN + lane * 16;
            const float eg = __builtin_bit_cast(float, __builtin_amdgcn_readlane(__builtin_bit_cast(int, egv), ci));
            bf16x8 sf[8];
#pragma unroll
            for (int ks = 0; ks < 8; ++ks) { const int d = ks >> 1, s = ks & 1; v4u w; w.x = cvt2bf(S[d][8 * s], S[d][8 * s + 1]); w.y = cvt2bf(S[d][8 * s + 2], S[d][8 * s + 3]); w.z = cvt2bf(S[d][8 * s + 4], S[d][8 * s + 5]); w.w = cvt2bf(S[d][8 * s + 6], S[d][8 * s + 7]); sf[ks] = __builtin_bit_cast(bf16x8, w);
                *(v4u*)(sfr + (size_t)ci * 32768 + ks * 1024) = w; }
            f32x16 vn[2];
#pragma unroll
            for (int ct = 0; ct < 2; ++ct) {
                const LAS unsigned char* up = L + slot * GREC_SCAN + GREC_UF + (et * 2 + ct) * 2048 + lane * 32;
                const v4u u0 = *(const LAS v4u*)up, u1 = *(const LAS v4u*)(up + 16);
                const unsigned uw[8] = {u0.x, u0.y, u0.z, u0.w, u1.x, u1.y, u1.z, u1.w};
#pragma unroll
                for (int i = 0; i < 8; ++i) { vn[ct][2 * i] = bf_lo(uw[i]); vn[ct][2 * i + 1] = bf_hi(uw[i]); }
#pragma unroll
                for (int ks = 0; ks < 8; ++ks) vn[ct] = __builtin_amdgcn_mfma_f32_32x32x16_bf16(*(const LAS bf16x8*)(A + GREC_WF + (ct * 8 + ks) * 1024), sf[ks], vn[ct], 0, 0, 0);
            }
            bf16x8 vf[4];
#pragma unroll
            for (int ks = 0; ks < 4; ++ks) { const int ct = ks >> 1, s = ks & 1; v4u w; w.x = cvt2bf(vn[ct][8 * s], vn[ct][8 * s + 1]); w.y = cvt2bf(vn[ct][8 * s + 2], vn[ct][8 * s + 3]); w.z = cvt2bf(vn[ct][8 * s + 4], vn[ct][8 * s + 5]); w.w = cvt2bf(vn[ct][8 * s + 6], vn[ct][8 * s + 7]); vf[ks] = __builtin_bit_cast(bf16x8, w); }
#pragma unroll
            for (int d = 0; d < 4; ++d) {
#pragma unroll
                for (int i = 0; i < 16; ++i) S[d][i] *= eg;
#pragma unroll
                for (int ks = 0; ks < 4; ++ks) S[d] = __builtin_amdgcn_mfma_f32_32x32x16_bf16(*(const LAS bf16x8*)(A + GREC_KTF + (d * 4 + ks) * 1024), vf[ks], S[d], 0, 0, 0);
            }
            asm volatile("s_waitcnt vmcnt(14) lgkmcnt(0)" ::: "memory");
        } else {
            asm volatile("s_waitcnt vmcnt(6)" ::: "memory");
        }
        __builtin_amdgcn_s_barrier(); asm volatile("" ::: "memory");
    }
#undef GS_DMA
    asm volatile("s_waitcnt vmcnt(0)" ::: "memory"); __syncthreads();
    if (F.wave < 4) { float* so = F.out + OUT_GREC + (size_t)chain * HD * HD + 32 * et + r32;
#pragma unroll
        for (int d = 0; d < 4; ++d)
#pragma unroll
            for (int i = 0; i < 16; ++i) so[(size_t)(32 * d + (i & 3) + 8 * (i >> 2) + 4 * hh) * HD] = S[d][i]; }
}

__device__ __forceinline__ void gdn_out_unit(Frame& F, int chain, int ci) {
    int lane = F.lane, tid = F.tid; asm volatile("" : "+v"(lane), "+v"(tid));
    const int b = chain >> 3, h = chain & 7, r32 = lane & 31, hh = lane >> 5, et = F.wave & 3, ct = F.wave >> 2;
    const unsigned char* rec = F.ws + WS_GREC + ((size_t)chain * NCHUNK + ci) * GREC_BYTES + lane * 16;
    const unsigned char* sfp = F.ws + WS_GSF + (((size_t)chain * NCHUNK + ci) * 4 + et) * 8192 + lane * 16;
    LAS float* OT = (LAS float*)(F.lds);
    bf16x8 sf[8];
#pragma unroll
    for (int ks = 0; ks < 8; ++ks) sf[ks] = *(const bf16x8*)(sfp + ks * 1024);
    f32x16 vn[2], o;
#pragma unroll
    for (int c2 = 0; c2 < 2; ++c2) {
        const unsigned char* up = F.ws + WS_GREC + ((size_t)chain * NCHUNK + ci) * GREC_BYTES + GREC_UF + (et * 2 + c2) * 2048 + lane * 32;
        const v4u u0 = *(const v4u*)up, u1 = *(const v4u*)(up + 16);
        const unsigned uw[8] = {u0.x, u0.y, u0.z, u0.w, u1.x, u1.y, u1.z, u1.w};
#pragma unroll
        for (int i = 0; i < 8; ++i) { vn[c2][2 * i] = bf_lo(uw[i]); vn[c2][2 * i + 1] = bf_hi(uw[i]); }
#pragma unroll
        for (int ks = 0; ks < 8; ++ks) vn[c2] = __builtin_amdgcn_mfma_f32_32x32x16_bf16(*(const bf16x8*)(rec + GREC_WF + (c2 * 8 + ks) * 1024), sf[ks], vn[c2], 0, 0, 0);
    }
#pragma unroll
    for (int i = 0; i < 16; ++i) o[i] = 0.f;
#pragma unroll
    for (int ks = 0; ks < 8; ++ks) o = __builtin_amdgcn_mfma_f32_32x32x16_bf16(*(const bf16x8*)(rec + GREC_QF + (ct * 8 + ks) * 1024), sf[ks], o, 0, 0, 0);
#pragma unroll
    for (int ks = 0; ks < 4; ++ks) { const int c2 = ks >> 1, s = ks & 1; v4u w; w.x = cvt2bf(vn[c2][8 * s], vn[c2][8 * s + 1]); w.y = cvt2bf(vn[c2][8 * s + 2], vn[c2][8 * s + 3]); w.z = cvt2bf(vn[c2][8 * s + 4], vn[c2][8 * s + 5]); w.w = cvt2bf(vn[c2][8 * s + 6], vn[c2][8 * s + 7]);
        o = __builtin_amdgcn_mfma_f32_32x32x16_bf16(*(const bf16x8*)(rec + GREC_QKF + (ct * 4 + ks) * 1024), __builtin_bit_cast(bf16x8, w), o, 0, 0, 0); }
#pragma unroll
    for (int i = 0; i < 16; ++i) OT[(32 * ct + (i & 3) + 8 * (i >> 2) + 4 * hh) * 132 + 32 * et + r32] = o[i];
    __syncthreads();
    {
        const int c = tid >> 3, sub = tid & 7; const size_t row = (size_t)b * T + 64 * ci + c;
        const LAS f32x4* op = (const LAS f32x4*)(OT + c * 132 + 16 * sub);
        const f32x4 a0 = op[0], a1 = op[1], a2 = op[2], a3 = op[3];
        float x[16] = {a0.x, a0.y, a0.z, a0.w, a1.x, a1.y, a1.z, a1.w, a2.x, a2.y, a2.z, a2.w, a3.x, a3.y, a3.z, a3.w};
        float ss = 0.f;
#pragma unroll
        for (int e = 0; e < 16; ++e) ss += x[e] * x[e];
        ss += __shfl_xor(ss, 1); ss += __shfl_xor(ss, 2); ss += __shfl_xor(ss, 4);
        const float rs = rsqrtf(ss * (1.f / HD) + EPS);
        const bf16* zp = WSP(bf16, WS_Z) + row * GW + h * HD + 16 * sub; const v4u z0 = *(const v4u*)zp, z1 = *(const v4u*)(zp + 8);
        const unsigned zw[8] = {z0.x, z0.y, z0.z, z0.w, z1.x, z1.y, z1.z, z1.w};
        const float* gn = kin(17) + 16 * sub;
        unsigned ow[8];
#pragma unroll
        for (int e = 0; e < 8; ++e) ow[e] = cvt2bf(x[2 * e] * rs * gn[2 * e] * silu_f(bf_lo(zw[e])), x[2 * e + 1] * rs * gn[2 * e + 1] * silu_f(bf_hi(zw[e])));
        bf16* mp = WSP(bf16, WS_MIX) + row * D + SBW + h * HD + 16 * sub;
        *(v4u*)mp = (v4u){ow[0], ow[1], ow[2], ow[3]}; *(v4u*)(mp + 8) = (v4u){ow[4], ow[5], ow[6], ow[7]};
    }
    __syncthreads();
}

#ifndef REP_PHASE
#define REP_PHASE -1
#endif
#ifndef REP_N
#define REP_N 0
#endif
#ifndef REP_SCAN
#define REP_SCAN 0
#endif
#ifndef REP_ATTN
#define REP_ATTN 0
#endif

__device__ __forceinline__ void p2_mixers(Frame& F, unsigned* qctr) {
    _Pragma("unroll") for (int rs_ = 0; rs_ < 1 + REP_SCAN; ++rs_) if (F.bid < NB * NH) gdn_scan_chain(F, F.bid);
    __syncthreads();
    _Pragma("unroll") for (int ra_ = 0; ra_ < 1 + REP_ATTN; ++ra_)
    for (int u = F.bid; u < NB * NH * 16; u += F.G) { const int bh = u & 15, qb = u >> 4; sb_attn_unit(F, bh >> 3, bh & 7, qb); }
    const int gw = F.bid * NWAVES + F.wave, NGW = F.G * NWAVES;
    for (int it = gw; it < MS * NH * 32; it += NGW) {
        const int chain = it >> 5, slice = it & 31, b = chain >> 3, h = chain & 7;
        gdn_recur_wave<false>(SSP(S_GQ), SSP(S_GK), SSP(S_GV), SSP(S_G), SSP(S_BETA), GW, NH, (size_t)b, 1, h, slice,
                              kin(6) + (size_t)chain * HD * HD, F.out + OUT_GRECS + (size_t)chain * HD * HD, SSP(S_GO), F.lane);
    }
    sb_decode_pull(F, qctr, nullptr);
}

__device__ __forceinline__ void p2_finish(Frame& F) {
    const int gw = F.bid * NWAVES + F.wave, NGW = F.G * NWAVES;
    const float* gnw = kin(17);
    for (int u = F.bid; u < NB * NH * NCHUNK; u += F.G) gdn_out_unit(F, u & 15, u >> 4);
    if (F.wave == 0 && F.G - 1 - F.bid < MS * NH) {
        const int bh = F.G - 1 - F.bid, b = bh >> 3, h = bh & 7;
        { const f32x2 o = *(const f32x2*)(SSP(S_GO) + (size_t)b * GW + h * HD + 2 * F.lane);
          const float rs = rsqrtf(wave_sum(o.x * o.x + o.y * o.y) * (1.f / HD) + EPS);
          const float* z = SSP(S_PROJ) + (size_t)b * IN_COLS + O_GZ + h * HD + 2 * F.lane;
          float* mo = SSP(S_MIX) + (size_t)b * D + SBW + h * HD + 2 * F.lane;
          mo[0] = o.x * rs * gnw[2 * F.lane] * silu_f(z[0]); mo[1] = o.y * rs * gnw[2 * F.lane + 1] * silu_f(z[1]); }
        { float o0 = 0.f, o1 = 0.f, R = 1.f;
          const float* P = SSP(S_PART) + (size_t)bh * DSEG * DPART;
          for (int s0 = DSEG - 32; s0 >= 0; s0 -= 32) {
              float pa[32], pb[32], pr[32];
#pragma unroll
              for (int i = 0; i < 32; ++i) { const float* Pi = P + (size_t)(s0 + i) * DPART; const f32x2 v = *(const f32x2*)(Pi + 2 * F.lane); pa[i] = v.x; pb[i] = v.y; pr[i] = Pi[128]; }
#pragma unroll
              for (int i = 31; i >= 0; --i) { o0 += R * pa[i]; o1 += R * pb[i]; R *= pr[i]; } }
          const float rs = rsqrtf(wave_sum(o0 * o0 + o1 * o1) * (1.f / HD) + EPS); const float* nw = kin(13);
          float* mo = SSP(S_MIX) + (size_t)b * D + h * HD + 2 * F.lane; mo[0] = o0 * rs * nw[2 * F.lane]; mo[1] = o1 * rs * nw[2 * F.lane + 1]; }
    }
}

__device__ __forceinline__ void p4b_fixup(Frame& F) {
    const float* TAIL = WSP(float, WS_TAIL); const float* FIXG = WSP(float, WS_FIXG); const float* FIXU = WSP(float, WS_FIXU); bf16* ACT = WSP(bf16, WS_ACT); const float* cw = kin(22);
    const int total = 32 * 2 * DFF;
    for (int i = F.bid * 512 + F.tid; i < total; i += F.G * 512) {
        const int pm = i / (2 * DFF), rr = (i / DFF) & 1, c = i % DFF;
        if ((pm & 15) == 0) continue;
        const float t0 = TAIL[((size_t)(pm - 1) * 2 + 0) * DFF + c], t1 = TAIL[((size_t)(pm - 1) * 2 + 1) * DFF + c];
        float g = FIXG[((size_t)pm * 2 + rr) * DFF + c];
        g += (rr == 0) ? (cw[c] * t0 + cw[DFF + c] * t1) : (cw[c] * t1);
        ACT[(size_t)(pm * 256 + rr) * DFF + c] = (bf16)f2bf(silu_f(g) * FIXU[((size_t)pm * 2 + rr) * DFF + c]);
    }
    const float* st = kin(7); const float* GP = SSP(S_GP); const float* UP = SSP(S_UP); float* SACT = SSP(S_ACT);
    for (int i = F.bid * 512 + F.tid; i < MS * DFF; i += F.G * 512) {
        const int b = i / DFF, c = i % DFF;
        const float s0 = st[((size_t)b * 2 + 0) * DFF + c], s1 = st[((size_t)b * 2 + 1) * DFF + c], gp = GP[i];
        const float g = cw[c] * s0 + cw[DFF + c] * s1 + cw[2 * DFF + c] * gp;
        SACT[i] = silu_f(g) * UP[i];
        F.out[OUT_FCONVS + ((size_t)b * 2 + 0) * DFF + c] = s1; F.out[OUT_FCONVS + ((size_t)b * 2 + 1) * DFF + c] = gp;
    }
}

__device__ __forceinline__ void p7_final(Frame& F) {
    const int gw = F.bid * NWAVES + F.wave, NGW = F.G * NWAVES;
    const float* fw = kin(27); const float* ss3 = (const float*)(F.ctl + CW_SUMSQ3);
    for (int m = gw; m < M; m += NGW) {
        const float rs = rsqrtf(ss3[m] * (1.f / D) + EPS);
        f32x4* y = (f32x4*)(F.out + OUT_Y + (size_t)m * D) + F.lane; const f32x4* w = (const f32x4*)fw + F.lane;
#pragma unroll
        for (int j = 0; j < 8; ++j) y[64 * j] = y[64 * j] * rs * w[64 * j];
    }
    if (F.bid == 0) {
        const int b = F.wave; float v[32]; float s = 0.f;
#pragma unroll
        for (int j = 0; j < 32; ++j) { const int c = F.lane + 64 * j; const float h = SSP(S_H2)[(size_t)b * D + c] + SSP(S_PP)[(size_t)b * D + c] * sigmoid_f(SSP(S_PG)[(size_t)b * D + c]); v[j] = h; s += h * h; }
        const float rs = rsqrtf(wave_sum(s) * (1.f / D) + EPS);
#pragma unroll
        for (int j = 0; j < 32; ++j) { const int c = F.lane + 64 * j; F.out[OUT_YS + (size_t)b * D + c] = v[j] * rs * fw[c]; }
    }
}

constexpr int NPHASES = 12;

constexpr int WS_DUMMY_WORDS = 3 * M;
constexpr int N_LAUNCHES = MK_N_LAUNCHES;
struct Args { const float* in[28]; float* out; unsigned char* ws; int ph_lo, ph_hi; };
__global__ void __launch_bounds__(NWAVES * 64, 2) hymba_fwd(Args args) {
    extern __shared__ __attribute__((aligned(16))) unsigned char lds[];
    Frame F;
    F.lds = (LAS unsigned char*)lds;
    F.MISC = (volatile LAS unsigned*)(F.lds + MISC_OFF);
    F.tid = threadIdx.x; F.lane = F.tid & 63; F.wave = __builtin_amdgcn_readfirstlane(F.tid >> 6);
    F.G = gridDim.x; F.bid = blockIdx.x;
    F.ws = args.ws; F.ctl = (unsigned*)(args.ws + WS_CTL); F.out = args.out;
    for (int u = F.tid; u < (LDS_BYTES - LDSCTL_OFF) / 4; u += NWAVES * 64) ((LAS unsigned*)(F.lds + LDSCTL_OFF))[u] = 0u;
    __syncthreads();
    XcdBarrier bar; bar.bar = F.ctl + CW_BAR; bar.x = 0; bar.st = nullptr;
    if (N_LAUNCHES == 1) bar = xcd_barrier_post(F.ctl + CW_BAR, F.MISC + 8);
#define GRID_BAR() do { if (N_LAUNCHES == 1) xcd_barrier(bar); } while (0)
    const int lo = args.ph_lo, hi = args.ph_hi;
#define IN(k) (lo <= (k) && (k) < hi)
#define NREP(k) ((k) == REP_PHASE ? 1 + REP_N : 1)
    float* ss1 = (float*)(F.ctl + CW_SUMSQ1); float* ss2 = (float*)(F.ctl + CW_SUMSQ2); float* ss3 = (float*)(F.ctl + CW_SUMSQ3); float* dummy = WSP(float, WS_DUMMY);

    if (IN(0)) { _Pragma("unroll") for (int rep = 0; rep < NREP(0); ++rep) p0_prologue(F); GRID_BAR(); }
    if (IN(1)) { _Pragma("unroll") for (int rep = 0; rep < NREP(1); ++rep) {
        { pg8::Gemm g{WSP(bf16, WS_XN), WSP(bf16, WS_WIN), M, NPROJ_PAD, D}; pg8::StaticOrder S; S.init(M, NPROJ_PAD, F.G, F.bid);
          pg8::EpiProj E{WSP(bf16, WS_Q), WSP(bf16, WS_K), WSP(bf16, WS_V), WSP(bf16, WS_CIN), WSP(bf16, WS_Z), F.out + OUT_K, F.out + OUT_V, F.out + OUT_GCONV, WSP(float, WS_G), WSP(float, WS_BETA), kin(15), kin(16)};
          pg8::gemm_phase<pg8::EpiProj, pg8::StaticOrder, true, true>(F.lds + RING_OFF, g, S, E); }
        { pg8::Gemm g{WSP(bf16, WS_PB), WSP(bf16, WS_WPP), M, D, PLE}; pg8::StaticOrder S; S.init(M, D, F.G, F.bid);
          pg8::EpiBf16 E{WSP(bf16, WS_PP), D};
          pg8::gemm_phase<pg8::EpiBf16, pg8::StaticOrder, true, true>(F.lds + RING_OFF, g, S, E); }
        { SEpiStore E{SSP(S_PROJ), IN_COLS, IN_COLS}; sample_gemm(F, SSP(S_A), D, false, WSP(bf16, WS_WIN), 225, E); }
        if (rep == 0) { constexpr int T0 = (29 * 32) % 256; convert_set(F, 1, (F.bid - T0) * NWAVES + F.wave, (F.G - T0) * NWAVES); }
        }
        GRID_BAR();
    }
    if (IN(2)) { _Pragma("unroll") for (int rep = 0; rep < NREP(2); ++rep) {
        for (int u = F.bid; u < NB * NH * NCHUNK; u += F.G) { const int chain = u & 15, ci = u >> 4;
            gdn_prep_unit(F, chain, ci, F.ws + WS_GREC + ((size_t)chain * NCHUNK + ci) * GREC_BYTES, WSP(float, WS_GEG) + chain * NCHUNK + ci, F.ctl + CW_QUEUE); }
        gdn_prep_sample(F); }
        GRID_BAR(); }
    if (IN(3)) { _Pragma("unroll") for (int rep = 0; rep < NREP(3); ++rep) p2_mixers(F, F.ctl + CW_QUEUE); GRID_BAR(); }
    if (IN(4)) { _Pragma("unroll") for (int rep = 0; rep < NREP(4); ++rep) p2_finish(F); GRID_BAR(); }
    if (IN(5)) { _Pragma("unroll") for (int rep = 0; rep < NREP(5); ++rep) {
        { pg8::Gemm g{WSP(bf16, WS_MIX), WSP(bf16, WS_WOUT), M, D, D}; pg8::StaticOrder S; S.init(M, D, F.G, F.bid);
          pg8::EpiResid<false> E{kin(0), WSP(bf16, WS_H1B), rep == 0 ? ss1 : dummy, D};
          pg8::gemm_phase<pg8::EpiResid<false>, pg8::StaticOrder, true, true>(F.lds + RING_OFF, g, S, E); }
        { SEpiAdd E{kin(1), SSP(S_H1), D}; sample_gemm(F, SSP(S_MIX), D, false, WSP(bf16, WS_WOUT), D / 32, E); }
        }
        GRID_BAR();
    }
    if (IN(6)) { _Pragma("unroll") for (int rep = 0; rep < NREP(6); ++rep) {
        { pg8::Gemm g{WSP(bf16, WS_H1B), WSP(bf16, WS_WGU), M, NGU, D}; pg8::StaticOrder S; S.init(M, NGU, F.G, F.bid);
          pg8::EpiGateUp E{ss1, kin(22), WSP(bf16, WS_ACT), WSP(float, WS_TAIL), WSP(float, WS_FIXG), WSP(float, WS_FIXU), F.out + OUT_FCONV, (PG8_LAS float*)(F.lds + HALO_OFF)};
          pg8::gemm_phase<pg8::EpiGateUp, pg8::StaticOrder, true, true>(F.lds + RING_OFF, g, S, E); }
        { SEpiGateUp E{SSP(S_GP), SSP(S_UP)}; sample_gemm(F, SSP(S_H1), D, true, WSP(bf16, WS_WGU), NGU / 32, E); }
        if (rep == 0) { constexpr int T1 = (43 * 32) % 256; convert_set(F, 2, (F.bid - T1) * NWAVES + F.wave, (F.G - T1) * NWAVES); }
        }
        GRID_BAR();
    }
    if (IN(7)) { _Pragma("unroll") for (int rep = 0; rep < NREP(7); ++rep) p4b_fixup(F); GRID_BAR(); }
    if (IN(8)) { _Pragma("unroll") for (int rep = 0; rep < NREP(8); ++rep) {
        { pg8::Gemm g{WSP(bf16, WS_ACT), WSP(bf16, WS_WDN), M, D, DFF}; pg8::StaticOrder S; S.init(M, D, F.G, F.bid);
          pg8::EpiResid<true> E{WSP(bf16, WS_H1B), WSP(bf16, WS_H2B), rep == 0 ? ss2 : dummy, D};
          pg8::gemm_phase<pg8::EpiResid<true>, pg8::StaticOrder, true, true>(F.lds + RING_OFF, g, S, E); }
        { SEpiAdd E{SSP(S_H1), SSP(S_H2), D}; sample_gemm(F, SSP(S_ACT), DFF, false, WSP(bf16, WS_WDN), D / 32, E); }
        }
        GRID_BAR();
    }
    if (IN(9)) { _Pragma("unroll") for (int rep = 0; rep < NREP(9); ++rep) {
        { pg8::Gemm g{WSP(bf16, WS_H2B), WSP(bf16, WS_WPG), M, D, D}; pg8::StaticOrder S; S.init(M, D, F.G, F.bid);
          pg8::EpiPle E{WSP(bf16, WS_H2B), WSP(bf16, WS_PP), ss2, F.out + OUT_Y, rep == 0 ? ss3 : dummy, D};
          pg8::gemm_phase<pg8::EpiPle, pg8::StaticOrder, true, true>(F.lds + RING_OFF, g, S, E); }
        { SEpiStore E{SSP(S_PG), D, D}; sample_gemm(F, SSP(S_H2), D, true, WSP(bf16, WS_WPG), D / 32, E); }
        { SEpiStore E{SSP(S_PP), D, D}; sample_gemm(F, kin(9), PLE, false, WSP(bf16, WS_WPP), D / 32, E); }
        }
        GRID_BAR();
    }
    if (IN(10)) { p7_final(F); }
#undef IN
#undef GRID_BAR
}

extern "C" void kernel_launch(void* const* d_in, const int* in_sizes, int n_in, void* d_out, int out_size, void* d_ws, size_t ws_size, hipStream_t stream) {
    static int grid = 0;
    if (grid == 0) {
        if (n_in != 28 || (size_t)out_size != OUT_END || ws_size < WS_END) { fprintf(stderr, "kernel_launch: unexpected sizes n_in %d out %d ws %zu (need %zu, %zu)\n", n_in, out_size, ws_size, (size_t)OUT_END, (size_t)WS_END); grid = -1; return; }
        int dev = 0, cus = 0, per_cu = 0;
        if (hipGetDevice(&dev) != hipSuccess || hipDeviceGetAttribute(&cus, hipDeviceAttributeMultiprocessorCount, dev) != hipSuccess) { grid = -1; return; }
        if (hipFuncSetAttribute((const void*)hymba_fwd, hipFuncAttributeMaxDynamicSharedMemorySize, LDS_BYTES) != hipSuccess) { fprintf(stderr, "kernel_launch: hipFuncSetAttribute failed\n"); grid = -1; return; }
        if (hipOccupancyMaxActiveBlocksPerMultiprocessor(&per_cu, (const void*)hymba_fwd, NWAVES * 64, LDS_BYTES) != hipSuccess || per_cu < 1) { fprintf(stderr, "kernel_launch: occupancy query says %d\n", per_cu); }
        (void)hipGetLastError();
        grid = cus;
    }
    if (grid < 0) return;
    (void)hipMemsetAsync((char*)d_ws + WS_CTL, 0, CTL_ZERO_BYTES, stream);
    Args a{};
    for (int i = 0; i < 28; ++i) a.in[i] = (const float*)d_in[i];
    a.out = (float*)d_out; a.ws = (unsigned char*)d_ws;
    if (N_LAUNCHES == 1) { a.ph_lo = 0; a.ph_hi = NPHASES; hipLaunchKernelGGL(hymba_fwd, dim3(grid), dim3(NWAVES * 64), LDS_BYTES, stream, a); }
    else for (int p = 0; p < 11; ++p) { a.ph_lo = p; a.ph_hi = p + 1; hipLaunchKernelGGL(hymba_fwd, dim3(grid), dim3(NWAVES * 64), LDS_BYTES, stream, a); }
}
```

```cpp
#include <hip/hip_runtime.h>
#include <cstdio>
#include <cstdint>

#ifndef MK_N_LAUNCHES
#define MK_N_LAUNCHES 1
#endif

namespace pg8 {
#define PG8_LAS __attribute__((address_space(3)))
typedef unsigned short bf16_t;
typedef short bf16x8 __attribute__((ext_vector_type(8)));
typedef float f32x4 __attribute__((ext_vector_type(4)));
typedef unsigned u32x4 __attribute__((ext_vector_type(4)));
constexpr int BM = 256, BK = 64, HALF = 128, HTB = HALF * BK * 2  , STAGE_BYTES = 8 * HTB, NXCD = 8, WGM = 8;

__host__ __device__ __forceinline__ int lds_byte(int r, int c) { const int st = (r >> 4) * 2 + (c >> 5), rr = r & 15, cc = c & 31, ob = rr * 64 + cc * 2; return st * 1024 + (ob ^ (((ob >> 9) & 1) << 5)); }
__host__ __device__ __forceinline__ void stage_rc(int b, int& R, int& C) { const int st = b / 1024, sb = b % 1024, swz = sb ^ (((sb >> 9) & 1) << 5); R = (st >> 1) * 16 + swz / 64; C = (st & 1) * 32 + (swz % 64) / 2; }
__host__ __device__ __forceinline__ int perm32(int rho) { const int n = rho >> 4, i = rho & 15; return 8 * (i >> 2) + 4 * n + (i & 3); }

struct Unit { int pm, pn; };
struct Gemm { const bf16_t* A; const bf16_t* Bt; int M, N, K; };

struct StaticOrder {
    int nM, nN, nwg, G, c;
    __host__ __device__ void init(int M, int N, int G_, int c_) { nM = M / BM; nN = N / BM; nwg = nM * nN; G = G_; c = c_; }
    __host__ __device__ bool next(int i, Unit& u) const {
        const long L = (long)i * G + c; if (L >= nwg) return false;
        int wgid = (int)L; { const int q = nwg / NXCD, r = nwg % NXCD, xcd = wgid % NXCD, off = wgid / NXCD; wgid = (xcd < r ? xcd * (q + 1) : r * (q + 1) + (xcd - r) * q) + off; }
        const int nig = WGM * nN, gid = wgid / nig, fm = gid * WGM, gsz = (nM - fm) < WGM ? (nM - fm) : WGM;
        u.pm = fm + ((wgid % nig) % gsz); u.pn = (wgid % nig) / gsz; return true;
    }
    __device__ __forceinline__ void a_ready(const Unit&) const {}
    __device__ __forceinline__ void done(const Unit&) const {}
};

__device__ __forceinline__ unsigned cvt_pk_bf16(float lo, float hi) { unsigned r; asm volatile("v_cvt_pk_bf16_f32 %0, %1, %2" : "=v"(r) : "v"(lo), "v"(hi)); return r; }
template <class Epi, class Sched, bool ALIGN_EPI = false, bool SP2 = false>
__device__ __forceinline__ void gemm_phase(PG8_LAS unsigned char* lds, const Gemm g, const Sched& S, const Epi& E) {
    int tid = threadIdx.x; asm volatile("" : "+v"(tid));
    const int wid = __builtin_amdgcn_readfirstlane(tid >> 6), lane = tid & 63, wr = wid >> 2, wc = wid & 3, fr = lane & 15, fq = lane >> 4;
    int K = g.K; asm volatile("" : "+s"(K));
    const int nt = K / BK;
    unsigned voffA[2], voffB[2];
#pragma unroll
    for (int i = 0; i < 2; ++i) { int R, C; stage_rc(tid * 16 + i * 8192, R, C); const int Rb = Epi::PERM ? ((R & ~31) + perm32(R & 31)) : R;
        voffA[i] = (unsigned)(R * K + C) * 2u; voffB[i] = (unsigned)(Rb * K + C) * 2u; }
    const size_t kstep = (size_t)(BK * 2);
    const size_t hstep = (size_t)HALF * K * 2;
    const size_t tstep = 2 * hstep;
    const unsigned ldsw = (unsigned)wid * 1024u;
    const int aoff = lds_byte(wr * 64 + fr, fq * 8), boff = lds_byte(wc * 32 + fr, fq * 8);
#define PG8_SA(b, h) (((b) * 2 + (h)) * HTB)
#define PG8_SB(b, h) ((4 + (b) * 2 + (h)) * HTB)
#define PG8_STAGE(bufoff, gbase, voff) do { _Pragma("unroll") for (int _i = 0; _i < 2; ++_i) \
        __builtin_amdgcn_global_load_lds((const unsigned*)((const char*)(gbase) + (voff)[_i]), (PG8_LAS unsigned*)(lds + (bufoff) + ldsw + _i * 8192), 16, 0, 0); } while (0)
#define PG8_LDA(dst, b, h) do { _Pragma("unroll") for (int m = 0; m < 4; ++m) _Pragma("unroll") for (int k = 0; k < 2; ++k) dst[m][k] = *(const PG8_LAS bf16x8*)(lds + PG8_SA(b, h) + aoff + m * 2048 + k * 1024); } while (0)
#define PG8_LDB(dst, b, h) do { _Pragma("unroll") for (int n = 0; n < 2; ++n) _Pragma("unroll") for (int k = 0; k < 2; ++k) dst[n][k] = *(const PG8_LAS bf16x8*)(lds + PG8_SB(b, h) + boff + n * 2048 + k * 1024); } while (0)
#define PG8_MMA(ai, bj, At, Bt) do { __builtin_amdgcn_s_setprio(1); _Pragma("unroll") for (int m = 0; m < 4; ++m) _Pragma("unroll") for (int n = 0; n < 2; ++n) _Pragma("unroll") for (int k = 0; k < 2; ++k) \
        acc[ai][bj][m][n] = __builtin_amdgcn_mfma_f32_16x16x32_bf16(Bt[n][k], At[m][k], acc[ai][bj][m][n], 0, 0, 0); __builtin_amdgcn_s_setprio(0); } while (0)
#define PG8_WAIT_V(n) asm volatile("s_waitcnt vmcnt(" #n ")" ::: "memory")
#define PG8_WAIT_L(n) asm volatile("s_waitcnt lgkmcnt(" #n ")" ::: "memory")
#define PG8_BAR __builtin_amdgcn_s_barrier()
#define PG8_SCHED __builtin_amdgcn_sched_barrier(0)
    Unit cur, nxt; int ui = 0;
    if (!S.next(0, cur)) return;
    f32x4 acc[2][2][4][2];
#pragma unroll
    for (int a = 0; a < 2; ++a)
#pragma unroll
        for (int b = 0; b < 2; ++b)
#pragma unroll
            for (int m = 0; m < 4; ++m)
#pragma unroll
                for (int n = 0; n < 2; ++n) acc[a][b][m][n] = (f32x4){0.f, 0.f, 0.f, 0.f};
    bf16x8 At[4][2], B0[2][2], B1[2][2];
    const char* cA = (const char*)g.A + (size_t)cur.pm * tstep; const char* cB = (const char*)g.Bt + (size_t)cur.pn * tstep;
    S.a_ready(cur);
    if constexpr (SP2) {
        PG8_STAGE(PG8_SB(0, 0), cB, voffB); PG8_STAGE(PG8_SB(0, 1), cB + hstep, voffB); PG8_STAGE(PG8_SA(0, 0), cA, voffA); PG8_STAGE(PG8_SA(0, 1), cA + hstep, voffA);
        if (wr == 1) PG8_BAR;
        PG8_WAIT_V(2); PG8_BAR;
        PG8_STAGE(PG8_SB(1, 0), cB + kstep, voffB); PG8_STAGE(PG8_SA(1, 0), cA + kstep, voffA); PG8_STAGE(PG8_SB(1, 1), cB + hstep + kstep, voffB);
        PG8_WAIT_V(6); PG8_BAR;
    } else {
        PG8_STAGE(PG8_SB(0, 0), cB, voffB); PG8_STAGE(PG8_SA(0, 0), cA, voffA); PG8_STAGE(PG8_SB(0, 1), cB + hstep, voffB); PG8_STAGE(PG8_SA(0, 1), cA + hstep, voffA);
        if (wr == 1) PG8_BAR;
        PG8_WAIT_V(4); PG8_BAR;
        PG8_STAGE(PG8_SB(1, 0), cB + kstep, voffB); PG8_STAGE(PG8_SA(1, 0), cA + kstep, voffA); PG8_STAGE(PG8_SB(1, 1), cB + hstep + kstep, voffB);
        PG8_WAIT_V(6); PG8_BAR;
    }
    for (;;) {
        const bool has_next = S.next(ui + 1, nxt);
        const char* nA = has_next ? (const char*)g.A + (size_t)nxt.pm * tstep : cA; const char* nB = has_next ? (const char*)g.Bt + (size_t)nxt.pn * tstep : cB;
        for (int t = 0; t < nt; t += 2) {
            const bool last = (t == nt - 2);
            const char* a1 = cA + (size_t)(t + 1) * kstep;
            const char* a2 = last ? nA : cA + (size_t)(t + 2) * kstep; const char* b2 = last ? nB : cB + (size_t)(t + 2) * kstep;
            const char* a3 = a2 + kstep; const char* b3 = b2 + kstep;
            if (last && has_next) S.a_ready(nxt);
            if constexpr (SP2) {
            PG8_LDB(B0, 0, 0); PG8_LDB(B1, 0, 1); PG8_SCHED; PG8_LDA(At, 0, 0); PG8_STAGE(PG8_SA(1, 1), a1 + hstep, voffA);
            PG8_WAIT_V(8); PG8_WAIT_L(0); PG8_BAR; PG8_MMA(0, 0, At, B0); PG8_MMA(0, 1, At, B1); PG8_BAR; PG8_SCHED;
            PG8_LDA(At, 0, 1); PG8_STAGE(PG8_SB(0, 0), b2, voffB); PG8_STAGE(PG8_SB(0, 1), b2 + hstep, voffB); PG8_STAGE(PG8_SA(0, 0), a2, voffA);
            PG8_WAIT_V(8); PG8_WAIT_L(0); PG8_BAR; PG8_MMA(1, 0, At, B0); PG8_MMA(1, 1, At, B1); PG8_BAR; PG8_SCHED;
            PG8_LDB(B0, 1, 0); PG8_LDB(B1, 1, 1); PG8_SCHED; PG8_LDA(At, 1, 0); PG8_STAGE(PG8_SA(0, 1), a2 + hstep, voffA);
            PG8_WAIT_V(8); PG8_WAIT_L(0); PG8_BAR; PG8_MMA(0, 0, At, B0); PG8_MMA(0, 1, At, B1); PG8_BAR; PG8_SCHED;
            PG8_LDA(At, 1, 1); PG8_STAGE(PG8_SB(1, 0), b3, voffB); PG8_STAGE(PG8_SB(1, 1), b3 + hstep, voffB); PG8_STAGE(PG8_SA(1, 0), a3, voffA);
            PG8_WAIT_V(8); PG8_WAIT_L(0); PG8_BAR; PG8_MMA(1, 0, At, B0); PG8_MMA(1, 1, At, B1); PG8_BAR; PG8_SCHED;
            } else {
            PG8_LDB(B0, 0, 0); PG8_SCHED; PG8_LDA(At, 0, 0); PG8_STAGE(PG8_SA(1, 1), a1 + hstep, voffA);
            PG8_WAIT_L(8); PG8_BAR; PG8_WAIT_L(0); PG8_MMA(0, 0, At, B0); PG8_BAR; PG8_SCHED;
            PG8_LDB(B1, 0, 1); PG8_STAGE(PG8_SB(0, 0), b2, voffB);
            PG8_BAR; PG8_WAIT_L(0); PG8_MMA(0, 1, At, B1); PG8_BAR;
            PG8_LDA(At, 0, 1); PG8_STAGE(PG8_SA(0, 0), a2, voffA);
            PG8_BAR; PG8_WAIT_L(0); PG8_MMA(1, 0, At, B0); PG8_BAR; PG8_SCHED;
            PG8_STAGE(PG8_SB(0, 1), b2 + hstep, voffB);
            PG8_WAIT_V(6); PG8_BAR; PG8_MMA(1, 1, At, B1); PG8_BAR;
            PG8_LDB(B0, 1, 0); PG8_SCHED; PG8_LDA(At, 1, 0); PG8_STAGE(PG8_SA(0, 1), a2 + hstep, voffA);
            PG8_WAIT_L(8); PG8_BAR; PG8_WAIT_L(0); PG8_MMA(0, 0, At, B0); PG8_BAR; PG8_SCHED;
            PG8_LDB(B1, 1, 1); PG8_STAGE(PG8_SB(1, 0), b3, voffB);
            PG8_BAR; PG8_WAIT_L(0); PG8_MMA(0, 1, At, B1); PG8_BAR;
            PG8_LDA(At, 1, 1); PG8_STAGE(PG8_SA(1, 0), a3, voffA);
            PG8_BAR; PG8_WAIT_L(0); PG8_MMA(1, 0, At, B0); PG8_BAR; PG8_SCHED;
            PG8_STAGE(PG8_SB(1, 1), b3 + hstep, voffB);
            PG8_WAIT_V(6); PG8_BAR; PG8_MMA(1, 1, At, B1); PG8_BAR;
            }
        }
        if constexpr (ALIGN_EPI) { if (wr == 0) PG8_BAR; }
        if constexpr (!Epi::AFTER_DRAIN) { int fr_e = fr, fq_e = fq; asm volatile("" : "+v"(fr_e), "+v"(fq_e));
            E(acc, cur, wr, wc, fr_e, fq_e); S.done(cur); }
        if (!has_next) break;
#pragma unroll
        for (int a = 0; a < 2; ++a)
#pragma unroll
            for (int b = 0; b < 2; ++b)
#pragma unroll
                for (int m = 0; m < 4; ++m)
#pragma unroll
                    for (int n = 0; n < 2; ++n) acc[a][b][m][n] = (f32x4){0.f, 0.f, 0.f, 0.f};
        cur = nxt; cA = nA; cB = nB; ++ui;
        if constexpr (ALIGN_EPI) { if (wr == 1) PG8_BAR; }
    }
    PG8_WAIT_V(0);
    if constexpr (!ALIGN_EPI) { if (wr == 0) PG8_BAR; }
    PG8_BAR;
    if constexpr (Epi::AFTER_DRAIN) { E.fused(acc, cur, wr, wc, fr, fq, lds, wid, lane); S.done(cur); }
#undef PG8_SA
#undef PG8_SB
#undef PG8_STAGE
#undef PG8_LDA
#undef PG8_LDB
#undef PG8_MMA
#undef PG8_WAIT_V
#undef PG8_WAIT_L
#undef PG8_BAR
#undef PG8_SCHED
}
}

constexpr int D = 2048, T = 4096, NB = 2, M = NB * T;
constexpr int MS = 8;
constexpr int HD = 128, NH = 8, SBW = NH * HD, GW = NH * HD;
constexpr int CONVCH = 3 * GW;
constexpr int IN_COLS = 7184, NPROJ_PAD = 7424;
constexpr int DFF = 5504, NGU = 2 * DFF;
constexpr int PLE = 256;
constexpr int PAST = 16384, PAGE = 128, NPAGES = PAST / PAGE, NPOOL = 1280;
constexpr float EPS = 1e-6f;
constexpr float SB_SCALE = 0.08838834764831845f;
constexpr int O_SB_K = 1024, O_SB_V = 2048, O_GQKV = 3072, O_GZ = 6144, O_GA = 7168, O_GB = 7176;

constexpr size_t OUT_Y = 0;
constexpr size_t OUT_YS = OUT_Y + (size_t)M * D;
constexpr size_t OUT_K = OUT_YS + (size_t)MS * D;
constexpr size_t OUT_V = OUT_K + (size_t)M * SBW;
constexpr size_t OUT_GCONV = OUT_V + (size_t)M * SBW;
constexpr size_t OUT_GREC = OUT_GCONV + (size_t)NB * 3 * CONVCH;
constexpr size_t OUT_FCONV = OUT_GREC + (size_t)NB * NH * HD * HD;
constexpr size_t OUT_KS = OUT_FCONV + (size_t)NB * 2 * DFF;
constexpr size_t OUT_VS = OUT_KS + (size_t)MS * SBW;
constexpr size_t OUT_GCONVS = OUT_VS + (size_t)MS * SBW;
constexpr size_t OUT_GRECS = OUT_GCONVS + (size_t)MS * 3 * CONVCH;
constexpr size_t OUT_FCONVS = OUT_GRECS + (size_t)MS * NH * HD * HD;
constexpr size_t OUT_END = OUT_FCONVS + (size_t)MS * 2 * DFF;

namespace pg8 {
__device__ __forceinline__ float silu_f(float x) { return x * __builtin_amdgcn_rcpf(1.0f + __expf(-x)); }
__device__ __forceinline__ float sigmoid_f(float x) { return __builtin_amdgcn_rcpf(1.0f + __expf(-x)); }
__device__ __forceinline__ float softplus_f(float x) { return fmaxf(x, 0.f) + log1pf(__expf(-fabsf(x))); }
typedef unsigned u32x2 __attribute__((ext_vector_type(2)));

struct EpiProj {
    static constexpr bool PERM = true, AFTER_DRAIN = false;
    bf16_t *Qb, *Kb, *Vb, *CIN, *Zb; float *outK, *outV, *outGconv; float *G, *BETA; const float *a_log, *dt_bias;
    __device__ __forceinline__ void operator()(const f32x4 (&acc)[2][2][4][2], const Unit& u, int wr, int wc, int fr, int fq) const {
        const int reg = u.pn >> 2;
#pragma unroll
        for (int ai = 0; ai < 2; ++ai)
#pragma unroll
            for (int m = 0; m < 4; ++m) {
                const int r = u.pm * BM + ai * HALF + wr * 64 + m * 16 + fr;
#pragma unroll
                for (int bj = 0; bj < 2; ++bj) {
                    const int c8 = u.pn * BM + bj * HALF + wc * 32 + 8 * fq;
                    const f32x4 v0 = acc[ai][bj][m][0], v1 = acc[ai][bj][m][1];
                    u32x4 w; w.x = cvt_pk_bf16(v0[0], v0[1]); w.y = cvt_pk_bf16(v0[2], v0[3]); w.z = cvt_pk_bf16(v1[0], v1[1]); w.w = cvt_pk_bf16(v1[2], v1[3]);
                    if (reg == 0) { *(u32x4*)(Qb + (size_t)r * SBW + c8) = w; }
                    else if (reg == 1) { const int c = c8 - O_SB_K; *(u32x4*)(Kb + (size_t)r * SBW + c) = w; float* o = outK + (size_t)r * SBW + c; *(f32x4*)o = v0; *(f32x4*)(o + 4) = v1; }
                    else if (reg == 2) { const int c = c8 - O_SB_V; *(u32x4*)(Vb + (size_t)r * SBW + c) = w; float* o = outV + (size_t)r * SBW + c; *(f32x4*)o = v0; *(f32x4*)(o + 4) = v1; }
                    else if (reg < 6) { const int c = c8 - O_GQKV; *(u32x4*)(CIN + (size_t)r * CONVCH + c) = w;
                        const int t = r & (T - 1); if (t >= T - 3) { float* o = outGconv + ((size_t)(r >> 12) * 3 + (t - (T - 3))) * CONVCH + c; *(f32x4*)o = v0; *(f32x4*)(o + 4) = v1; } }
                    else if (reg == 6) { const int c = c8 - O_GZ; *(u32x4*)(Zb + (size_t)r * GW + c) = w; }
                    else if (bj == 0 && wc == 0 && fq < 2 && u.pn == 28) {
                        float x[8] = {v0[0], v0[1], v0[2], v0[3], v1[0], v1[1], v1[2], v1[3]}; float y[8];
#pragma unroll
                        for (int h = 0; h < 8; ++h) y[h] = (fq == 0) ? -__expf(a_log[h]) * softplus_f(x[h] + dt_bias[h]) : sigmoid_f(x[h]);
                        float* o = (fq == 0 ? G : BETA) + (size_t)r * NH; *(f32x4*)o = (f32x4){y[0], y[1], y[2], y[3]}; *(f32x4*)(o + 4) = (f32x4){y[4], y[5], y[6], y[7]};
                    }
                }
            }
    }
};

struct EpiBf16 {
    static constexpr bool PERM = true, AFTER_DRAIN = false;
    bf16_t* O; int ldc;
    __device__ __forceinline__ void operator()(const f32x4 (&acc)[2][2][4][2], const Unit& u, int wr, int wc, int fr, int fq) const {
#pragma unroll
        for (int ai = 0; ai < 2; ++ai)
#pragma unroll
            for (int m = 0; m < 4; ++m) { const int r = u.pm * BM + ai * HALF + wr * 64 + m * 16 + fr;
#pragma unroll
                for (int bj = 0; bj < 2; ++bj) { const int c8 = u.pn * BM + bj * HALF + wc * 32 + 8 * fq; const f32x4 v0 = acc[ai][bj][m][0], v1 = acc[ai][bj][m][1];
                    u32x4 w; w.x = cvt_pk_bf16(v0[0], v0[1]); w.y = cvt_pk_bf16(v0[2], v0[3]); w.z = cvt_pk_bf16(v1[0], v1[1]); w.w = cvt_pk_bf16(v1[2], v1[3]);
                    *(u32x4*)(O + (size_t)r * ldc + c8) = w; } }
    }
};

__device__ __forceinline__ float bflo(unsigned w) { return __builtin_bit_cast(float, w << 16); }
__device__ __forceinline__ float bfhi(unsigned w) { return __builtin_bit_cast(float, w & 0xffff0000u); }
template <bool BF> struct EpiResid {
    static constexpr bool PERM = true, AFTER_DRAIN = false;
    const void* base; bf16_t* Hb; float* sumsq; int ldc;
    __device__ __forceinline__ void operator()(const f32x4 (&acc)[2][2][4][2], const Unit& u, int wr, int wc, int fr, int fq) const {
#pragma unroll
        for (int ai = 0; ai < 2; ++ai)
#pragma unroll
            for (int m = 0; m < 4; ++m) { const int r = u.pm * BM + ai * HALF + wr * 64 + m * 16 + fr; float ss = 0.f;
#pragma unroll
                for (int bj = 0; bj < 2; ++bj) { const int c8 = u.pn * BM + bj * HALF + wc * 32 + 8 * fq; const size_t off = (size_t)r * ldc + c8;
                    float b[8];
                    if (BF) { const u32x4 w = *(const u32x4*)((const bf16_t*)base + off); b[0] = bflo(w.x); b[1] = bfhi(w.x); b[2] = bflo(w.y); b[3] = bfhi(w.y); b[4] = bflo(w.z); b[5] = bfhi(w.z); b[6] = bflo(w.w); b[7] = bfhi(w.w); }
                    else { const f32x4 b0 = *(const f32x4*)((const float*)base + off), b1 = *(const f32x4*)((const float*)base + off + 4); b[0] = b0[0]; b[1] = b0[1]; b[2] = b0[2]; b[3] = b0[3]; b[4] = b1[0]; b[5] = b1[1]; b[6] = b1[2]; b[7] = b1[3]; }
                    float h[8];
#pragma unroll
                    for (int j = 0; j < 4; ++j) { h[j] = b[j] + acc[ai][bj][m][0][j]; h[4 + j] = b[4 + j] + acc[ai][bj][m][1][j]; }
#pragma unroll
                    for (int j = 0; j < 8; ++j) ss += h[j] * h[j];
                    u32x4 w; w.x = cvt_pk_bf16(h[0], h[1]); w.y = cvt_pk_bf16(h[2], h[3]); w.z = cvt_pk_bf16(h[4], h[5]); w.w = cvt_pk_bf16(h[6], h[7]);
                    *(u32x4*)(Hb + off) = w; }
                ss += __shfl_xor(ss, 16); ss += __shfl_xor(ss, 32);
                if (fq == 0) unsafeAtomicAdd(sumsq + r, ss); }
    }
};

struct EpiGateUp {
    static constexpr bool PERM = true, AFTER_DRAIN = false;
    const float* sumsq; const float* convw; bf16_t* ACT; float* TAIL; float* FIXG; float* FIXU; float* outFconv; PG8_LAS float* halo;
    __device__ __forceinline__ void operator()(const f32x4 (&acc)[2][2][4][2], const Unit& u, int wr, int wc, int fr, int fq) const {
        const int lane = fr + 16 * fq;
        const int cg = u.pn * HALF + wc * 32 + 8 * fq;
        float w0[8], w1[8], w2[8];
#pragma unroll
        for (int j = 0; j < 8; ++j) { w0[j] = convw[cg + j]; w1[j] = convw[DFF + cg + j]; w2[j] = convw[2 * DFF + cg + j]; }
        float gp[2][4][8], up[2][4][8];
#pragma unroll
        for (int ai = 0; ai < 2; ++ai)
#pragma unroll
            for (int m = 0; m < 4; ++m) { const int r = u.pm * BM + ai * HALF + wr * 64 + m * 16 + fr; const float rs = rsqrtf(sumsq[r] * (1.0f / D) + EPS);
#pragma unroll
                for (int n = 0; n < 2; ++n)
#pragma unroll
                    for (int j = 0; j < 4; ++j) { gp[ai][m][4 * n + j] = acc[ai][0][m][n][j] * rs; up[ai][m][4 * n + j] = acc[ai][1][m][n][j] * rs; } }
        if (fr >= 14) {
#pragma unroll
            for (int ai = 0; ai < 2; ++ai) { PG8_LAS float* hp = halo + ((wc * 4 + (2 * ai + wr)) * 2 + (fr - 14)) * 32 + 8 * fq;
                *(PG8_LAS f32x4*)hp = (f32x4){gp[ai][3][0], gp[ai][3][1], gp[ai][3][2], gp[ai][3][3]}; *(PG8_LAS f32x4*)(hp + 4) = (f32x4){gp[ai][3][4], gp[ai][3][5], gp[ai][3][6], gp[ai][3][7]}; }
        }
        asm volatile("s_waitcnt lgkmcnt(0)" ::: "memory"); __builtin_amdgcn_s_barrier(); asm volatile("" ::: "memory");
        const int src1 = (lane & 48) | ((fr - 1) & 15), src2 = (lane & 48) | ((fr - 2) & 15);
#pragma unroll
        for (int ai = 0; ai < 2; ++ai) {
            const int B = 2 * ai + wr;
            float h62[8], h63[8];
            if (B > 0) { const PG8_LAS float* hp = halo + ((wc * 4 + (B - 1)) * 2) * 32 + 8 * fq;
                const f32x4 a0 = *(const PG8_LAS f32x4*)hp, a1 = *(const PG8_LAS f32x4*)(hp + 4), b0 = *(const PG8_LAS f32x4*)(hp + 32), b1 = *(const PG8_LAS f32x4*)(hp + 36);
#pragma unroll
                for (int j = 0; j < 4; ++j) { h62[j] = a0[j]; h62[4 + j] = a1[j]; h63[j] = b0[j]; h63[4 + j] = b1[j]; } }
            else {
#pragma unroll
                for (int j = 0; j < 8; ++j) { h62[j] = 0.f; h63[j] = 0.f; } }
            float ps1[8], ps2[8];
#pragma unroll
            for (int j = 0; j < 8; ++j) { ps1[j] = h63[j]; ps2[j] = (fr == 0) ? h62[j] : h63[j]; }
#pragma unroll
            for (int m = 0; m < 4; ++m) {
                const int r = u.pm * BM + ai * HALF + wr * 64 + m * 16 + fr;
                float gate[8], a[8];
#pragma unroll
                for (int j = 0; j < 8; ++j) {
                    const float s1 = __shfl(gp[ai][m][j], src1), s2 = __shfl(gp[ai][m][j], src2);
                    const float p1 = (fr >= 1) ? s1 : ps1[j], p2 = (fr >= 2) ? s2 : ps2[j];
                    ps1[j] = s1; ps2[j] = s2;
                    gate[j] = w0[j] * p2 + w1[j] * p1 + w2[j] * gp[ai][m][j];
                    a[j] = silu_f(gate[j]) * up[ai][m][j];
                }
                u32x4 w; w.x = cvt_pk_bf16(a[0], a[1]); w.y = cvt_pk_bf16(a[2], a[3]); w.z = cvt_pk_bf16(a[4], a[5]); w.w = cvt_pk_bf16(a[6], a[7]);
                *(u32x4*)(ACT + (size_t)r * DFF + cg) = w;
                if (B == 0 && m == 0 && fr < 2 && (u.pm & 15) != 0) {
                    float* fg = FIXG + ((size_t)u.pm * 2 + fr) * DFF + cg; float* fu = FIXU + ((size_t)u.pm * 2 + fr) * DFF + cg;
                    *(f32x4*)fg = (f32x4){gate[0], gate[1], gate[2], gate[3]}; *(f32x4*)(fg + 4) = (f32x4){gate[4], gate[5], gate[6], gate[7]};
                    *(f32x4*)fu = (f32x4){up[ai][m][0], up[ai][m][1], up[ai][m][2], up[ai][m][3]}; *(f32x4*)(fu + 4) = (f32x4){up[ai][m][4], up[ai][m][5], up[ai][m][6], up[ai][m][7]};
                }
                if (B == 3 && m == 3 && fr >= 14) {
                    float* tp = TAIL + ((size_t)u.pm * 2 + (fr - 14)) * DFF + cg;
                    *(f32x4*)tp = (f32x4){gp[ai][m][0], gp[ai][m][1], gp[ai][m][2], gp[ai][m][3]}; *(f32x4*)(tp + 4) = (f32x4){gp[ai][m][4], gp[ai][m][5], gp[ai][m][6], gp[ai][m][7]};
                    if ((u.pm & 15) == 15) { float* op = outFconv + ((size_t)(u.pm >> 4) * 2 + (fr - 14)) * DFF + cg;
                        *(f32x4*)op = (f32x4){gp[ai][m][0], gp[ai][m][1], gp[ai][m][2], gp[ai][m][3]}; *(f32x4*)(op + 4) = (f32x4){gp[ai][m][4], gp[ai][m][5], gp[ai][m][6], gp[ai][m][7]}; }
                }
            }
        }
    }
};

struct EpiPle {
    static constexpr bool PERM = true, AFTER_DRAIN = false;
    const bf16_t* H2; const bf16_t* PP; const float* sumsq2; float* H3; float* sumsq3; int ldc;
    __device__ __forceinline__ void operator()(const f32x4 (&acc)[2][2][4][2], const Unit& u, int wr, int wc, int fr, int fq) const {
#pragma unroll
        for (int ai = 0; ai < 2; ++ai)
#pragma unroll
            for (int m = 0; m < 4; ++m) { const int r = u.pm * BM + ai * HALF + wr * 64 + m * 16 + fr; float ss = 0.f;
                const float rs = rsqrtf(sumsq2[r] * (1.0f / D) + EPS);
#pragma unroll
                for (int bj = 0; bj < 2; ++bj) { const int c8 = u.pn * BM + bj * HALF + wc * 32 + 8 * fq; const size_t off = (size_t)r * ldc + c8;
                    const u32x4 hw = *(const u32x4*)(H2 + off), pw = *(const u32x4*)(PP + off);
                    const float hb[8] = {bflo(hw.x), bfhi(hw.x), bflo(hw.y), bfhi(hw.y), bflo(hw.z), bfhi(hw.z), bflo(hw.w), bfhi(hw.w)};
                    const float pb[8] = {bflo(pw.x), bfhi(pw.x), bflo(pw.y), bfhi(pw.y), bflo(pw.z), bfhi(pw.z), bflo(pw.w), bfhi(pw.w)};
                    float h[8];
#pragma unroll
                    for (int j = 0; j < 4; ++j) { h[j] = hb[j] + pb[j] * sigmoid_f(acc[ai][bj][m][0][j] * rs); h[4 + j] = hb[4 + j] + pb[4 + j] * sigmoid_f(acc[ai][bj][m][1][j] * rs); }
#pragma unroll
                    for (int j = 0; j < 8; ++j) ss += h[j] * h[j];
                    *(f32x4*)(H3 + off) = (f32x4){h[0], h[1], h[2], h[3]}; *(f32x4*)(H3 + off + 4) = (f32x4){h[4], h[5], h[6], h[7]}; }
                ss += __shfl_xor(ss, 16); ss += __shfl_xor(ss, 32);
                if (fq == 0) unsafeAtomicAdd(sumsq3 + r, ss); }
    }
};
}

constexpr size_t MiB = 1u << 20;
constexpr size_t WS_CTL = 0, CTL_ZERO_BYTES = 1 * MiB;
constexpr int CW_QUEUE = 1024;
constexpr int CW_BAR = 4096;
constexpr int CW_SUMSQ1 = 32768, CW_SUMSQ2 = CW_SUMSQ1 + M, CW_SUMSQ3 = CW_SUMSQ2 + M;
static_assert((CW_SUMSQ3 + M) * 4 <= (int)CTL_ZERO_BYTES, "ctl");
constexpr size_t WS_WIN = 2 * MiB;
constexpr size_t WS_WOUT = WS_WIN + (size_t)NPROJ_PAD * D * 2;
constexpr size_t WS_WGU = WS_WOUT + (size_t)D * D * 2;
constexpr size_t WS_WDN = WS_WGU + (size_t)NGU * D * 2;
constexpr size_t WS_WPG = WS_WDN + (size_t)D * DFF * 2;
constexpr size_t WS_WPP = WS_WPG + (size_t)D * D * 2;
constexpr size_t WS_XN = WS_WPP + (size_t)D * PLE * 2;
constexpr size_t WS_PB = WS_XN + (size_t)M * D * 2;
constexpr size_t WS_Q = WS_PB + (size_t)M * PLE * 2;
constexpr size_t WS_K = WS_Q + (size_t)M * SBW * 2;
constexpr size_t WS_V = WS_K + (size_t)M * SBW * 2;
constexpr size_t WS_CIN = WS_V + (size_t)M * SBW * 2;
constexpr size_t WS_Z = WS_CIN + (size_t)M * CONVCH * 2;
constexpr size_t WS_G = WS_Z + (size_t)M * GW * 2;
constexpr size_t WS_BETA = WS_G + (size_t)M * NH * 4;
constexpr size_t WS_GQ = WS_BETA + (size_t)M * NH * 4;
constexpr size_t WS_GK = WS_GQ + (size_t)M * GW * 4;
constexpr size_t WS_GV = WS_GK + (size_t)M * GW * 4;
constexpr size_t WS_GO = WS_GV + (size_t)M * GW * 4;
constexpr size_t WS_GSF = WS_GO;
constexpr size_t WS_MIX = WS_GO + (size_t)M * GW * 4;
constexpr size_t WS_H1 = WS_MIX + (size_t)M * D * 2;
constexpr size_t WS_H1B = WS_H1 + (size_t)M * D * 4;
constexpr size_t WS_ACT = WS_H1B + (size_t)M * D * 2;
constexpr size_t WS_TAIL = WS_ACT + (size_t)M * DFF * 2;
constexpr size_t WS_FIXG = WS_TAIL + (size_t)32 * 2 * DFF * 4;
constexpr size_t WS_FIXU = WS_FIXG + (size_t)32 * 2 * DFF * 4;
constexpr size_t WS_H2 = WS_FIXU + (size_t)32 * 2 * DFF * 4;
constexpr size_t WS_H2B = WS_H2 + (size_t)M * D * 4;
constexpr size_t WS_PP = WS_H2B + (size_t)M * D * 2;
constexpr size_t WS_S = WS_PP + (size_t)M * D * 4;
constexpr size_t S_A = 0;
constexpr size_t S_PROJ = S_A + MS * D;
constexpr size_t S_GQ = S_PROJ + MS * IN_COLS;
constexpr size_t S_GK = S_GQ + MS * GW;
constexpr size_t S_GV = S_GK + MS * GW;
constexpr size_t S_G = S_GV + MS * GW;
constexpr size_t S_BETA = S_G + 64;
constexpr size_t S_GO = S_BETA + 64;
constexpr size_t S_PART = S_GO + MS * GW;
constexpr int DSEG = 256, DPART = 132;
constexpr size_t S_MIX = S_PART + (size_t)MS * NH * DSEG * DPART;
constexpr size_t S_H1 = S_MIX + MS * D;
constexpr size_t S_GP = S_H1 + MS * D;
constexpr size_t S_UP = S_GP + MS * DFF;
constexpr size_t S_ACT = S_UP + MS * DFF;
constexpr size_t S_H2 = S_ACT + MS * DFF;
constexpr size_t S_PG = S_H2 + MS * D;
constexpr size_t S_PP = S_PG + MS * D;
constexpr size_t S_END = S_PP + MS * D;
constexpr size_t WS_GREC = ((WS_S + S_END * 4 + 4095) / 4096) * 4096;
constexpr size_t WS_GEG = WS_GREC + (size_t)16 * 64 * 73728;
constexpr size_t WS_DUMMY = WS_GEG + 16 * 64 * 4;
constexpr size_t WS_END = WS_DUMMY + (size_t)M * 4;

constexpr int RING_OFF = 0, RING_BYTES = 131072;
constexpr int HALO_OFF = RING_BYTES;
constexpr int LDSCTL_OFF = 151552, MISC_OFF = LDSCTL_OFF + 320;
constexpr int LDS_BYTES = 155648;
constexpr int NWAVES = 8;

#define GAS __attribute__((address_space(1)))
#define LAS __attribute__((address_space(3)))
typedef unsigned short bf16;
typedef unsigned v4u __attribute__((ext_vector_type(4)));
typedef unsigned v2u __attribute__((ext_vector_type(2)));
typedef float f32x4 __attribute__((ext_vector_type(4)));
typedef float f32x2 __attribute__((ext_vector_type(2)));
typedef GAS unsigned gu32;
typedef short bf16x8 __attribute__((ext_vector_type(8)));
typedef short s16x4 __attribute__((ext_vector_type(4)));
typedef float f32x16 __attribute__((ext_vector_type(16)));
typedef __bf16 bf16x2_t __attribute__((ext_vector_type(2)));
__device__ __forceinline__ unsigned cvt2bf(float lo, float hi) { const f32x2 v = {lo, hi}; return __builtin_bit_cast(unsigned, __builtin_convertvector(v, bf16x2_t)); }
#define RLX_AGENT __ATOMIC_RELAXED, __HIP_MEMORY_SCOPE_AGENT
#define LDS_WAIT() asm volatile("s_waitcnt lgkmcnt(0)" ::: "memory")
#define VM_WAIT() asm volatile("s_waitcnt vmcnt(0)" ::: "memory")
__device__ __forceinline__ unsigned f2bf(float f) { unsigned u = __builtin_bit_cast(unsigned, f); return (u + 0x7fffu + ((u >> 16) & 1u)) >> 16; }
__device__ __forceinline__ unsigned pk2(float lo, float hi) { return f2bf(lo) | (f2bf(hi) << 16); }
__device__ __forceinline__ float bf_lo(unsigned w) { return __builtin_bit_cast(float, w << 16); }
__device__ __forceinline__ float bf_hi(unsigned w) { return __builtin_bit_cast(float, w & 0xffff0000u); }
__device__ __forceinline__ float bf2f(bf16 b) { return __builtin_bit_cast(float, (unsigned)b << 16); }
using pg8::silu_f; using pg8::sigmoid_f; using pg8::softplus_f;

#define XB_TMO      128
#define XB_XCNT(j)  (256  + 64 * (j))
#define XB_XSUB(j)  (1280 + 64 * (j))
#define XB_XGEN(j)  (2304 + 64 * (j))
#define XB_TOP      3328
#define XB_TOPGEN   3392
#define XCD_BAR_WORDS 3456
#define XB_SPIN_CAP (1u << 18)
__device__ __forceinline__ unsigned xb_ld(unsigned* p)              { return __hip_atomic_load(p, __ATOMIC_RELAXED, __HIP_MEMORY_SCOPE_AGENT); }
__device__ __forceinline__ unsigned xb_add(unsigned* p, unsigned v) { return __hip_atomic_fetch_add(p, v, __ATOMIC_RELAXED, __HIP_MEMORY_SCOPE_AGENT); }
__device__ __forceinline__ unsigned xb_xcc_id() { return (unsigned)__builtin_amdgcn_s_getreg((3 << 11) | 20) & 0xFu; }
#define XB_SPIN(cond, bar) do { unsigned _sp = 0; while (cond) { __builtin_amdgcn_s_sleep(1); \
    if ((++_sp & 255u) == 0u) { if (xb_ld(&(bar)[XB_TMO])) break; if (_sp > XB_SPIN_CAP) { atomicAdd(&(bar)[XB_TMO], 1u); break; } } } } while (0)
struct XcdBarrier { unsigned* bar; unsigned x; volatile LAS unsigned* st; };
__device__ __forceinline__ XcdBarrier xcd_barrier_post(unsigned* bar, volatile LAS unsigned* st) {
    XcdBarrier b; b.bar = bar; b.x = xb_xcc_id(); b.st = st;
    if (threadIdx.x == 0) (void)xb_add(&bar[XB_XCNT(b.x)], 1u);
    return b;
}
__device__ __forceinline__ void xcd_barrier_complete(unsigned* bar, unsigned x, unsigned& nloc, unsigned& nx) {
    const unsigned G = gridDim.x * gridDim.y * gridDim.z;
    unsigned sum, cnt, mine, sp = 0u;
    for (;;) {
        sum = 0u; cnt = 0u; mine = 0u;
#pragma unroll
        for (unsigned j = 0; j < 16; ++j) { const unsigned c = xb_ld(&bar[XB_XCNT(j)]); sum += c; cnt += (c > 0u) ? 1u : 0u; mine = (j == x) ? c : mine; }
        if (sum == G) break;
        __builtin_amdgcn_s_sleep(1);
        if ((++sp & 255u) == 0u) { if (xb_ld(&bar[XB_TMO])) break; if (sp > XB_SPIN_CAP) { atomicAdd(&bar[XB_TMO], 1u); break; } }
    }
    nloc = mine > 0u ? mine : 1u; nx = cnt > 0u ? cnt : 1u;
}
__device__ __forceinline__ void xcd_barrier(const XcdBarrier& b) {
    asm volatile("s_waitcnt vmcnt(0)" ::: "memory");
    __syncthreads();
    if (threadIdx.x == 0) {
        unsigned* bar = b.bar;
        __builtin_amdgcn_s_waitcnt(0);
        unsigned nloc = b.st[0], nx = b.st[1];
        if (nloc == 0u) { xcd_barrier_complete(bar, b.x, nloc, nx); b.st[0] = nloc; b.st[1] = nx; }
        const unsigned old = xb_add(&bar[XB_XSUB(b.x)], 1u);
        const unsigned gen = old / nloc;
        if (old + 1u == (gen + 1u) * nloc) {
            __builtin_amdgcn_fence(__ATOMIC_RELEASE, "agent");
            asm volatile("s_waitcnt vmcnt(0)" ::: "memory");
            const unsigned og = xb_add(&bar[XB_TOP], 1u);
            const unsigned tg = og / nx;
            if (og + 1u == (tg + 1u) * nx) xb_add(&bar[XB_TOPGEN], 1u);
            else XB_SPIN(xb_ld(&bar[XB_TOPGEN]) == tg, bar);
            __builtin_amdgcn_fence(__ATOMIC_ACQUIRE, "agent");
            xb_add(&bar[XB_XGEN(b.x)], 1u);
            asm volatile("s_waitcnt vmcnt(0)" ::: "memory");
        } else {
            XB_SPIN(xb_ld(&bar[XB_XGEN(b.x)]) == gen, bar);
            __builtin_amdgcn_fence(__ATOMIC_ACQUIRE, "agent");
            asm volatile("s_waitcnt vmcnt(0)" ::: "memory");
        }
    }
    __syncthreads();
}

struct Frame {
    LAS unsigned char* lds;
    volatile LAS unsigned* MISC;
    unsigned* ctl;
    int tid, lane, wave, G, bid;
    float* out;
    unsigned char* ws;
};
__device__ __forceinline__ const float* kin(int i) {
    const unsigned char __attribute__((address_space(4)))* ka = (const unsigned char __attribute__((address_space(4)))*)__builtin_amdgcn_kernarg_segment_ptr();
    unsigned off = (unsigned)i * 8u; asm volatile("" : "+s"(off));
    return *(const float* const __attribute__((address_space(4)))*)(ka + off);
}
#define WSP(T_, off) ((T_*)(F.ws + (off)))
#define SSP(off) ((float*)(F.ws + WS_S) + (off))

__device__ __forceinline__ float wave_sum(float v) {
#pragma unroll
    for (int o = 1; o < 64; o <<= 1) v += __shfl_xor(v, o);
    return v;
}

struct TItem { const float* W; const float* ks; bf16* WT; int ldw, nvalid, K, drow, k0, n0; };
constexpr int TI_NB_IN = 113;
constexpr int TI_IN = (D / 64) * TI_NB_IN, TI_OUT = (D / 64) * (D / 64), TI_G = (D / 64) * (DFF / 64), TI_D = (DFF / 64) * (D / 64), TI_PG = TI_OUT, TI_PP = (PLE / 64) * (D / 64);
__device__ __forceinline__ int ti_count(int set) { return set == 0 ? TI_IN + TI_PP + TI_OUT : set == 1 ? 2 * TI_G : TI_D + TI_PG; }
__device__ __forceinline__ void ti_decode(Frame& F, int set, int r, TItem& t) {
    t.ks = nullptr;
    if (set == 0) {
        if (r < TI_IN) { const int kb = r / TI_NB_IN, nb = r % TI_NB_IN; t.W = kin(11); t.ldw = IN_COLS; t.nvalid = IN_COLS; t.K = D; t.WT = WSP(bf16, WS_WIN); t.drow = 64 * nb; t.k0 = 64 * kb; t.n0 = 64 * nb; return; } r -= TI_IN;
        if (r < TI_PP) { const int kb = r / (D / 64), nb = r % (D / 64); t.W = kin(26); t.ldw = D; t.nvalid = D; t.K = PLE; t.WT = WSP(bf16, WS_WPP); t.drow = 64 * nb; t.k0 = 64 * kb; t.n0 = 64 * nb; return; } r -= TI_PP;
        { const int kb = r / (D / 64), nb = r % (D / 64); t.W = kin(18); t.ldw = D; t.nvalid = D; t.K = D; t.WT = WSP(bf16, WS_WOUT); t.drow = 64 * nb; t.k0 = 64 * kb; t.n0 = 64 * nb; return; }
    } else if (set == 1) {
        const int up = r >= TI_G; if (up) r -= TI_G;
        const int kb = r / (DFF / 64), nb = r % (DFF / 64), n0 = 64 * nb;
        t.W = up ? kin(21) : kin(20); t.ks = kin(19); t.ldw = DFF; t.nvalid = DFF; t.K = D; t.WT = WSP(bf16, WS_WGU); t.drow = 256 * (n0 >> 7) + 128 * up + (n0 & 127); t.k0 = 64 * kb; t.n0 = n0; return;
    } else {
        if (r < TI_D) { const int kb = r / (D / 64), nb = r % (D / 64); t.W = kin(23); t.ldw = D; t.nvalid = D; t.K = DFF; t.WT = WSP(bf16, WS_WDN); t.drow = 64 * nb; t.k0 = 64 * kb; t.n0 = 64 * nb; return; } r -= TI_D;
        { const int kb = r / (D / 64), nb = r % (D / 64); t.W = kin(25); t.ks = kin(24); t.ldw = D; t.nvalid = D; t.K = D; t.WT = WSP(bf16, WS_WPG); t.drow = 64 * nb; t.k0 = 64 * kb; t.n0 = 64 * nb; return; }
    }
}
__device__ __forceinline__ void ti_load(const TItem& t, f32x4 (&v)[16], float (&sc)[16], int lane) {
    const int n4 = (lane & 15) * 4, kq = lane >> 4; const bool nv = (t.n0 + n4) < t.nvalid;
#pragma unroll
    for (int i = 0; i < 16; ++i) { const int kk = 4 * i + kq;
        v[i] = nv ? *(const f32x4*)(t.W + (size_t)(t.k0 + kk) * t.ldw + t.n0 + n4) : (f32x4){0.f, 0.f, 0.f, 0.f};
        sc[i] = t.ks ? t.ks[t.k0 + kk] : 1.f; }
}
__device__ __forceinline__ void ti_store(const TItem& t, const f32x4 (&v)[16], const float (&sc)[16], LAS float* scr, int lane) {
    const int n4 = (lane & 15) * 4, kq = lane >> 4;
#pragma unroll
    for (int i = 0; i < 16; ++i) { const int kk = 4 * i + kq; const f32x4 x = v[i] * sc[i]; LAS float* d = scr + kk * 65 + n4; d[0] = x.x; d[1] = x.y; d[2] = x.z; d[3] = x.w; }
    LDS_WAIT(); asm volatile("" ::: "memory");
    const int c = lane & 7;
#pragma unroll
    for (int j = 0; j < 8; ++j) { const int n = (lane >> 3) + 8 * j; const LAS float* s = scr + (8 * c) * 65 + n;
        v4u o; o.x = pk2(s[0 * 65], s[1 * 65]); o.y = pk2(s[2 * 65], s[3 * 65]); o.z = pk2(s[4 * 65], s[5 * 65]); o.w = pk2(s[6 * 65], s[7 * 65]);
        *(v4u*)(t.WT + (size_t)(t.drow + n) * t.K + t.k0 + 8 * c) = o; }
    LDS_WAIT(); asm volatile("" ::: "memory");
}
__device__ __forceinline__ void convert_set(Frame& F, int set, int wv, int nw) {
    if (wv < 0 || wv >= nw) return;
    LAS float* scr = (LAS float*)(F.lds + RING_OFF + F.wave * 16640);
    const int n = ti_count(set);
    int it = wv; if (it >= n) return;
    TItem cur, nxt; f32x4 vc[16], vn[16]; float sc[16], sn[16];
    ti_decode(F, set, it, cur); ti_load(cur, vc, sc, F.lane);
    for (;;) {
        const int itn = it + nw; const bool hn = itn < n;
        if (hn) { ti_decode(F, set, itn, nxt); ti_load(nxt, vn, sn, F.lane); }
        ti_store(cur, vc, sc, scr, F.lane);
        if (!hn) break;
        cur = nxt; it = itn;
#pragma unroll
        for (int i = 0; i < 16; ++i) { vc[i] = vn[i]; sc[i] = sn[i]; }
    }
}
__device__ __forceinline__ void rms_row(const float* xrow, const float* w, bf16* ob, float* of, int lane) {
    const f32x4* xr = (const f32x4*)xrow + lane; const f32x4* wr_ = (const f32x4*)w + lane;
    f32x4 v[8]; float s = 0.f;
#pragma unroll
    for (int j = 0; j < 8; ++j) { v[j] = xr[64 * j]; s += (v[j].x * v[j].x + v[j].y * v[j].y) + (v[j].z * v[j].z + v[j].w * v[j].w); }
    const float rstd = rsqrtf(wave_sum(s) * (1.f / D) + EPS);
#pragma unroll
    for (int j = 0; j < 8; ++j) { const f32x4 g = wr_[64 * j]; const f32x4 y = v[j] * rstd * g;
        if (ob) ((unsigned long long*)ob)[lane + 64 * j] = (unsigned long long)pk2(y.x, y.y) | ((unsigned long long)pk2(y.z, y.w) << 32);
        if (of) ((f32x4*)of)[lane + 64 * j] = y; }
}

__device__ __forceinline__ void p0_prologue(Frame& F) {
    const int gw = F.bid * NWAVES + F.wave, NGW = F.G * NWAVES;
    bf16* Win = WSP(bf16, WS_WIN);
    convert_set(F, 0, gw, NGW);
    { const size_t z0 = (size_t)7232 * D * 2, z1 = (size_t)NPROJ_PAD * D * 2; v4u* p = (v4u*)((unsigned char*)Win + z0); const size_t n16 = (z1 - z0) / 16;
      for (size_t i = (size_t)F.bid * 512 + F.tid; i < n16; i += (size_t)F.G * 512) p[i] = (v4u){0u, 0u, 0u, 0u}; }
    bf16* XN = WSP(bf16, WS_XN);
    for (int m = gw; m < M; m += NGW) rms_row(kin(0) + (size_t)m * D, kin(10), XN + (size_t)m * D, nullptr, F.lane);
    if (gw < MS) rms_row(kin(1) + (size_t)gw * D, kin(10), nullptr, SSP(S_A) + (size_t)gw * D, F.lane);
    { const f32x4* p = (const f32x4*)kin(8); v2u* o = (v2u*)WSP(bf16, WS_PB); const size_t n4 = (size_t)M * PLE / 4;
      for (size_t i = (size_t)F.bid * 512 + F.tid; i < n4; i += (size_t)F.G * 512) { const f32x4 v = p[i]; o[i] = (v2u){pk2(v.x, v.y), pk2(v.z, v.w)}; } }
}

template <class Epi>
__device__ __forceinline__ void sample_gemm(Frame& F, const float* A, int K, bool norm, const bf16* Wt, int ntiles, const Epi& E) {
    const int first = F.G - 1 - F.bid;
    if (first >= ntiles) return;
    LAS bf16* As = (LAS bf16*)(F.lds);
    LAS float* Red = (LAS float*)(F.lds + 98304);
    LAS float* Rs = (LAS float*)(F.lds + 98304 + 8192);
    const int lane = F.lane, r32 = lane & 31, hh = lane >> 5;
    __syncthreads();
    if (norm) { float s = 0.f; for (int k = lane; k < K; k += 64) { const float v = A[(size_t)F.wave * K + k]; s += v * v; } s = wave_sum(s); if (lane == 0) Rs[F.wave] = rsqrtf(s / (float)K + EPS); }
    else if (lane == 0) Rs[F.wave] = 1.f;
    __syncthreads();
    { const float rs = Rs[F.wave]; for (int k = 2 * lane; k < K; k += 128) { const f32x2 v = *(const f32x2*)(A + (size_t)F.wave * K + k); *(LAS unsigned*)(As + F.wave * K + k) = cvt2bf(v.x * rs, v.y * rs); } }
    __syncthreads();
    const int ksteps = K / 128;
    for (int tl = first; tl < ntiles; tl += F.G) {
        f32x16 acc;
#pragma unroll
        for (int i = 0; i < 16; ++i) acc[i] = 0.f;
        const bf16* wp = Wt + (size_t)(32 * tl + r32) * K + F.wave * (K / 8) + 8 * hh;
        const LAS bf16* ap = As + (r32 & 7) * K + F.wave * (K / 8) + 8 * hh;
#pragma unroll 4
        for (int ks = 0; ks < ksteps; ++ks) {
            const bf16x8 bfr = *(const bf16x8*)(wp + 16 * ks);
            bf16x8 af = *(const LAS bf16x8*)(ap + 16 * ks);
            if (r32 >= 8) af = (bf16x8){0, 0, 0, 0, 0, 0, 0, 0};
            acc = __builtin_amdgcn_mfma_f32_32x32x16_bf16(af, bfr, acc, 0, 0, 0);
        }
        __syncthreads();
#pragma unroll
        for (int i = 0; i < 4; ++i) Red[(F.wave * 8 + 4 * hh + i) * 32 + r32] = acc[i];
        __syncthreads();
        if (F.tid < 256) { const int r = F.tid >> 5, c = F.tid & 31; float s = 0.f;
#pragma unroll
            for (int w = 0; w < 8; ++w) s += Red[(w * 8 + r) * 32 + c];
            E(r, 32 * tl + c, s); }
    }
    __syncthreads();
}
struct SEpiStore { float* O; int ld; int nmax; __device__ __forceinline__ void operator()(int r, int n, float v) const { if (n < nmax) O[(size_t)r * ld + n] = v; } };
struct SEpiAdd { const float* B; float* O; int ld; __device__ __forceinline__ void operator()(int r, int n, float v) const { O[(size_t)r * ld + n] = B[(size_t)r * ld + n] + v; } };
struct SEpiGateUp { float* GP; float* UP; __device__ __forceinline__ void operator()(int r, int n, float v) const { const int j = n >> 8, w = n & 255; if (w < 128) GP[(size_t)r * DFF + 128 * j + w] = v; else UP[(size_t)r * DFF + 128 * j + (w - 128)] = v; } };

__device__ __forceinline__ void gdn_prep_prompt(Frame& F) {
    const int gw = F.bid * NWAVES + F.wave, NGW = F.G * NWAVES;
    const bf16* CIN = WSP(bf16, WS_CIN); const float* cw = kin(14);
    float* GQ = WSP(float, WS_GQ); float* GK = WSP(float, WS_GK); float* GV = WSP(float, WS_GV);
    for (int it = gw; it < M * NH; it += NGW) {
        const int row = it >> 3, h = it & 7, t = row & (T - 1);
#pragma unroll
        for (int seg = 0; seg < 3; ++seg) {
            const int ch = seg * GW + h * HD + 2 * F.lane;
            float a0 = 0.f, a1 = 0.f;
#pragma unroll
            for (int j = 0; j < 4; ++j) { const int tt = t - 3 + j; if (tt >= 0) { const unsigned w = *(const unsigned*)(CIN + (size_t)(row - 3 + j) * CONVCH + ch); a0 += bf_lo(w) * cw[j * CONVCH + ch]; a1 += bf_hi(w) * cw[j * CONVCH + ch + 1]; } }
            a0 = silu_f(a0); a1 = silu_f(a1);
            float* dst = (seg == 0 ? GQ : seg == 1 ? GK : GV) + (size_t)row * GW + h * HD + 2 * F.lane;
            if (seg < 2) { const float ss = wave_sum(a0 * a0 + a1 * a1); float sc = rsqrtf(ss + 1e-6f); if (seg == 0) sc *= SB_SCALE; a0 *= sc; a1 *= sc; }
            *(f32x2*)dst = (f32x2){a0, a1};
        }
    }
}
__device__ __forceinline__ void gdn_prep_sample(Frame& F) {
    const float* PR = SSP(S_PROJ); const float* hist = kin(5); const float* cw = kin(14);
    const int gt = F.bid * 512 + F.tid, NT = F.G * 512;
    for (int i = gt; i < MS * SBW; i += NT) { const int b = i >> 10, c = i & 1023; F.out[OUT_KS + i] = PR[(size_t)b * IN_COLS + O_SB_K + c]; F.out[OUT_VS + i] = PR[(size_t)b * IN_COLS + O_SB_V + c]; }
    for (int i = gt; i < MS * 3 * CONVCH; i += NT) { const int b = i / (3 * CONVCH), rr = (i / CONVCH) % 3, c = i % CONVCH;
        F.out[OUT_GCONVS + i] = (rr < 2) ? hist[((size_t)b * 3 + rr + 1) * CONVCH + c] : PR[(size_t)b * IN_COLS + O_GQKV + c]; }
    if (gt < 64) { const int b = gt >> 3, h = gt & 7; SSP(S_G)[gt] = -__expf(kin(15)[h]) * softplus_f(PR[(size_t)b * IN_COLS + O_GA + h] + kin(16)[h]); SSP(S_BETA)[gt] = sigmoid_f(PR[(size_t)b * IN_COLS + O_GB + h]); }
    const int gw = F.bid * NWAVES + F.wave;
    if (gw < MS * NH * 3) {
        const int b = gw / (NH * 3), h = (gw / 3) % NH, seg = gw % 3;
        const int ch = seg * GW + h * HD + 2 * F.lane; float a[2];
        float hv[3][2], pv[2], wv[4][2];
#pragma unroll
        for (int e = 0; e < 2; ++e) {
#pragma unroll
            for (int j = 0; j < 3; ++j) { hv[j][e] = hist[((size_t)b * 3 + j) * CONVCH + ch + e]; wv[j][e] = cw[j * CONVCH + ch + e]; }
            pv[e] = PR[(size_t)b * IN_COLS + O_GQKV + ch + e]; wv[3][e] = cw[3 * CONVCH + ch + e]; }
#pragma unroll
        for (int e = 0; e < 2; ++e) a[e] = silu_f(hv[0][e] * wv[0][e] + hv[1][e] * wv[1][e] + hv[2][e] * wv[2][e] + pv[e] * wv[3][e]);
        float* dst = SSP(seg == 0 ? S_GQ : seg == 1 ? S_GK : S_GV) + (size_t)b * GW + h * HD + 2 * F.lane;
        if (seg < 2) { const float ss = wave_sum(a[0] * a[0] + a[1] * a[1]); float sc = rsqrtf(ss + 1e-6f); if (seg == 0) sc *= SB_SCALE; a[0] *= sc; a[1] *= sc; }
        dst[0] = a[0]; dst[1] = a[1];
    }
}

template <bool PIPE>
__device__ __forceinline__ void gdn_recur_wave(const float* GQ, const float* GK, const float* GV, const float* Gg, const float* Gb, int ld, int gld, size_t row0, int ntok, int h, int slice,
                                               const float* S0, float* Sout, float* GO, int lane) {
    const int e = 4 * slice + (lane >> 4), d0 = 8 * (lane & 15);
    float S[8];
#pragma unroll
    for (int i = 0; i < 8; ++i) S[i] = S0 ? S0[(size_t)(d0 + i) * HD + e] : 0.f;
    constexpr int NT = PIPE ? 4 : 1;
    f32x4 ck0[NT], ck1[NT], cq0[NT], cq1[NT]; float cv[NT], cg[NT], cb[NT];
#define GDN_LOAD(dk0, dk1, dq0, dq1, dv, dg, db, tb) do { _Pragma("unroll") for (int i_ = 0; i_ < NT; ++i_) { const size_t row_ = row0 + (tb) + i_; \
        dk0[i_] = *(const f32x4*)(GK + row_ * ld + h * HD + d0); dk1[i_] = *(const f32x4*)(GK + row_ * ld + h * HD + d0 + 4); \
        dq0[i_] = *(const f32x4*)(GQ + row_ * ld + h * HD + d0); dq1[i_] = *(const f32x4*)(GQ + row_ * ld + h * HD + d0 + 4); \
        dv[i_] = GV[row_ * ld + h * HD + e]; dg[i_] = Gg[row_ * gld + h]; db[i_] = Gb[row_ * gld + h]; } } while (0)
    GDN_LOAD(ck0, ck1, cq0, cq1, cv, cg, cb, 0);
    for (int t = 0; t < ntok; t += NT) {
        f32x4 nk0[NT], nk1[NT], nq0[NT], nq1[NT]; float nv[NT], ng[NT], nb[NT];
        const int tn = (t + NT < ntok) ? t + NT : t;
        GDN_LOAD(nk0, nk1, nq0, nq1, nv, ng, nb, tn);
#pragma unroll
        for (int i = 0; i < NT; ++i) {
            const float kk[8] = {ck0[i].x, ck0[i].y, ck0[i].z, ck0[i].w, ck1[i].x, ck1[i].y, ck1[i].z, ck1[i].w}, qq[8] = {cq0[i].x, cq0[i].y, cq0[i].z, cq0[i].w, cq1[i].x, cq1[i].y, cq1[i].z, cq1[i].w};
            const float eg = __expf(cg[i]);
            float kv = 0.f;
#pragma unroll
            for (int j = 0; j < 8; ++j) kv += S[j] * kk[j];
            kv += __shfl_xor(kv, 1); kv += __shfl_xor(kv, 2); kv += __shfl_xor(kv, 4); kv += __shfl_xor(kv, 8);
            const float u = cb[i] * (cv[i] - eg * kv);
            float o = 0.f;
#pragma unroll
            for (int j = 0; j < 8; ++j) { S[j] = eg * S[j] + kk[j] * u; o += S[j] * qq[j]; }
            o += __shfl_xor(o, 1); o += __shfl_xor(o, 2); o += __shfl_xor(o, 4); o += __shfl_xor(o, 8);
            if ((lane & 15) == 0) GO[(row0 + t + i) * ld + h * HD + e] = o;
        }
#pragma unroll
        for (int i = 0; i < NT; ++i) { ck0[i] = nk0[i]; ck1[i] = nk1[i]; cq0[i] = nq0[i]; cq1[i] = nq1[i]; cv[i] = nv[i]; cg[i] = ng[i]; cb[i] = nb[i]; }
    }
#undef GDN_LOAD
#pragma unroll
    for (int i = 0; i < 8; ++i) Sout[(size_t)(d0 + i) * HD + e] = S[i];
}

__device__ __forceinline__ void sb_query_simple(Frame& F, int b, int h, int t, LAS float* qs) {
    const bf16* Qb = WSP(bf16, WS_Q); const bf16* Kb = WSP(bf16, WS_K); const bf16* Vb = WSP(bf16, WS_V); bf16* MIX = WSP(bf16, WS_MIX);
    const size_t row = (size_t)b * T + t; const int lane = F.lane;
    { const unsigned w = *(const unsigned*)(Qb + row * SBW + h * HD + 2 * lane); qs[2 * lane] = bf_lo(w); qs[2 * lane + 1] = bf_hi(w); }
    LDS_WAIT(); asm volatile("" ::: "memory");
    const float ch = kin(12)[h];
    float o0 = 0.f, o1 = 0.f, R = 0.f;
    const int nblk = (t + 63) >> 6;
    for (int blk = nblk - 1; blk >= 0; --blk) {
        const int k0 = blk * 64, key = k0 + lane; const bool valid = key < t;
        const v4u* kr = (const v4u*)(Kb + ((size_t)b * T + key) * SBW + h * HD);
        float dot = 0.f;
#pragma unroll
        for (int c = 0; c < 16; ++c) { const v4u w = kr[c]; const f32x4 qa = *(const LAS f32x4*)(qs + 8 * c), qb = *(const LAS f32x4*)(qs + 8 * c + 4);
            dot += bf_lo(w.x) * qa.x + bf_hi(w.x) * qa.y + bf_lo(w.y) * qa.z + bf_hi(w.y) * qa.w + bf_lo(w.z) * qb.x + bf_hi(w.z) * qb.y + bf_lo(w.w) * qb.z + bf_hi(w.w) * qb.w; }
        const float z = dot * SB_SCALE + ch;
        const float sp = softplus_f(z);
        const float L = valid ? -sp : 0.f, lb = z - sp;
        float s = L;
#pragma unroll
        for (int o = 1; o < 64; o <<= 1) { const float tmp = __shfl_down(s, o); if (lane + o < 64) s += tmp; }
        const float tot = __shfl(s, 0);
        const float a = valid ? __expf(lb + (s - L) + R) : 0.f;
        R += tot;
        const bf16* vr = Vb + ((size_t)b * T + k0) * SBW + h * HD + 2 * lane;
#pragma unroll 8
        for (int j = 0; j < 64; ++j) { const float aj = __shfl(a, j); const unsigned w = *(const unsigned*)(vr + (size_t)j * SBW); o0 += aj * bf_lo(w); o1 += aj * bf_hi(w); }
    }
    const float ss = wave_sum(o0 * o0 + o1 * o1); const float rs = rsqrtf(ss * (1.f / HD) + EPS);
    const float* nw = kin(13);
    *(unsigned*)(MIX + row * D + h * HD + 2 * lane) = pk2(o0 * rs * nw[2 * lane], o1 * rs * nw[2 * lane + 1]);
}

__device__ __forceinline__ void sb_decode_block(Frame& F, int bh, int blk) {
    const int b = bh >> 3, h = bh & 7;
    const float* q = SSP(S_PROJ) + (size_t)b * IN_COLS + h * HD;
    const float* CK = kin(2); const float* CV = kin(3); const int* PT = (const int*)kin(4);
    int lane = F.lane; asm volatile("" : "+v"(lane));
    const int half = lane >> 5, l32 = lane & 31;
    const f32x4 q4 = *(const f32x4*)(q + 4 * l32);
    const float k2 = kin(12)[h] * 1.4426950408889634f, k1 = SB_SCALE * 1.4426950408889634f;
    const int p0 = blk * 64;
    const int page = PT[b * NPAGES + (p0 >> 7)];
    const size_t base = (((size_t)page * PAGE + (p0 & 127)) * NH + h) * HD;
    int zi = 0;
#pragma unroll
    for (int hb = 0; hb < 2; ++hb) {
        f32x4 kv[16];
#pragma unroll
        for (int i = 0; i < 16; ++i) kv[i] = *(const f32x4*)(CK + base + (size_t)(32 * hb + 2 * i + half) * (NH * HD) + 4 * l32);
#pragma unroll
        for (int i = 0; i < 16; ++i) {
            float p = (kv[i].x * q4.x + kv[i].y * q4.y) + (kv[i].z * q4.z + kv[i].w * q4.w);
            p += __shfl_xor(p, 1); p += __shfl_xor(p, 2); p += __shfl_xor(p, 4); p += __shfl_xor(p, 8); p += __shfl_xor(p, 16);
            const int pe = __builtin_amdgcn_readlane(__builtin_bit_cast(int, p), 0), po = __builtin_amdgcn_readlane(__builtin_bit_cast(int, p), 32);
            asm volatile("s_nop 3\n\tv_writelane_b32 %0, %1, %2" : "+v"(zi) : "s"(pe), "i"(32 * hb + 2 * i)); asm volatile("v_writelane_b32 %0, %1, %2" : "+v"(zi) : "s"(po), "i"(32 * hb + 2 * i + 1));
        }
    }
    const float z = __builtin_bit_cast(float, zi);
    const float e = __builtin_amdgcn_exp2f(-(z * k1 + k2));
    const float be = __builtin_amdgcn_rcpf(1.0f + e), m = 1.0f - be;
    float s = m;
#pragma unroll
    for (int o = 1; o < 64; o <<= 1) { const float t = __shfl_down(s, o); if (lane + o < 64) s *= t; }
    const float tot = __shfl(s, 0);
    const float sx = __shfl_down(s, 1);
    const float a = be * (lane < 63 ? sx : 1.0f);
    f32x4 o4 = {0.f, 0.f, 0.f, 0.f};
#pragma unroll
    for (int hb = 0; hb < 2; ++hb) {
        f32x4 vv[16];
#pragma unroll
        for (int i = 0; i < 16; ++i) vv[i] = *(const f32x4*)(CV + base + (size_t)(32 * hb + 2 * i + half) * (NH * HD) + 4 * l32);
#pragma unroll
        for (int i = 0; i < 16; ++i) { const float aj = __shfl(a, 32 * hb + 2 * i + half); o4 += aj * vv[i]; }
    }
    o4.x += __shfl_xor(o4.x, 32); o4.y += __shfl_xor(o4.y, 32); o4.z += __shfl_xor(o4.z, 32); o4.w += __shfl_xor(o4.w, 32);
    float* P = SSP(S_PART) + ((size_t)bh * DSEG + blk) * DPART;
    if (half == 0) *(f32x4*)(P + 4 * l32) = o4; if (lane == 0) P[128] = tot;
}
__device__ __forceinline__ void sb_decode_pull(Frame& F, unsigned* qctr, volatile LAS unsigned* stop) {
    for (;;) {
        if (stop && __builtin_amdgcn_readfirstlane(*stop) != 0u) break;
        const unsigned v = __hip_atomic_fetch_add(qctr, 1u, __ATOMIC_RELAXED, __HIP_MEMORY_SCOPE_AGENT);
        const int it = (int)(__builtin_amdgcn_readfirstlane(v) >> 6);
        if (it >= MS * NH * DSEG) break;
        sb_decode_block(F, ((it >> 11) << 3) | (it & 7), (it >> 3) & 255);
    }
}

__device__ __forceinline__ unsigned offb(unsigned row, unsigned ch) { return 256u * row + 16u * (ch ^ (((row & 3u) << 2) | ((row >> 2) & 3u))); }
constexpr float LOG2E = 1.4426950408889634f;

__device__ __forceinline__ void sb_attn_unit(Frame& F, int b, int h, int qb) {
    const bf16* Qb = WSP(bf16, WS_Q); const bf16* Kb = WSP(bf16, WS_K); const bf16* Vb = WSP(bf16, WS_V); bf16* MIX = WSP(bf16, WS_MIX);
    const int lane = F.lane, r32 = lane & 31, hh = lane >> 5;
    const int q0w = 256 * qb + 32 * F.wave;
    LAS unsigned char* KB0 = F.lds + RING_OFF; LAS unsigned char* VB0 = F.lds + RING_OFF + 32768;
    bf16x8 qf[8];
    { const bf16* qp = Qb + ((size_t)b * T + q0w + r32) * SBW + h * HD + 8 * hh;
#pragma unroll
      for (int s = 0; s < 8; ++s) qf[s] = *(const bf16x8*)(qp + 16 * s); }
    const float k1 = SB_SCALE * LOG2E, k2 = kin(12)[h] * LOG2E;
    f32x16 oacc[4];
#pragma unroll
    for (int d = 0; d < 4; ++d)
#pragma unroll
        for (int i = 0; i < 16; ++i) oacc[d][i] = 0.f;
    float R = 1.f;
    const int nt = 4 * qb + 4;
    const int srow = F.tid >> 4, sch = F.tid & 15;
    const size_t gbase = ((size_t)b * T) * SBW + h * HD + sch * 8;
    v4u rk[2], rv[2];
#define SB_LOAD(k0_) do { _Pragma("unroll") for (int i_ = 0; i_ < 2; ++i_) { const size_t o_ = gbase + (size_t)((k0_) + srow + 32 * i_) * SBW; rk[i_] = *(const v4u*)(Kb + o_); rv[i_] = *(const v4u*)(Vb + o_); } } while (0)
    const unsigned kwo = (unsigned)((sch >> 1) * 1024 + srow * 32 + (((sch & 1) ^ ((srow >> 3) & 1)) * 16));
    const unsigned vwo = (unsigned)((((srow >> 3) * 4 + (sch >> 2)) * 512) + (srow & 7) * 64 + (sch & 3) * 16);
#define SB_WRITE(buf_) do { _Pragma("unroll") for (int i_ = 0; i_ < 2; ++i_) { *(LAS v4u*)(KB0 + (buf_) * 16384 + kwo + i_ * 8192) = rk[i_]; *(LAS v4u*)(VB0 + (buf_) * 16384 + vwo + i_ * 8192) = rv[i_]; } } while (0)
    SB_LOAD(64 * (nt - 1)); SB_WRITE(0);
    __syncthreads();
    const int tq = (lane & 15) >> 2, tp = lane & 3, tblk = (lane >> 4) & 1;
    const unsigned kro = (unsigned)(r32 * 32 + ((hh ^ ((r32 >> 3) & 1)) * 16));
    const unsigned vro = (unsigned)((4 * hh + tq) * 64 + tblk * 32 + tp * 8);
    for (int it = 0; it < nt; ++it) {
        const int kt = nt - 1 - it, buf = it & 1, k0 = 64 * kt;
        if (it + 1 < nt) SB_LOAD(64 * (kt - 1));
        if (k0 < q0w + 31) {
            const bool diag = (k0 + 63 >= q0w);
            LAS unsigned char* Kt = KB0 + buf * 16384; LAS unsigned char* Vt = VB0 + buf * 16384;
            f32x16 sacc[2];
#pragma unroll
            for (int kb = 0; kb < 2; ++kb) {
#pragma unroll
                for (int i = 0; i < 16; ++i) sacc[kb][i] = 0.f;
#pragma unroll
                for (int s = 0; s < 8; ++s) { const bf16x8 kf = *(const LAS bf16x8*)(Kt + kro + (kb * 8 + s) * 1024); sacc[kb] = __builtin_amdgcn_mfma_f32_32x32x16_bf16(kf, qf[s], sacc[kb], 0, 0, 0); }
            }
            float after = R;
            unsigned pp[2][8];
            const int qabs = q0w + r32;
#define SB_TILE(DIAG_) do { _Pragma("unroll") for (int kb = 1; kb >= 0; --kb) _Pragma("unroll") for (int g = 3; g >= 0; --g) { \
                    float be[4], m[4]; \
                    _Pragma("unroll") for (int j = 0; j < 4; ++j) { \
                        const float e = __builtin_amdgcn_exp2f(-(sacc[kb][4 * g + j] * k1 + k2)); \
                        be[j] = __builtin_amdgcn_rcpf(1.0f + e); m[j] = 1.0f - be[j]; \
                        if (DIAG_) { const bool vd = (k0 + 32 * kb + 8 * g + 4 * hh + j) < qabs; be[j] = vd ? be[j] : 0.f; m[j] = vd ? m[j] : 1.f; } } \
                    const float s3 = m[3], s2 = m[2] * s3, s1 = m[1] * s2, s0 = m[0] * s1; \
                    const float p4 = __shfl_xor(s0, 32); \
                    const float base = after * (hh == 0 ? p4 : 1.0f); \
                    const float a0 = be[0] * s1 * base, a1 = be[1] * s2 * base, a2 = be[2] * s3 * base, a3 = be[3] * base; \
                    after *= s0 * p4; \
                    pp[kb][2 * g] = cvt2bf(a0, a1); pp[kb][2 * g + 1] = cvt2bf(a2, a3); } } while (0)
            if (diag) SB_TILE(true); else SB_TILE(false);
#undef SB_TILE
            R = after;
#pragma unroll
            for (int kb = 0; kb < 2; ++kb)
#pragma unroll
                for (int sp = 0; sp < 2; ++sp) {
                    const v4u pw = {pp[kb][4 * sp], pp[kb][4 * sp + 1], pp[kb][4 * sp + 2], pp[kb][4 * sp + 3]};
                    const bf16x8 pf = __builtin_bit_cast(bf16x8, pw);
                    const int keybase = 32 * kb + 16 * sp;
#pragma unroll
                    for (int db = 0; db < 4; ++db) {
                        const s16x4 lo = __builtin_amdgcn_ds_read_tr16_b64_v4i16((LAS s16x4*)(Vt + vro + ((keybase >> 3) * 4 + db) * 512));
                        const s16x4 hi = __builtin_amdgcn_ds_read_tr16_b64_v4i16((LAS s16x4*)(Vt + vro + (((keybase >> 3) + 1) * 4 + db) * 512));
                        const bf16x8 vf = __builtin_shufflevector(lo, hi, 0, 1, 2, 3, 4, 5, 6, 7);
                        oacc[db] = __builtin_amdgcn_mfma_f32_32x32x16_bf16(vf, pf, oacc[db], 0, 0, 0);
                    }
                }
        }
        if (it + 1 < nt) SB_WRITE(buf ^ 1);
        __syncthreads();
    }
#undef SB_LOAD
#undef SB_WRITE
    float ss = 0.f;
#pragma unroll
    for (int d = 0; d < 4; ++d)
#pragma unroll
        for (int i = 0; i < 16; ++i) ss += oacc[d][i] * oacc[d][i];
    ss += __shfl_xor(ss, 32);
    const float rs = rsqrtf(ss * (1.f / HD) + EPS);
    const float* nw = kin(13);
    bf16* op = MIX + ((size_t)b * T + q0w + r32) * D + h * HD + 4 * hh;
#pragma unroll
    for (int d = 0; d < 4; ++d)
#pragma unroll
        for (int g = 0; g < 4; ++g) { const int dd = 32 * d + 8 * g + 4 * hh; const f32x4 w4 = *(const f32x4*)(nw + dd);
            v2u w; w.x = cvt2bf(oacc[d][4 * g] * rs * w4.x, oacc[d][4 * g + 1] * rs * w4.y); w.y = cvt2bf(oacc[d][4 * g + 2] * rs * w4.z, oacc[d][4 * g + 3] * rs * w4.w);
            *(v2u*)(op + 32 * d + 8 * g) = w; }
}

constexpr int GREC_WF = 0, GREC_KTF = 16384, GREC_UF = 32768, GREC_SCAN = 49152  , GREC_QF = 49152, GREC_QKF = 65536, GREC_BYTES = 73728;
constexpr int NCHUNK = T / 64;
constexpr int PL_LOW = 0  , PL_TK = 16384, PL_TQ = 32768, PL_TKBG = 49152, PL_TKT = 65536, PL_TVB = 81920, PL_TT = 98304  , PL_GC = 107520  , PL_BETA = 107776, PL_CW = 108032  ;
__device__ __forceinline__ unsigned rowimg(unsigned row, unsigned c16) { return ((row >> 5) * 8 + (c16 >> 1)) * 1024 + (row & 31) * 32 + (((c16 & 1) ^ ((row >> 3) & 1)) * 16); }
__device__ __forceinline__ unsigned trimg(unsigned row, unsigned c16) { return ((row >> 3) * 4 + (c16 >> 2)) * 512 + (row & 7) * 64 + (c16 & 3) * 16; }

__device__ __forceinline__ void gdn_prep_unit(Frame& F, int chain, int ci, unsigned char* rec, float* EGp, unsigned* qctr) {
    int lane = F.lane, tid = F.tid; asm volatile("" : "+v"(lane), "+v"(tid));
    const int b = chain >> 3, h = chain & 7, r32 = lane & 31, hh = lane >> 5;
    const size_t R0 = (size_t)b * T + 64 * ci;
    unsigned lb0 = 0; asm volatile("" : "+v"(lb0));
    LAS unsigned char* L = F.lds + lb0;
    LAS float* GC = (LAS float*)(L + PL_GC); LAS float* BE = (LAS float*)(L + PL_BETA); LAS float* LOW = (LAS float*)(L + PL_LOW);
    const bf16* CIN = WSP(bf16, WS_CIN); const float* cw = kin(14);
    for (int i = tid - 64; i >= 0 && i < 4 * 3 * 128; i += 448) { const int j = i / 384, seg = (i / 128) % 3, c = i & 127; ((LAS float*)(L + PL_CW))[i] = cw[j * CONVCH + seg * GW + h * HD + c]; }
    if (tid == 0) F.MISC[16] = 0u;
    if (F.wave == 0) { float g = WSP(float, WS_G)[(R0 + lane) * NH + h];
#pragma unroll
        for (int o = 1; o < 64; o <<= 1) { const float t = __shfl_up(g, o); if (lane >= o) g += t; }
        GC[lane] = g; BE[lane] = WSP(float, WS_BETA)[(R0 + lane) * NH + h]; }
    __syncthreads();
    {
        const int t = tid >> 3, sub = tid & 7; const int tseq = 64 * ci + t;
        const float gc = GC[t], gl = GC[63], be = BE[t];
        const float egc = __expf(gc), egl = __expf(gl - gc);
        float val[3][16];
        v4u cin[4][3][2]; float tmask[4];
#pragma unroll
        for (int j = 0; j < 4; ++j) { const bool ok = (tseq - 3 + j) >= 0; tmask[j] = ok ? 1.f : 0.f; const size_t rr = ok ? (R0 + t - 3 + j) : R0;
#pragma unroll
            for (int seg = 0; seg < 3; ++seg) { const bf16* p = CIN + rr * CONVCH + seg * GW + h * HD + 16 * sub; cin[j][seg][0] = *(const v4u*)p; cin[j][seg][1] = *(const v4u*)(p + 8); } }
#pragma unroll
        for (int seg = 0; seg < 3; ++seg) {
            float a[16];
#pragma unroll
            for (int e = 0; e < 16; ++e) a[e] = 0.f;
#pragma unroll
            for (int j = 0; j < 4; ++j) {
                const v4u w0 = cin[j][seg][0], w1 = cin[j][seg][1];
                const unsigned ww[8] = {w0.x, w0.y, w0.z, w0.w, w1.x, w1.y, w1.z, w1.w};
                const LAS f32x4* wl = (const LAS f32x4*)(L + PL_CW + ((j * 3 + seg) * 128 + 16 * sub) * 4);
                const f32x4 c0 = wl[0] * tmask[j], c1 = wl[1] * tmask[j], c2 = wl[2] * tmask[j], c3 = wl[3] * tmask[j];
                const float cwv[16] = {c0.x, c0.y, c0.z, c0.w, c1.x, c1.y, c1.z, c1.w, c2.x, c2.y, c2.z, c2.w, c3.x, c3.y, c3.z, c3.w};
#pragma unroll
                for (int e = 0; e < 8; ++e) { a[2 * e] += bf_lo(ww[e]) * cwv[2 * e]; a[2 * e + 1] += bf_hi(ww[e]) * cwv[2 * e + 1]; }
            }
            float ss = 0.f;
#pragma unroll
            for (int e = 0; e < 16; ++e) { a[e] = silu_f(a[e]); ss += a[e] * a[e]; }
            if (seg < 2) { ss += __shfl_xor(ss, 1); ss += __shfl_xor(ss, 2); ss += __shfl_xor(ss, 4); float sc = rsqrtf(ss + 1e-6f); if (seg == 0) sc *= SB_SCALE;
#pragma unroll
                for (int e = 0; e < 16; ++e) a[e] *= sc; }
#pragma unroll
            for (int e = 0; e < 16; ++e) val[seg][e] = a[e];
        }
#define PK8(dst, src, mul, o) do { dst.x = cvt2bf(src[o] * (mul), src[o + 1] * (mul)); dst.y = cvt2bf(src[o + 2] * (mul), src[o + 3] * (mul)); dst.z = cvt2bf(src[o + 4] * (mul), src[o + 5] * (mul)); dst.w = cvt2bf(src[o + 6] * (mul), src[o + 7] * (mul)); } while (0)
        v4u p0, p1;
        PK8(p0, val[1], 1.0f, 0); PK8(p1, val[1], 1.0f, 8); *(LAS v4u*)(L + PL_TK + rowimg(t, 2 * sub)) = p0; *(LAS v4u*)(L + PL_TK + rowimg(t, 2 * sub + 1)) = p1;
        PK8(p0, val[1], be * egc, 0); PK8(p1, val[1], be * egc, 8); *(LAS v4u*)(L + PL_TKBG + trimg(t, 2 * sub)) = p0; *(LAS v4u*)(L + PL_TKBG + trimg(t, 2 * sub + 1)) = p1;
        PK8(p0, val[1], egl, 0); PK8(p1, val[1], egl, 8); *(LAS v4u*)(L + PL_TKT + trimg(t, 2 * sub)) = p0; *(LAS v4u*)(L + PL_TKT + trimg(t, 2 * sub + 1)) = p1;
        PK8(p0, val[0], 1.0f, 0); PK8(p1, val[0], 1.0f, 8); *(LAS v4u*)(L + PL_TQ + rowimg(t, 2 * sub)) = p0; *(LAS v4u*)(L + PL_TQ + rowimg(t, 2 * sub + 1)) = p1;
        PK8(p0, val[2], be, 0); PK8(p1, val[2], be, 8); *(LAS v4u*)(L + PL_TVB + trimg(t, 2 * sub)) = p0; *(LAS v4u*)(L + PL_TVB + trimg(t, 2 * sub + 1)) = p1;
        { float qg[16];
#pragma unroll
          for (int e = 0; e < 16; ++e) qg[e] = val[0][e] * egc;
          unsigned char* qf = rec + GREC_QF + ((t >> 5) * 8 + sub) * 1024 + (t & 31) * 16;
          v4u f0, f1; f0.x = cvt2bf(qg[0], qg[1]); f0.y = cvt2bf(qg[2], qg[3]); f0.z = cvt2bf(qg[8], qg[9]); f0.w = cvt2bf(qg[10], qg[11]);
          f1.x = cvt2bf(qg[4], qg[5]); f1.y = cvt2bf(qg[6], qg[7]); f1.z = cvt2bf(qg[12], qg[13]); f1.w = cvt2bf(qg[14], qg[15]);
          *(v4u*)qf = f0; *(v4u*)(qf + 512) = f1; }
#undef PK8
        if (tid == 0) *EGp = __expf(gl);
    }
    __syncthreads();
    {
        const int which = F.wave >> 2, ta = (F.wave >> 1) & 1, tb = F.wave & 1;
        const unsigned aro = r32 * 32 + ((hh ^ ((r32 >> 3) & 1)) * 16);
        f32x16 acc;
#pragma unroll
        for (int i = 0; i < 16; ++i) acc[i] = 0.f;
        const bool zero_tile = (which == 0) ? (ta < tb) : (ta > tb);
        if (!zero_tile) {
#pragma unroll
            for (int ks = 0; ks < 8; ++ks) {
                const bf16x8 af = *(const LAS bf16x8*)(L + PL_TK + aro + (ta * 8 + ks) * 1024);
                const bf16x8 bfr = *(const LAS bf16x8*)(L + (which == 0 ? PL_TK : PL_TQ) + aro + (tb * 8 + ks) * 1024);
                acc = __builtin_amdgcn_mfma_f32_32x32x16_bf16(af, bfr, acc, 0, 0, 0);
            }
        }
        if (which == 0) {
            const int s = 32 * tb + r32; const float gs = GC[s];
#pragma unroll
            for (int g = 0; g < 4; ++g) { const int c0 = 32 * ta + 8 * g + 4 * hh; const f32x4 gc4 = *(const LAS f32x4*)(GC + c0), be4 = *(const LAS f32x4*)(BE + c0);
#pragma unroll
                for (int j = 0; j < 4; ++j) { const float e = __expf(fminf(gc4[j] - gs, 0.f)); const float v = be4[j] * acc[4 * g + j] * e; LOW[(c0 + j) * 64 + s] = (c0 + j > s) ? v : 0.f; } }
        } else {
            const int c = 32 * tb + r32; const float gcc = GC[c]; float v[16];
#pragma unroll
            for (int g = 0; g < 4; ++g) { const int s0 = 32 * ta + 8 * g + 4 * hh; const f32x4 gc4 = *(const LAS f32x4*)(GC + s0);
#pragma unroll
                for (int j = 0; j < 4; ++j) { const float e = __expf(fminf(gcc - gc4[j], 0.f)); const float x = acc[4 * g + j] * e; v[4 * g + j] = (c >= s0 + j) ? x : 0.f; } }
#pragma unroll
            for (int s = 0; s < 2; ++s) { v4u f; f.x = cvt2bf(v[8 * s], v[8 * s + 1]); f.y = cvt2bf(v[8 * s + 2], v[8 * s + 3]); f.z = cvt2bf(v[8 * s + 4], v[8 * s + 5]); f.w = cvt2bf(v[8 * s + 6], v[8 * s + 7]);
                *(v4u*)(rec + GREC_QKF + (tb * 4 + 2 * ta + s) * 1024 + lane * 16) = f; }
        }
    }
    __syncthreads();
    if (F.wave != 0) sb_decode_pull(F, qctr, F.MISC + 16);
    if (F.wave == 0) {
        float Tc[64];
#pragma unroll
        for (int c = 0; c < 64; ++c) {
            float a0 = 0.f, a1 = 0.f, a2 = 0.f, a3 = 0.f;
#pragma unroll
            for (int s4 = 0; s4 < (c + 3) / 4; ++s4) { const f32x4 l4 = *(const LAS f32x4*)(LOW + c * 64 + 4 * s4);
                a0 += l4.x * Tc[4 * s4]; if (4 * s4 + 1 < c) a1 += l4.y * Tc[4 * s4 + 1]; if (4 * s4 + 2 < c) a2 += l4.z * Tc[4 * s4 + 2]; if (4 * s4 + 3 < c) a3 += l4.w * Tc[4 * s4 + 3]; }
            Tc[c] = ((c == lane) ? 1.f : 0.f) - ((a0 + a1) + (a2 + a3));
        }
#pragma unroll
        for (int c = 0; c < 64; ++c) *(LAS bf16*)(L + PL_TT + c * 144 + lane * 2) = (bf16)f2bf(Tc[c]);
        F.MISC[16] = 1u;
    }
    __syncthreads();
    {
        const int tq = (lane & 15) >> 2, tp = lane & 3, tblk = (lane >> 4) & 1;
        const unsigned trn = hh * 2048 + tq * 64 + tblk * 32 + tp * 8;
        const unsigned trm = (4 * hh + tq) * 64 + tblk * 32 + tp * 8;
        const unsigned tro = r32 * 144 + hh * 16;
        {
            const int ct = F.wave >> 2, et = F.wave & 3; f32x16 acc;
#pragma unroll
            for (int i = 0; i < 16; ++i) acc[i] = 0.f;
#pragma unroll
            for (int ks = 0; ks < 4; ++ks) {
                const bf16x8 af = *(const LAS bf16x8*)(L + PL_TT + tro + ct * 32 * 144 + ks * 32);
                const s16x4 lo = __builtin_amdgcn_ds_read_tr16_b64_v4i16((LAS s16x4*)(L + PL_TVB + trn + ks * 4096 + et * 512));
                const s16x4 hi = __builtin_amdgcn_ds_read_tr16_b64_v4i16((LAS s16x4*)(L + PL_TVB + trn + ks * 4096 + et * 512 + 256));
                acc = __builtin_amdgcn_mfma_f32_32x32x16_bf16(af, __builtin_shufflevector(lo, hi, 0, 1, 2, 3, 4, 5, 6, 7), acc, 0, 0, 0);
            }
            v4u f0, f1; f0.x = cvt2bf(acc[0], acc[1]); f0.y = cvt2bf(acc[2], acc[3]); f0.z = cvt2bf(acc[4], acc[5]); f0.w = cvt2bf(acc[6], acc[7]);
            f1.x = cvt2bf(acc[8], acc[9]); f1.y = cvt2bf(acc[10], acc[11]); f1.z = cvt2bf(acc[12], acc[13]); f1.w = cvt2bf(acc[14], acc[15]);
            unsigned char* up = rec + GREC_UF + (et * 2 + ct) * 2048 + lane * 32; *(v4u*)up = f0; *(v4u*)(up + 16) = f1;
        }
        {
            const int dt = F.wave >> 1, ct = F.wave & 1; f32x16 acc;
#pragma unroll
            for (int i = 0; i < 16; ++i) acc[i] = 0.f;
#pragma unroll
            for (int ks = 0; ks < 4; ++ks) {
                const s16x4 lo = __builtin_amdgcn_ds_read_tr16_b64_v4i16((LAS s16x4*)(L + PL_TKBG + trn + ks * 4096 + dt * 512));
                const s16x4 hi = __builtin_amdgcn_ds_read_tr16_b64_v4i16((LAS s16x4*)(L + PL_TKBG + trn + ks * 4096 + dt * 512 + 256));
                const bf16x8 bfr = *(const LAS bf16x8*)(L + PL_TT + tro + ct * 32 * 144 + ks * 32);
                acc = __builtin_amdgcn_mfma_f32_32x32x16_bf16(__builtin_shufflevector(lo, hi, 0, 1, 2, 3, 4, 5, 6, 7), bfr, acc, 0, 0, 0);
            }
#pragma unroll
            for (int s = 0; s < 2; ++s) { v4u f; f.x = cvt2bf(-acc[8 * s], -acc[8 * s + 1]); f.y = cvt2bf(-acc[8 * s + 2], -acc[8 * s + 3]); f.z = cvt2bf(-acc[8 * s + 4], -acc[8 * s + 5]); f.w = cvt2bf(-acc[8 * s + 6], -acc[8 * s + 7]);
                *(v4u*)(rec + GREC_WF + (ct * 8 + 2 * dt + s) * 1024 + lane * 16) = f; }
        }
        {
#pragma unroll
            for (int q = 0; q < 2; ++q) { const int f = 2 * F.wave + q, dt = f >> 2, ksp = f & 3;
                const s16x4 lo = __builtin_amdgcn_ds_read_tr16_b64_v4i16((LAS s16x4*)(L + PL_TKT + trm + (2 * ksp) * 2048 + dt * 512));
                const s16x4 hi = __builtin_amdgcn_ds_read_tr16_b64_v4i16((LAS s16x4*)(L + PL_TKT + trm + (2 * ksp + 1) * 2048 + dt * 512));
                const bf16x8 kf = __builtin_shufflevector(lo, hi, 0, 1, 2, 3, 4, 5, 6, 7);
                *(bf16x8*)(rec + GREC_KTF + (dt * 4 + ksp) * 1024 + lane * 16) = kf; }
        }
    }
    __syncthreads();
}

__device__ __forceinline__ void gdn_scan_chain(Frame& F, int chain) {
    const int lane = F.lane, r32 = lane & 31, hh = lane >> 5, et = F.wave;
    const unsigned char* recs = F.ws + WS_GREC + (size_t)chain * NCHUNK * GREC_BYTES;
    const float* EG = WSP(float, WS_GEG) + chain * NCHUNK;
    unsigned char* sfr = F.ws + WS_GSF + ((size_t)chain * NCHUNK * 4 + et) * 8192 + lane * 16;
    LAS unsigned char* L = F.lds;
    f32x16 S[4];
#pragma unroll
    for (int d = 0; d < 4; ++d)
#pragma unroll
        for (int i = 0; i < 16; ++i) S[d][i] = 0.f;
#define GS_DMA(ci_, slot_) do { const unsigned char* g_ = recs + (size_t)(ci_) * GREC_BYTES + lane * 16; \
        _Pragma("unroll") for (int p_ = 0; p_ < 6; ++p_) __builtin_amdgcn_global_load_lds((const unsigned*)(g_ + (F.wave + 8 * p_) * 1024), (LAS unsigned*)(L + (slot_) * GREC_SCAN + (F.wave + 8 * p_) * 1024), 16, 0, 0); } while (0)
    const float egv = EG[lane];
    asm volatile("s_waitcnt vmcnt(0)" ::: "memory");
    GS_DMA(0, 0); GS_DMA(1, 1);
    asm volatile("s_waitcnt vmcnt(6)" ::: "memory"); __builtin_amdgcn_s_barrier(); asm volatile("" ::: "memory");
    for (int ci = 0; ci < NCHUNK; ++ci) {
        const int slot = ci % 3;
        { const int cn = (ci + 2 < NCHUNK) ? ci + 2 : ci; GS_DMA(cn, (ci + 2) % 3); }
        if (F.wave < 4) {
            const LAS unsigned char* A = L + slot * GREC_SCAN + lane * 16;
            const float eg = __builtin_bit_cast(float, __builtin_amdgcn_readlane(__builtin_bit_cast(int, egv), ci));
            bf16x8 sf[8];
#pragma unroll
            for (int ks = 0; ks < 8; ++ks) { const int d = ks >> 1, s = ks & 1; v4u w; w.x = cvt2bf(S[d][8 * s], S[d][8 * s + 1]); w.y = cvt2bf(S[d][8 * s + 2], S[d][8 * s + 3]); w.z = cvt2bf(S[d][8 * s + 4], S[d][8 * s + 5]); w.w = cvt2bf(S[d][8 * s + 6], S[d][8 * s + 7]); sf[ks] = __builtin_bit_cast(bf16x8, w);
                *(v4u*)(sfr + (size_t)ci * 32768 + ks * 1024) = w; }
            f32x16 vn[2];
#pragma unroll
            for (int ct = 0; ct < 2; ++ct) {
                const LAS unsigned char* up = L + slot * GREC_SCAN + GREC_UF + (et * 2 + ct) * 2048 + lane * 32;
                const v4u u0 = *(const LAS v4u*)up, u1 = *(const LAS v4u*)(up + 16);
                const unsigned uw[8] = {u0.x, u0.y, u0.z, u0.w, u1.x, u1.y, u1.z, u1.w};
#pragma unroll
                for (int i = 0; i < 8; ++i) { vn[ct][2 * i] = bf_lo(uw[i]); vn[ct][2 * i + 1] = bf_hi(uw[i]); }
#pragma unroll
                for (int ks = 0; ks < 8; ++ks) vn[ct] = __builtin_amdgcn_mfma_f32_32x32x16_bf16(*(const LAS bf16x8*)(A + GREC_WF + (ct * 8 + ks) * 1024), sf[ks], vn[ct], 0, 0, 0);
            }
            bf16x8 vf[4];
#pragma unroll
            for (int ks = 0; ks < 4; ++ks) { const int ct = ks >> 1, s = ks & 1; v4u w; w.x = cvt2bf(vn[ct][8 * s], vn[ct][8 * s + 1]); w.y = cvt2bf(vn[ct][8 * s + 2], vn[ct][8 * s + 3]); w.z = cvt2bf(vn[ct][8 * s + 4], vn[ct][8 * s + 5]); w.w = cvt2bf(vn[ct][8 * s + 6], vn[ct][8 * s + 7]); vf[ks] = __builtin_bit_cast(bf16x8, w); }
#pragma unroll
            for (int d = 0; d < 4; ++d) {
#pragma unroll
                for (int i = 0; i < 16; ++i) S[d][i] *= eg;
#pragma unroll
                for (int ks = 0; ks < 4; ++ks) S[d] = __builtin_amdgcn_mfma_f32_32x32x16_bf16(*(const LAS bf16x8*)(A + GREC_KTF + (d * 4 + ks) * 1024), vf[ks], S[d], 0, 0, 0);
            }
            asm volatile("s_waitcnt vmcnt(14) lgkmcnt(0)" ::: "memory");
        } else {
            asm volatile("s_waitcnt vmcnt(6)" ::: "memory");
        }
        __builtin_amdgcn_s_barrier(); asm volatile("" ::: "memory");
    }
#undef GS_DMA
    asm volatile("s_waitcnt vmcnt(0)" ::: "memory"); __syncthreads();
    if (F.wave < 4) { float* so = F.out + OUT_GREC + (size_t)chain * HD * HD + 32 * et + r32;
#pragma unroll
        for (int d = 0; d < 4; ++d)
#pragma unroll
            for (int i = 0; i < 16; ++i) so[(size_t)(32 * d + (i & 3) + 8 * (i >> 2) + 4 * hh) * HD] = S[d][i]; }
}

__device__ __forceinline__ void gdn_out_unit(Frame& F, int chain, int ci) {
    int lane = F.lane, tid = F.tid; asm volatile("" : "+v"(lane), "+v"(tid));
    const int b = chain >> 3, h = chain & 7, r32 = lane & 31, hh = lane >> 5, et = F.wave & 3, ct = F.wave >> 2;
    const unsigned char* rec = F.ws + WS_GREC + ((size_t)chain * NCHUNK + ci) * GREC_BYTES + lane * 16;
    const unsigned char* sfp = F.ws + WS_GSF + (((size_t)chain * NCHUNK + ci) * 4 + et) * 8192 + lane * 16;
    LAS float* OT = (LAS float*)(F.lds);
    bf16x8 sf[8];
#pragma unroll
    for (int ks = 0; ks < 8; ++ks) sf[ks] = *(const bf16x8*)(sfp + ks * 1024);
    f32x16 vn[2], o;
#pragma unroll
    for (int c2 = 0; c2 < 2; ++c2) {
        const unsigned char* up = F.ws + WS_GREC + ((size_t)chain * NCHUNK + ci) * GREC_BYTES + GREC_UF + (et * 2 + c2) * 2048 + lane * 32;
        const v4u u0 = *(const v4u*)up, u1 = *(const v4u*)(up + 16);
        const unsigned uw[8] = {u0.x, u0.y, u0.z, u0.w, u1.x, u1.y, u1.z, u1.w};
#pragma unroll
        for (int i = 0; i < 8; ++i) { vn[c2][2 * i] = bf_lo(uw[i]); vn[c2][2 * i + 1] = bf_hi(uw[i]); }
#pragma unroll
        for (int ks = 0; ks < 8; ++ks) vn[c2] = __builtin_amdgcn_mfma_f32_32x32x16_bf16(*(const bf16x8*)(rec + GREC_WF + (c2 * 8 + ks) * 1024), sf[ks], vn[c2], 0, 0, 0);
    }
#pragma unroll
    for (int i = 0; i < 16; ++i) o[i] = 0.f;
#pragma unroll
    for (int ks = 0; ks < 8; ++ks) o = __builtin_amdgcn_mfma_f32_32x32x16_bf16(*(const bf16x8*)(rec + GREC_QF + (ct * 8 + ks) * 1024), sf[ks], o, 0, 0, 0);
#pragma unroll
    for (int ks = 0; ks < 4; ++ks) { const int c2 = ks >> 1, s = ks & 1; v4u w; w.x = cvt2bf(vn[c2][8 * s], vn[c2][8 * s + 1]); w.y = cvt2bf(vn[c2][8 * s + 2], vn[c2][8 * s + 3]); w.z = cvt2bf(vn[c2][8 * s + 4], vn[c2][8 * s + 5]); w.w = cvt2bf(vn[c2][8 * s + 6], vn[c2][8 * s + 7]);
        o = __builtin_amdgcn_mfma_f32_32x32x16_bf16(*(const bf16x8*)(rec + GREC_QKF + (ct * 4 + ks) * 1024), __builtin_bit_cast(bf16x8, w), o, 0, 0, 0); }
#pragma unroll
    for (int i = 0; i < 16; ++i) OT[(32 * ct + (i & 3) + 8 * (i >> 2) + 4 * hh) * 132 + 32 * et + r32] = o[i];
    __syncthreads();
    {
        const int c = tid >> 3, sub = tid & 7; const size_t row = (size_t)b * T + 64 * ci + c;
        const LAS f32x4* op = (const LAS f32x4*)(OT + c * 132 + 16 * sub);
        const f32x4 a0 = op[0], a1 = op[1], a2 = op[2], a3 = op[3];
        float x[16] = {a0.x, a0.y, a0.z, a0.w, a1.x, a1.y, a1.z, a1.w, a2.x, a2.y, a2.z, a2.w, a3.x, a3.y, a3.z, a3.w};
        float ss = 0.f;
#pragma unroll
        for (int e = 0; e < 16; ++e) ss += x[e] * x[e];
        ss += __shfl_xor(ss, 1); ss += __shfl_xor(ss, 2); ss += __shfl_xor(ss, 4);
        const float rs = rsqrtf(ss * (1.f / HD) + EPS);
        const bf16* zp = WSP(bf16, WS_Z) + row * GW + h * HD + 16 * sub; const v4u z0 = *(const v4u*)zp, z1 = *(const v4u*)(zp + 8);
        const unsigned zw[8] = {z0.x, z0.y, z0.z, z0.w, z1.x, z1.y, z1.z, z1.w};
        const float* gn = kin(17) + 16 * sub;
        unsigned ow[8];
#pragma unroll
        for (int e = 0; e < 8; ++e) ow[e] = cvt2bf(x[2 * e] * rs * gn[2 * e] * silu_f(bf_lo(zw[e])), x[2 * e + 1] * rs * gn[2 * e + 1] * silu_f(bf_hi(zw[e])));
        bf16* mp = WSP(bf16, WS_MIX) + row * D + SBW + h * HD + 16 * sub;
        *(v4u*)mp = (v4u){ow[0], ow[1], ow[2], ow[3]}; *(v4u*)(mp + 8) = (v4u){ow[4], ow[5], ow[6], ow[7]};
    }
    __syncthreads();
}

#ifndef REP_PHASE
#define REP_PHASE -1
#endif
#ifndef REP_N
#define REP_N 0
#endif
#ifndef REP_SCAN
#define REP_SCAN 0
#endif
#ifndef REP_ATTN
#define REP_ATTN 0
#endif

__device__ __forceinline__ void p2_mixers(Frame& F, unsigned* qctr) {
    _Pragma("unroll") for (int rs_ = 0; rs_ < 1 + REP_SCAN; ++rs_) if (F.bid < NB * NH) gdn_scan_chain(F, F.bid);
    __syncthreads();
    _Pragma("unroll") for (int ra_ = 0; ra_ < 1 + REP_ATTN; ++ra_)
    for (int u = F.bid; u < NB * NH * 16; u += F.G) { const int bh = u & 15, qb = u >> 4; sb_attn_unit(F, bh >> 3, bh & 7, qb); }
    const int gw = F.bid * NWAVES + F.wave, NGW = F.G * NWAVES;
    for (int it = gw; it < MS * NH * 32; it += NGW) {
        const int chain = it >> 5, slice = it & 31, b = chain >> 3, h = chain & 7;
        gdn_recur_wave<false>(SSP(S_GQ), SSP(S_GK), SSP(S_GV), SSP(S_G), SSP(S_BETA), GW, NH, (size_t)b, 1, h, slice,
                              kin(6) + (size_t)chain * HD * HD, F.out + OUT_GRECS + (size_t)chain * HD * HD, SSP(S_GO), F.lane);
    }
    sb_decode_pull(F, qctr, nullptr);
}

__device__ __forceinline__ void p2_finish(Frame& F) {
    const int gw = F.bid * NWAVES + F.wave, NGW = F.G * NWAVES;
    const float* gnw = kin(17);
    for (int u = F.bid; u < NB * NH * NCHUNK; u += F.G) gdn_out_unit(F, u & 15, u >> 4);
    if (F.wave == 0 && F.G - 1 - F.bid < MS * NH) {
        const int bh = F.G - 1 - F.bid, b = bh >> 3, h = bh & 7;
        { const f32x2 o = *(const f32x2*)(SSP(S_GO) + (size_t)b * GW + h * HD + 2 * F.lane);
          const float rs = rsqrtf(wave_sum(o.x * o.x + o.y * o.y) * (1.f / HD) + EPS);
          const float* z = SSP(S_PROJ) + (size_t)b * IN_COLS + O_GZ + h * HD + 2 * F.lane;
          float* mo = SSP(S_MIX) + (size_t)b * D + SBW + h * HD + 2 * F.lane;
          mo[0] = o.x * rs * gnw[2 * F.lane] * silu_f(z[0]); mo[1] = o.y * rs * gnw[2 * F.lane + 1] * silu_f(z[1]); }
        { float o0 = 0.f, o1 = 0.f, R = 1.f;
          const float* P = SSP(S_PART) + (size_t)bh * DSEG * DPART;
          for (int s0 = DSEG - 32; s0 >= 0; s0 -= 32) {
              float pa[32], pb[32], pr[32];
#pragma unroll
              for (int i = 0; i < 32; ++i) { const float* Pi = P + (size_t)(s0 + i) * DPART; const f32x2 v = *(const f32x2*)(Pi + 2 * F.lane); pa[i] = v.x; pb[i] = v.y; pr[i] = Pi[128]; }
#pragma unroll
              for (int i = 31; i >= 0; --i) { o0 += R * pa[i]; o1 += R * pb[i]; R *= pr[i]; } }
          const float rs = rsqrtf(wave_sum(o0 * o0 + o1 * o1) * (1.f / HD) + EPS); const float* nw = kin(13);
          float* mo = SSP(S_MIX) + (size_t)b * D + h * HD + 2 * F.lane; mo[0] = o0 * rs * nw[2 * F.lane]; mo[1] = o1 * rs * nw[2 * F.lane + 1]; }
    }
}

__device__ __forceinline__ void p4b_fixup(Frame& F) {
    const float* TAIL = WSP(float, WS_TAIL); const float* FIXG = WSP(float, WS_FIXG); const float* FIXU = WSP(float, WS_FIXU); bf16* ACT = WSP(bf16, WS_ACT); const float* cw = kin(22);
    const int total = 32 * 2 * DFF;
    for (int i = F.bid * 512 + F.tid; i < total; i += F.G * 512) {
        const int pm = i / (2 * DFF), rr = (i / DFF) & 1, c = i % DFF;
        if ((pm & 15) == 0) continue;
        const float t0 = TAIL[((size_t)(pm - 1) * 2 + 0) * DFF + c], t1 = TAIL[((size_t)(pm - 1) * 2 + 1) * DFF + c];
        float g = FIXG[((size_t)pm * 2 + rr) * DFF + c];
        g += (rr == 0) ? (cw[c] * t0 + cw[DFF + c] * t1) : (cw[c] * t1);
        ACT[(size_t)(pm * 256 + rr) * DFF + c] = (bf16)f2bf(silu_f(g) * FIXU[((size_t)pm * 2 + rr) * DFF + c]);
    }
    const float* st = kin(7); const float* GP = SSP(S_GP); const float* UP = SSP(S_UP); float* SACT = SSP(S_ACT);
    for (int i = F.bid * 512 + F.tid; i < MS * DFF; i += F.G * 512) {
        const int b = i / DFF, c = i % DFF;
        const float s0 = st[((size_t)b * 2 + 0) * DFF + c], s1 = st[((size_t)b * 2 + 1) * DFF + c], gp = GP[i];
        const float g = cw[c] * s0 + cw[DFF + c] * s1 + cw[2 * DFF + c] * gp;
        SACT[i] = silu_f(g) * UP[i];
        F.out[OUT_FCONVS + ((size_t)b * 2 + 0) * DFF + c] = s1; F.out[OUT_FCONVS + ((size_t)b * 2 + 1) * DFF + c] = gp;
    }
}

__device__ __forceinline__ void p7_final(Frame& F) {
    const int gw = F.bid * NWAVES + F.wave, NGW = F.G * NWAVES;
    const float* fw = kin(27); const float* ss3 = (const float*)(F.ctl + CW_SUMSQ3);
    for (int m = gw; m < M; m += NGW) {
        const float rs = rsqrtf(ss3[m] * (1.f / D) + EPS);
        f32x4* y = (f32x4*)(F.out + OUT_Y + (size_t)m * D) + F.lane; const f32x4* w = (const f32x4*)fw + F.lane;
#pragma unroll
        for (int j = 0; j < 8; ++j) y[64 * j] = y[64 * j] * rs * w[64 * j];
    }
    if (F.bid == 0) {
        const int b = F.wave; float v[32]; float s = 0.f;
#pragma unroll
        for (int j = 0; j < 32; ++j) { const int c = F.lane + 64 * j; const float h = SSP(S_H2)[(size_t)b * D + c] + SSP(S_PP)[(size_t)b * D + c] * sigmoid_f(SSP(S_PG)[(size_t)b * D + c]); v[j] = h; s += h * h; }
        const float rs = rsqrtf(wave_sum(s) * (1.f / D) + EPS);
#pragma unroll
        for (int j = 0; j < 32; ++j) { const int c = F.lane + 64 * j; F.out[OUT_YS + (size_t)b * D + c] = v[j] * rs * fw[c]; }
    }
}

constexpr int NPHASES = 12;

constexpr int WS_DUMMY_WORDS = 3 * M;
constexpr int N_LAUNCHES = MK_N_LAUNCHES;
struct Args { const float* in[28]; float* out; unsigned char* ws; int ph_lo, ph_hi; };
__global__ void __launch_bounds__(NWAVES * 64, 2) hymba_fwd(Args args) {
    extern __shared__ __attribute__((aligned(16))) unsigned char lds[];
    Frame F;
    F.lds = (LAS unsigned char*)lds;
    F.MISC = (volatile LAS unsigned*)(F.lds + MISC_OFF);
    F.tid = threadIdx.x; F.lane = F.tid & 63; F.wave = __builtin_amdgcn_readfirstlane(F.tid >> 6);
    F.G = gridDim.x; F.bid = blockIdx.x;
    F.ws = args.ws; F.ctl = (unsigned*)(args.ws + WS_CTL); F.out = args.out;
    for (int u = F.tid; u < (LDS_BYTES - LDSCTL_OFF) / 4; u += NWAVES * 64) ((LAS unsigned*)(F.lds + LDSCTL_OFF))[u] = 0u;
    __syncthreads();
    XcdBarrier bar; bar.bar = F.ctl + CW_BAR; bar.x = 0; bar.st = nullptr;
    if (N_LAUNCHES == 1) bar = xcd_barrier_post(F.ctl + CW_BAR, F.MISC + 8);
#define GRID_BAR() do { if (N_LAUNCHES == 1) xcd_barrier(bar); } while (0)
    const int lo = args.ph_lo, hi = args.ph_hi;
#define IN(k) (lo <= (k) && (k) < hi)
#define NREP(k) ((k) == REP_PHASE ? 1 + REP_N : 1)
    float* ss1 = (float*)(F.ctl + CW_SUMSQ1); float* ss2 = (float*)(F.ctl + CW_SUMSQ2); float* ss3 = (float*)(F.ctl + CW_SUMSQ3); float* dummy = WSP(float, WS_DUMMY);

    if (IN(0)) { _Pragma("unroll") for (int rep = 0; rep < NREP(0); ++rep) p0_prologue(F); GRID_BAR(); }
    if (IN(1)) { _Pragma("unroll") for (int rep = 0; rep < NREP(1); ++rep) {
        { pg8::Gemm g{WSP(bf16, WS_XN), WSP(bf16, WS_WIN), M, NPROJ_PAD, D}; pg8::StaticOrder S; S.init(M, NPROJ_PAD, F.G, F.bid);
          pg8::EpiProj E{WSP(bf16, WS_Q), WSP(bf16, WS_K), WSP(bf16, WS_V), WSP(bf16, WS_CIN), WSP(bf16, WS_Z), F.out + OUT_K, F.out + OUT_V, F.out + OUT_GCONV, WSP(float, WS_G), WSP(float, WS_BETA), kin(15), kin(16)};
          pg8::gemm_phase<pg8::EpiProj, pg8::StaticOrder, true, true>(F.lds + RING_OFF, g, S, E); }
        { pg8::Gemm g{WSP(bf16, WS_PB), WSP(bf16, WS_WPP), M, D, PLE}; pg8::StaticOrder S; S.init(M, D, F.G, F.bid);
          pg8::EpiBf16 E{WSP(bf16, WS_PP), D};
          pg8::gemm_phase<pg8::EpiBf16, pg8::StaticOrder, true, true>(F.lds + RING_OFF, g, S, E); }
        { SEpiStore E{SSP(S_PROJ), IN_COLS, IN_COLS}; sample_gemm(F, SSP(S_A), D, false, WSP(bf16, WS_WIN), 225, E); }
        if (rep == 0) { constexpr int T0 = (29 * 32) % 256; convert_set(F, 1, (F.bid - T0) * NWAVES + F.wave, (F.G - T0) * NWAVES); }
        }
        GRID_BAR();
    }
    if (IN(2)) { _Pragma("unroll") for (int rep = 0; rep < NREP(2); ++rep) {
        for (int u = F.bid; u < NB * NH * NCHUNK; u += F.G) { const int chain = u & 15, ci = u >> 4;
            gdn_prep_unit(F, chain, ci, F.ws + WS_GREC + ((size_t)chain * NCHUNK + ci) * GREC_BYTES, WSP(float, WS_GEG) + chain * NCHUNK + ci, F.ctl + CW_QUEUE); }
        gdn_prep_sample(F); }
        GRID_BAR(); }
    if (IN(3)) { _Pragma("unroll") for (int rep = 0; rep < NREP(3); ++rep) p2_mixers(F, F.ctl + CW_QUEUE); GRID_BAR(); }
    if (IN(4)) { _Pragma("unroll") for (int rep = 0; rep < NREP(4); ++rep) p2_finish(F); GRID_BAR(); }
    if (IN(5)) { _Pragma("unroll") for (int rep = 0; rep < NREP(5); ++rep) {
        { pg8::Gemm g{WSP(bf16, WS_MIX), WSP(bf16, WS_WOUT), M, D, D}; pg8::StaticOrder S; S.init(M, D, F.G, F.bid);
          pg8::EpiResid<false> E{kin(0), WSP(bf16, WS_H1B), rep == 0 ? ss1 : dummy, D};
          pg8::gemm_phase<pg8::EpiResid<false>, pg8::StaticOrder, true, true>(F.lds + RING_OFF, g, S, E); }
        { SEpiAdd E{kin(1), SSP(S_H1), D}; sample_gemm(F, SSP(S_MIX), D, false, WSP(bf16, WS_WOUT), D / 32, E); }
        }
        GRID_BAR();
    }
    if (IN(6)) { _Pragma("unroll") for (int rep = 0; rep < NREP(6); ++rep) {
        { pg8::Gemm g{WSP(bf16, WS_H1B), WSP(bf16, WS_WGU), M, NGU, D}; pg8::StaticOrder S; S.init(M, NGU, F.G, F.bid);
          pg8::EpiGateUp E{ss1, kin(22), WSP(bf16, WS_ACT), WSP(float, WS_TAIL), WSP(float, WS_FIXG), WSP(float, WS_FIXU), F.out + OUT_FCONV, (PG8_LAS float*)(F.lds + HALO_OFF)};
          pg8::gemm_phase<pg8::EpiGateUp, pg8::StaticOrder, true, true>(F.lds + RING_OFF, g, S, E); }
        { SEpiGateUp E{SSP(S_GP), SSP(S_UP)}; sample_gemm(F, SSP(S_H1), D, true, WSP(bf16, WS_WGU), NGU / 32, E); }
        if (rep == 0) { constexpr int T1 = (43 * 32) % 256; convert_set(F, 2, (F.bid - T1) * NWAVES + F.wave, (F.G - T1) * NWAVES); }
        }
        GRID_BAR();
    }
    if (IN(7)) { _Pragma("unroll") for (int rep = 0; rep < NREP(7); ++rep) p4b_fixup(F); GRID_BAR(); }
    if (IN(8)) { _Pragma("unroll") for (int rep = 0; rep < NREP(8); ++rep) {
        { pg8::Gemm g{WSP(bf16, WS_ACT), WSP(bf16, WS_WDN), M, D, DFF}; pg8::StaticOrder S; S.init(M, D, F.G, F.bid);
          pg8::EpiResid<true> E{WSP(bf16, WS_H1B), WSP(bf16, WS_H2B), rep == 0 ? ss2 : dummy, D};
          pg8::gemm_phase<pg8::EpiResid<true>, pg8::StaticOrder, true, true>(F.lds + RING_OFF, g, S, E); }
        { SEpiAdd E{SSP(S_H1), SSP(S_H2), D}; sample_gemm(F, SSP(S_ACT), DFF, false, WSP(bf16, WS_WDN), D / 32, E); }
        }
        GRID_BAR();
    }
    if (IN(9)) { _Pragma("unroll") for (int rep = 0; rep < NREP(9); ++rep) {
        { pg8::Gemm g{WSP(bf16, WS_H2B), WSP(bf16, WS_WPG), M, D, D}; pg8::StaticOrder S; S.init(M, D, F.G, F.bid);
          pg8::EpiPle E{WSP(bf16, WS_H2B), WSP(bf16, WS_PP), ss2, F.out + OUT_Y, rep == 0 ? ss3 : dummy, D};
          pg8::gemm_phase<pg8::EpiPle, pg8::StaticOrder, true, true>(F.lds + RING_OFF, g, S, E); }
        { SEpiStore E{SSP(S_PG), D, D}; sample_gemm(F, SSP(S_H2), D, true, WSP(bf16, WS_WPG), D / 32, E); }
        { SEpiStore E{SSP(S_PP), D, D}; sample_gemm(F, kin(9), PLE, false, WSP(bf16, WS_WPP), D / 32, E); }
        }
        GRID_BAR();
    }
    if (IN(10)) { p7_final(F); }
#undef IN
#undef GRID_BAR
}

extern "C" void kernel_launch(void* const* d_in, const int* in_sizes, int n_in, void* d_out, int out_size, void* d_ws, size_t ws_size, hipStream_t stream) {
    static int grid = 0;
    if (grid == 0) {
        if (n_in != 28 || (size_t)out_size != OUT_END || ws_size < WS_END) { fprintf(stderr, "kernel_launch: unexpected sizes n_in %d out %d ws %zu (need %zu, %zu)\n", n_in, out_size, ws_size, (size_t)OUT_END, (size_t)WS_END); grid = -1; return; }
        int dev = 0, cus = 0, per_cu = 0;
        if (hipGetDevice(&dev) != hipSuccess || hipDeviceGetAttribute(&cus, hipDeviceAttributeMultiprocessorCount, dev) != hipSuccess) { grid = -1; return; }
        if (hipFuncSetAttribute((const void*)hymba_fwd, hipFuncAttributeMaxDynamicSharedMemorySize, LDS_BYTES) != hipSuccess) { fprintf(stderr, "kernel_launch: hipFuncSetAttribute failed\n"); grid = -1; return; }
        if (hipOccupancyMaxActiveBlocksPerMultiprocessor(&per_cu, (const void*)hymba_fwd, NWAVES * 64, LDS_BYTES) != hipSuccess || per_cu < 1) { fprintf(stderr, "kernel_launch: occupancy query says %d\n", per_cu); }
        (void)hipGetLastError();
        grid = cus;
    }
    if (grid < 0) return;
    (void)hipMemsetAsync((char*)d_ws + WS_CTL, 0, CTL_ZERO_BYTES, stream);
    Args a{};
    for (int i = 0; i < 28; ++i) a.in[i] = (const float*)d_in[i];
    a.out = (float*)d_out; a.ws = (unsigned char*)d_ws;
    if (N_LAUNCHES == 1) { a.ph_lo = 0; a.ph_hi = NPHASES; hipLaunchKernelGGL(hymba_fwd, dim3(grid), dim3(NWAVES * 64), LDS_BYTES, stream, a); }
    else for (int p = 0; p < 11; ++p) { a.ph_lo = p; a.ph_hi = p + 1; hipLaunchKernelGGL(hymba_fwd, dim3(grid), dim3(NWAVES * 64), LDS_BYTES, stream, a); }
}
```

```cpp
#include <hip/hip_runtime.h>
#include <cstdio>
#include <cstdint>

#ifndef MK_N_LAUNCHES
#define MK_N_LAUNCHES 1
#endif

namespace pg8 {
#define PG8_LAS __attribute__((address_space(3)))
typedef unsigned short bf16_t;
typedef short bf16x8 __attribute__((ext_vector_type(8)));
typedef float f32x4 __attribute__((ext_vector_type(4)));
typedef unsigned u32x4 __attribute__((ext_vector_type(4)));
constexpr int BM = 256, BK = 64, HALF = 128, HTB = HALF * BK * 2  , STAGE_BYTES = 8 * HTB, NXCD = 8, WGM = 8;

__host__ __device__ __forceinline__ int lds_byte(int r, int c) { const int st = (r >> 4) * 2 + (c >> 5), rr = r & 15, cc = c & 31, ob = rr * 64 + cc * 2; return st * 1024 + (ob ^ (((ob >> 9) & 1) << 5)); }
__host__ __device__ __forceinline__ void stage_rc(int b, int& R, int& C) { const int st = b / 1024, sb = b % 1024, swz = sb ^ (((sb >> 9) & 1) << 5); R = (st >> 1) * 16 + swz / 64; C = (st & 1) * 32 + (swz % 64) / 2; }
__host__ __device__ __forceinline__ int perm32(int rho) { const int n = rho >> 4, i = rho & 15; return 8 * (i >> 2) + 4 * n + (i & 3); }

struct Unit { int pm, pn; };
struct Gemm { const bf16_t* A; const bf16_t* Bt; int M, N, K; };

struct StaticOrder {
    int nM, nN, nwg, G, c;
    __host__ __device__ void init(int M, int N, int G_, int c_) { nM = M / BM; nN = N / BM; nwg = nM * nN; G = G_; c = c_; }
    __host__ __device__ bool next(int i, Unit& u) const {
        const long L = (long)i * G + c; if (L >= nwg) return false;
        int wgid = (int)L; { const int q = nwg / NXCD, r = nwg % NXCD, xcd = wgid % NXCD, off = wgid / NXCD; wgid = (xcd < r ? xcd * (q + 1) : r * (q + 1) + (xcd - r) * q) + off; }
        const int nig = WGM * nN, gid = wgid / nig, fm = gid * WGM, gsz = (nM - fm) < WGM ? (nM - fm) : WGM;
        u.pm = fm + ((wgid % nig) % gsz); u.pn = (wgid % nig) / gsz; return true;
    }
    __device__ __forceinline__ void a_ready(const Unit&) const {}
    __device__ __forceinline__ void done(const Unit&) const {}
};

__device__ __forceinline__ unsigned cvt_pk_bf16(float lo, float hi) { unsigned r; asm volatile("v_cvt_pk_bf16_f32 %0, %1, %2" : "=v"(r) : "v"(lo), "v"(hi)); return r; }
template <class Epi, class Sched, bool ALIGN_EPI = false, bool SP2 = false>
__device__ __forceinline__ void gemm_phase(PG8_LAS unsigned char* lds, const Gemm g, const Sched& S, const Epi& E) {
    int tid = threadIdx.x; asm volatile("" : "+v"(tid));
    const int wid = __builtin_amdgcn_readfirstlane(tid >> 6), lane = tid & 63, wr = wid >> 2, wc = wid & 3, fr = lane & 15, fq = lane >> 4;
    int K = g.K; asm volatile("" : "+s"(K));
    const int nt = K / BK;
    unsigned voffA[2], voffB[2];
#pragma unroll
    for (int i = 0; i < 2; ++i) { int R, C; stage_rc(tid * 16 + i * 8192, R, C); const int Rb = Epi::PERM ? ((R & ~31) + perm32(R & 31)) : R;
        voffA[i] = (unsigned)(R * K + C) * 2u; voffB[i] = (unsigned)(Rb * K + C) * 2u; }
    const size_t kstep = (size_t)(BK * 2);
    const size_t hstep = (size_t)HALF * K * 2;
    const size_t tstep = 2 * hstep;
    const unsigned ldsw = (unsigned)wid * 1024u;
    const int aoff = lds_byte(wr * 64 + fr, fq * 8), boff = lds_byte(wc * 32 + fr, fq * 8);
#define PG8_SA(b, h) (((b) * 2 + (h)) * HTB)
#define PG8_SB(b, h) ((4 + (b) * 2 + (h)) * HTB)
#define PG8_STAGE(bufoff, gbase, voff) do { _Pragma("unroll") for (int _i = 0; _i < 2; ++_i) \
        __builtin_amdgcn_global_load_lds((const unsigned*)((const char*)(gbase) + (voff)[_i]), (PG8_LAS unsigned*)(lds + (bufoff) + ldsw + _i * 8192), 16, 0, 0); } while (0)
#define PG8_LDA(dst, b, h) do { _Pragma("unroll") for (int m = 0; m < 4; ++m) _Pragma("unroll") for (int k = 0; k < 2; ++k) dst[m][k] = *(const PG8_LAS bf16x8*)(lds + PG8_SA(b, h) + aoff + m * 2048 + k * 1024); } while (0)
#define PG8_LDB(dst, b, h) do { _Pragma("unroll") for (int n = 0; n < 2; ++n) _Pragma("unroll") for (int k = 0; k < 2; ++k) dst[n][k] = *(const PG8_LAS bf16x8*)(lds + PG8_SB(b, h) + boff + n * 2048 + k * 1024); } while (0)
#define PG8_MMA(ai, bj, At, Bt) do { __builtin_amdgcn_s_setprio(1); _Pragma("unroll") for (int m = 0; m < 4; ++m) _Pragma("unroll") for (int n = 0; n < 2; ++n) _Pragma("unroll") for (int k = 0; k < 2; ++k) \
        acc[ai][bj][m][n] = __builtin_amdgcn_mfma_f32_16x16x32_bf16(Bt[n][k], At[m][k], acc[ai][bj][m][n], 0, 0, 0); __builtin_amdgcn_s_setprio(0); } while (0)
#define PG8_WAIT_V(n) asm volatile("s_waitcnt vmcnt(" #n ")" ::: "memory")
#define PG8_WAIT_L(n) asm volatile("s_waitcnt lgkmcnt(" #n ")" ::: "memory")
#define PG8_BAR __builtin_amdgcn_s_barrier()
#define PG8_SCHED __builtin_amdgcn_sched_barrier(0)
    Unit cur, nxt; int ui = 0;
    if (!S.next(0, cur)) return;
    f32x4 acc[2][2][4][2];
#pragma unroll
    for (int a = 0; a < 2; ++a)
#pragma unroll
        for (int b = 0; b < 2; ++b)
#pragma unroll
            for (int m = 0; m < 4; ++m)
#pragma unroll
                for (int n = 0; n < 2; ++n) acc[a][b][m][n] = (f32x4){0.f, 0.f, 0.f, 0.f};
    bf16x8 At[4][2], B0[2][2], B1[2][2];
    const char* cA = (const char*)g.A + (size_t)cur.pm * tstep; const char* cB = (const char*)g.Bt + (size_t)cur.pn * tstep;
    S.a_ready(cur);
    if constexpr (SP2) {
        PG8_STAGE(PG8_SB(0, 0), cB, voffB); PG8_STAGE(PG8_SB(0, 1), cB + hstep, voffB); PG8_STAGE(PG8_SA(0, 0), cA, voffA); PG8_STAGE(PG8_SA(0, 1), cA + hstep, voffA);
        if (wr == 1) PG8_BAR;
        PG8_WAIT_V(2); PG8_BAR;
        PG8_STAGE(PG8_SB(1, 0), cB + kstep, voffB); PG8_STAGE(PG8_SA(1, 0), cA + kstep, voffA); PG8_STAGE(PG8_SB(1, 1), cB + hstep + kstep, voffB);
        PG8_WAIT_V(6); PG8_BAR;
    } else {
        PG8_STAGE(PG8_SB(0, 0), cB, voffB); PG8_STAGE(PG8_SA(0, 0), cA, voffA); PG8_STAGE(PG8_SB(0, 1), cB + hstep, voffB); PG8_STAGE(PG8_SA(0, 1), cA + hstep, voffA);
        if (wr == 1) PG8_BAR;
        PG8_WAIT_V(4); PG8_BAR;
        PG8_STAGE(PG8_SB(1, 0), cB + kstep, voffB); PG8_STAGE(PG8_SA(1, 0), cA + kstep, voffA); PG8_STAGE(PG8_SB(1, 1), cB + hstep + kstep, voffB);
        PG8_WAIT_V(6); PG8_BAR;
    }
    for (;;) {
        const bool has_next = S.next(ui + 1, nxt);
        const char* nA = has_next ? (const char*)g.A + (size_t)nxt.pm * tstep : cA; const char* nB = has_next ? (const char*)g.Bt + (size_t)nxt.pn * tstep : cB;
        for (int t = 0; t < nt; t += 2) {
            const bool last = (t == nt - 2);
            const char* a1 = cA + (size_t)(t + 1) * kstep;
            const char* a2 = last ? nA : cA + (size_t)(t + 2) * kstep; const char* b2 = last ? nB : cB + (size_t)(t + 2) * kstep;
            const char* a3 = a2 + kstep; const char* b3 = b2 + kstep;
            if (last && has_next) S.a_ready(nxt);
            if constexpr (SP2) {
            PG8_LDB(B0, 0, 0); PG8_LDB(B1, 0, 1); PG8_SCHED; PG8_LDA(At, 0, 0); PG8_STAGE(PG8_SA(1, 1), a1 + hstep, voffA);
            PG8_WAIT_V(8); PG8_WAIT_L(0); PG8_BAR; PG8_MMA(0, 0, At, B0); PG8_MMA(0, 1, At, B1); PG8_BAR; PG8_SCHED;
            PG8_LDA(At, 0, 1); PG8_STAGE(PG8_SB(0, 0), b2, voffB); PG8_STAGE(PG8_SB(0, 1), b2 + hstep, voffB); PG8_STAGE(PG8_SA(0, 0), a2, voffA);
            PG8_WAIT_V(8); PG8_WAIT_L(0); PG8_BAR; PG8_MMA(1, 0, At, B0); PG8_MMA(1, 1, At, B1); PG8_BAR; PG8_SCHED;
            PG8_LDB(B0, 1, 0); PG8_LDB(B1, 1, 1); PG8_SCHED; PG8_LDA(At, 1, 0); PG8_STAGE(PG8_SA(0, 1), a2 + hstep, voffA);
            PG8_WAIT_V(8); PG8_WAIT_L(0); PG8_BAR; PG8_MMA(0, 0, At, B0); PG8_MMA(0, 1, At, B1); PG8_BAR; PG8_SCHED;
            PG8_LDA(At, 1, 1); PG8_STAGE(PG8_SB(1, 0), b3, voffB); PG8_STAGE(PG8_SB(1, 1), b3 + hstep, voffB); PG8_STAGE(PG8_SA(1, 0), a3, voffA);
            PG8_WAIT_V(8); PG8_WAIT_L(0); PG8_BAR; PG8_MMA(1, 0, At, B0); PG8_MMA(1, 1, At, B1); PG8_BAR; PG8_SCHED;
            } else {
            PG8_LDB(B0, 0, 0); PG8_SCHED; PG8_LDA(At, 0, 0); PG8_STAGE(PG8_SA(1, 1), a1 + hstep, voffA);
            PG8_WAIT_L(8); PG8_BAR; PG8_WAIT_L(0); PG8_MMA(0, 0, At, B0); PG8_BAR; PG8_SCHED;
            PG8_LDB(B1, 0, 1); PG8_STAGE(PG8_SB(0, 0), b2, voffB);
            PG8_BAR; PG8_WAIT_L(0); PG8_MMA(0, 1, At, B1); PG8_BAR;
            PG8_LDA(At, 0, 1); PG8_STAGE(PG8_SA(0, 0), a2, voffA);
            PG8_BAR; PG8_WAIT_L(0); PG8_MMA(1, 0, At, B0); PG8_BAR; PG8_SCHED;
            PG8_STAGE(PG8_SB(0, 1), b2 + hstep, voffB);
            PG8_WAIT_V(6); PG8_BAR; PG8_MMA(1, 1, At, B1); PG8_BAR;
            PG8_LDB(B0, 1, 0); PG8_SCHED; PG8_LDA(At, 1, 0); PG8_STAGE(PG8_SA(0, 1), a2 + hstep, voffA);
            PG8_WAIT_L(8); PG8_BAR; PG8_WAIT_L(0); PG8_MMA(0, 0, At, B0); PG8_BAR; PG8_SCHED;
            PG8_LDB(B1, 1, 1); PG8_STAGE(PG8_SB(1, 0), b3, voffB);
            PG8_BAR; PG8_WAIT_L(0); PG8_MMA(0, 1, At, B1); PG8_BAR;
            PG8_LDA(At, 1, 1); PG8_STAGE(PG8_SA(1, 0), a3, voffA);
            PG8_BAR; PG8_WAIT_L(0); PG8_MMA(1, 0, At, B0); PG8_BAR; PG8_SCHED;
            PG8_STAGE(PG8_SB(1, 1), b3 + hstep, voffB);
            PG8_WAIT_V(6); PG8_BAR; PG8_MMA(1, 1, At, B1); PG8_BAR;
            }
        }
        if constexpr (ALIGN_EPI) { if (wr == 0) PG8_BAR; }
        if constexpr (!Epi::AFTER_DRAIN) { int fr_e = fr, fq_e = fq; asm volatile("" : "+v"(fr_e), "+v"(fq_e));
            E(acc, cur, wr, wc, fr_e, fq_e); S.done(cur); }
        if (!has_next) break;
#pragma unroll
        for (int a = 0; a < 2; ++a)
#pragma unroll
            for (int b = 0; b < 2; ++b)
#pragma unroll
                for (int m = 0; m < 4; ++m)
#pragma unroll
                    for (int n = 0; n < 2; ++n) acc[a][b][m][n] = (f32x4){0.f, 0.f, 0.f, 0.f};
        cur = nxt; cA = nA; cB = nB; ++ui;
        if constexpr (ALIGN_EPI) { if (wr == 1) PG8_BAR; }
    }
    PG8_WAIT_V(0);
    if constexpr (!ALIGN_EPI) { if (wr == 0) PG8_BAR; }
    PG8_BAR;
    if constexpr (Epi::AFTER_DRAIN) { E.fused(acc, cur, wr, wc, fr, fq, lds, wid, lane); S.done(cur); }
#undef PG8_SA
#undef PG8_SB
#undef PG8_STAGE
#undef PG8_LDA
#undef PG8_LDB
#undef PG8_MMA
#undef PG8_WAIT_V
#undef PG8_WAIT_L
#undef PG8_BAR
#undef PG8_SCHED
}
}

constexpr int D = 2048, T = 4096, NB = 2, M = NB * T;
constexpr int MS = 8;
constexpr int HD = 128, NH = 8, SBW = NH * HD, GW = NH * HD;
constexpr int CONVCH = 3 * GW;
constexpr int IN_COLS = 7184, NPROJ_PAD = 7424;
constexpr int DFF = 5504, NGU = 2 * DFF;
constexpr int PLE = 256;
constexpr int PAST = 16384, PAGE = 128, NPAGES = PAST / PAGE, NPOOL = 1280;
constexpr float EPS = 1e-6f;
constexpr float SB_SCALE = 0.08838834764831845f;
constexpr int O_SB_K = 1024, O_SB_V = 2048, O_GQKV = 3072, O_GZ = 6144, O_GA = 7168, O_GB = 7176;

constexpr size_t OUT_Y = 0;
constexpr size_t OUT_YS = OUT_Y + (size_t)M * D;
constexpr size_t OUT_K = OUT_YS + (size_t)MS * D;
constexpr size_t OUT_V = OUT_K + (size_t)M * SBW;
constexpr size_t OUT_GCONV = OUT_V + (size_t)M * SBW;
constexpr size_t OUT_GREC = OUT_GCONV + (size_t)NB * 3 * CONVCH;
constexpr size_t OUT_FCONV = OUT_GREC + (size_t)NB * NH * HD * HD;
constexpr size_t OUT_KS = OUT_FCONV + (size_t)NB * 2 * DFF;
constexpr size_t OUT_VS = OUT_KS + (size_t)MS * SBW;
constexpr size_t OUT_GCONVS = OUT_VS + (size_t)MS * SBW;
constexpr size_t OUT_GRECS = OUT_GCONVS + (size_t)MS * 3 * CONVCH;
constexpr size_t OUT_FCONVS = OUT_GRECS + (size_t)MS * NH * HD * HD;
constexpr size_t OUT_END = OUT_FCONVS + (size_t)MS * 2 * DFF;

namespace pg8 {
__device__ __forceinline__ float silu_f(float x) { return x * __builtin_amdgcn_rcpf(1.0f + __expf(-x)); }
__device__ __forceinline__ float sigmoid_f(float x) { return __builtin_amdgcn_rcpf(1.0f + __expf(-x)); }
__device__ __forceinline__ float softplus_f(float x) { return fmaxf(x, 0.f) + log1pf(__expf(-fabsf(x))); }
typedef unsigned u32x2 __attribute__((ext_vector_type(2)));

struct EpiProj {
    static constexpr bool PERM = true, AFTER_DRAIN = false;
    bf16_t *Qb, *Kb, *Vb, *CIN, *Zb; float *outK, *outV, *outGconv; float *G, *BETA; const float *a_log, *dt_bias;
    __device__ __forceinline__ void operator()(const f32x4 (&acc)[2][2][4][2], const Unit& u, int wr, int wc, int fr, int fq) const {
        const int reg = u.pn >> 2;
#pragma unroll
        for (int ai = 0; ai < 2; ++ai)
#pragma unroll
            for (int m = 0; m < 4; ++m) {
                const int r = u.pm * BM + ai * HALF + wr * 64 + m * 16 + fr;
#pragma unroll
                for (int bj = 0; bj < 2; ++bj) {
                    const int c8 = u.pn * BM + bj * HALF + wc * 32 + 8 * fq;
                    const f32x4 v0 = acc[ai][bj][m][0], v1 = acc[ai][bj][m][1];
                    u32x4 w; w.x = cvt_pk_bf16(v0[0], v0[1]); w.y = cvt_pk_bf16(v0[2], v0[3]); w.z = cvt_pk_bf16(v1[0], v1[1]); w.w = cvt_pk_bf16(v1[2], v1[3]);
                    if (reg == 0) { *(u32x4*)(Qb + (size_t)r * SBW + c8) = w; }
                    else if (reg == 1) { const int c = c8 - O_SB_K; *(u32x4*)(Kb + (size_t)r * SBW + c) = w; float* o = outK + (size_t)r * SBW + c; *(f32x4*)o = v0; *(f32x4*)(o + 4) = v1; }
                    else if (reg == 2) { const int c = c8 - O_SB_V; *(u32x4*)(Vb + (size_t)r * SBW + c) = w; float* o = outV + (size_t)r * SBW + c; *(f32x4*)o = v0; *(f32x4*)(o + 4) = v1; }
                    else if (reg < 6) { const int c = c8 - O_GQKV; *(u32x4*)(CIN + (size_t)r * CONVCH + c) = w;
                        const int t = r & (T - 1); if (t >= T - 3) { float* o = outGconv + ((size_t)(r >> 12) * 3 + (t - (T - 3))) * CONVCH + c; *(f32x4*)o = v0; *(f32x4*)(o + 4) = v1; } }
                    else if (reg == 6) { const int c = c8 - O_GZ; *(u32x4*)(Zb + (size_t)r * GW + c) = w; }
                    else if (bj == 0 && wc == 0 && fq < 2 && u.pn == 28) {
                        float x[8] = {v0[0], v0[1], v0[2], v0[3], v1[0], v1[1], v1[2], v1[3]}; float y[8];
#pragma unroll
                        for (int h = 0; h < 8; ++h) y[h] = (fq == 0) ? -__expf(a_log[h]) * softplus_f(x[h] + dt_bias[h]) : sigmoid_f(x[h]);
                        float* o = (fq == 0 ? G : BETA) + (size_t)r * NH; *(f32x4*)o = (f32x4){y[0], y[1], y[2], y[3]}; *(f32x4*)(o + 4) = (f32x4){y[4], y[5], y[6], y[7]};
                    }
                }
            }
    }
};

struct EpiBf16 {
    static constexpr bool PERM = true, AFTER_DRAIN = false;
    bf16_t* O; int ldc;
    __device__ __forceinline__ void operator()(const f32x4 (&acc)[2][2][4][2], const Unit& u, int wr, int wc, int fr, int fq) const {
#pragma unroll
        for (int ai = 0; ai < 2; ++ai)
#pragma unroll
            for (int m = 0; m < 4; ++m) { const int r = u.pm * BM + ai * HALF + wr * 64 + m * 16 + fr;
#pragma unroll
                for (int bj = 0; bj < 2; ++bj) { const int c8 = u.pn * BM + bj * HALF + wc * 32 + 8 * fq; const f32x4 v0 = acc[ai][bj][m][0], v1 = acc[ai][bj][m][1];
                    u32x4 w; w.x = cvt_pk_bf16(v0[0], v0[1]); w.y = cvt_pk_bf16(v0[2], v0[3]); w.z = cvt_pk_bf16(v1[0], v1[1]); w.w = cvt_pk_bf16(v1[2], v1[3]);
                    *(u32x4*)(O + (size_t)r * ldc + c8) = w; } }
    }
};

__device__ __forceinline__ float bflo(unsigned w) { return __builtin_bit_cast(float, w << 16); }
__device__ __forceinline__ float bfhi(unsigned w) { return __builtin_bit_cast(float, w & 0xffff0000u); }
template <bool BF> struct EpiResid {
    static constexpr bool PERM = true, AFTER_DRAIN = false;
    const void* base; bf16_t* Hb; float* sumsq; int ldc;
    __device__ __forceinline__ void operator()(const f32x4 (&acc)[2][2][4][2], const Unit& u, int wr, int wc, int fr, int fq) const {
#pragma unroll
        for (int ai = 0; ai < 2; ++ai)
#pragma unroll
            for (int m = 0; m < 4; ++m) { const int r = u.pm * BM + ai * HALF + wr * 64 + m * 16 + fr; float ss = 0.f;
#pragma unroll
                for (int bj = 0; bj < 2; ++bj) { const int c8 = u.pn * BM + bj * HALF + wc * 32 + 8 * fq; const size_t off = (size_t)r * ldc + c8;
                    float b[8];
                    if (BF) { const u32x4 w = *(const u32x4*)((const bf16_t*)base + off); b[0] = bflo(w.x); b[1] = bfhi(w.x); b[2] = bflo(w.y); b[3] = bfhi(w.y); b[4] = bflo(w.z); b[5] = bfhi(w.z); b[6] = bflo(w.w); b[7] = bfhi(w.w); }
                    else { const f32x4 b0 = *(const f32x4*)((const float*)base + off), b1 = *(const f32x4*)((const float*)base + off + 4); b[0] = b0[0]; b[1] = b0[1]; b[2] = b0[2]; b[3] = b0[3]; b[4] = b1[0]; b[5] = b1[1]; b[6] = b1[2]; b[7] = b1[3]; }
                    float h[8];
#pragma unroll
                    for (int j = 0; j < 4; ++j) { h[j] = b[j] + acc[ai][bj][m][0][j]; h[4 + j] = b[4 + j] + acc[ai][bj][m][1][j]; }
#pragma unroll
                    for (int j = 0; j < 8; ++j) ss += h[j] * h[j];
                    u32x4 w; w.x = cvt_pk_bf16(h[0], h[1]); w.y = cvt_pk_bf16(h[2], h[3]); w.z = cvt_pk_bf16(h[4], h[5]); w.w = cvt_pk_bf16(h[6], h[7]);
                    *(u32x4*)(Hb + off) = w; }
                ss += __shfl_xor(ss, 16); ss += __shfl_xor(ss, 32);
                if (fq == 0) unsafeAtomicAdd(sumsq + r, ss); }
    }
};

struct EpiGateUp {
    static constexpr bool PERM = true, AFTER_DRAIN = false;
    const float* sumsq; const float* convw; bf16_t* ACT; float* TAIL; float* FIXG; float* FIXU; float* outFconv; PG8_LAS float* halo;
    __device__ __forceinline__ void operator()(const f32x4 (&acc)[2][2][4][2], const Unit& u, int wr, int wc, int fr, int fq) const {
        const int lane = fr + 16 * fq;
        const int cg = u.pn * HALF + wc * 32 + 8 * fq;
        float w0[8], w1[8], w2[8];
#pragma unroll
        for (int j = 0; j < 8; ++j) { w0[j] = convw[cg + j]; w1[j] = convw[DFF + cg + j]; w2[j] = convw[2 * DFF + cg + j]; }
        float gp[2][4][8], up[2][4][8];
#pragma unroll
        for (int ai = 0; ai < 2; ++ai)
#pragma unroll
            for (int m = 0; m < 4; ++m) { const int r = u.pm * BM + ai * HALF + wr * 64 + m * 16 + fr; const float rs = rsqrtf(sumsq[r] * (1.0f / D) + EPS);
#pragma unroll
                for (int n = 0; n < 2; ++n)
#pragma unroll
                    for (int j = 0; j < 4; ++j) { gp[ai][m][4 * n + j] = acc[ai][0][m][n][j] * rs; up[ai][m][4 * n + j] = acc[ai][1][m][n][j] * rs; } }
        if (fr >= 14) {
#pragma unroll
            for (int ai = 0; ai < 2; ++ai) { PG8_LAS float* hp = halo + ((wc * 4 + (2 * ai + wr)) * 2 + (fr - 14)) * 32 + 8 * fq;
                *(PG8_LAS f32x4*)hp = (f32x4){gp[ai][3][0], gp[ai][3][1], gp[ai][3][2], gp[ai][3][3]}; *(PG8_LAS f32x4*)(hp + 4) = (f32x4){gp[ai][3][4], gp[ai][3][5], gp[ai][3][6], gp[ai][3][7]}; }
        }
        asm volatile("s_waitcnt lgkmcnt(0)" ::: "memory"); __builtin_amdgcn_s_barrier(); asm volatile("" ::: "memory");
        const int src1 = (lane & 48) | ((fr - 1) & 15), src2 = (lane & 48) | ((fr - 2) & 15);
#pragma unroll
        for (int ai = 0; ai < 2; ++ai) {
            const int B = 2 * ai + wr;
            float h62[8], h63[8];
            if (B > 0) { const PG8_LAS float* hp = halo + ((wc * 4 + (B - 1)) * 2) * 32 + 8 * fq;
                const f32x4 a0 = *(const PG8_LAS f32x4*)hp, a1 = *(const PG8_LAS f32x4*)(hp + 4), b0 = *(const PG8_LAS f32x4*)(hp + 32), b1 = *(const PG8_LAS f32x4*)(hp + 36);
#pragma unroll
                for (int j = 0; j < 4; ++j) { h62[j] = a0[j]; h62[4 + j] = a1[j]; h63[j] = b0[j]; h63[4 + j] = b1[j]; } }
            else {
#pragma unroll
                for (int j = 0; j < 8; ++j) { h62[j] = 0.f; h63[j] = 0.f; } }
            float ps1[8], ps2[8];
#pragma unroll
            for (int j = 0; j < 8; ++j) { ps1[j] = h63[j]; ps2[j] = (fr == 0) ? h62[j] : h63[j]; }
#pragma unroll
            for (int m = 0; m < 4; ++m) {
                const int r = u.pm * BM + ai * HALF + wr * 64 + m * 16 + fr;
                float gate[8], a[8];
#pragma unroll
                for (int j = 0; j < 8; ++j) {
                    const float s1 = __shfl(gp[ai][m][j], src1), s2 = __shfl(gp[ai][m][j], src2);
                    const float p1 = (fr >= 1) ? s1 : ps1[j], p2 = (fr >= 2) ? s2 : ps2[j];
                    ps1[j] = s1; ps2[j] = s2;
                    gate[j] = w0[j] * p2 + w1[j] * p1 + w2[j] * gp[ai][m][j];
                    a[j] = silu_f(gate[j]) * up[ai][m][j];
                }
                u32x4 w; w.x = cvt_pk_bf16(a[0], a[1]); w.y = cvt_pk_bf16(a[2], a[3]); w.z = cvt_pk_bf16(a[4], a[5]); w.w = cvt_pk_bf16(a[6], a[7]);
                *(u32x4*)(ACT + (size_t)r * DFF + cg) = w;
                if (B == 0 && m == 0 && fr < 2 && (u.pm & 15) != 0) {
                    float* fg = FIXG + ((size_t)u.pm * 2 + fr) * DFF + cg; float* fu = FIXU + ((size_t)u.pm * 2 + fr) * DFF + cg;
                    *(f32x4*)fg = (f32x4){gate[0], gate[1], gate[2], gate[3]}; *(f32x4*)(fg + 4) = (f32x4){gate[4], gate[5], gate[6], gate[7]};
                    *(f32x4*)fu = (f32x4){up[ai][m][0], up[ai][m][1], up[ai][m][2], up[ai][m][3]}; *(f32x4*)(fu + 4) = (f32x4){up[ai][m][4], up[ai][m][5], up[ai][m][6], up[ai][m][7]};
                }
                if (B == 3 && m == 3 && fr >= 14) {
                    float* tp = TAIL + ((size_t)u.pm * 2 + (fr - 14)) * DFF + cg;
                    *(f32x4*)tp = (f32x4){gp[ai][m][0], gp[ai][m][1], gp[ai][m][2], gp[ai][m][3]}; *(f32x4*)(tp + 4) = (f32x4){gp[ai][m][4], gp[ai][m][5], gp[ai][m][6], gp[ai][m][7]};
                    if ((u.pm & 15) == 15) { float* op = outFconv + ((size_t)(u.pm >> 4) * 2 + (fr - 14)) * DFF + cg;
                        *(f32x4*)op = (f32x4){gp[ai][m][0], gp[ai][m][1], gp[ai][m][2], gp[ai][m][3]}; *(f32x4*)(op + 4) = (f32x4){gp[ai][m][4], gp[ai][m][5], gp[ai][m][6], gp[ai][m][7]}; }
                }
            }
        }
    }
};

struct EpiPle {
    static constexpr bool PERM = true, AFTER_DRAIN = false;
    const bf16_t* H2; const bf16_t* PP; const float* sumsq2; float* H3; float* sumsq3; int ldc;
    __device__ __forceinline__ void operator()(const f32x4 (&acc)[2][2][4][2], const Unit& u, int wr, int wc, int fr, int fq) const {
#pragma unroll
        for (int ai = 0; ai < 2; ++ai)
#pragma unroll
            for (int m = 0; m < 4; ++m) { const int r = u.pm * BM + ai * HALF + wr * 64 + m * 16 + fr; float ss = 0.f;
                const float rs = rsqrtf(sumsq2[r] * (1.0f / D) + EPS);
#pragma unroll
                for (int bj = 0; bj < 2; ++bj) { const int c8 = u.pn * BM + bj * HALF + wc * 32 + 8 * fq; const size_t off = (size_t)r * ldc + c8;
                    const u32x4 hw = *(const u32x4*)(H2 + off), pw = *(const u32x4*)(PP + off);
                    const float hb[8] = {bflo(hw.x), bfhi(hw.x), bflo(hw.y), bfhi(hw.y), bflo(hw.z), bfhi(hw.z), bflo(hw.w), bfhi(hw.w)};
                    const float pb[8] = {bflo(pw.x), bfhi(pw.x), bflo(pw.y), bfhi(pw.y), bflo(pw.z), bfhi(pw.z), bflo(pw.w), bfhi(pw.w)};
                    float h[8];
#pragma unroll
                    for (int j = 0; j < 4; ++j) { h[j] = hb[j] + pb[j] * sigmoid_f(acc[ai][bj][m][0][j] * rs); h[4 + j] = hb[4 + j] + pb[4 + j] * sigmoid_f(acc[ai][bj][m][1][j] * rs); }
#pragma unroll
                    for (int j = 0; j < 8; ++j) ss += h[j] * h[j];
                    *(f32x4*)(H3 + off) = (f32x4){h[0], h[1], h[2], h[3]}; *(f32x4*)(H3 + off + 4) = (f32x4){h[4], h[5], h[6], h[7]}; }
                ss += __shfl_xor(ss, 16); ss += __shfl_xor(ss, 32);
                if (fq == 0) unsafeAtomicAdd(sumsq3 + r, ss); }
    }
};
}

constexpr size_t MiB = 1u << 20;
constexpr size_t WS_CTL = 0, CTL_ZERO_BYTES = 1 * MiB;
constexpr int CW_QUEUE = 1024;
constexpr int CW_BAR = 4096;
constexpr int CW_SUMSQ1 = 32768, CW_SUMSQ2 = CW_SUMSQ1 + M, CW_SUMSQ3 = CW_SUMSQ2 + M;
static_assert((CW_SUMSQ3 + M) * 4 <= (int)CTL_ZERO_BYTES, "ctl");
constexpr size_t WS_WIN = 2 * MiB;
constexpr size_t WS_WOUT = WS_WIN + (size_t)NPROJ_PAD * D * 2;
constexpr size_t WS_WGU = WS_WOUT + (size_t)D * D * 2;
constexpr size_t WS_WDN = WS_WGU + (size_t)NGU * D * 2;
constexpr size_t WS_WPG = WS_WDN + (size_t)D * DFF * 2;
constexpr size_t WS_WPP = WS_WPG + (size_t)D * D * 2;
constexpr size_t WS_XN = WS_WPP + (size_t)D * PLE * 2;
constexpr size_t WS_PB = WS_XN + (size_t)M * D * 2;
constexpr size_t WS_Q = WS_PB + (size_t)M * PLE * 2;
constexpr size_t WS_K = WS_Q + (size_t)M * SBW * 2;
constexpr size_t WS_V = WS_K + (size_t)M * SBW * 2;
constexpr size_t WS_CIN = WS_V + (size_t)M * SBW * 2;
constexpr size_t WS_Z = WS_CIN + (size_t)M * CONVCH * 2;
constexpr size_t WS_G = WS_Z + (size_t)M * GW * 2;
constexpr size_t WS_BETA = WS_G + (size_t)M * NH * 4;
constexpr size_t WS_GQ = WS_BETA + (size_t)M * NH * 4;
constexpr size_t WS_GK = WS_GQ + (size_t)M * GW * 4;
constexpr size_t WS_GV = WS_GK + (size_t)M * GW * 4;
constexpr size_t WS_GO = WS_GV + (size_t)M * GW * 4;
constexpr size_t WS_GSF = WS_GO;
constexpr size_t WS_MIX = WS_GO + (size_t)M * GW * 4;
constexpr size_t WS_H1 = WS_MIX + (size_t)M * D * 2;
constexpr size_t WS_H1B = WS_H1 + (size_t)M * D * 4;
constexpr size_t WS_ACT = WS_H1B + (size_t)M * D * 2;
constexpr size_t WS_TAIL = WS_ACT + (size_t)M * DFF * 2;
constexpr size_t WS_FIXG = WS_TAIL + (size_t)32 * 2 * DFF * 4;
constexpr size_t WS_FIXU = WS_FIXG + (size_t)32 * 2 * DFF * 4;
constexpr size_t WS_H2 = WS_FIXU + (size_t)32 * 2 * DFF * 4;
constexpr size_t WS_H2B = WS_H2 + (size_t)M * D * 4;
constexpr size_t WS_PP = WS_H2B + (size_t)M * D * 2;
constexpr size_t WS_S = WS_PP + (size_t)M * D * 4;
constexpr size_t S_A = 0;
constexpr size_t S_PROJ = S_A + MS * D;
constexpr size_t S_GQ = S_PROJ + MS * IN_COLS;
constexpr size_t S_GK = S_GQ + MS * GW;
constexpr size_t S_GV = S_GK + MS * GW;
constexpr size_t S_G = S_GV + MS * GW;
constexpr size_t S_BETA = S_G + 64;
constexpr size_t S_GO = S_BETA + 64;
constexpr size_t S_PART = S_GO + MS * GW;
constexpr int DSEG = 256, DPART = 132;
constexpr size_t S_MIX = S_PART + (size_t)MS * NH * DSEG * DPART;
constexpr size_t S_H1 = S_MIX + MS * D;
constexpr size_t S_GP = S_H1 + MS * D;
constexpr size_t S_UP = S_GP + MS * DFF;
constexpr size_t S_ACT = S_UP + MS * DFF;
constexpr size_t S_H2 = S_ACT + MS * DFF;
constexpr size_t S_PG = S_H2 + MS * D;
constexpr size_t S_PP = S_PG + MS * D;
constexpr size_t S_END = S_PP + MS * D;
constexpr size_t WS_GREC = ((WS_S + S_END * 4 + 4095) / 4096) * 4096;
constexpr size_t WS_GEG = WS_GREC + (size_t)16 * 64 * 73728;
constexpr size_t WS_DUMMY = WS_GEG + 16 * 64 * 4;
constexpr size_t WS_END = WS_DUMMY + (size_t)M * 4;

constexpr int RING_OFF = 0, RING_BYTES = 131072;
constexpr int HALO_OFF = RING_BYTES;
constexpr int LDSCTL_OFF = 151552, MISC_OFF = LDSCTL_OFF + 320;
constexpr int LDS_BYTES = 155648;
constexpr int NWAVES = 8;

#define GAS __attribute__((address_space(1)))
#define LAS __attribute__((address_space(3)))
typedef unsigned short bf16;
typedef unsigned v4u __attribute__((ext_vector_type(4)));
typedef unsigned v2u __attribute__((ext_vector_type(2)));
typedef float f32x4 __attribute__((ext_vector_type(4)));
typedef float f32x2 __attribute__((ext_vector_type(2)));
typedef GAS unsigned gu32;
typedef short bf16x8 __attribute__((ext_vector_type(8)));
typedef short s16x4 __attribute__((ext_vector_type(4)));
typedef float f32x16 __attribute__((ext_vector_type(16)));
typedef __bf16 bf16x2_t __attribute__((ext_vector_type(2)));
__device__ __forceinline__ unsigned cvt2bf(float lo, float hi) { const f32x2 v = {lo, hi}; return __builtin_bit_cast(unsigned, __builtin_convertvector(v, bf16x2_t)); }
#define RLX_AGENT __ATOMIC_RELAXED, __HIP_MEMORY_SCOPE_AGENT
#define LDS_WAIT() asm volatile("s_waitcnt lgkmcnt(0)" ::: "memory")
#define VM_WAIT() asm volatile("s_waitcnt vmcnt(0)" ::: "memory")
__device__ __forceinline__ unsigned f2bf(float f) { unsigned u = __builtin_bit_cast(unsigned, f); return (u + 0x7fffu + ((u >> 16) & 1u)) >> 16; }
__device__ __forceinline__ unsigned pk2(float lo, float hi) { return f2bf(lo) | (f2bf(hi) << 16); }
__device__ __forceinline__ float bf_lo(unsigned w) { return __builtin_bit_cast(float, w << 16); }
__device__ __forceinline__ float bf_hi(unsigned w) { return __builtin_bit_cast(float, w & 0xffff0000u); }
__device__ __forceinline__ float bf2f(bf16 b) { return __builtin_bit_cast(float, (unsigned)b << 16); }
using pg8::silu_f; using pg8::sigmoid_f; using pg8::softplus_f;

#define XB_TMO      128
#define XB_XCNT(j)  (256  + 64 * (j))
#define XB_XSUB(j)  (1280 + 64 * (j))
#define XB_XGEN(j)  (2304 + 64 * (j))
#define XB_TOP      3328
#define XB_TOPGEN   3392
#define XCD_BAR_WORDS 3456
#define XB_SPIN_CAP (1u << 18)
__device__ __forceinline__ unsigned xb_ld(unsigned* p)              { return __hip_atomic_load(p, __ATOMIC_RELAXED, __HIP_MEMORY_SCOPE_AGENT); }
__device__ __forceinline__ unsigned xb_add(unsigned* p, unsigned v) { return __hip_atomic_fetch_add(p, v, __ATOMIC_RELAXED, __HIP_MEMORY_SCOPE_AGENT); }
__device__ __forceinline__ unsigned xb_xcc_id() { return (unsigned)__builtin_amdgcn_s_getreg((3 << 11) | 20) & 0xFu; }
#define XB_SPIN(cond, bar) do { unsigned _sp = 0; while (cond) { __builtin_amdgcn_s_sleep(1); \
    if ((++_sp & 255u) == 0u) { if (xb_ld(&(bar)[XB_TMO])) break; if (_sp > XB_SPIN_CAP) { atomicAdd(&(bar)[XB_TMO], 1u); break; } } } } while (0)
struct XcdBarrier { unsigned* bar; unsigned x; volatile LAS unsigned* st; };
__device__ __forceinline__ XcdBarrier xcd_barrier_post(unsigned* bar, volatile LAS unsigned* st) {
    XcdBarrier b; b.bar = bar; b.x = xb_xcc_id(); b.st = st;
    if (threadIdx.x == 0) (void)xb_add(&bar[XB_XCNT(b.x)], 1u);
    return b;
}
__device__ __forceinline__ void xcd_barrier_complete(unsigned* bar, unsigned x, unsigned& nloc, unsigned& nx) {
    const unsigned G = gridDim.x * gridDim.y * gridDim.z;
    unsigned sum, cnt, mine, sp = 0u;
    for (;;) {
        sum = 0u; cnt = 0u; mine = 0u;
#pragma unroll
        for (unsigned j = 0; j < 16; ++j) { const unsigned c = xb_ld(&bar[XB_XCNT(j)]); sum += c; cnt += (c > 0u) ? 1u : 0u; mine = (j == x) ? c : mine; }
        if (sum == G) break;
        __builtin_amdgcn_s_sleep(1);
        if ((++sp & 255u) == 0u) { if (xb_ld(&bar[XB_TMO])) break; if (sp > XB_SPIN_CAP) { atomicAdd(&bar[XB_TMO], 1u); break; } }
    }
    nloc = mine > 0u ? mine : 1u; nx = cnt > 0u ? cnt : 1u;
}
__device__ __forceinline__ void xcd_barrier(const XcdBarrier& b) {
    asm volatile("s_waitcnt vmcnt(0)" ::: "memory");
    __syncthreads();
    if (threadIdx.x == 0) {
        unsigned* bar = b.bar;
        __builtin_amdgcn_s_waitcnt(0);
        unsigned nloc = b.st[0], nx = b.st[1];
        if (nloc == 0u) { xcd_barrier_complete(bar, b.x, nloc, nx); b.st[0] = nloc; b.st[1] = nx; }
        const unsigned old = xb_add(&bar[XB_XSUB(b.x)], 1u);
        const unsigned gen = old / nloc;
        if (old + 1u == (gen + 1u) * nloc) {
            __builtin_amdgcn_fence(__ATOMIC_RELEASE, "agent");
            asm volatile("s_waitcnt vmcnt(0)" ::: "memory");
            const unsigned og = xb_add(&bar[XB_TOP], 1u);
            const unsigned tg = og / nx;
            if (og + 1u == (tg + 1u) * nx) xb_add(&bar[XB_TOPGEN], 1u);
            else XB_SPIN(xb_ld(&bar[XB_TOPGEN]) == tg, bar);
            __builtin_amdgcn_fence(__ATOMIC_ACQUIRE, "agent");
            xb_add(&bar[XB_XGEN(b.x)], 1u);
            asm volatile("s_waitcnt vmcnt(0)" ::: "memory");
        } else {
            XB_SPIN(xb_ld(&bar[XB_XGEN(b.x)]) == gen, bar);
            __builtin_amdgcn_fence(__ATOMIC_ACQUIRE, "agent");
            asm volatile("s_waitcnt vmcnt(0)" ::: "memory");
        }
    }
    __syncthreads();
}

struct Frame {
    LAS unsigned char* lds;
    volatile LAS unsigned* MISC;
    unsigned* ctl;
    int tid, lane, wave, G, bid;
    float* out;
    unsigned char* ws;
};
__device__ __forceinline__ const float* kin(int i) {
    const unsigned char __attribute__((address_space(4)))* ka = (const unsigned char __attribute__((address_space(4)))*)__builtin_amdgcn_kernarg_segment_ptr();
    unsigned off = (unsigned)i * 8u; asm volatile("" : "+s"(off));
    return *(const float* const __attribute__((address_space(4)))*)(ka + off);
}
#define WSP(T_, off) ((T_*)(F.ws + (off)))
#define SSP(off) ((float*)(F.ws + WS_S) + (off))

__device__ __forceinline__ float wave_sum(float v) {
#pragma unroll
    for (int o = 1; o < 64; o <<= 1) v += __shfl_xor(v, o);
    return v;
}

struct TItem { const float* W; const float* ks; bf16* WT; int ldw, nvalid, K, drow, k0, n0; };
constexpr int TI_NB_IN = 113;
constexpr int TI_IN = (D / 64) * TI_NB_IN, TI_OUT = (D / 64) * (D / 64), TI_G = (D / 64) * (DFF / 64), TI_D = (DFF / 64) * (D / 64), TI_PG = TI_OUT, TI_PP = (PLE / 64) * (D / 64);
__device__ __forceinline__ int ti_count(int set) { return set == 0 ? TI_IN + TI_PP + TI_OUT : set == 1 ? 2 * TI_G : TI_D + TI_PG; }
__device__ __forceinline__ void ti_decode(Frame& F, int set, int r, TItem& t) {
    t.ks = nullptr;
    if (set == 0) {
        if (r < TI_IN) { const int kb = r / TI_NB_IN, nb = r % TI_NB_IN; t.W = kin(11); t.ldw = IN_COLS; t.nvalid = IN_COLS; t.K = D; t.WT = WSP(bf16, WS_WIN); t.drow = 64 * nb; t.k0 = 64 * kb; t.n0 = 64 * nb; return; } r -= TI_IN;
        if (r < TI_PP) { const int kb = r / (D / 64), nb = r % (D / 64); t.W = kin(26); t.ldw = D; t.nvalid = D; t.K = PLE; t.WT = WSP(bf16, WS_WPP); t.drow = 64 * nb; t.k0 = 64 * kb; t.n0 = 64 * nb; return; } r -= TI_PP;
        { const int kb = r / (D / 64), nb = r % (D / 64); t.W = kin(18); t.ldw = D; t.nvalid = D; t.K = D; t.WT = WSP(bf16, WS_WOUT); t.drow = 64 * nb; t.k0 = 64 * kb; t.n0 = 64 * nb; return; }
    } else if (set == 1) {
        const int up = r >= TI_G; if (up) r -= TI_G;
        const int kb = r / (DFF / 64), nb = r % (DFF / 64), n0 = 64 * nb;
        t.W = up ? kin(21) : kin(20); t.ks = kin(19); t.ldw = DFF; t.nvalid = DFF; t.K = D; t.WT = WSP(bf16, WS_WGU); t.drow = 256 * (n0 >> 7) + 128 * up + (n0 & 127); t.k0 = 64 * kb; t.n0 = n0; return;
    } else {
        if (r < TI_D) { const int kb = r / (D / 64), nb = r % (D / 64); t.W = kin(23); t.ldw = D; t.nvalid = D; t.K = DFF; t.WT = WSP(bf16, WS_WDN); t.drow = 64 * nb; t.k0 = 64 * kb; t.n0 = 64 * nb; return; } r -= TI_D;
        { const int kb = r / (D / 64), nb = r % (D / 64); t.W = kin(25); t.ks = kin(24); t.ldw = D; t.nvalid = D; t.K = D; t.WT = WSP(bf16, WS_WPG); t.drow = 64 * nb; t.k0 = 64 * kb; t.n0 = 64 * nb; return; }
    }
}
__device__ __forceinline__ void ti_load(const TItem& t, f32x4 (&v)[16], float (&sc)[16], int lane) {
    const int n4 = (lane & 15) * 4, kq = lane >> 4; const bool nv = (t.n0 + n4) < t.nvalid;
#pragma unroll
    for (int i = 0; i < 16; ++i) { const int kk = 4 * i + kq;
        v[i] = nv ? *(const f32x4*)(t.W + (size_t)(t.k0 + kk) * t.ldw + t.n0 + n4) : (f32x4){0.f, 0.f, 0.f, 0.f};
        sc[i] = t.ks ? t.ks[t.k0 + kk] : 1.f; }
}
__device__ __forceinline__ void ti_store(const TItem& t, const f32x4 (&v)[16], const float (&sc)[16], LAS float* scr, int lane) {
    const int n4 = (lane & 15) * 4, kq = lane >> 4;
#pragma unroll
    for (int i = 0; i < 16; ++i) { const int kk = 4 * i + kq; const f32x4 x = v[i] * sc[i]; LAS float* d = scr + kk * 65 + n4; d[0] = x.x; d[1] = x.y; d[2] = x.z; d[3] = x.w; }
    LDS_WAIT(); asm volatile("" ::: "memory");
    const int c = lane & 7;
#pragma unroll
    for (int j = 0; j < 8; ++j) { const int n = (lane >> 3) + 8 * j; const LAS float* s = scr + (8 * c) * 65 + n;
        v4u o; o.x = pk2(s[0 * 65], s[1 * 65]); o.y = pk2(s[2 * 65], s[3 * 65]); o.z = pk2(s[4 * 65], s[5 * 65]); o.w = pk2(s[6 * 65], s[7 * 65]);
        *(v4u*)(t.WT + (size_t)(t.drow + n) * t.K + t.k0 + 8 * c) = o; }
    LDS_WAIT(); asm volatile("" ::: "memory");
}
__device__ __forceinline__ void convert_set(Frame& F, int set, int wv, int nw) {
    if (wv < 0 || wv >= nw) return;
    LAS float* scr = (LAS float*)(F.lds + RING_OFF + F.wave * 16640);
    const int n = ti_count(set);
    int it = wv; if (it >= n) return;
    TItem cur, nxt; f32x4 vc[16], vn[16]; float sc[16], sn[16];
    ti_decode(F, set, it, cur); ti_load(cur, vc, sc, F.lane);
    for (;;) {
        const int itn = it + nw; const bool hn = itn < n;
        if (hn) { ti_decode(F, set, itn, nxt); ti_load(nxt, vn, sn, F.lane); }
        ti_store(cur, vc, sc, scr, F.lane);
        if (!hn) break;
        cur = nxt; it = itn;
#pragma unroll
        for (int i = 0; i < 16; ++i) { vc[i] = vn[i]; sc[i] = sn[i]; }
    }
}
__device__ __forceinline__ void rms_row(const float* xrow, const float* w, bf16* ob, float* of, int lane) {
    const f32x4* xr = (const f32x4*)xrow + lane; const f32x4* wr_ = (const f32x4*)w + lane;
    f32x4 v[8]; float s = 0.f;
#pragma unroll
    for (int j = 0; j < 8; ++j) { v[j] = xr[64 * j]; s += (v[j].x * v[j].x + v[j].y * v[j].y) + (v[j].z * v[j].z + v[j].w * v[j].w); }
    const float rstd = rsqrtf(wave_sum(s) * (1.f / D) + EPS);
#pragma unroll
    for (int j = 0; j < 8; ++j) { const f32x4 g = wr_[64 * j]; const f32x4 y = v[j] * rstd * g;
        if (ob) ((unsigned long long*)ob)[lane + 64 * j] = (unsigned long long)pk2(y.x, y.y) | ((unsigned long long)pk2(y.z, y.w) << 32);
        if (of) ((f32x4*)of)[lane + 64 * j] = y; }
}

__device__ __forceinline__ void p0_prologue(Frame& F) {
    const int gw = F.bid * NWAVES + F.wave, NGW = F.G * NWAVES;
    bf16* Win = WSP(bf16, WS_WIN);
    convert_set(F, 0, gw, NGW);
    { const size_t z0 = (size_t)7232 * D * 2, z1 = (size_t)NPROJ_PAD * D * 2; v4u* p = (v4u*)((unsigned char*)Win + z0); const size_t n16 = (z1 - z0) / 16;
      for (size_t i = (size_t)F.bid * 512 + F.tid; i < n16; i += (size_t)F.G * 512) p[i] = (v4u){0u, 0u, 0u, 0u}; }
    bf16* XN = WSP(bf16, WS_XN);
    for (int m = gw; m < M; m += NGW) rms_row(kin(0) + (size_t)m * D, kin(10), XN + (size_t)m * D, nullptr, F.lane);
    if (gw < MS) rms_row(kin(1) + (size_t)gw * D, kin(10), nullptr, SSP(S_A) + (size_t)gw * D, F.lane);
    { const f32x4* p = (const f32x4*)kin(8); v2u* o = (v2u*)WSP(bf16, WS_PB); const size_t n4 = (size_t)M * PLE / 4;
      for (size_t i = (size_t)F.bid * 512 + F.tid; i < n4; i += (size_t)F.G * 512) { const f32x4 v = p[i]; o[i] = (v2u){pk2(v.x, v.y), pk2(v.z, v.w)}; } }
}

template <class Epi>
__device__ __forceinline__ void sample_gemm(Frame& F, const float* A, int K, bool norm, const bf16* Wt, int ntiles, const Epi& E) {
    const int first = F.G - 1 - F.bid;
    if (first >= ntiles) return;
    LAS bf16* As = (LAS bf16*)(F.lds);
    LAS float* Red = (LAS float*)(F.lds + 98304);
    LAS float* Rs = (LAS float*)(F.lds + 98304 + 8192);
    const int lane = F.lane, r32 = lane & 31, hh = lane >> 5;
    __syncthreads();
    if (norm) { float s = 0.f; for (int k = lane; k < K; k += 64) { const float v = A[(size_t)F.wave * K + k]; s += v * v; } s = wave_sum(s); if (lane == 0) Rs[F.wave] = rsqrtf(s / (float)K + EPS); }
    else if (lane == 0) Rs[F.wave] = 1.f;
    __syncthreads();
    { const float rs = Rs[F.wave]; for (int k = 2 * lane; k < K; k += 128) { const f32x2 v = *(const f32x2*)(A + (size_t)F.wave * K + k); *(LAS unsigned*)(As + F.wave * K + k) = cvt2bf(v.x * rs, v.y * rs); } }
    __syncthreads();
    const int ksteps = K / 128;
    for (int tl = first; tl < ntiles; tl += F.G) {
        f32x16 acc;
#pragma unroll
        for (int i = 0; i < 16; ++i) acc[i] = 0.f;
        const bf16* wp = Wt + (size_t)(32 * tl + r32) * K + F.wave * (K / 8) + 8 * hh;
        const LAS bf16* ap = As + (r32 & 7) * K + F.wave * (K / 8) + 8 * hh;
#pragma unroll 4
        for (int ks = 0; ks < ksteps; ++ks) {
            const bf16x8 bfr = *(const bf16x8*)(wp + 16 * ks);
            bf16x8 af = *(const LAS bf16x8*)(ap + 16 * ks);
            if (r32 >= 8) af = (bf16x8){0, 0, 0, 0, 0, 0, 0, 0};
            acc = __builtin_amdgcn_mfma_f32_32x32x16_bf16(af, bfr, acc, 0, 0, 0);
        }
        __syncthreads();
#pragma unroll
        for (int i = 0; i < 4; ++i) Red[(F.wave * 8 + 4 * hh + i) * 32 + r32] = acc[i];
        __syncthreads();
        if (F.tid < 256) { const int r = F.tid >> 5, c = F.tid & 31; float s = 0.f;
#pragma unroll
            for (int w = 0; w < 8; ++w) s += Red[(w * 8 + r) * 32 + c];
            E(r, 32 * tl + c, s); }
    }
    __syncthreads();
}
struct SEpiStore { float* O; int ld; int nmax; __device__ __forceinline__ void operator()(int r, int n, float v) const { if (n < nmax) O[(size_t)r * ld + n] = v; } };
struct SEpiAdd { const float* B; float* O; int ld; __device__ __forceinline__ void operator()(int r, int n, float v) const { O[(size_t)r * ld + n] = B[(size_t)r * ld + n] + v; } };
struct SEpiGateUp { float* GP; float* UP; __device__ __forceinline__ void operator()(int r, int n, float v) const { const int j = n >> 8, w = n & 255; if (w < 128) GP[(size_t)r * DFF + 128 * j + w] = v; else UP[(size_t)r * DFF + 128 * j + (w - 128)] = v; } };

__device__ __forceinline__ void gdn_prep_prompt(Frame& F) {
    const int gw = F.bid * NWAVES + F.wave, NGW = F.G * NWAVES;
    const bf16* CIN = WSP(bf16, WS_CIN); const float* cw = kin(14);
    float* GQ = WSP(float, WS_GQ); float* GK = WSP(float, WS_GK); float* GV = WSP(float, WS_GV);
    for (int it = gw; it < M * NH; it += NGW) {
        const int row = it >> 3, h = it & 7, t = row & (T - 1);
#pragma unroll
        for (int seg = 0; seg < 3; ++seg) {
            const int ch = seg * GW + h * HD + 2 * F.lane;
            float a0 = 0.f, a1 = 0.f;
#pragma unroll
            for (int j = 0; j < 4; ++j) { const int tt = t - 3 + j; if (tt >= 0) { const unsigned w = *(const unsigned*)(CIN + (size_t)(row - 3 + j) * CONVCH + ch); a0 += bf_lo(w) * cw[j * CONVCH + ch]; a1 += bf_hi(w) * cw[j * CONVCH + ch + 1]; } }
            a0 = silu_f(a0); a1 = silu_f(a1);
            float* dst = (seg == 0 ? GQ : seg == 1 ? GK : GV) + (size_t)row * GW + h * HD + 2 * F.lane;
            if (seg < 2) { const float ss = wave_sum(a0 * a0 + a1 * a1); float sc = rsqrtf(ss + 1e-6f); if (seg == 0) sc *= SB_SCALE; a0 *= sc; a1 *= sc; }
            *(f32x2*)dst = (f32x2){a0, a1};
        }
    }
}
__device__ __forceinline__ void gdn_prep_sample(Frame& F) {
    const float* PR = SSP(S_PROJ); const float* hist = kin(5); const float* cw = kin(14);
    const int gt = F.bid * 512 + F.tid, NT = F.G * 512;
    for (int i = gt; i < MS * SBW; i += NT) { const int b = i >> 10, c = i & 1023; F.out[OUT_KS + i] = PR[(size_t)b * IN_COLS + O_SB_K + c]; F.out[OUT_VS + i] = PR[(size_t)b * IN_COLS + O_SB_V + c]; }
    for (int i = gt; i < MS * 3 * CONVCH; i += NT) { const int b = i / (3 * CONVCH), rr = (i / CONVCH) % 3, c = i % CONVCH;
        F.out[OUT_GCONVS + i] = (rr < 2) ? hist[((size_t)b * 3 + rr + 1) * CONVCH + c] : PR[(size_t)b * IN_COLS + O_GQKV + c]; }
    if (gt < 64) { const int b = gt >> 3, h = gt & 7; SSP(S_G)[gt] = -__expf(kin(15)[h]) * softplus_f(PR[(size_t)b * IN_COLS + O_GA + h] + kin(16)[h]); SSP(S_BETA)[gt] = sigmoid_f(PR[(size_t)b * IN_COLS + O_GB + h]); }
    const int gw = F.bid * NWAVES + F.wave;
    if (gw < MS * NH * 3) {
        const int b = gw / (NH * 3), h = (gw / 3) % NH, seg = gw % 3;
        const int ch = seg * GW + h * HD + 2 * F.lane; float a[2];
        float hv[3][2], pv[2], wv[4][2];
#pragma unroll
        for (int e = 0; e < 2; ++e) {
#pragma unroll
            for (int j = 0; j < 3; ++j) { hv[j][e] = hist[((size_t)b * 3 + j) * CONVCH + ch + e]; wv[j][e] = cw[j * CONVCH + ch + e]; }
            pv[e] = PR[(size_t)b * IN_COLS + O_GQKV + ch + e]; wv[3][e] = cw[3 * CONVCH + ch + e]; }
#pragma unroll
        for (int e = 0; e < 2; ++e) a[e] = silu_f(hv[0][e] * wv[0][e] + hv[1][e] * wv[1][e] + hv[2][e] * wv[2][e] + pv[e] * wv[3][e]);
        float* dst = SSP(seg == 0 ? S_GQ : seg == 1 ? S_GK : S_GV) + (size_t)b * GW + h * HD + 2 * F.lane;
        if (seg < 2) { const float ss = wave_sum(a[0] * a[0] + a[1] * a[1]); float sc = rsqrtf(ss + 1e-6f); if (seg == 0) sc *= SB_SCALE; a[0] *= sc; a[1] *= sc; }
        dst[0] = a[0]; dst[1] = a[1];
    }
}

template <bool PIPE>
__device__ __forceinline__ void gdn_recur_wave(const float* GQ, const float* GK, const float* GV, const float* Gg, const float* Gb, int ld, int gld, size_t row0, int ntok, int h, int slice,
                                               const float* S0, float* Sout, float* GO, int lane) {
    const int e = 4 * slice + (lane >> 4), d0 = 8 * (lane & 15);
    float S[8];
#pragma unroll
    for (int i = 0; i < 8; ++i) S[i] = S0 ? S0[(size_t)(d0 + i) * HD + e] : 0.f;
    constexpr int NT = PIPE ? 4 : 1;
    f32x4 ck0[NT], ck1[NT], cq0[NT], cq1[NT]; float cv[NT], cg[NT], cb[NT];
#define GDN_LOAD(dk0, dk1, dq0, dq1, dv, dg, db, tb) do { _Pragma("unroll") for (int i_ = 0; i_ < NT; ++i_) { const size_t row_ = row0 + (tb) + i_; \
        dk0[i_] = *(const f32x4*)(GK + row_ * ld + h * HD + d0); dk1[i_] = *(const f32x4*)(GK + row_ * ld + h * HD + d0 + 4); \
        dq0[i_] = *(const f32x4*)(GQ + row_ * ld + h * HD + d0); dq1[i_] = *(const f32x4*)(GQ + row_ * ld + h * HD + d0 + 4); \
        dv[i_] = GV[row_ * ld + h * HD + e]; dg[i_] = Gg[row_ * gld + h]; db[i_] = Gb[row_ * gld + h]; } } while (0)
    GDN_LOAD(ck0, ck1, cq0, cq1, cv, cg, cb, 0);
    for (int t = 0; t < ntok; t += NT) {
        f32x4 nk0[NT], nk1[NT], nq0[NT], nq1[NT]; float nv[NT], ng[NT], nb[NT];
        const int tn = (t + NT < ntok) ? t + NT : t;
        GDN_LOAD(nk0, nk1, nq0, nq1, nv, ng, nb, tn);
#pragma unroll
        for (int i = 0; i < NT; ++i) {
            const float kk[8] = {ck0[i].x, ck0[i].y, ck0[i].z, ck0[i].w, ck1[i].x, ck1[i].y, ck1[i].z, ck1[i].w}, qq[8] = {cq0[i].x, cq0[i].y, cq0[i].z, cq0[i].w, cq1[i].x, cq1[i].y, cq1[i].z, cq1[i].w};
            const float eg = __expf(cg[i]);
            float kv = 0.f;
#pragma unroll
            for (int j = 0; j < 8; ++j) kv += S[j] * kk[j];
            kv += __shfl_xor(kv, 1); kv += __shfl_xor(kv, 2); kv += __shfl_xor(kv, 4); kv += __shfl_xor(kv, 8);
            const float u = cb[i] * (cv[i] - eg * kv);
            float o = 0.f;
#pragma unroll
            for (int j = 0; j < 8; ++j) { S[j] = eg * S[j] + kk[j] * u; o += S[j] * qq[j]; }
            o += __shfl_xor(o, 1); o += __shfl_xor(o, 2); o += __shfl_xor(o, 4); o += __shfl_xor(o, 8);
            if ((lane & 15) == 0) GO[(row0 + t + i) * ld + h * HD + e] = o;
        }
#pragma unroll
        for (int i = 0; i < NT; ++i) { ck0[i] = nk0[i]; ck1[i] = nk1[i]; cq0[i] = nq0[i]; cq1[i] = nq1[i]; cv[i] = nv[i]; cg[i] = ng[i]; cb[i] = nb[i]; }
    }
#undef GDN_LOAD
#pragma unroll
    for (int i = 0; i < 8; ++i) Sout[(size_t)(d0 + i) * HD + e] = S[i];
}

__device__ __forceinline__ void sb_query_simple(Frame& F, int b, int h, int t, LAS float* qs) {
    const bf16* Qb = WSP(bf16, WS_Q); const bf16* Kb = WSP(bf16, WS_K); const bf16* Vb = WSP(bf16, WS_V); bf16* MIX = WSP(bf16, WS_MIX);
    const size_t row = (size_t)b * T + t; const int lane = F.lane;
    { const unsigned w = *(const unsigned*)(Qb + row * SBW + h * HD + 2 * lane); qs[2 * lane] = bf_lo(w); qs[2 * lane + 1] = bf_hi(w); }
    LDS_WAIT(); asm volatile("" ::: "memory");
    const float ch = kin(12)[h];
    float o0 = 0.f, o1 = 0.f, R = 0.f;
    const int nblk = (t + 63) >> 6;
    for (int blk = nblk - 1; blk >= 0; --blk) {
        const int k0 = blk * 64, key = k0 + lane; const bool valid = key < t;
        const v4u* kr = (const v4u*)(Kb + ((size_t)b * T + key) * SBW + h * HD);
        float dot = 0.f;
#pragma unroll
        for (int c = 0; c < 16; ++c) { const v4u w = kr[c]; const f32x4 qa = *(const LAS f32x4*)(qs + 8 * c), qb = *(const LAS f32x4*)(qs + 8 * c + 4);
            dot += bf_lo(w.x) * qa.x + bf_hi(w.x) * qa.y + bf_lo(w.y) * qa.z + bf_hi(w.y) * qa.w + bf_lo(w.z) * qb.x + bf_hi(w.z) * qb.y + bf_lo(w.w) * qb.z + bf_hi(w.w) * qb.w; }
        const float z = dot * SB_SCALE + ch;
        const float sp = softplus_f(z);
        const float L = valid ? -sp : 0.f, lb = z - sp;
        float s = L;
#pragma unroll
        for (int o = 1; o < 64; o <<= 1) { const float tmp = __shfl_down(s, o); if (lane + o < 64) s += tmp; }
        const float tot = __shfl(s, 0);
        const float a = valid ? __expf(lb + (s - L) + R) : 0.f;
        R += tot;
        const bf16* vr = Vb + ((size_t)b * T + k0) * SBW + h * HD + 2 * lane;
#pragma unroll 8
        for (int j = 0; j < 64; ++j) { const float aj = __shfl(a, j); const unsigned w = *(const unsigned*)(vr + (size_t)j * SBW); o0 += aj * bf_lo(w); o1 += aj * bf_hi(w); }
    }
    const float ss = wave_sum(o0 * o0 + o1 * o1); const float rs = rsqrtf(ss * (1.f / HD) + EPS);
    const float* nw = kin(13);
    *(unsigned*)(MIX + row * D + h * HD + 2 * lane) = pk2(o0 * rs * nw[2 * lane], o1 * rs * nw[2 * lane + 1]);
}

__device__ __forceinline__ void sb_decode_block(Frame& F, int bh, int blk) {
    const int b = bh >> 3, h = bh & 7;
    const float* q = SSP(S_PROJ) + (size_t)b * IN_COLS + h * HD;
    const float* CK = kin(2); const float* CV = kin(3); const int* PT = (const int*)kin(4);
    int lane = F.lane; asm volatile("" : "+v"(lane));
    const int half = lane >> 5, l32 = lane & 31;
    const f32x4 q4 = *(const f32x4*)(q + 4 * l32);
    const float k2 = kin(12)[h] * 1.4426950408889634f, k1 = SB_SCALE * 1.4426950408889634f;
    const int p0 = blk * 64;
    const int page = PT[b * NPAGES + (p0 >> 7)];
    const size_t base = (((size_t)page * PAGE + (p0 & 127)) * NH + h) * HD;
    int zi = 0;
#pragma unroll
    for (int hb = 0; hb < 2; ++hb) {
        f32x4 kv[16];
#pragma unroll
        for (int i = 0; i < 16; ++i) kv[i] = __builtin_nontemporal_load((const f32x4*)(CK + base + (size_t)(32 * hb + 2 * i + half) * (NH * HD) + 4 * l32));
#pragma unroll
        for (int i = 0; i < 16; ++i) {
            float p = (kv[i].x * q4.x + kv[i].y * q4.y) + (kv[i].z * q4.z + kv[i].w * q4.w);
            { int pi = __builtin_bit_cast(int, p);
              p += __builtin_bit_cast(float, __builtin_amdgcn_update_dpp(0, pi, 0xB1, 0xF, 0xF, false)); pi = __builtin_bit_cast(int, p);
              p += __builtin_bit_cast(float, __builtin_amdgcn_update_dpp(0, pi, 0x4E, 0xF, 0xF, false)); pi = __builtin_bit_cast(int, p);
              p += __builtin_bit_cast(float, __builtin_amdgcn_update_dpp(0, pi, 0x141, 0xF, 0xF, false)); pi = __builtin_bit_cast(int, p);
              p += __builtin_bit_cast(float, __builtin_amdgcn_update_dpp(0, pi, 0x140, 0xF, 0xF, false)); pi = __builtin_bit_cast(int, p);
              p += __builtin_bit_cast(float, __builtin_amdgcn_ds_swizzle(pi, 0x401F)); }
            const int pe = __builtin_amdgcn_readlane(__builtin_bit_cast(int, p), 0), po = __builtin_amdgcn_readlane(__builtin_bit_cast(int, p), 32);
            asm volatile("s_nop 3\n\tv_writelane_b32 %0, %1, %2" : "+v"(zi) : "s"(pe), "i"(32 * hb + 2 * i)); asm volatile("v_writelane_b32 %0, %1, %2" : "+v"(zi) : "s"(po), "i"(32 * hb + 2 * i + 1));
        }
    }
    const float z = __builtin_bit_cast(float, zi);
    const float e = __builtin_amdgcn_exp2f(-(z * k1 + k2));
    const float be = __builtin_amdgcn_rcpf(1.0f + e), m = 1.0f - be;
    float s = m;
#pragma unroll
    for (int o = 1; o < 64; o <<= 1) { const float t = __shfl_down(s, o); if (lane + o < 64) s *= t; }
    const float tot = __shfl(s, 0);
    const float sx = __shfl_down(s, 1);
    const float a = be * (lane < 63 ? sx : 1.0f);
    f32x4 o4 = {0.f, 0.f, 0.f, 0.f};
#pragma unroll
    for (int hb = 0; hb < 2; ++hb) {
        f32x4 vv[16];
#pragma unroll
        for (int i = 0; i < 16; ++i) vv[i] = __builtin_nontemporal_load((const f32x4*)(CV + base + (size_t)(32 * hb + 2 * i + half) * (NH * HD) + 4 * l32));
#pragma unroll
        for (int i = 0; i < 16; ++i) { const float aj = __shfl(a, 32 * hb + 2 * i + half); o4 += aj * vv[i]; }
    }
    o4.x += __shfl_xor(o4.x, 32); o4.y += __shfl_xor(o4.y, 32); o4.z += __shfl_xor(o4.z, 32); o4.w += __shfl_xor(o4.w, 32);
    float* P = SSP(S_PART) + ((size_t)bh * DSEG + blk) * DPART;
    if (half == 0) *(f32x4*)(P + 4 * l32) = o4; if (lane == 0) P[128] = tot;
}
__device__ __forceinline__ void sb_decode_pull(Frame& F, unsigned* qctr, volatile LAS unsigned* stop) {
    for (;;) {
        if (stop && __builtin_amdgcn_readfirstlane(*stop) != 0u) break;
        const unsigned v = __hip_atomic_fetch_add(qctr, 1u, __ATOMIC_RELAXED, __HIP_MEMORY_SCOPE_AGENT);
        const int it = (int)(__builtin_amdgcn_readfirstlane(v) >> 6);
        if (it >= MS * NH * DSEG) break;
        sb_decode_block(F, ((it >> 11) << 3) | (it & 7), (it >> 3) & 255);
    }
}

__device__ __forceinline__ unsigned offb(unsigned row, unsigned ch) { return 256u * row + 16u * (ch ^ (((row & 3u) << 2) | ((row >> 2) & 3u))); }
constexpr float LOG2E = 1.4426950408889634f;

__device__ __forceinline__ void sb_attn_unit(Frame& F, int b, int h, int qb) {
    const bf16* Qb = WSP(bf16, WS_Q); const bf16* Kb = WSP(bf16, WS_K); const bf16* Vb = WSP(bf16, WS_V); bf16* MIX = WSP(bf16, WS_MIX);
    const int lane = F.lane, r32 = lane & 31, hh = lane >> 5;
    const int q0w = 256 * qb + 32 * F.wave;
    LAS unsigned char* KB0 = F.lds + RING_OFF; LAS unsigned char* VB0 = F.lds + RING_OFF + 32768;
    bf16x8 qf[8];
    { const bf16* qp = Qb + ((size_t)b * T + q0w + r32) * SBW + h * HD + 8 * hh;
#pragma unroll
      for (int s = 0; s < 8; ++s) qf[s] = *(const bf16x8*)(qp + 16 * s); }
    const float k1 = SB_SCALE * LOG2E, k2 = kin(12)[h] * LOG2E;
    f32x16 oacc[4];
#pragma unroll
    for (int d = 0; d < 4; ++d)
#pragma unroll
        for (int i = 0; i < 16; ++i) oacc[d][i] = 0.f;
    float R = 1.f;
    const int nt = 4 * qb + 4;
    const int srow = F.tid >> 4, sch = F.tid & 15;
    const size_t gbase = ((size_t)b * T) * SBW + h * HD + sch * 8;
    v4u rk[2], rv[2];
#define SB_LOAD(k0_) do { _Pragma("unroll") for (int i_ = 0; i_ < 2; ++i_) { const size_t o_ = gbase + (size_t)((k0_) + srow + 32 * i_) * SBW; rk[i_] = *(const v4u*)(Kb + o_); rv[i_] = *(const v4u*)(Vb + o_); } } while (0)
    const unsigned kwo = (unsigned)((sch >> 1) * 1024 + srow * 32 + (((sch & 1) ^ ((srow >> 3) & 1)) * 16));
    const unsigned vwo = (unsigned)((((srow >> 3) * 4 + (sch >> 2)) * 512) + (srow & 7) * 64 + (sch & 3) * 16);
#define SB_WRITE(buf_) do { _Pragma("unroll") for (int i_ = 0; i_ < 2; ++i_) { *(LAS v4u*)(KB0 + (buf_) * 16384 + kwo + i_ * 8192) = rk[i_]; *(LAS v4u*)(VB0 + (buf_) * 16384 + vwo + i_ * 8192) = rv[i_]; } } while (0)
    SB_LOAD(64 * (nt - 1)); SB_WRITE(0);
    __syncthreads();
    const int tq = (lane & 15) >> 2, tp = lane & 3, tblk = (lane >> 4) & 1;
    const unsigned kro = (unsigned)(r32 * 32 + ((hh ^ ((r32 >> 3) & 1)) * 16));
    const unsigned vro = (unsigned)((4 * hh + tq) * 64 + tblk * 32 + tp * 8);
    for (int it = 0; it < nt; ++it) {
        const int kt = nt - 1 - it, buf = it & 1, k0 = 64 * kt;
        if (it + 1 < nt) SB_LOAD(64 * (kt - 1));
        if (k0 < q0w + 31) {
            const bool diag = (k0 + 63 >= q0w);
            LAS unsigned char* Kt = KB0 + buf * 16384; LAS unsigned char* Vt = VB0 + buf * 16384;
            f32x16 sacc[2];
#pragma unroll
            for (int kb = 0; kb < 2; ++kb) {
#pragma unroll
                for (int i = 0; i < 16; ++i) sacc[kb][i] = 0.f;
#pragma unroll
                for (int s = 0; s < 8; ++s) { const bf16x8 kf = *(const LAS bf16x8*)(Kt + kro + (kb * 8 + s) * 1024); sacc[kb] = __builtin_amdgcn_mfma_f32_32x32x16_bf16(kf, qf[s], sacc[kb], 0, 0, 0); }
            }
            float after = R;
            unsigned pp[2][8];
            const int qabs = q0w + r32;
#define SB_TILE(DIAG_) do { _Pragma("unroll") for (int kb = 1; kb >= 0; --kb) _Pragma("unroll") for (int g = 3; g >= 0; --g) { \
                    float be[4], m[4]; \
                    _Pragma("unroll") for (int j = 0; j < 4; ++j) { \
                        const float e = __builtin_amdgcn_exp2f(-(sacc[kb][4 * g + j] * k1 + k2)); \
                        be[j] = __builtin_amdgcn_rcpf(1.0f + e); m[j] = 1.0f - be[j]; \
                        if (DIAG_) { const bool vd = (k0 + 32 * kb + 8 * g + 4 * hh + j) < qabs; be[j] = vd ? be[j] : 0.f; m[j] = vd ? m[j] : 1.f; } } \
                    const float s3 = m[3], s2 = m[2] * s3, s1 = m[1] * s2, s0 = m[0] * s1; \
                    const float p4 = __shfl_xor(s0, 32); \
                    const float base = after * (hh == 0 ? p4 : 1.0f); \
                    const float a0 = be[0] * s1 * base, a1 = be[1] * s2 * base, a2 = be[2] * s3 * base, a3 = be[3] * base; \
                    after *= s0 * p4; \
                    pp[kb][2 * g] = cvt2bf(a0, a1); pp[kb][2 * g + 1] = cvt2bf(a2, a3); } } while (0)
            if (diag) SB_TILE(true); else SB_TILE(false);
#undef SB_TILE
            R = after;
#pragma unroll
            for (int kb = 0; kb < 2; ++kb)
#pragma unroll
                for (int sp = 0; sp < 2; ++sp) {
                    const v4u pw = {pp[kb][4 * sp], pp[kb][4 * sp + 1], pp[kb][4 * sp + 2], pp[kb][4 * sp + 3]};
                    const bf16x8 pf = __builtin_bit_cast(bf16x8, pw);
                    const int keybase = 32 * kb + 16 * sp;
#pragma unroll
                    for (int db = 0; db < 4; ++db) {
                        const s16x4 lo = __builtin_amdgcn_ds_read_tr16_b64_v4i16((LAS s16x4*)(Vt + vro + ((keybase >> 3) * 4 + db) * 512));
                        const s16x4 hi = __builtin_amdgcn_ds_read_tr16_b64_v4i16((LAS s16x4*)(Vt + vro + (((keybase >> 3) + 1) * 4 + db) * 512));
                        const bf16x8 vf = __builtin_shufflevector(lo, hi, 0, 1, 2, 3, 4, 5, 6, 7);
                        oacc[db] = __builtin_amdgcn_mfma_f32_32x32x16_bf16(vf, pf, oacc[db], 0, 0, 0);
                    }
                }
        }
        if (it + 1 < nt) SB_WRITE(buf ^ 1);
        __syncthreads();
    }
#undef SB_LOAD
#undef SB_WRITE
    float ss = 0.f;
#pragma unroll
    for (int d = 0; d < 4; ++d)
#pragma unroll
        for (int i = 0; i < 16; ++i) ss += oacc[d][i] * oacc[d][i];
    ss += __shfl_xor(ss, 32);
    const float rs = rsqrtf(ss * (1.f / HD) + EPS);
    const float* nw = kin(13);
    bf16* op = MIX + ((size_t)b * T + q0w + r32) * D + h * HD + 4 * hh;
#pragma unroll
    for (int d = 0; d < 4; ++d)
#pragma unroll
        for (int g = 0; g < 4; ++g) { const int dd = 32 * d + 8 * g + 4 * hh; const f32x4 w4 = *(const f32x4*)(nw + dd);
            v2u w; w.x = cvt2bf(oacc[d][4 * g] * rs * w4.x, oacc[d][4 * g + 1] * rs * w4.y); w.y = cvt2bf(oacc[d][4 * g + 2] * rs * w4.z, oacc[d][4 * g + 3] * rs * w4.w);
            *(v2u*)(op + 32 * d + 8 * g) = w; }
}

constexpr int GREC_WF = 0, GREC_KTF = 16384, GREC_UF = 32768, GREC_SCAN = 49152  , GREC_QF = 49152, GREC_QKF = 65536, GREC_BYTES = 73728;
constexpr int NCHUNK = T / 64;
constexpr int PL_LOW = 0  , PL_TK = 16384, PL_TQ = 32768, PL_TKBG = 49152, PL_TKT = 65536, PL_TVB = 81920, PL_TT = 98304  , PL_GC = 107520  , PL_BETA = 107776, PL_CW = 108032  ;
__device__ __forceinline__ unsigned rowimg(unsigned row, unsigned c16) { return ((row >> 5) * 8 + (c16 >> 1)) * 1024 + (row & 31) * 32 + (((c16 & 1) ^ ((row >> 3) & 1)) * 16); }
__device__ __forceinline__ unsigned trimg(unsigned row, unsigned c16) { return ((row >> 3) * 4 + (c16 >> 2)) * 512 + (row & 7) * 64 + (c16 & 3) * 16; }

__device__ __forceinline__ void gdn_prep_unit(Frame& F, int chain, int ci, unsigned char* rec, float* EGp, unsigned* qctr) {
    int lane = F.lane, tid = F.tid; asm volatile("" : "+v"(lane), "+v"(tid));
    const int b = chain >> 3, h = chain & 7, r32 = lane & 31, hh = lane >> 5;
    const size_t R0 = (size_t)b * T + 64 * ci;
    unsigned lb0 = 0; asm volatile("" : "+v"(lb0));
    LAS unsigned char* L = F.lds + lb0;
    LAS float* GC = (LAS float*)(L + PL_GC); LAS float* BE = (LAS float*)(L + PL_BETA); LAS float* LOW = (LAS float*)(L + PL_LOW);
    const bf16* CIN = WSP(bf16, WS_CIN); const float* cw = kin(14);
    for (int i = tid - 64; i >= 0 && i < 4 * 3 * 128; i += 448) { const int j = i / 384, seg = (i / 128) % 3, c = i & 127; ((LAS float*)(L + PL_CW))[i] = cw[j * CONVCH + seg * GW + h * HD + c]; }
    if (tid == 0) F.MISC[16] = 0u;
    if (F.wave == 0) { float g = WSP(float, WS_G)[(R0 + lane) * NH + h];
#pragma unroll
        for (int o = 1; o < 64; o <<= 1) { const float t = __shfl_up(g, o); if (lane >= o) g += t; }
        GC[lane] = g; BE[lane] = WSP(float, WS_BETA)[(R0 + lane) * NH + h]; }
    __syncthreads();
    {
        const int t = tid >> 3, sub = tid & 7; const int tseq = 64 * ci + t;
        const float gc = GC[t], gl = GC[63], be = BE[t];
        const float egc = __expf(gc), egl = __expf(gl - gc);
        float val[3][16];
        v4u cin[4][3][2]; float tmask[4];
#pragma unroll
        for (int j = 0; j < 4; ++j) { const bool ok = (tseq - 3 + j) >= 0; tmask[j] = ok ? 1.f : 0.f; const size_t rr = ok ? (R0 + t - 3 + j) : R0;
#pragma unroll
            for (int seg = 0; seg < 3; ++seg) { const bf16* p = CIN + rr * CONVCH + seg * GW + h * HD + 16 * sub; cin[j][seg][0] = *(const v4u*)p; cin[j][seg][1] = *(const v4u*)(p + 8); } }
#pragma unroll
        for (int seg = 0; seg < 3; ++seg) {
            float a[16];
#pragma unroll
            for (int e = 0; e < 16; ++e) a[e] = 0.f;
#pragma unroll
            for (int j = 0; j < 4; ++j) {
                const v4u w0 = cin[j][seg][0], w1 = cin[j][seg][1];
                const unsigned ww[8] = {w0.x, w0.y, w0.z, w0.w, w1.x, w1.y, w1.z, w1.w};
                const LAS f32x4* wl = (const LAS f32x4*)(L + PL_CW + ((j * 3 + seg) * 128 + 16 * sub) * 4);
                const f32x4 c0 = wl[0] * tmask[j], c1 = wl[1] * tmask[j], c2 = wl[2] * tmask[j], c3 = wl[3] * tmask[j];
                const float cwv[16] = {c0.x, c0.y, c0.z, c0.w, c1.x, c1.y, c1.z, c1.w, c2.x, c2.y, c2.z, c2.w, c3.x, c3.y, c3.z, c3.w};
#pragma unroll
                for (int e = 0; e < 8; ++e) { a[2 * e] += bf_lo(ww[e]) * cwv[2 * e]; a[2 * e + 1] += bf_hi(ww[e]) * cwv[2 * e + 1]; }
            }
            float ss = 0.f;
#pragma unroll
            for (int e = 0; e < 16; ++e) { a[e] = silu_f(a[e]); ss += a[e] * a[e]; }
            if (seg < 2) { ss += __shfl_xor(ss, 1); ss += __shfl_xor(ss, 2); ss += __shfl_xor(ss, 4); float sc = rsqrtf(ss + 1e-6f); if (seg == 0) sc *= SB_SCALE;
#pragma unroll
                for (int e = 0; e < 16; ++e) a[e] *= sc; }
#pragma unroll
            for (int e = 0; e < 16; ++e) val[seg][e] = a[e];
        }
#define PK8(dst, src, mul, o) do { dst.x = cvt2bf(src[o] * (mul), src[o + 1] * (mul)); dst.y = cvt2bf(src[o + 2] * (mul), src[o + 3] * (mul)); dst.z = cvt2bf(src[o + 4] * (mul), src[o + 5] * (mul)); dst.w = cvt2bf(src[o + 6] * (mul), src[o + 7] * (mul)); } while (0)
        v4u p0, p1;
        PK8(p0, val[1], 1.0f, 0); PK8(p1, val[1], 1.0f, 8); *(LAS v4u*)(L + PL_TK + rowimg(t, 2 * sub)) = p0; *(LAS v4u*)(L + PL_TK + rowimg(t, 2 * sub + 1)) = p1;
        PK8(p0, val[1], be * egc, 0); PK8(p1, val[1], be * egc, 8); *(LAS v4u*)(L + PL_TKBG + trimg(t, 2 * sub)) = p0; *(LAS v4u*)(L + PL_TKBG + trimg(t, 2 * sub + 1)) = p1;
        PK8(p0, val[1], egl, 0); PK8(p1, val[1], egl, 8); *(LAS v4u*)(L + PL_TKT + trimg(t, 2 * sub)) = p0; *(LAS v4u*)(L + PL_TKT + trimg(t, 2 * sub + 1)) = p1;
        PK8(p0, val[0], 1.0f, 0); PK8(p1, val[0], 1.0f, 8); *(LAS v4u*)(L + PL_TQ + rowimg(t, 2 * sub)) = p0; *(LAS v4u*)(L + PL_TQ + rowimg(t, 2 * sub + 1)) = p1;
        PK8(p0, val[2], be, 0); PK8(p1, val[2], be, 8); *(LAS v4u*)(L + PL_TVB + trimg(t, 2 * sub)) = p0; *(LAS v4u*)(L + PL_TVB + trimg(t, 2 * sub + 1)) = p1;
        { float qg[16];
#pragma unroll
          for (int e = 0; e < 16; ++e) qg[e] = val[0][e] * egc;
          unsigned char* qf = rec + GREC_QF + ((t >> 5) * 8 + sub) * 1024 + (t & 31) * 16;
          v4u f0, f1; f0.x = cvt2bf(qg[0], qg[1]); f0.y = cvt2bf(qg[2], qg[3]); f0.z = cvt2bf(qg[8], qg[9]); f0.w = cvt2bf(qg[10], qg[11]);
          f1.x = cvt2bf(qg[4], qg[5]); f1.y = cvt2bf(qg[6], qg[7]); f1.z = cvt2bf(qg[12], qg[13]); f1.w = cvt2bf(qg[14], qg[15]);
          *(v4u*)qf = f0; *(v4u*)(qf + 512) = f1; }
#undef PK8
        if (tid == 0) *EGp = __expf(gl);
    }
    __syncthreads();
    {
        const int which = F.wave >> 2, ta = (F.wave >> 1) & 1, tb = F.wave & 1;
        const unsigned aro = r32 * 32 + ((hh ^ ((r32 >> 3) & 1)) * 16);
        f32x16 acc;
#pragma unroll
        for (int i = 0; i < 16; ++i) acc[i] = 0.f;
        const bool zero_tile = (which == 0) ? (ta < tb) : (ta > tb);
        if (!zero_tile) {
#pragma unroll
            for (int ks = 0; ks < 8; ++ks) {
                const bf16x8 af = *(const LAS bf16x8*)(L + PL_TK + aro + (ta * 8 + ks) * 1024);
                const bf16x8 bfr = *(const LAS bf16x8*)(L + (which == 0 ? PL_TK : PL_TQ) + aro + (tb * 8 + ks) * 1024);
                acc = __builtin_amdgcn_mfma_f32_32x32x16_bf16(af, bfr, acc, 0, 0, 0);
            }
        }
        if (which == 0) {
            const int s = 32 * tb + r32; const float gs = GC[s];
#pragma unroll
            for (int g = 0; g < 4; ++g) { const int c0 = 32 * ta + 8 * g + 4 * hh; const f32x4 gc4 = *(const LAS f32x4*)(GC + c0), be4 = *(const LAS f32x4*)(BE + c0);
#pragma unroll
                for (int j = 0; j < 4; ++j) { const float e = __expf(fminf(gc4[j] - gs, 0.f)); const float v = be4[j] * acc[4 * g + j] * e; LOW[(c0 + j) * 64 + s] = (c0 + j > s) ? v : 0.f; } }
        } else {
            const int c = 32 * tb + r32; const float gcc = GC[c]; float v[16];
#pragma unroll
            for (int g = 0; g < 4; ++g) { const int s0 = 32 * ta + 8 * g + 4 * hh; const f32x4 gc4 = *(const LAS f32x4*)(GC + s0);
#pragma unroll
                for (int j = 0; j < 4; ++j) { const float e = __expf(fminf(gcc - gc4[j], 0.f)); const float x = acc[4 * g + j] * e; v[4 * g + j] = (c >= s0 + j) ? x : 0.f; } }
#pragma unroll
            for (int s = 0; s < 2; ++s) { v4u f; f.x = cvt2bf(v[8 * s], v[8 * s + 1]); f.y = cvt2bf(v[8 * s + 2], v[8 * s + 3]); f.z = cvt2bf(v[8 * s + 4], v[8 * s + 5]); f.w = cvt2bf(v[8 * s + 6], v[8 * s + 7]);
                *(v4u*)(rec + GREC_QKF + (tb * 4 + 2 * ta + s) * 1024 + lane * 16) = f; }
        }
    }
    __syncthreads();
    if (F.wave != 0) sb_decode_pull(F, qctr, F.MISC + 16);
    if (F.wave == 0) {
        float Tc[64];
#pragma unroll
        for (int c = 0; c < 64; ++c) {
            float a0 = 0.f, a1 = 0.f, a2 = 0.f, a3 = 0.f;
#pragma unroll
            for (int s4 = 0; s4 < (c + 3) / 4; ++s4) { const f32x4 l4 = *(const LAS f32x4*)(LOW + c * 64 + 4 * s4);
                a0 += l4.x * Tc[4 * s4]; if (4 * s4 + 1 < c) a1 += l4.y * Tc[4 * s4 + 1]; if (4 * s4 + 2 < c) a2 += l4.z * Tc[4 * s4 + 2]; if (4 * s4 + 3 < c) a3 += l4.w * Tc[4 * s4 + 3]; }
            Tc[c] = ((c == lane) ? 1.f : 0.f) - ((a0 + a1) + (a2 + a3));
        }
#pragma unroll
        for (int c = 0; c < 64; ++c) *(LAS bf16*)(L + PL_TT + c * 144 + lane * 2) = (bf16)f2bf(Tc[c]);
        F.MISC[16] = 1u;
    }
    __syncthreads();
    {
        const int tq = (lane & 15) >> 2, tp = lane & 3, tblk = (lane >> 4) & 1;
        const unsigned trn = hh * 2048 + tq * 64 + tblk * 32 + tp * 8;
        const unsigned trm = (4 * hh + tq) * 64 + tblk * 32 + tp * 8;
        const unsigned tro = r32 * 144 + hh * 16;
        {
            const int ct = F.wave >> 2, et = F.wave & 3; f32x16 acc;
#pragma unroll
            for (int i = 0; i < 16; ++i) acc[i] = 0.f;
#pragma unroll
            for (int ks = 0; ks < 4; ++ks) {
                const bf16x8 af = *(const LAS bf16x8*)(L + PL_TT + tro + ct * 32 * 144 + ks * 32);
                const s16x4 lo = __builtin_amdgcn_ds_read_tr16_b64_v4i16((LAS s16x4*)(L + PL_TVB + trn + ks * 4096 + et * 512));
                const s16x4 hi = __builtin_amdgcn_ds_read_tr16_b64_v4i16((LAS s16x4*)(L + PL_TVB + trn + ks * 4096 + et * 512 + 256));
                acc = __builtin_amdgcn_mfma_f32_32x32x16_bf16(af, __builtin_shufflevector(lo, hi, 0, 1, 2, 3, 4, 5, 6, 7), acc, 0, 0, 0);
            }
            v4u f0, f1; f0.x = cvt2bf(acc[0], acc[1]); f0.y = cvt2bf(acc[2], acc[3]); f0.z = cvt2bf(acc[4], acc[5]); f0.w = cvt2bf(acc[6], acc[7]);
            f1.x = cvt2bf(acc[8], acc[9]); f1.y = cvt2bf(acc[10], acc[11]); f1.z = cvt2bf(acc[12], acc[13]); f1.w = cvt2bf(acc[14], acc[15]);
            unsigned char* up = rec + GREC_UF + (et * 2 + ct) * 2048 + lane * 32; *(v4u*)up = f0; *(v4u*)(up + 16) = f1;
        }
        {
            const int dt = F.wave >> 1, ct = F.wave & 1; f32x16 acc;
#pragma unroll
            for (int i = 0; i < 16; ++i) acc[i] = 0.f;
#pragma unroll
            for (int ks = 0; ks < 4; ++ks) {
                const s16x4 lo = __builtin_amdgcn_ds_read_tr16_b64_v4i16((LAS s16x4*)(L + PL_TKBG + trn + ks * 4096 + dt * 512));
                const s16x4 hi = __builtin_amdgcn_ds_read_tr16_b64_v4i16((LAS s16x4*)(L + PL_TKBG + trn + ks * 4096 + dt * 512 + 256));
                const bf16x8 bfr = *(const LAS bf16x8*)(L + PL_TT + tro + ct * 32 * 144 + ks * 32);
                acc = __builtin_amdgcn_mfma_f32_32x32x16_bf16(__builtin_shufflevector(lo, hi, 0, 1, 2, 3, 4, 5, 6, 7), bfr, acc, 0, 0, 0);
            }
#pragma unroll
            for (int s = 0; s < 2; ++s) { v4u f; f.x = cvt2bf(-acc[8 * s], -acc[8 * s + 1]); f.y = cvt2bf(-acc[8 * s + 2], -acc[8 * s + 3]); f.z = cvt2bf(-acc[8 * s + 4], -acc[8 * s + 5]); f.w = cvt2bf(-acc[8 * s + 6], -acc[8 * s + 7]);
                *(v4u*)(rec + GREC_WF + (ct * 8 + 2 * dt + s) * 1024 + lane * 16) = f; }
        }
        {
#pragma unroll
            for (int q = 0; q < 2; ++q) { const int f = 2 * F.wave + q, dt = f >> 2, ksp = f & 3;
                const s16x4 lo = __builtin_amdgcn_ds_read_tr16_b64_v4i16((LAS s16x4*)(L + PL_TKT + trm + (2 * ksp) * 2048 + dt * 512));
                const s16x4 hi = __builtin_amdgcn_ds_read_tr16_b64_v4i16((LAS s16x4*)(L + PL_TKT + trm + (2 * ksp + 1) * 2048 + dt * 512));
                const bf16x8 kf = __builtin_shufflevector(lo, hi, 0, 1, 2, 3, 4, 5, 6, 7);
                *(bf16x8*)(rec + GREC_KTF + (dt * 4 + ksp) * 1024 + lane * 16) = kf; }
        }
    }
    __syncthreads();
}

__device__ __forceinline__ void gdn_scan_chain(Frame& F, int chain) {
    const int lane = F.lane, r32 = lane & 31, hh = lane >> 5, et = F.wave;
    const unsigned char* recs = F.ws + WS_GREC + (size_t)chain * NCHUNK * GREC_BYTES;
    const float* EG = WSP(float, WS_GEG) + chain * NCHUNK;
    unsigned char* sfr = F.ws + WS_GSF + ((size_t)chain * NCHUNK * 4 + et) * 8192 + lane * 16;
    LAS unsigned char* L = F.lds;
    f32x16 S[4];
#pragma unroll
    for (int d = 0; d < 4; ++d)
#pragma unroll
        for (int i = 0; i < 16; ++i) S[d][i] = 0.f;
#define GS_DMA(ci_, slot_) do { const unsigned char* g_ = recs + (size_t)(ci_) * GREC_BYTES + lane * 16; \
        _Pragma("unroll") for (int p_ = 0; p_ < 6; ++p_) __builtin_amdgcn_global_load_lds((const unsigned*)(g_ + (F.wave + 8 * p_) * 1024), (LAS unsigned*)(L + (slot_) * GREC_SCAN + (F.wave + 8 * p_) * 1024), 16, 0, 0); } while (0)
    const float egv = EG[lane];
    asm volatile("s_waitcnt vmcnt(0)" ::: "memory");
    GS_DMA(0, 0); GS_DMA(1, 1);
    asm volatile("s_waitcnt vmcnt(6)" ::: "memory"); __builtin_amdgcn_s_barrier(); asm volatile("" ::: "memory");
    for (int ci = 0; ci < NCHUNK; ++ci) {
        const int slot = ci % 3;
        { const int cn = (ci + 2 < NCHUNK) ? ci + 2 : ci; GS_DMA(cn, (ci + 2) % 3); }
        if (F.wave < 4) {
            const LAS unsigned char* A = L + slot * GREC_SCAN + lane * 16;
            const float eg = __builtin_bit_cast(float, __builtin_amdgcn_readlane(__builtin_bit_cast(int, egv), ci));
            bf16x8 sf[8];
#pragma unroll
            for (int ks = 0; ks < 8; ++ks) { const int d = ks >> 1, s = ks & 1; v4u w; w.x = cvt2bf(S[d][8 * s], S[d][8 * s + 1]); w.y = cvt2bf(S[d][8 * s + 2], S[d][8 * s + 3]); w.z = cvt2bf(S[d][8 * s + 4], S[d][8 * s + 5]); w.w = cvt2bf(S[d][8 * s + 6], S[d][8 * s + 7]); sf[ks] = __builtin_bit_cast(bf16x8, w);
                *(v4u*)(sfr + (size_t)ci * 32768 + ks * 1024) = w; }
            f32x16 vn[2];
#pragma unroll
            for (int ct = 0; ct < 2; ++ct) {
                const LAS unsigned char* up = L + slot * GREC_SCAN + GREC_UF + (et * 2 + ct) * 2048 + lane * 32;
                const v4u u0 = *(const LAS v4u*)up, u1 = *(const LAS v4u*)(up + 16);
                const unsigned uw[8] = {u0.x, u0.y, u0.z, u0.w, u1.x, u1.y, u1.z, u1.w};
#pragma unroll
                for (int i = 0; i < 8; ++i) { vn[ct][2 * i] = bf_lo(uw[i]); vn[ct][2 * i + 1] = bf_hi(uw[i]); }
#pragma unroll
                for (int ks = 0; ks < 8; ++ks) vn[ct] = __builtin_amdgcn_mfma_f32_32x32x16_bf16(*(const LAS bf16x8*)(A + GREC_WF + (ct * 8 + ks) * 1024), sf[ks], vn[ct], 0, 0, 0);
            }
            bf16x8 vf[4];
#pragma unroll
            for (int ks = 0; ks < 4; ++ks) { const int ct = ks >> 1, s = ks & 1; v4u w; w.x = cvt2bf(vn[ct][8 * s], vn[ct][8 * s + 1]); w.y = cvt2bf(vn[ct][8 * s + 2], vn[ct][8 * s + 3]); w.z = cvt2bf(vn[ct][8 * s + 4], vn[ct][8 * s + 5]); w.w = cvt2bf(vn[ct][8 * s + 6], vn[ct][8 * s + 7]); vf[ks] = __builtin_bit_cast(bf16x8, w); }
#pragma unroll
            for (int d = 0; d < 4; ++d) {
#pragma unroll
                for (int i = 0; i < 16; ++i) S[d][i] *= eg;
#pragma unroll
                for (int ks = 0; ks < 4; ++ks) S[d] = __builtin_amdgcn_mfma_f32_32x32x16_bf16(*(const LAS bf16x8*)(A + GREC_KTF + (d * 4 + ks) * 1024), vf[ks], S[d], 0, 0, 0);
            }
            asm volatile("s_waitcnt vmcnt(14) lgkmcnt(0)" ::: "memory");
        } else {
            asm volatile("s_waitcnt vmcnt(6)" ::: "memory");
        }
        __builtin_amdgcn_s_barrier(); asm volatile("" ::: "memory");
    }
#undef GS_DMA
    asm volatile("s_waitcnt vmcnt(0)" ::: "memory"); __syncthreads();
    if (F.wave < 4) { float* so = F.out + OUT_GREC + (size_t)chain * HD * HD + 32 * et + r32;
#pragma unroll
        for (int d = 0; d < 4; ++d)
#pragma unroll
            for (int i = 0; i < 16; ++i) so[(size_t)(32 * d + (i & 3) + 8 * (i >> 2) + 4 * hh) * HD] = S[d][i]; }
}

__device__ __forceinline__ void gdn_out_unit(Frame& F, int chain, int ci) {
    int lane = F.lane, tid = F.tid; asm volatile("" : "+v"(lane), "+v"(tid));
    const int b = chain >> 3, h = chain & 7, r32 = lane & 31, hh = lane >> 5, et = F.wave & 3, ct = F.wave >> 2;
    const unsigned char* rec = F.ws + WS_GREC + ((size_t)chain * NCHUNK + ci) * GREC_BYTES + lane * 16;
    const unsigned char* sfp = F.ws + WS_GSF + (((size_t)chain * NCHUNK + ci) * 4 + et) * 8192 + lane * 16;
    LAS float* OT = (LAS float*)(F.lds);
    bf16x8 sf[8];
#pragma unroll
    for (int ks = 0; ks < 8; ++ks) sf[ks] = *(const bf16x8*)(sfp + ks * 1024);
    f32x16 vn[2], o;
#pragma unroll
    for (int c2 = 0; c2 < 2; ++c2) {
        const unsigned char* up = F.ws + WS_GREC + ((size_t)chain * NCHUNK + ci) * GREC_BYTES + GREC_UF + (et * 2 + c2) * 2048 + lane * 32;
        const v4u u0 = *(const v4u*)up, u1 = *(const v4u*)(up + 16);
        const unsigned uw[8] = {u0.x, u0.y, u0.z, u0.w, u1.x, u1.y, u1.z, u1.w};
#pragma unroll
        for (int i = 0; i < 8; ++i) { vn[c2][2 * i] = bf_lo(uw[i]); vn[c2][2 * i + 1] = bf_hi(uw[i]); }
#pragma unroll
        for (int ks = 0; ks < 8; ++ks) vn[c2] = __builtin_amdgcn_mfma_f32_32x32x16_bf16(*(const bf16x8*)(rec + GREC_WF + (c2 * 8 + ks) * 1024), sf[ks], vn[c2], 0, 0, 0);
    }
#pragma unroll
    for (int i = 0; i < 16; ++i) o[i] = 0.f;
#pragma unroll
    for (int ks = 0; ks < 8; ++ks) o = __builtin_amdgcn_mfma_f32_32x32x16_bf16(*(const bf16x8*)(rec + GREC_QF + (ct * 8 + ks) * 1024), sf[ks], o, 0, 0, 0);
#pragma unroll
    for (int ks = 0; ks < 4; ++ks) { const int c2 = ks >> 1, s = ks & 1; v4u w; w.x = cvt2bf(vn[c2][8 * s], vn[c2][8 * s + 1]); w.y = cvt2bf(vn[c2][8 * s + 2], vn[c2][8 * s + 3]); w.z = cvt2bf(vn[c2][8 * s + 4], vn[c2][8 * s + 5]); w.w = cvt2bf(vn[c2][8 * s + 6], vn[c2][8 * s + 7]);
        o = __builtin_amdgcn_mfma_f32_32x32x16_bf16(*(const bf16x8*)(rec + GREC_QKF + (ct * 4 + ks) * 1024), __builtin_bit_cast(bf16x8, w), o, 0, 0, 0); }
#pragma unroll
    for (int i = 0; i < 16; ++i) OT[(32 * ct + (i & 3) + 8 * (i >> 2) + 4 * hh) * 132 + 32 * et + r32] = o[i];
    __syncthreads();
    {
        const int c = tid >> 3, sub = tid & 7; const size_t row = (size_t)b * T + 64 * ci + c;
        const LAS f32x4* op = (const LAS f32x4*)(OT + c * 132 + 16 * sub);
        const f32x4 a0 = op[0], a1 = op[1], a2 = op[2], a3 = op[3];
        float x[16] = {a0.x, a0.y, a0.z, a0.w, a1.x, a1.y, a1.z, a1.w, a2.x, a2.y, a2.z, a2.w, a3.x, a3.y, a3.z, a3.w};
        float ss = 0.f;
#pragma unroll
        for (int e = 0; e < 16; ++e) ss += x[e] * x[e];
        ss += __shfl_xor(ss, 1); ss += __shfl_xor(ss, 2); ss += __shfl_xor(ss, 4);
        const float rs = rsqrtf(ss * (1.f / HD) + EPS);
        const bf16* zp = WSP(bf16, WS_Z) + row * GW + h * HD + 16 * sub; const v4u z0 = *(const v4u*)zp, z1 = *(const v4u*)(zp + 8);
        const unsigned zw[8] = {z0.x, z0.y, z0.z, z0.w, z1.x, z1.y, z1.z, z1.w};
        const float* gn = kin(17) + 16 * sub;
        unsigned ow[8];
#pragma unroll
        for (int e = 0; e < 8; ++e) ow[e] = cvt2bf(x[2 * e] * rs * gn[2 * e] * silu_f(bf_lo(zw[e])), x[2 * e + 1] * rs * gn[2 * e + 1] * silu_f(bf_hi(zw[e])));
        bf16* mp = WSP(bf16, WS_MIX) + row * D + SBW + h * HD + 16 * sub;
        *(v4u*)mp = (v4u){ow[0], ow[1], ow[2], ow[3]}; *(v4u*)(mp + 8) = (v4u){ow[4], ow[5], ow[6], ow[7]};
    }
    __syncthreads();
}

#ifndef REP_PHASE
#define REP_PHASE -1
#endif
#ifndef REP_N
#define REP_N 0
#endif
#ifndef REP_SCAN
#define REP_SCAN 0
#endif
#ifndef REP_ATTN
#define REP_ATTN 0
#endif

__device__ __forceinline__ void p2_mixers(Frame& F, unsigned* qctr) {
    _Pragma("unroll") for (int rs_ = 0; rs_ < 1 + REP_SCAN; ++rs_) if (F.bid < NB * NH) gdn_scan_chain(F, F.bid);
    __syncthreads();
    _Pragma("unroll") for (int ra_ = 0; ra_ < 1 + REP_ATTN; ++ra_)
    for (int u = F.bid; u < NB * NH * 16; u += F.G) { const int bh = u & 15, qb = u >> 4; sb_attn_unit(F, bh >> 3, bh & 7, qb); }
    const int gw = F.bid * NWAVES + F.wave, NGW = F.G * NWAVES;
    for (int it = gw; it < MS * NH * 32; it += NGW) {
        const int chain = it >> 5, slice = it & 31, b = chain >> 3, h = chain & 7;
        gdn_recur_wave<false>(SSP(S_GQ), SSP(S_GK), SSP(S_GV), SSP(S_G), SSP(S_BETA), GW, NH, (size_t)b, 1, h, slice,
                              kin(6) + (size_t)chain * HD * HD, F.out + OUT_GRECS + (size_t)chain * HD * HD, SSP(S_GO), F.lane);
    }
    sb_decode_pull(F, qctr, nullptr);
}

__device__ __forceinline__ void p2_finish(Frame& F) {
    const int gw = F.bid * NWAVES + F.wave, NGW = F.G * NWAVES;
    const float* gnw = kin(17);
    for (int u = F.bid; u < NB * NH * NCHUNK; u += F.G) gdn_out_unit(F, u & 15, u >> 4);
    if (F.wave == 0 && F.G - 1 - F.bid < MS * NH) {
        const int bh = F.G - 1 - F.bid, b = bh >> 3, h = bh & 7;
        { const f32x2 o = *(const f32x2*)(SSP(S_GO) + (size_t)b * GW + h * HD + 2 * F.lane);
          const float rs = rsqrtf(wave_sum(o.x * o.x + o.y * o.y) * (1.f / HD) + EPS);
          const float* z = SSP(S_PROJ) + (size_t)b * IN_COLS + O_GZ + h * HD + 2 * F.lane;
          float* mo = SSP(S_MIX) + (size_t)b * D + SBW + h * HD + 2 * F.lane;
          mo[0] = o.x * rs * gnw[2 * F.lane] * silu_f(z[0]); mo[1] = o.y * rs * gnw[2 * F.lane + 1] * silu_f(z[1]); }
        { float o0 = 0.f, o1 = 0.f, R = 1.f;
          const float* P = SSP(S_PART) + (size_t)bh * DSEG * DPART;
          for (int s0 = DSEG - 32; s0 >= 0; s0 -= 32) {
              float pa[32], pb[32], pr[32];
#pragma unroll
              for (int i = 0; i < 32; ++i) { const float* Pi = P + (size_t)(s0 + i) * DPART; const f32x2 v = *(const f32x2*)(Pi + 2 * F.lane); pa[i] = v.x; pb[i] = v.y; pr[i] = Pi[128]; }
#pragma unroll
              for (int i = 31; i >= 0; --i) { o0 += R * pa[i]; o1 += R * pb[i]; R *= pr[i]; } }
          const float rs = rsqrtf(wave_sum(o0 * o0 + o1 * o1) * (1.f / HD) + EPS); const float* nw = kin(13);
          float* mo = SSP(S_MIX) + (size_t)b * D + h * HD + 2 * F.lane; mo[0] = o0 * rs * nw[2 * F.lane]; mo[1] = o1 * rs * nw[2 * F.lane + 1]; }
    }
}

__device__ __forceinline__ void p4b_fixup(Frame& F) {
    const float* TAIL = WSP(float, WS_TAIL); const float* FIXG = WSP(float, WS_FIXG); const float* FIXU = WSP(float, WS_FIXU); bf16* ACT = WSP(bf16, WS_ACT); const float* cw = kin(22);
    const int total = 32 * 2 * DFF;
    for (int i = F.bid * 512 + F.tid; i < total; i += F.G * 512) {
        const int pm = i / (2 * DFF), rr = (i / DFF) & 1, c = i % DFF;
        if ((pm & 15) == 0) continue;
        const float t0 = TAIL[((size_t)(pm - 1) * 2 + 0) * DFF + c], t1 = TAIL[((size_t)(pm - 1) * 2 + 1) * DFF + c];
        float g = FIXG[((size_t)pm * 2 + rr) * DFF + c];
        g += (rr == 0) ? (cw[c] * t0 + cw[DFF + c] * t1) : (cw[c] * t1);
        ACT[(size_t)(pm * 256 + rr) * DFF + c] = (bf16)f2bf(silu_f(g) * FIXU[((size_t)pm * 2 + rr) * DFF + c]);
    }
    const float* st = kin(7); const float* GP = SSP(S_GP); const float* UP = SSP(S_UP); float* SACT = SSP(S_ACT);
    for (int i = F.bid * 512 + F.tid; i < MS * DFF; i += F.G * 512) {
        const int b = i / DFF, c = i % DFF;
        const float s0 = st[((size_t)b * 2 + 0) * DFF + c], s1 = st[((size_t)b * 2 + 1) * DFF + c], gp = GP[i];
        const float g = cw[c] * s0 + cw[DFF + c] * s1 + cw[2 * DFF + c] * gp;
        SACT[i] = silu_f(g) * UP[i];
        F.out[OUT_FCONVS + ((size_t)b * 2 + 0) * DFF + c] = s1; F.out[OUT_FCONVS + ((size_t)b * 2 + 1) * DFF + c] = gp;
    }
}

__device__ __forceinline__ void p7_final(Frame& F) {
    const int gw = F.bid * NWAVES + F.wave, NGW = F.G * NWAVES;
    const float* fw = kin(27); const float* ss3 = (const float*)(F.ctl + CW_SUMSQ3);
    for (int m = gw; m < M; m += NGW) {
        const float rs = rsqrtf(ss3[m] * (1.f / D) + EPS);
        f32x4* y = (f32x4*)(F.out + OUT_Y + (size_t)m * D) + F.lane; const f32x4* w = (const f32x4*)fw + F.lane;
#pragma unroll
        for (int j = 0; j < 8; ++j) y[64 * j] = y[64 * j] * rs * w[64 * j];
    }
    if (F.bid == 0) {
        const int b = F.wave; float v[32]; float s = 0.f;
#pragma unroll
        for (int j = 0; j < 32; ++j) { const int c = F.lane + 64 * j; const float h = SSP(S_H2)[(size_t)b * D + c] + SSP(S_PP)[(size_t)b * D + c] * sigmoid_f(SSP(S_PG)[(size_t)b * D + c]); v[j] = h; s += h * h; }
        const float rs = rsqrtf(wave_sum(s) * (1.f / D) + EPS);
#pragma unroll
        for (int j = 0; j < 32; ++j) { const int c = F.lane + 64 * j; F.out[OUT_YS + (size_t)b * D + c] = v[j] * rs * fw[c]; }
    }
}

constexpr int NPHASES = 12;

constexpr int WS_DUMMY_WORDS = 3 * M;
constexpr int N_LAUNCHES = MK_N_LAUNCHES;
struct Args { const float* in[28]; float* out; unsigned char* ws; int ph_lo, ph_hi; };
__global__ void __launch_bounds__(NWAVES * 64, 2) hymba_fwd(Args args) {
    extern __shared__ __attribute__((aligned(16))) unsigned char lds[];
    Frame F;
    F.lds = (LAS unsigned char*)lds;
    F.MISC = (volatile LAS unsigned*)(F.lds + MISC_OFF);
    F.tid = threadIdx.x; F.lane = F.tid & 63; F.wave = __builtin_amdgcn_readfirstlane(F.tid >> 6);
    F.G = gridDim.x; F.bid = blockIdx.x;
    F.ws = args.ws; F.ctl = (unsigned*)(args.ws + WS_CTL); F.out = args.out;
    for (int u = F.tid; u < (LDS_BYTES - LDSCTL_OFF) / 4; u += NWAVES * 64) ((LAS unsigned*)(F.lds + LDSCTL_OFF))[u] = 0u;
    __syncthreads();
    XcdBarrier bar; bar.bar = F.ctl + CW_BAR; bar.x = 0; bar.st = nullptr;
    if (N_LAUNCHES == 1) bar = xcd_barrier_post(F.ctl + CW_BAR, F.MISC + 8);
#define GRID_BAR() do { if (N_LAUNCHES == 1) xcd_barrier(bar); } while (0)
    const int lo = args.ph_lo, hi = args.ph_hi;
#define IN(k) (lo <= (k) && (k) < hi)
#define NREP(k) ((k) == REP_PHASE ? 1 + REP_N : 1)
    float* ss1 = (float*)(F.ctl + CW_SUMSQ1); float* ss2 = (float*)(F.ctl + CW_SUMSQ2); float* ss3 = (float*)(F.ctl + CW_SUMSQ3); float* dummy = WSP(float, WS_DUMMY);

    if (IN(0)) { _Pragma("unroll") for (int rep = 0; rep < NREP(0); ++rep) p0_prologue(F); GRID_BAR(); }
    if (IN(1)) { _Pragma("unroll") for (int rep = 0; rep < NREP(1); ++rep) {
        { pg8::Gemm g{WSP(bf16, WS_XN), WSP(bf16, WS_WIN), M, NPROJ_PAD, D}; pg8::StaticOrder S; S.init(M, NPROJ_PAD, F.G, F.bid);
          pg8::EpiProj E{WSP(bf16, WS_Q), WSP(bf16, WS_K), WSP(bf16, WS_V), WSP(bf16, WS_CIN), WSP(bf16, WS_Z), F.out + OUT_K, F.out + OUT_V, F.out + OUT_GCONV, WSP(float, WS_G), WSP(float, WS_BETA), kin(15), kin(16)};
          pg8::gemm_phase<pg8::EpiProj, pg8::StaticOrder, true, true>(F.lds + RING_OFF, g, S, E); }
        { pg8::Gemm g{WSP(bf16, WS_PB), WSP(bf16, WS_WPP), M, D, PLE}; pg8::StaticOrder S; S.init(M, D, F.G, F.bid);
          pg8::EpiBf16 E{WSP(bf16, WS_PP), D};
          pg8::gemm_phase<pg8::EpiBf16, pg8::StaticOrder, true, true>(F.lds + RING_OFF, g, S, E); }
        { SEpiStore E{SSP(S_PROJ), IN_COLS, IN_COLS}; sample_gemm(F, SSP(S_A), D, false, WSP(bf16, WS_WIN), 225, E); }
        if (rep == 0) { constexpr int T0 = (29 * 32) % 256; convert_set(F, 1, (F.bid - T0) * NWAVES + F.wave, (F.G - T0) * NWAVES); }
        }
        GRID_BAR();
    }
    if (IN(2)) { _Pragma("unroll") for (int rep = 0; rep < NREP(2); ++rep) {
        for (int u = F.bid; u < NB * NH * NCHUNK; u += F.G) { const int chain = u & 15, ci = u >> 4;
            gdn_prep_unit(F, chain, ci, F.ws + WS_GREC + ((size_t)chain * NCHUNK + ci) * GREC_BYTES, WSP(float, WS_GEG) + chain * NCHUNK + ci, F.ctl + CW_QUEUE); }
        gdn_prep_sample(F); }
        GRID_BAR(); }
    if (IN(3)) { _Pragma("unroll") for (int rep = 0; rep < NREP(3); ++rep) p2_mixers(F, F.ctl + CW_QUEUE); GRID_BAR(); }
    if (IN(4)) { _Pragma("unroll") for (int rep = 0; rep < NREP(4); ++rep) p2_finish(F); GRID_BAR(); }
    if (IN(5)) { _Pragma("unroll") for (int rep = 0; rep < NREP(5); ++rep) {
        { pg8::Gemm g{WSP(bf16, WS_MIX), WSP(bf16, WS_WOUT), M, D, D}; pg8::StaticOrder S; S.init(M, D, F.G, F.bid);
          pg8::EpiResid<false> E{kin(0), WSP(bf16, WS_H1B), rep == 0 ? ss1 : dummy, D};
          pg8::gemm_phase<pg8::EpiResid<false>, pg8::StaticOrder, true, true>(F.lds + RING_OFF, g, S, E); }
        { SEpiAdd E{kin(1), SSP(S_H1), D}; sample_gemm(F, SSP(S_MIX), D, false, WSP(bf16, WS_WOUT), D / 32, E); }
        }
        GRID_BAR();
    }
    if (IN(6)) { _Pragma("unroll") for (int rep = 0; rep < NREP(6); ++rep) {
        { pg8::Gemm g{WSP(bf16, WS_H1B), WSP(bf16, WS_WGU), M, NGU, D}; pg8::StaticOrder S; S.init(M, NGU, F.G, F.bid);
          pg8::EpiGateUp E{ss1, kin(22), WSP(bf16, WS_ACT), WSP(float, WS_TAIL), WSP(float, WS_FIXG), WSP(float, WS_FIXU), F.out + OUT_FCONV, (PG8_LAS float*)(F.lds + HALO_OFF)};
          pg8::gemm_phase<pg8::EpiGateUp, pg8::StaticOrder, true, true>(F.lds + RING_OFF, g, S, E); }
        { SEpiGateUp E{SSP(S_GP), SSP(S_UP)}; sample_gemm(F, SSP(S_H1), D, true, WSP(bf16, WS_WGU), NGU / 32, E); }
        if (rep == 0) { constexpr int T1 = (43 * 32) % 256; convert_set(F, 2, (F.bid - T1) * NWAVES + F.wave, (F.G - T1) * NWAVES); }
        }
        GRID_BAR();
    }
    if (IN(7)) { _Pragma("unroll") for (int rep = 0; rep < NREP(7); ++rep) p4b_fixup(F); GRID_BAR(); }
    if (IN(8)) { _Pragma("unroll") for (int rep = 0; rep < NREP(8); ++rep) {
        { pg8::Gemm g{WSP(bf16, WS_ACT), WSP(bf16, WS_WDN), M, D, DFF}; pg8::StaticOrder S; S.init(M, D, F.G, F.bid);
          pg8::EpiResid<true> E{WSP(bf16, WS_H1B), WSP(bf16, WS_H2B), rep == 0 ? ss2 : dummy, D};
          pg8::gemm_phase<pg8::EpiResid<true>, pg8::StaticOrder, true, true>(F.lds + RING_OFF, g, S, E); }
        { SEpiAdd E{SSP(S_H1), SSP(S_H2), D}; sample_gemm(F, SSP(S_ACT), DFF, false, WSP(bf16, WS_WDN), D / 32, E); }
        }
        GRID_BAR();
    }
    if (IN(9)) { _Pragma("unroll") for (int rep = 0; rep < NREP(9); ++rep) {
        { pg8::Gemm g{WSP(bf16, WS_H2B), WSP(bf16, WS_WPG), M, D, D}; pg8::StaticOrder S; S.init(M, D, F.G, F.bid);
          pg8::EpiPle E{WSP(bf16, WS_H2B), WSP(bf16, WS_PP), ss2, F.out + OUT_Y, rep == 0 ? ss3 : dummy, D};
          pg8::gemm_phase<pg8::EpiPle, pg8::StaticOrder, true, true>(F.lds + RING_OFF, g, S, E); }
        { SEpiStore E{SSP(S_PG), D, D}; sample_gemm(F, SSP(S_H2), D, true, WSP(bf16, WS_WPG), D / 32, E); }
        { SEpiStore E{SSP(S_PP), D, D}; sample_gemm(F, kin(9), PLE, false, WSP(bf16, WS_WPP), D / 32, E); }
        }
        GRID_BAR();
    }
    if (IN(10)) { p7_final(F); }
#undef IN
#undef GRID_BAR
}

extern "C" void kernel_launch(void* const* d_in, const int* in_sizes, int n_in, void* d_out, int out_size, void* d_ws, size_t ws_size, hipStream_t stream) {
    static int grid = 0;
    if (grid == 0) {
        if (n_in != 28 || (size_t)out_size != OUT_END || ws_size < WS_END) { fprintf(stderr, "kernel_launch: unexpected sizes n_in %d out %d ws %zu (need %zu, %zu)\n", n_in, out_size, ws_size, (size_t)OUT_END, (size_t)WS_END); grid = -1; return; }
        int dev = 0, cus = 0, per_cu = 0;
        if (hipGetDevice(&dev) != hipSuccess || hipDeviceGetAttribute(&cus, hipDeviceAttributeMultiprocessorCount, dev) != hipSuccess) { grid = -1; return; }
        if (hipFuncSetAttribute((const void*)hymba_fwd, hipFuncAttributeMaxDynamicSharedMemorySize, LDS_BYTES) != hipSuccess) { fprintf(stderr, "kernel_launch: hipFuncSetAttribute failed\n"); grid = -1; return; }
        if (hipOccupancyMaxActiveBlocksPerMultiprocessor(&per_cu, (const void*)hymba_fwd, NWAVES * 64, LDS_BYTES) != hipSuccess || per_cu < 1) { fprintf(stderr, "kernel_launch: occupancy query says %d\n", per_cu); }
        (void)hipGetLastError();
        grid = cus;
    }
    if (grid < 0) return;
    (void)hipMemsetAsync((char*)d_ws + WS_CTL, 0, CTL_ZERO_BYTES, stream);
    Args a{};
    for (int i = 0; i < 28; ++i) a.in[i] = (const float*)d_in[i];
    a.out = (float*)d_out; a.ws = (unsigned char*)d_ws;
    if (N_LAUNCHES == 1) { a.ph_lo = 0; a.ph_hi = NPHASES; hipLaunchKernelGGL(hymba_fwd, dim3(grid), dim3(NWAVES * 64), LDS_BYTES, stream, a); }
    else for (int p = 0; p < 11; ++p) { a.ph_lo = p; a.ph_hi = p + 1; hipLaunchKernelGGL(hymba_fwd, dim3(grid), dim3(NWAVES * 64), LDS_BYTES, stream, a); }
}
```

```cpp
#include <hip/hip_runtime.h>
#include <cstdio>
#include <cstdint>

#ifndef MK_N_LAUNCHES
#define MK_N_LAUNCHES 1
#endif

namespace pg8 {
#define PG8_LAS __attribute__((address_space(3)))
typedef unsigned short bf16_t;
typedef short bf16x8 __attribute__((ext_vector_type(8)));
typedef float f32x4 __attribute__((ext_vector_type(4)));
typedef unsigned u32x4 __attribute__((ext_vector_type(4)));
constexpr int BM = 256, BK = 64, HALF = 128, HTB = HALF * BK * 2  , STAGE_BYTES = 8 * HTB, NXCD = 8, WGM = 8;

__host__ __device__ __forceinline__ int lds_byte(int r, int c) { const int st = (r >> 4) * 2 + (c >> 5), rr = r & 15, cc = c & 31, ob = rr * 64 + cc * 2; return st * 1024 + (ob ^ (((ob >> 9) & 1) << 5)); }
__host__ __device__ __forceinline__ void stage_rc(int b, int& R, int& C) { const int st = b / 1024, sb = b % 1024, swz = sb ^ (((sb >> 9) & 1) << 5); R = (st >> 1) * 16 + swz / 64; C = (st & 1) * 32 + (swz % 64) / 2; }
__host__ __device__ __forceinline__ int perm32(int rho) { const int n = rho >> 4, i = rho & 15; return 8 * (i >> 2) + 4 * n + (i & 3); }

struct Unit { int pm, pn; };
struct Gemm { const bf16_t* A; const bf16_t* Bt; int M, N, K; };

struct StaticOrder {
    int nM, nN, nwg, G, c;
    __host__ __device__ void init(int M, int N, int G_, int c_) { nM = M / BM; nN = N / BM; nwg = nM * nN; G = G_; c = c_; }
    __host__ __device__ bool next(int i, Unit& u) const {
        const long L = (long)i * G + c; if (L >= nwg) return false;
        int wgid = (int)L; { const int q = nwg / NXCD, r = nwg % NXCD, xcd = wgid % NXCD, off = wgid / NXCD; wgid = (xcd < r ? xcd * (q + 1) : r * (q + 1) + (xcd - r) * q) + off; }
        const int nig = WGM * nN, gid = wgid / nig, fm = gid * WGM, gsz = (nM - fm) < WGM ? (nM - fm) : WGM;
        u.pm = fm + ((wgid % nig) % gsz); u.pn = (wgid % nig) / gsz; return true;
    }
    __device__ __forceinline__ void a_ready(const Unit&) const {}
    __device__ __forceinline__ void done(const Unit&) const {}
};

__device__ __forceinline__ unsigned cvt_pk_bf16(float lo, float hi) { unsigned r; asm volatile("v_cvt_pk_bf16_f32 %0, %1, %2" : "=v"(r) : "v"(lo), "v"(hi)); return r; }
template <class Epi, class Sched, bool ALIGN_EPI = false, bool SP2 = false>
__device__ __forceinline__ void gemm_phase(PG8_LAS unsigned char* lds, const Gemm g, const Sched& S, const Epi& E) {
    int tid = threadIdx.x; asm volatile("" : "+v"(tid));
    const int wid = __builtin_amdgcn_readfirstlane(tid >> 6), lane = tid & 63, wr = wid >> 2, wc = wid & 3, fr = lane & 15, fq = lane >> 4;
    int K = g.K; asm volatile("" : "+s"(K));
    const int nt = K / BK;
    unsigned voffA[2], voffB[2];
#pragma unroll
    for (int i = 0; i < 2; ++i) { int R, C; stage_rc(tid * 16 + i * 8192, R, C); const int Rb = Epi::PERM ? ((R & ~31) + perm32(R & 31)) : R;
        voffA[i] = (unsigned)(R * K + C) * 2u; voffB[i] = (unsigned)(Rb * K + C) * 2u; }
    const size_t kstep = (size_t)(BK * 2);
    const size_t hstep = (size_t)HALF * K * 2;
    const size_t tstep = 2 * hstep;
    const unsigned ldsw = (unsigned)wid * 1024u;
    const int aoff = lds_byte(wr * 64 + fr, fq * 8), boff = lds_byte(wc * 32 + fr, fq * 8);
#define PG8_SA(b, h) (((b) * 2 + (h)) * HTB)
#define PG8_SB(b, h) ((4 + (b) * 2 + (h)) * HTB)
#define PG8_STAGE(bufoff, gbase, voff) do { _Pragma("unroll") for (int _i = 0; _i < 2; ++_i) \
        __builtin_amdgcn_global_load_lds((const unsigned*)((const char*)(gbase) + (voff)[_i]), (PG8_LAS unsigned*)(lds + (bufoff) + ldsw + _i * 8192), 16, 0, 0); } while (0)
#define PG8_LDA(dst, b, h) do { _Pragma("unroll") for (int m = 0; m < 4; ++m) _Pragma("unroll") for (int k = 0; k < 2; ++k) dst[m][k] = *(const PG8_LAS bf16x8*)(lds + PG8_SA(b, h) + aoff + m * 2048 + k * 1024); } while (0)
#define PG8_LDB(dst, b, h) do { _Pragma("unroll") for (int n = 0; n < 2; ++n) _Pragma("unroll") for (int k = 0; k < 2; ++k) dst[n][k] = *(const PG8_LAS bf16x8*)(lds + PG8_SB(b, h) + boff + n * 2048 + k * 1024); } while (0)
#define PG8_MMA(ai, bj, At, Bt) do { __builtin_amdgcn_s_setprio(1); _Pragma("unroll") for (int m = 0; m < 4; ++m) _Pragma("unroll") for (int n = 0; n < 2; ++n) _Pragma("unroll") for (int k = 0; k < 2; ++k) \
        acc[ai][bj][m][n] = __builtin_amdgcn_mfma_f32_16x16x32_bf16(Bt[n][k], At[m][k], acc[ai][bj][m][n], 0, 0, 0); __builtin_amdgcn_s_setprio(0); } while (0)
#define PG8_WAIT_V(n) asm volatile("s_waitcnt vmcnt(" #n ")" ::: "memory")
#define PG8_WAIT_L(n) asm volatile("s_waitcnt lgkmcnt(" #n ")" ::: "memory")
#define PG8_BAR __builtin_amdgcn_s_barrier()
#define PG8_SCHED __builtin_amdgcn_sched_barrier(0)
    Unit cur, nxt; int ui = 0;
    if (!S.next(0, cur)) return;
    f32x4 acc[2][2][4][2];
#pragma unroll
    for (int a = 0; a < 2; ++a)
#pragma unroll
        for (int b = 0; b < 2; ++b)
#pragma unroll
            for (int m = 0; m < 4; ++m)
#pragma unroll
                for (int n = 0; n < 2; ++n) acc[a][b][m][n] = (f32x4){0.f, 0.f, 0.f, 0.f};
    bf16x8 At[4][2], B0[2][2], B1[2][2];
    const char* cA = (const char*)g.A + (size_t)cur.pm * tstep; const char* cB = (const char*)g.Bt + (size_t)cur.pn * tstep;
    S.a_ready(cur);
    if constexpr (SP2) {
        PG8_STAGE(PG8_SB(0, 0), cB, voffB); PG8_STAGE(PG8_SB(0, 1), cB + hstep, voffB); PG8_STAGE(PG8_SA(0, 0), cA, voffA); PG8_STAGE(PG8_SA(0, 1), cA + hstep, voffA);
        if (wr == 1) PG8_BAR;
        PG8_WAIT_V(2); PG8_BAR;
        PG8_STAGE(PG8_SB(1, 0), cB + kstep, voffB); PG8_STAGE(PG8_SA(1, 0), cA + kstep, voffA); PG8_STAGE(PG8_SB(1, 1), cB + hstep + kstep, voffB);
        PG8_WAIT_V(6); PG8_BAR;
    } else {
        PG8_STAGE(PG8_SB(0, 0), cB, voffB); PG8_STAGE(PG8_SA(0, 0), cA, voffA); PG8_STAGE(PG8_SB(0, 1), cB + hstep, voffB); PG8_STAGE(PG8_SA(0, 1), cA + hstep, voffA);
        if (wr == 1) PG8_BAR;
        PG8_WAIT_V(4); PG8_BAR;
        PG8_STAGE(PG8_SB(1, 0), cB + kstep, voffB); PG8_STAGE(PG8_SA(1, 0), cA + kstep, voffA); PG8_STAGE(PG8_SB(1, 1), cB + hstep + kstep, voffB);
        PG8_WAIT_V(6); PG8_BAR;
    }
    for (;;) {
        const bool has_next = S.next(ui + 1, nxt);
        const char* nA = has_next ? (const char*)g.A + (size_t)nxt.pm * tstep : cA; const char* nB = has_next ? (const char*)g.Bt + (size_t)nxt.pn * tstep : cB;
        for (int t = 0; t < nt; t += 2) {
            const bool last = (t == nt - 2);
            const char* a1 = cA + (size_t)(t + 1) * kstep;
            const char* a2 = last ? nA : cA + (size_t)(t + 2) * kstep; const char* b2 = last ? nB : cB + (size_t)(t + 2) * kstep;
            const char* a3 = a2 + kstep; const char* b3 = b2 + kstep;
            if (last && has_next) S.a_ready(nxt);
            if constexpr (SP2) {
            PG8_LDB(B0, 0, 0); PG8_LDB(B1, 0, 1); PG8_SCHED; PG8_LDA(At, 0, 0); PG8_STAGE(PG8_SA(1, 1), a1 + hstep, voffA);
            PG8_WAIT_V(8); PG8_WAIT_L(0); PG8_BAR; PG8_MMA(0, 0, At, B0); PG8_MMA(0, 1, At, B1); PG8_BAR; PG8_SCHED;
            PG8_LDA(At, 0, 1); PG8_STAGE(PG8_SB(0, 0), b2, voffB); PG8_STAGE(PG8_SB(0, 1), b2 + hstep, voffB); PG8_STAGE(PG8_SA(0, 0), a2, voffA);
            PG8_WAIT_V(8); PG8_WAIT_L(0); PG8_BAR; PG8_MMA(1, 0, At, B0); PG8_MMA(1, 1, At, B1); PG8_BAR; PG8_SCHED;
            PG8_LDB(B0, 1, 0); PG8_LDB(B1, 1, 1); PG8_SCHED; PG8_LDA(At, 1, 0); PG8_STAGE(PG8_SA(0, 1), a2 + hstep, voffA);
            PG8_WAIT_V(8); PG8_WAIT_L(0); PG8_BAR; PG8_MMA(0, 0, At, B0); PG8_MMA(0, 1, At, B1); PG8_BAR; PG8_SCHED;
            PG8_LDA(At, 1, 1); PG8_STAGE(PG8_SB(1, 0), b3, voffB); PG8_STAGE(PG8_SB(1, 1), b3 + hstep, voffB); PG8_STAGE(PG8_SA(1, 0), a3, voffA);
            PG8_WAIT_V(8); PG8_WAIT_L(0); PG8_BAR; PG8_MMA(1, 0, At, B0); PG8_MMA(1, 1, At, B1); PG8_BAR; PG8_SCHED;
            } else {
            PG8_LDB(B0, 0, 0); PG8_SCHED; PG8_LDA(At, 0, 0); PG8_STAGE(PG8_SA(1, 1), a1 + hstep, voffA);
            PG8_WAIT_L(8); PG8_BAR; PG8_WAIT_L(0); PG8_MMA(0, 0, At, B0); PG8_BAR; PG8_SCHED;
            PG8_LDB(B1, 0, 1); PG8_STAGE(PG8_SB(0, 0), b2, voffB);
            PG8_BAR; PG8_WAIT_L(0); PG8_MMA(0, 1, At, B1); PG8_BAR;
            PG8_LDA(At, 0, 1); PG8_STAGE(PG8_SA(0, 0), a2, voffA);
            PG8_BAR; PG8_WAIT_L(0); PG8_MMA(1, 0, At, B0); PG8_BAR; PG8_SCHED;
            PG8_STAGE(PG8_SB(0, 1), b2 + hstep, voffB);
            PG8_WAIT_V(6); PG8_BAR; PG8_MMA(1, 1, At, B1); PG8_BAR;
            PG8_LDB(B0, 1, 0); PG8_SCHED; PG8_LDA(At, 1, 0); PG8_STAGE(PG8_SA(0, 1), a2 + hstep, voffA);
            PG8_WAIT_L(8); PG8_BAR; PG8_WAIT_L(0); PG8_MMA(0, 0, At, B0); PG8_BAR; PG8_SCHED;
            PG8_LDB(B1, 1, 1); PG8_STAGE(PG8_SB(1, 0), b3, voffB);
            PG8_BAR; PG8_WAIT_L(0); PG8_MMA(0, 1, At, B1); PG8_BAR;
            PG8_LDA(At, 1, 1); PG8_STAGE(PG8_SA(1, 0), a3, voffA);
            PG8_BAR; PG8_WAIT_L(0); PG8_MMA(1, 0, At, B0); PG8_BAR; PG8_SCHED;
            PG8_STAGE(PG8_SB(1, 1), b3 + hstep, voffB);
            PG8_WAIT_V(6); PG8_BAR; PG8_MMA(1, 1, At, B1); PG8_BAR;
            }
        }
        if constexpr (ALIGN_EPI) { if (wr == 0) PG8_BAR; }
        if constexpr (!Epi::AFTER_DRAIN) { int fr_e = fr, fq_e = fq; asm volatile("" : "+v"(fr_e), "+v"(fq_e));
            E(acc, cur, wr, wc, fr_e, fq_e); S.done(cur); }
        if (!has_next) break;
#pragma unroll
        for (int a = 0; a < 2; ++a)
#pragma unroll
            for (int b = 0; b < 2; ++b)
#pragma unroll
                for (int m = 0; m < 4; ++m)
#pragma unroll
                    for (int n = 0; n < 2; ++n) acc[a][b][m][n] = (f32x4){0.f, 0.f, 0.f, 0.f};
        cur = nxt; cA = nA; cB = nB; ++ui;
        if constexpr (ALIGN_EPI) { if (wr == 1) PG8_BAR; }
    }
    PG8_WAIT_V(0);
    if constexpr (!ALIGN_EPI) { if (wr == 0) PG8_BAR; }
    PG8_BAR;
    if constexpr (Epi::AFTER_DRAIN) { E.fused(acc, cur, wr, wc, fr, fq, lds, wid, lane); S.done(cur); }
#undef PG8_SA
#undef PG8_SB
#undef PG8_STAGE
#undef PG8_LDA
#undef PG8_LDB
#undef PG8_MMA
#undef PG8_WAIT_V
#undef PG8_WAIT_L
#undef PG8_BAR
#undef PG8_SCHED
}
}

constexpr int D = 2048, T = 4096, NB = 2, M = NB * T;
constexpr int MS = 8;
constexpr int HD = 128, NH = 8, SBW = NH * HD, GW = NH * HD;
constexpr int CONVCH = 3 * GW;
constexpr int IN_COLS = 7184, NPROJ_PAD = 7424;
constexpr int DFF = 5504, NGU = 2 * DFF;
constexpr int PLE = 256;
constexpr int PAST = 16384, PAGE = 128, NPAGES = PAST / PAGE, NPOOL = 1280;
constexpr float EPS = 1e-6f;
constexpr float SB_SCALE = 0.08838834764831845f;
constexpr int O_SB_K = 1024, O_SB_V = 2048, O_GQKV = 3072, O_GZ = 6144, O_GA = 7168, O_GB = 7176;

constexpr size_t OUT_Y = 0;
constexpr size_t OUT_YS = OUT_Y + (size_t)M * D;
constexpr size_t OUT_K = OUT_YS + (size_t)MS * D;
constexpr size_t OUT_V = OUT_K + (size_t)M * SBW;
constexpr size_t OUT_GCONV = OUT_V + (size_t)M * SBW;
constexpr size_t OUT_GREC = OUT_GCONV + (size_t)NB * 3 * CONVCH;
constexpr size_t OUT_FCONV = OUT_GREC + (size_t)NB * NH * HD * HD;
constexpr size_t OUT_KS = OUT_FCONV + (size_t)NB * 2 * DFF;
constexpr size_t OUT_VS = OUT_KS + (size_t)MS * SBW;
constexpr size_t OUT_GCONVS = OUT_VS + (size_t)MS * SBW;
constexpr size_t OUT_GRECS = OUT_GCONVS + (size_t)MS * 3 * CONVCH;
constexpr size_t OUT_FCONVS = OUT_GRECS + (size_t)MS * NH * HD * HD;
constexpr size_t OUT_END = OUT_FCONVS + (size_t)MS * 2 * DFF;

namespace pg8 {
__device__ __forceinline__ float silu_f(float x) { return x * __builtin_amdgcn_rcpf(1.0f + __expf(-x)); }
__device__ __forceinline__ float sigmoid_f(float x) { return __builtin_amdgcn_rcpf(1.0f + __expf(-x)); }
__device__ __forceinline__ float softplus_f(float x) { return fmaxf(x, 0.f) + log1pf(__expf(-fabsf(x))); }
typedef unsigned u32x2 __attribute__((ext_vector_type(2)));

struct EpiProj {
    static constexpr bool PERM = true, AFTER_DRAIN = false;
    bf16_t *Qb, *Kb, *Vb, *CIN, *Zb; float *outK, *outV, *outGconv; float *G, *BETA; const float *a_log, *dt_bias;
    __device__ __forceinline__ void operator()(const f32x4 (&acc)[2][2][4][2], const Unit& u, int wr, int wc, int fr, int fq) const {
        const int reg = u.pn >> 2;
#pragma unroll
        for (int ai = 0; ai < 2; ++ai)
#pragma unroll
            for (int m = 0; m < 4; ++m) {
                const int r = u.pm * BM + ai * HALF + wr * 64 + m * 16 + fr;
#pragma unroll
                for (int bj = 0; bj < 2; ++bj) {
                    const int c8 = u.pn * BM + bj * HALF + wc * 32 + 8 * fq;
                    const f32x4 v0 = acc[ai][bj][m][0], v1 = acc[ai][bj][m][1];
                    u32x4 w; w.x = cvt_pk_bf16(v0[0], v0[1]); w.y = cvt_pk_bf16(v0[2], v0[3]); w.z = cvt_pk_bf16(v1[0], v1[1]); w.w = cvt_pk_bf16(v1[2], v1[3]);
                    if (reg == 0) { *(u32x4*)(Qb + (size_t)r * SBW + c8) = w; }
                    else if (reg == 1) { const int c = c8 - O_SB_K; *(u32x4*)(Kb + (size_t)r * SBW + c) = w; float* o = outK + (size_t)r * SBW + c; __builtin_nontemporal_store(v0, (f32x4*)o); __builtin_nontemporal_store(v1, (f32x4*)(o + 4)); }
                    else if (reg == 2) { const int c = c8 - O_SB_V; *(u32x4*)(Vb + (size_t)r * SBW + c) = w; float* o = outV + (size_t)r * SBW + c; __builtin_nontemporal_store(v0, (f32x4*)o); __builtin_nontemporal_store(v1, (f32x4*)(o + 4)); }
                    else if (reg < 6) { const int c = c8 - O_GQKV; *(u32x4*)(CIN + (size_t)r * CONVCH + c) = w;
                        const int t = r & (T - 1); if (t >= T - 3) { float* o = outGconv + ((size_t)(r >> 12) * 3 + (t - (T - 3))) * CONVCH + c; *(f32x4*)o = v0; *(f32x4*)(o + 4) = v1; } }
                    else if (reg == 6) { const int c = c8 - O_GZ; *(u32x4*)(Zb + (size_t)r * GW + c) = w; }
                    else if (bj == 0 && wc == 0 && fq < 2 && u.pn == 28) {
                        float x[8] = {v0[0], v0[1], v0[2], v0[3], v1[0], v1[1], v1[2], v1[3]}; float y[8];
#pragma unroll
                        for (int h = 0; h < 8; ++h) y[h] = (fq == 0) ? -__expf(a_log[h]) * softplus_f(x[h] + dt_bias[h]) : sigmoid_f(x[h]);
                        float* o = (fq == 0 ? G : BETA) + (size_t)r * NH; *(f32x4*)o = (f32x4){y[0], y[1], y[2], y[3]}; *(f32x4*)(o + 4) = (f32x4){y[4], y[5], y[6], y[7]};
                    }
                }
            }
    }
};

struct EpiBf16 {
    static constexpr bool PERM = true, AFTER_DRAIN = false;
    bf16_t* O; int ldc;
    __device__ __forceinline__ void operator()(const f32x4 (&acc)[2][2][4][2], const Unit& u, int wr, int wc, int fr, int fq) const {
#pragma unroll
        for (int ai = 0; ai < 2; ++ai)
#pragma unroll
            for (int m = 0; m < 4; ++m) { const int r = u.pm * BM + ai * HALF + wr * 64 + m * 16 + fr;
#pragma unroll
                for (int bj = 0; bj < 2; ++bj) { const int c8 = u.pn * BM + bj * HALF + wc * 32 + 8 * fq; const f32x4 v0 = acc[ai][bj][m][0], v1 = acc[ai][bj][m][1];
                    u32x4 w; w.x = cvt_pk_bf16(v0[0], v0[1]); w.y = cvt_pk_bf16(v0[2], v0[3]); w.z = cvt_pk_bf16(v1[0], v1[1]); w.w = cvt_pk_bf16(v1[2], v1[3]);
                    *(u32x4*)(O + (size_t)r * ldc + c8) = w; } }
    }
};

__device__ __forceinline__ float bflo(unsigned w) { return __builtin_bit_cast(float, w << 16); }
__device__ __forceinline__ float bfhi(unsigned w) { return __builtin_bit_cast(float, w & 0xffff0000u); }
template <bool BF> struct EpiResid {
    static constexpr bool PERM = true, AFTER_DRAIN = false;
    const void* base; bf16_t* Hb; float* sumsq; int ldc;
    __device__ __forceinline__ void operator()(const f32x4 (&acc)[2][2][4][2], const Unit& u, int wr, int wc, int fr, int fq) const {
#pragma unroll
        for (int ai = 0; ai < 2; ++ai)
#pragma unroll
            for (int m = 0; m < 4; ++m) { const int r = u.pm * BM + ai * HALF + wr * 64 + m * 16 + fr; float ss = 0.f;
#pragma unroll
                for (int bj = 0; bj < 2; ++bj) { const int c8 = u.pn * BM + bj * HALF + wc * 32 + 8 * fq; const size_t off = (size_t)r * ldc + c8;
                    float b[8];
                    if (BF) { const u32x4 w = *(const u32x4*)((const bf16_t*)base + off); b[0] = bflo(w.x); b[1] = bfhi(w.x); b[2] = bflo(w.y); b[3] = bfhi(w.y); b[4] = bflo(w.z); b[5] = bfhi(w.z); b[6] = bflo(w.w); b[7] = bfhi(w.w); }
                    else { const f32x4 b0 = __builtin_nontemporal_load((const f32x4*)((const float*)base + off)), b1 = __builtin_nontemporal_load((const f32x4*)((const float*)base + off + 4)); b[0] = b0[0]; b[1] = b0[1]; b[2] = b0[2]; b[3] = b0[3]; b[4] = b1[0]; b[5] = b1[1]; b[6] = b1[2]; b[7] = b1[3]; }
                    float h[8];
#pragma unroll
                    for (int j = 0; j < 4; ++j) { h[j] = b[j] + acc[ai][bj][m][0][j]; h[4 + j] = b[4 + j] + acc[ai][bj][m][1][j]; }
#pragma unroll
                    for (int j = 0; j < 8; ++j) ss += h[j] * h[j];
                    u32x4 w; w.x = cvt_pk_bf16(h[0], h[1]); w.y = cvt_pk_bf16(h[2], h[3]); w.z = cvt_pk_bf16(h[4], h[5]); w.w = cvt_pk_bf16(h[6], h[7]);
                    *(u32x4*)(Hb + off) = w; }
                ss += __shfl_xor(ss, 16); ss += __shfl_xor(ss, 32);
                if (fq == 0) unsafeAtomicAdd(sumsq + r, ss); }
    }
};

struct EpiGateUp {
    static constexpr bool PERM = true, AFTER_DRAIN = false;
    const float* sumsq; const float* convw; bf16_t* ACT; float* TAIL; float* FIXG; float* FIXU; float* outFconv; PG8_LAS float* halo;
    __device__ __forceinline__ void operator()(const f32x4 (&acc)[2][2][4][2], const Unit& u, int wr, int wc, int fr, int fq) const {
        const int lane = fr + 16 * fq;
        const int cg = u.pn * HALF + wc * 32 + 8 * fq;
        float w0[8], w1[8], w2[8];
#pragma unroll
        for (int j = 0; j < 8; ++j) { w0[j] = convw[cg + j]; w1[j] = convw[DFF + cg + j]; w2[j] = convw[2 * DFF + cg + j]; }
        float gp[2][4][8], up[2][4][8];
#pragma unroll
        for (int ai = 0; ai < 2; ++ai)
#pragma unroll
            for (int m = 0; m < 4; ++m) { const int r = u.pm * BM + ai * HALF + wr * 64 + m * 16 + fr; const float rs = rsqrtf(sumsq[r] * (1.0f / D) + EPS);
#pragma unroll
                for (int n = 0; n < 2; ++n)
#pragma unroll
                    for (int j = 0; j < 4; ++j) { gp[ai][m][4 * n + j] = acc[ai][0][m][n][j] * rs; up[ai][m][4 * n + j] = acc[ai][1][m][n][j] * rs; } }
        if (fr >= 14) {
#pragma unroll
            for (int ai = 0; ai < 2; ++ai) { PG8_LAS float* hp = halo + ((wc * 4 + (2 * ai + wr)) * 2 + (fr - 14)) * 32 + 8 * fq;
                *(PG8_LAS f32x4*)hp = (f32x4){gp[ai][3][0], gp[ai][3][1], gp[ai][3][2], gp[ai][3][3]}; *(PG8_LAS f32x4*)(hp + 4) = (f32x4){gp[ai][3][4], gp[ai][3][5], gp[ai][3][6], gp[ai][3][7]}; }
        }
        asm volatile("s_waitcnt lgkmcnt(0)" ::: "memory"); __builtin_amdgcn_s_barrier(); asm volatile("" ::: "memory");
        const int src1 = (lane & 48) | ((fr - 1) & 15), src2 = (lane & 48) | ((fr - 2) & 15);
#pragma unroll
        for (int ai = 0; ai < 2; ++ai) {
            const int B = 2 * ai + wr;
            float h62[8], h63[8];
            if (B > 0) { const PG8_LAS float* hp = halo + ((wc * 4 + (B - 1)) * 2) * 32 + 8 * fq;
                const f32x4 a0 = *(const PG8_LAS f32x4*)hp, a1 = *(const PG8_LAS f32x4*)(hp + 4), b0 = *(const PG8_LAS f32x4*)(hp + 32), b1 = *(const PG8_LAS f32x4*)(hp + 36);
#pragma unroll
                for (int j = 0; j < 4; ++j) { h62[j] = a0[j]; h62[4 + j] = a1[j]; h63[j] = b0[j]; h63[4 + j] = b1[j]; } }
            else {
#pragma unroll
                for (int j = 0; j < 8; ++j) { h62[j] = 0.f; h63[j] = 0.f; } }
            float ps1[8], ps2[8];
#pragma unroll
            for (int j = 0; j < 8; ++j) { ps1[j] = h63[j]; ps2[j] = (fr == 0) ? h62[j] : h63[j]; }
#pragma unroll
            for (int m = 0; m < 4; ++m) {
                const int r = u.pm * BM + ai * HALF + wr * 64 + m * 16 + fr;
                float gate[8], a[8];
#pragma unroll
                for (int j = 0; j < 8; ++j) {
                    const float s1 = __shfl(gp[ai][m][j], src1), s2 = __shfl(gp[ai][m][j], src2);
                    const float p1 = (fr >= 1) ? s1 : ps1[j], p2 = (fr >= 2) ? s2 : ps2[j];
                    ps1[j] = s1; ps2[j] = s2;
                    gate[j] = w0[j] * p2 + w1[j] * p1 + w2[j] * gp[ai][m][j];
                    a[j] = silu_f(gate[j]) * up[ai][m][j];
                }
                u32x4 w; w.x = cvt_pk_bf16(a[0], a[1]); w.y = cvt_pk_bf16(a[2], a[3]); w.z = cvt_pk_bf16(a[4], a[5]); w.w = cvt_pk_bf16(a[6], a[7]);
                *(u32x4*)(ACT + (size_t)r * DFF + cg) = w;
                if (B == 0 && m == 0 && fr < 2 && (u.pm & 15) != 0) {
                    float* fg = FIXG + ((size_t)u.pm * 2 + fr) * DFF + cg; float* fu = FIXU + ((size_t)u.pm * 2 + fr) * DFF + cg;
                    *(f32x4*)fg = (f32x4){gate[0], gate[1], gate[2], gate[3]}; *(f32x4*)(fg + 4) = (f32x4){gate[4], gate[5], gate[6], gate[7]};
                    *(f32x4*)fu = (f32x4){up[ai][m][0], up[ai][m][1], up[ai][m][2], up[ai][m][3]}; *(f32x4*)(fu + 4) = (f32x4){up[ai][m][4], up[ai][m][5], up[ai][m][6], up[ai][m][7]};
                }
                if (B == 3 && m == 3 && fr >= 14) {
                    float* tp = TAIL + ((size_t)u.pm * 2 + (fr - 14)) * DFF + cg;
                    *(f32x4*)tp = (f32x4){gp[ai][m][0], gp[ai][m][1], gp[ai][m][2], gp[ai][m][3]}; *(f32x4*)(tp + 4) = (f32x4){gp[ai][m][4], gp[ai][m][5], gp[ai][m][6], gp[ai][m][7]};
                    if ((u.pm & 15) == 15) { float* op = outFconv + ((size_t)(u.pm >> 4) * 2 + (fr - 14)) * DFF + cg;
                        *(f32x4*)op = (f32x4){gp[ai][m][0], gp[ai][m][1], gp[ai][m][2], gp[ai][m][3]}; *(f32x4*)(op + 4) = (f32x4){gp[ai][m][4], gp[ai][m][5], gp[ai][m][6], gp[ai][m][7]}; }
                }
            }
        }
    }
};

struct EpiPle {
    static constexpr bool PERM = true, AFTER_DRAIN = false;
    const bf16_t* H2; const bf16_t* PP; const float* sumsq2; float* H3; float* sumsq3; int ldc;
    __device__ __forceinline__ void operator()(const f32x4 (&acc)[2][2][4][2], const Unit& u, int wr, int wc, int fr, int fq) const {
#pragma unroll
        for (int ai = 0; ai < 2; ++ai)
#pragma unroll
            for (int m = 0; m < 4; ++m) { const int r = u.pm * BM + ai * HALF + wr * 64 + m * 16 + fr; float ss = 0.f;
                const float rs = rsqrtf(sumsq2[r] * (1.0f / D) + EPS);
#pragma unroll
                for (int bj = 0; bj < 2; ++bj) { const int c8 = u.pn * BM + bj * HALF + wc * 32 + 8 * fq; const size_t off = (size_t)r * ldc + c8;
                    const u32x4 hw = *(const u32x4*)(H2 + off), pw = *(const u32x4*)(PP + off);
                    const float hb[8] = {bflo(hw.x), bfhi(hw.x), bflo(hw.y), bfhi(hw.y), bflo(hw.z), bfhi(hw.z), bflo(hw.w), bfhi(hw.w)};
                    const float pb[8] = {bflo(pw.x), bfhi(pw.x), bflo(pw.y), bfhi(pw.y), bflo(pw.z), bfhi(pw.z), bflo(pw.w), bfhi(pw.w)};
                    float h[8];
#pragma unroll
                    for (int j = 0; j < 4; ++j) { h[j] = hb[j] + pb[j] * sigmoid_f(acc[ai][bj][m][0][j] * rs); h[4 + j] = hb[4 + j] + pb[4 + j] * sigmoid_f(acc[ai][bj][m][1][j] * rs); }
#pragma unroll
                    for (int j = 0; j < 8; ++j) ss += h[j] * h[j];
                    *(f32x4*)(H3 + off) = (f32x4){h[0], h[1], h[2], h[3]}; *(f32x4*)(H3 + off + 4) = (f32x4){h[4], h[5], h[6], h[7]}; }
                ss += __shfl_xor(ss, 16); ss += __shfl_xor(ss, 32);
                if (fq == 0) unsafeAtomicAdd(sumsq3 + r, ss); }
    }
};
}

constexpr size_t MiB = 1u << 20;
constexpr size_t WS_CTL = 0, CTL_ZERO_BYTES = 1 * MiB;
constexpr int CW_QUEUE = 1024;
constexpr int CW_BAR = 4096;
constexpr int CW_SUMSQ1 = 32768, CW_SUMSQ2 = CW_SUMSQ1 + M, CW_SUMSQ3 = CW_SUMSQ2 + M;
static_assert((CW_SUMSQ3 + M) * 4 <= (int)CTL_ZERO_BYTES, "ctl");
constexpr size_t WS_WIN = 2 * MiB;
constexpr size_t WS_WOUT = WS_WIN + (size_t)NPROJ_PAD * D * 2;
constexpr size_t WS_WGU = WS_WOUT + (size_t)D * D * 2;
constexpr size_t WS_WDN = WS_WGU + (size_t)NGU * D * 2;
constexpr size_t WS_WPG = WS_WDN + (size_t)D * DFF * 2;
constexpr size_t WS_WPP = WS_WPG + (size_t)D * D * 2;
constexpr size_t WS_XN = WS_WPP + (size_t)D * PLE * 2;
constexpr size_t WS_PB = WS_XN + (size_t)M * D * 2;
constexpr size_t WS_Q = WS_PB + (size_t)M * PLE * 2;
constexpr size_t WS_K = WS_Q + (size_t)M * SBW * 2;
constexpr size_t WS_V = WS_K + (size_t)M * SBW * 2;
constexpr size_t WS_CIN = WS_V + (size_t)M * SBW * 2;
constexpr size_t WS_Z = WS_CIN + (size_t)M * CONVCH * 2;
constexpr size_t WS_G = WS_Z + (size_t)M * GW * 2;
constexpr size_t WS_BETA = WS_G + (size_t)M * NH * 4;
constexpr size_t WS_GQ = WS_BETA + (size_t)M * NH * 4;
constexpr size_t WS_GK = WS_GQ + (size_t)M * GW * 4;
constexpr size_t WS_GV = WS_GK + (size_t)M * GW * 4;
constexpr size_t WS_GO = WS_GV + (size_t)M * GW * 4;
constexpr size_t WS_GSF = WS_GO;
constexpr size_t WS_MIX = WS_GO + (size_t)M * GW * 4;
constexpr size_t WS_H1 = WS_MIX + (size_t)M * D * 2;
constexpr size_t WS_H1B = WS_H1 + (size_t)M * D * 4;
constexpr size_t WS_ACT = WS_H1B + (size_t)M * D * 2;
constexpr size_t WS_TAIL = WS_ACT + (size_t)M * DFF * 2;
constexpr size_t WS_FIXG = WS_TAIL + (size_t)32 * 2 * DFF * 4;
constexpr size_t WS_FIXU = WS_FIXG + (size_t)32 * 2 * DFF * 4;
constexpr size_t WS_H2 = WS_FIXU + (size_t)32 * 2 * DFF * 4;
constexpr size_t WS_H2B = WS_H2 + (size_t)M * D * 4;
constexpr size_t WS_PP = WS_H2B + (size_t)M * D * 2;
constexpr size_t WS_S = WS_PP + (size_t)M * D * 4;
constexpr size_t S_A = 0;
constexpr size_t S_PROJ = S_A + MS * D;
constexpr size_t S_GQ = S_PROJ + MS * IN_COLS;
constexpr size_t S_GK = S_GQ + MS * GW;
constexpr size_t S_GV = S_GK + MS * GW;
constexpr size_t S_G = S_GV + MS * GW;
constexpr size_t S_BETA = S_G + 64;
constexpr size_t S_GO = S_BETA + 64;
constexpr size_t S_PART = S_GO + MS * GW;
constexpr int DSEG = 256, DPART = 132;
constexpr size_t S_MIX = S_PART + (size_t)MS * NH * DSEG * DPART;
constexpr size_t S_H1 = S_MIX + MS * D;
constexpr size_t S_GP = S_H1 + MS * D;
constexpr size_t S_UP = S_GP + MS * DFF;
constexpr size_t S_ACT = S_UP + MS * DFF;
constexpr size_t S_H2 = S_ACT + MS * DFF;
constexpr size_t S_PG = S_H2 + MS * D;
constexpr size_t S_PP = S_PG + MS * D;
constexpr size_t S_END = S_PP + MS * D;
constexpr size_t WS_GREC = ((WS_S + S_END * 4 + 4095) / 4096) * 4096;
constexpr size_t WS_GEG = WS_GREC + (size_t)16 * 64 * 73728;
constexpr size_t WS_DUMMY = WS_GEG + 16 * 64 * 4;
constexpr size_t WS_END = WS_DUMMY + (size_t)M * 4;

constexpr int RING_OFF = 0, RING_BYTES = 131072;
constexpr int HALO_OFF = RING_BYTES;
constexpr int LDSCTL_OFF = 151552, MISC_OFF = LDSCTL_OFF + 320;
constexpr int LDS_BYTES = 155648;
constexpr int NWAVES = 8;

#define GAS __attribute__((address_space(1)))
#define LAS __attribute__((address_space(3)))
typedef unsigned short bf16;
typedef unsigned v4u __attribute__((ext_vector_type(4)));
typedef unsigned v2u __attribute__((ext_vector_type(2)));
typedef float f32x4 __attribute__((ext_vector_type(4)));
typedef float f32x2 __attribute__((ext_vector_type(2)));
typedef GAS unsigned gu32;
typedef short bf16x8 __attribute__((ext_vector_type(8)));
typedef short s16x4 __attribute__((ext_vector_type(4)));
typedef float f32x16 __attribute__((ext_vector_type(16)));
typedef __bf16 bf16x2_t __attribute__((ext_vector_type(2)));
__device__ __forceinline__ unsigned cvt2bf(float lo, float hi) { const f32x2 v = {lo, hi}; return __builtin_bit_cast(unsigned, __builtin_convertvector(v, bf16x2_t)); }
#define RLX_AGENT __ATOMIC_RELAXED, __HIP_MEMORY_SCOPE_AGENT
#define LDS_WAIT() asm volatile("s_waitcnt lgkmcnt(0)" ::: "memory")
#define VM_WAIT() asm volatile("s_waitcnt vmcnt(0)" ::: "memory")
__device__ __forceinline__ unsigned f2bf(float f) { unsigned u = __builtin_bit_cast(unsigned, f); return (u + 0x7fffu + ((u >> 16) & 1u)) >> 16; }
__device__ __forceinline__ unsigned pk2(float lo, float hi) { return f2bf(lo) | (f2bf(hi) << 16); }
__device__ __forceinline__ float bf_lo(unsigned w) { return __builtin_bit_cast(float, w << 16); }
__device__ __forceinline__ float bf_hi(unsigned w) { return __builtin_bit_cast(float, w & 0xffff0000u); }
__device__ __forceinline__ float bf2f(bf16 b) { return __builtin_bit_cast(float, (unsigned)b << 16); }
using pg8::silu_f; using pg8::sigmoid_f; using pg8::softplus_f;

#define XB_TMO      128
#define XB_XCNT(j)  (256  + 64 * (j))
#define XB_XSUB(j)  (1280 + 64 * (j))
#define XB_XGEN(j)  (2304 + 64 * (j))
#define XB_TOP      3328
#define XB_TOPGEN   3392
#define XCD_BAR_WORDS 3456
#define XB_SPIN_CAP (1u << 18)
__device__ __forceinline__ unsigned xb_ld(unsigned* p)              { return __hip_atomic_load(p, __ATOMIC_RELAXED, __HIP_MEMORY_SCOPE_AGENT); }
__device__ __forceinline__ unsigned xb_add(unsigned* p, unsigned v) { return __hip_atomic_fetch_add(p, v, __ATOMIC_RELAXED, __HIP_MEMORY_SCOPE_AGENT); }
__device__ __forceinline__ unsigned xb_xcc_id() { return (unsigned)__builtin_amdgcn_s_getreg((3 << 11) | 20) & 0xFu; }
#define XB_SPIN(cond, bar) do { unsigned _sp = 0; while (cond) { __builtin_amdgcn_s_sleep(1); \
    if ((++_sp & 255u) == 0u) { if (xb_ld(&(bar)[XB_TMO])) break; if (_sp > XB_SPIN_CAP) { atomicAdd(&(bar)[XB_TMO], 1u); break; } } } } while (0)
struct XcdBarrier { unsigned* bar; unsigned x; volatile LAS unsigned* st; };
__device__ __forceinline__ XcdBarrier xcd_barrier_post(unsigned* bar, volatile LAS unsigned* st) {
    XcdBarrier b; b.bar = bar; b.x = xb_xcc_id(); b.st = st;
    if (threadIdx.x == 0) (void)xb_add(&bar[XB_XCNT(b.x)], 1u);
    return b;
}
__device__ __forceinline__ void xcd_barrier_complete(unsigned* bar, unsigned x, unsigned& nloc, unsigned& nx) {
    const unsigned G = gridDim.x * gridDim.y * gridDim.z;
    unsigned sum, cnt, mine, sp = 0u;
    for (;;) {
        sum = 0u; cnt = 0u; mine = 0u;
#pragma unroll
        for (unsigned j = 0; j < 16; ++j) { const unsigned c = xb_ld(&bar[XB_XCNT(j)]); sum += c; cnt += (c > 0u) ? 1u : 0u; mine = (j == x) ? c : mine; }
        if (sum == G) break;
        __builtin_amdgcn_s_sleep(1);
        if ((++sp & 255u) == 0u) { if (xb_ld(&bar[XB_TMO])) break; if (sp > XB_SPIN_CAP) { atomicAdd(&bar[XB_TMO], 1u); break; } }
    }
    nloc = mine > 0u ? mine : 1u; nx = cnt > 0u ? cnt : 1u;
}
__device__ __forceinline__ void xcd_barrier(const XcdBarrier& b) {
    asm volatile("s_waitcnt vmcnt(0)" ::: "memory");
    __syncthreads();
    if (threadIdx.x == 0) {
        unsigned* bar = b.bar;
        __builtin_amdgcn_s_waitcnt(0);
        unsigned nloc = b.st[0], nx = b.st[1];
        if (nloc == 0u) { xcd_barrier_complete(bar, b.x, nloc, nx); b.st[0] = nloc; b.st[1] = nx; }
        const unsigned old = xb_add(&bar[XB_XSUB(b.x)], 1u);
        const unsigned gen = old / nloc;
        if (old + 1u == (gen + 1u) * nloc) {
            __builtin_amdgcn_fence(__ATOMIC_RELEASE, "agent");
            asm volatile("s_waitcnt vmcnt(0)" ::: "memory");
            const unsigned og = xb_add(&bar[XB_TOP], 1u);
            const unsigned tg = og / nx;
            if (og + 1u == (tg + 1u) * nx) xb_add(&bar[XB_TOPGEN], 1u);
            else XB_SPIN(xb_ld(&bar[XB_TOPGEN]) == tg, bar);
            __builtin_amdgcn_fence(__ATOMIC_ACQUIRE, "agent");
            xb_add(&bar[XB_XGEN(b.x)], 1u);
            asm volatile("s_waitcnt vmcnt(0)" ::: "memory");
        } else {
            XB_SPIN(xb_ld(&bar[XB_XGEN(b.x)]) == gen, bar);
            __builtin_amdgcn_fence(__ATOMIC_ACQUIRE, "agent");
            asm volatile("s_waitcnt vmcnt(0)" ::: "memory");
        }
    }
    __syncthreads();
}

struct Frame {
    LAS unsigned char* lds;
    volatile LAS unsigned* MISC;
    unsigned* ctl;
    int tid, lane, wave, G, bid;
    float* out;
    unsigned char* ws;
};
__device__ __forceinline__ const float* kin(int i) {
    const unsigned char __attribute__((address_space(4)))* ka = (const unsigned char __attribute__((address_space(4)))*)__builtin_amdgcn_kernarg_segment_ptr();
    unsigned off = (unsigned)i * 8u; asm volatile("" : "+s"(off));
    return *(const float* const __attribute__((address_space(4)))*)(ka + off);
}
#define WSP(T_, off) ((T_*)(F.ws + (off)))
#define SSP(off) ((float*)(F.ws + WS_S) + (off))

__device__ __forceinline__ float wave_sum(float v) {
#pragma unroll
    for (int o = 1; o < 64; o <<= 1) v += __shfl_xor(v, o);
    return v;
}

struct TItem { const float* W; const float* ks; bf16* WT; int ldw, nvalid, K, drow, k0, n0; };
constexpr int TI_NB_IN = 113;
constexpr int TI_IN = (D / 64) * TI_NB_IN, TI_OUT = (D / 64) * (D / 64), TI_G = (D / 64) * (DFF / 64), TI_D = (DFF / 64) * (D / 64), TI_PG = TI_OUT, TI_PP = (PLE / 64) * (D / 64);
__device__ __forceinline__ int ti_count(int set) { return set == 0 ? TI_IN + TI_PP + TI_OUT : set == 1 ? 2 * TI_G : TI_D + TI_PG; }
__device__ __forceinline__ void ti_decode(Frame& F, int set, int r, TItem& t) {
    t.ks = nullptr;
    if (set == 0) {
        if (r < TI_IN) { const int kb = r / TI_NB_IN, nb = r % TI_NB_IN; t.W = kin(11); t.ldw = IN_COLS; t.nvalid = IN_COLS; t.K = D; t.WT = WSP(bf16, WS_WIN); t.drow = 64 * nb; t.k0 = 64 * kb; t.n0 = 64 * nb; return; } r -= TI_IN;
        if (r < TI_PP) { const int kb = r / (D / 64), nb = r % (D / 64); t.W = kin(26); t.ldw = D; t.nvalid = D; t.K = PLE; t.WT = WSP(bf16, WS_WPP); t.drow = 64 * nb; t.k0 = 64 * kb; t.n0 = 64 * nb; return; } r -= TI_PP;
        { const int kb = r / (D / 64), nb = r % (D / 64); t.W = kin(18); t.ldw = D; t.nvalid = D; t.K = D; t.WT = WSP(bf16, WS_WOUT); t.drow = 64 * nb; t.k0 = 64 * kb; t.n0 = 64 * nb; return; }
    } else if (set == 1) {
        const int up = r >= TI_G; if (up) r -= TI_G;
        const int kb = r / (DFF / 64), nb = r % (DFF / 64), n0 = 64 * nb;
        t.W = up ? kin(21) : kin(20); t.ks = kin(19); t.ldw = DFF; t.nvalid = DFF; t.K = D; t.WT = WSP(bf16, WS_WGU); t.drow = 256 * (n0 >> 7) + 128 * up + (n0 & 127); t.k0 = 64 * kb; t.n0 = n0; return;
    } else {
        if (r < TI_D) { const int kb = r / (D / 64), nb = r % (D / 64); t.W = kin(23); t.ldw = D; t.nvalid = D; t.K = DFF; t.WT = WSP(bf16, WS_WDN); t.drow = 64 * nb; t.k0 = 64 * kb; t.n0 = 64 * nb; return; } r -= TI_D;
        { const int kb = r / (D / 64), nb = r % (D / 64); t.W = kin(25); t.ks = kin(24); t.ldw = D; t.nvalid = D; t.K = D; t.WT = WSP(bf16, WS_WPG); t.drow = 64 * nb; t.k0 = 64 * kb; t.n0 = 64 * nb; return; }
    }
}
__device__ __forceinline__ void ti_load(const TItem& t, f32x4 (&v)[16], float (&sc)[16], int lane) {
    const int n4 = (lane & 15) * 4, kq = lane >> 4; const bool nv = (t.n0 + n4) < t.nvalid;
#pragma unroll
    for (int i = 0; i < 16; ++i) { const int kk = 4 * i + kq;
        v[i] = nv ? __builtin_nontemporal_load((const f32x4*)(t.W + (size_t)(t.k0 + kk) * t.ldw + t.n0 + n4)) : (f32x4){0.f, 0.f, 0.f, 0.f};
        sc[i] = t.ks ? t.ks[t.k0 + kk] : 1.f; }
}
__device__ __forceinline__ void ti_store(const TItem& t, const f32x4 (&v)[16], const float (&sc)[16], LAS float* scr, int lane) {
    const int n4 = (lane & 15) * 4, kq = lane >> 4;
#pragma unroll
    for (int i = 0; i < 16; ++i) { const int kk = 4 * i + kq; const f32x4 x = v[i] * sc[i]; LAS float* d = scr + kk * 65 + n4; d[0] = x.x; d[1] = x.y; d[2] = x.z; d[3] = x.w; }
    LDS_WAIT(); asm volatile("" ::: "memory");
    const int c = lane & 7;
#pragma unroll
    for (int j = 0; j < 8; ++j) { const int n = (lane >> 3) + 8 * j; const LAS float* s = scr + (8 * c) * 65 + n;
        v4u o; o.x = pk2(s[0 * 65], s[1 * 65]); o.y = pk2(s[2 * 65], s[3 * 65]); o.z = pk2(s[4 * 65], s[5 * 65]); o.w = pk2(s[6 * 65], s[7 * 65]);
        *(v4u*)(t.WT + (size_t)(t.drow + n) * t.K + t.k0 + 8 * c) = o; }
    LDS_WAIT(); asm volatile("" ::: "memory");
}
__device__ __forceinline__ void convert_set(Frame& F, int set, int wv, int nw) {
    if (wv < 0 || wv >= nw) return;
    LAS float* scr = (LAS float*)(F.lds + RING_OFF + F.wave * 16640);
    const int n = ti_count(set);
    int it = wv; if (it >= n) return;
    TItem cur, nxt; f32x4 vc[16], vn[16]; float sc[16], sn[16];
    ti_decode(F, set, it, cur); ti_load(cur, vc, sc, F.lane);
    for (;;) {
        const int itn = it + nw; const bool hn = itn < n;
        if (hn) { ti_decode(F, set, itn, nxt); ti_load(nxt, vn, sn, F.lane); }
        ti_store(cur, vc, sc, scr, F.lane);
        if (!hn) break;
        cur = nxt; it = itn;
#pragma unroll
        for (int i = 0; i < 16; ++i) { vc[i] = vn[i]; sc[i] = sn[i]; }
    }
}
__device__ __forceinline__ void rms_row(const float* xrow, const float* w, bf16* ob, float* of, int lane) {
    const f32x4* xr = (const f32x4*)xrow + lane; const f32x4* wr_ = (const f32x4*)w + lane;
    f32x4 v[8]; float s = 0.f;
#pragma unroll
    for (int j = 0; j < 8; ++j) { v[j] = __builtin_nontemporal_load(xr + 64 * j); s += (v[j].x * v[j].x + v[j].y * v[j].y) + (v[j].z * v[j].z + v[j].w * v[j].w); }
    const float rstd = rsqrtf(wave_sum(s) * (1.f / D) + EPS);
#pragma unroll
    for (int j = 0; j < 8; ++j) { const f32x4 g = wr_[64 * j]; const f32x4 y = v[j] * rstd * g;
        if (ob) ((unsigned long long*)ob)[lane + 64 * j] = (unsigned long long)pk2(y.x, y.y) | ((unsigned long long)pk2(y.z, y.w) << 32);
        if (of) ((f32x4*)of)[lane + 64 * j] = y; }
}

__device__ __forceinline__ void p0_prologue(Frame& F) {
    const int gw = F.bid * NWAVES + F.wave, NGW = F.G * NWAVES;
    bf16* Win = WSP(bf16, WS_WIN);
    convert_set(F, 0, gw, NGW);
    { const size_t z0 = (size_t)7232 * D * 2, z1 = (size_t)NPROJ_PAD * D * 2; v4u* p = (v4u*)((unsigned char*)Win + z0); const size_t n16 = (z1 - z0) / 16;
      for (size_t i = (size_t)F.bid * 512 + F.tid; i < n16; i += (size_t)F.G * 512) p[i] = (v4u){0u, 0u, 0u, 0u}; }
    bf16* XN = WSP(bf16, WS_XN);
    for (int m = gw; m < M; m += NGW) rms_row(kin(0) + (size_t)m * D, kin(10), XN + (size_t)m * D, nullptr, F.lane);
    if (gw < MS) rms_row(kin(1) + (size_t)gw * D, kin(10), nullptr, SSP(S_A) + (size_t)gw * D, F.lane);
    { const f32x4* p = (const f32x4*)kin(8); v2u* o = (v2u*)WSP(bf16, WS_PB); const size_t n4 = (size_t)M * PLE / 4;
      for (size_t i = (size_t)F.bid * 512 + F.tid; i < n4; i += (size_t)F.G * 512) { const f32x4 v = __builtin_nontemporal_load(p + i); o[i] = (v2u){pk2(v.x, v.y), pk2(v.z, v.w)}; } }
}

template <class Epi>
__device__ __forceinline__ void sample_gemm(Frame& F, const float* A, int K, bool norm, const bf16* Wt, int ntiles, const Epi& E) {
    const int first = F.G - 1 - F.bid;
    if (first >= ntiles) return;
    LAS bf16* As = (LAS bf16*)(F.lds);
    LAS float* Red = (LAS float*)(F.lds + 98304);
    LAS float* Rs = (LAS float*)(F.lds + 98304 + 8192);
    const int lane = F.lane, r32 = lane & 31, hh = lane >> 5;
    __syncthreads();
    if (norm) { float s = 0.f; for (int k = lane; k < K; k += 64) { const float v = A[(size_t)F.wave * K + k]; s += v * v; } s = wave_sum(s); if (lane == 0) Rs[F.wave] = rsqrtf(s / (float)K + EPS); }
    else if (lane == 0) Rs[F.wave] = 1.f;
    __syncthreads();
    { const float rs = Rs[F.wave]; for (int k = 2 * lane; k < K; k += 128) { const f32x2 v = *(const f32x2*)(A + (size_t)F.wave * K + k); *(LAS unsigned*)(As + F.wave * K + k) = cvt2bf(v.x * rs, v.y * rs); } }
    __syncthreads();
    const int ksteps = K / 128;
    for (int tl = first; tl < ntiles; tl += F.G) {
        f32x16 acc;
#pragma unroll
        for (int i = 0; i < 16; ++i) acc[i] = 0.f;
        const bf16* wp = Wt + (size_t)(32 * tl + r32) * K + F.wave * (K / 8) + 8 * hh;
        const LAS bf16* ap = As + (r32 & 7) * K + F.wave * (K / 8) + 8 * hh;
#pragma unroll 4
        for (int ks = 0; ks < ksteps; ++ks) {
            const bf16x8 bfr = *(const bf16x8*)(wp + 16 * ks);
            bf16x8 af = *(const LAS bf16x8*)(ap + 16 * ks);
            if (r32 >= 8) af = (bf16x8){0, 0, 0, 0, 0, 0, 0, 0};
            acc = __builtin_amdgcn_mfma_f32_32x32x16_bf16(af, bfr, acc, 0, 0, 0);
        }
        __syncthreads();
#pragma unroll
        for (int i = 0; i < 4; ++i) Red[(F.wave * 8 + 4 * hh + i) * 32 + r32] = acc[i];
        __syncthreads();
        if (F.tid < 256) { const int r = F.tid >> 5, c = F.tid & 31; float s = 0.f;
#pragma unroll
            for (int w = 0; w < 8; ++w) s += Red[(w * 8 + r) * 32 + c];
            E(r, 32 * tl + c, s); }
    }
    __syncthreads();
}
struct SEpiStore { float* O; int ld; int nmax; __device__ __forceinline__ void operator()(int r, int n, float v) const { if (n < nmax) O[(size_t)r * ld + n] = v; } };
struct SEpiAdd { const float* B; float* O; int ld; __device__ __forceinline__ void operator()(int r, int n, float v) const { O[(size_t)r * ld + n] = B[(size_t)r * ld + n] + v; } };
struct SEpiGateUp { float* GP; float* UP; __device__ __forceinline__ void operator()(int r, int n, float v) const { const int j = n >> 8, w = n & 255; if (w < 128) GP[(size_t)r * DFF + 128 * j + w] = v; else UP[(size_t)r * DFF + 128 * j + (w - 128)] = v; } };

__device__ __forceinline__ void gdn_prep_prompt(Frame& F) {
    const int gw = F.bid * NWAVES + F.wave, NGW = F.G * NWAVES;
    const bf16* CIN = WSP(bf16, WS_CIN); const float* cw = kin(14);
    float* GQ = WSP(float, WS_GQ); float* GK = WSP(float, WS_GK); float* GV = WSP(float, WS_GV);
    for (int it = gw; it < M * NH; it += NGW) {
        const int row = it >> 3, h = it & 7, t = row & (T - 1);
#pragma unroll
        for (int seg = 0; seg < 3; ++seg) {
            const int ch = seg * GW + h * HD + 2 * F.lane;
            float a0 = 0.f, a1 = 0.f;
#pragma unroll
            for (int j = 0; j < 4; ++j) { const int tt = t - 3 + j; if (tt >= 0) { const unsigned w = *(const unsigned*)(CIN + (size_t)(row - 3 + j) * CONVCH + ch); a0 += bf_lo(w) * cw[j * CONVCH + ch]; a1 += bf_hi(w) * cw[j * CONVCH + ch + 1]; } }
            a0 = silu_f(a0); a1 = silu_f(a1);
            float* dst = (seg == 0 ? GQ : seg == 1 ? GK : GV) + (size_t)row * GW + h * HD + 2 * F.lane;
            if (seg < 2) { const float ss = wave_sum(a0 * a0 + a1 * a1); float sc = rsqrtf(ss + 1e-6f); if (seg == 0) sc *= SB_SCALE; a0 *= sc; a1 *= sc; }
            *(f32x2*)dst = (f32x2){a0, a1};
        }
    }
}
__device__ __forceinline__ void gdn_prep_sample(Frame& F) {
    const float* PR = SSP(S_PROJ); const float* hist = kin(5); const float* cw = kin(14);
    const int gt = F.bid * 512 + F.tid, NT = F.G * 512;
    for (int i = gt; i < MS * SBW; i += NT) { const int b = i >> 10, c = i & 1023; F.out[OUT_KS + i] = PR[(size_t)b * IN_COLS + O_SB_K + c]; F.out[OUT_VS + i] = PR[(size_t)b * IN_COLS + O_SB_V + c]; }
    for (int i = gt; i < MS * 3 * CONVCH; i += NT) { const int b = i / (3 * CONVCH), rr = (i / CONVCH) % 3, c = i % CONVCH;
        F.out[OUT_GCONVS + i] = (rr < 2) ? hist[((size_t)b * 3 + rr + 1) * CONVCH + c] : PR[(size_t)b * IN_COLS + O_GQKV + c]; }
    if (gt < 64) { const int b = gt >> 3, h = gt & 7; SSP(S_G)[gt] = -__expf(kin(15)[h]) * softplus_f(PR[(size_t)b * IN_COLS + O_GA + h] + kin(16)[h]); SSP(S_BETA)[gt] = sigmoid_f(PR[(size_t)b * IN_COLS + O_GB + h]); }
    const int gw = F.bid * NWAVES + F.wave;
    if (gw < MS * NH * 3) {
        const int b = gw / (NH * 3), h = (gw / 3) % NH, seg = gw % 3;
        const int ch = seg * GW + h * HD + 2 * F.lane; float a[2];
        float hv[3][2], pv[2], wv[4][2];
#pragma unroll
        for (int e = 0; e < 2; ++e) {
#pragma unroll
            for (int j = 0; j < 3; ++j) { hv[j][e] = hist[((size_t)b * 3 + j) * CONVCH + ch + e]; wv[j][e] = cw[j * CONVCH + ch + e]; }
            pv[e] = PR[(size_t)b * IN_COLS + O_GQKV + ch + e]; wv[3][e] = cw[3 * CONVCH + ch + e]; }
#pragma unroll
        for (int e = 0; e < 2; ++e) a[e] = silu_f(hv[0][e] * wv[0][e] + hv[1][e] * wv[1][e] + hv[2][e] * wv[2][e] + pv[e] * wv[3][e]);
        float* dst = SSP(seg == 0 ? S_GQ : seg == 1 ? S_GK : S_GV) + (size_t)b * GW + h * HD + 2 * F.lane;
        if (seg < 2) { const float ss = wave_sum(a[0] * a[0] + a[1] * a[1]); float sc = rsqrtf(ss + 1e-6f); if (seg == 0) sc *= SB_SCALE; a[0] *= sc; a[1] *= sc; }
        dst[0] = a[0]; dst[1] = a[1];
    }
}

template <bool PIPE>
__device__ __forceinline__ void gdn_recur_wave(const float* GQ, const float* GK, const float* GV, const float* Gg, const float* Gb, int ld, int gld, size_t row0, int ntok, int h, int slice,
                                               const float* S0, float* Sout, float* GO, int lane) {
    const int e = 4 * slice + (lane >> 4), d0 = 8 * (lane & 15);
    float S[8];
#pragma unroll
    for (int i = 0; i < 8; ++i) S[i] = S0 ? S0[(size_t)(d0 + i) * HD + e] : 0.f;
    constexpr int NT = PIPE ? 4 : 1;
    f32x4 ck0[NT], ck1[NT], cq0[NT], cq1[NT]; float cv[NT], cg[NT], cb[NT];
#define GDN_LOAD(dk0, dk1, dq0, dq1, dv, dg, db, tb) do { _Pragma("unroll") for (int i_ = 0; i_ < NT; ++i_) { const size_t row_ = row0 + (tb) + i_; \
        dk0[i_] = *(const f32x4*)(GK + row_ * ld + h * HD + d0); dk1[i_] = *(const f32x4*)(GK + row_ * ld + h * HD + d0 + 4); \
        dq0[i_] = *(const f32x4*)(GQ + row_ * ld + h * HD + d0); dq1[i_] = *(const f32x4*)(GQ + row_ * ld + h * HD + d0 + 4); \
        dv[i_] = GV[row_ * ld + h * HD + e]; dg[i_] = Gg[row_ * gld + h]; db[i_] = Gb[row_ * gld + h]; } } while (0)
    GDN_LOAD(ck0, ck1, cq0, cq1, cv, cg, cb, 0);
    for (int t = 0; t < ntok; t += NT) {
        f32x4 nk0[NT], nk1[NT], nq0[NT], nq1[NT]; float nv[NT], ng[NT], nb[NT];
        const int tn = (t + NT < ntok) ? t + NT : t;
        GDN_LOAD(nk0, nk1, nq0, nq1, nv, ng, nb, tn);
#pragma unroll
        for (int i = 0; i < NT; ++i) {
            const float kk[8] = {ck0[i].x, ck0[i].y, ck0[i].z, ck0[i].w, ck1[i].x, ck1[i].y, ck1[i].z, ck1[i].w}, qq[8] = {cq0[i].x, cq0[i].y, cq0[i].z, cq0[i].w, cq1[i].x, cq1[i].y, cq1[i].z, cq1[i].w};
            const float eg = __expf(cg[i]);
            float kv = 0.f;
#pragma unroll
            for (int j = 0; j < 8; ++j) kv += S[j] * kk[j];
            kv += __shfl_xor(kv, 1); kv += __shfl_xor(kv, 2); kv += __shfl_xor(kv, 4); kv += __shfl_xor(kv, 8);
            const float u = cb[i] * (cv[i] - eg * kv);
            float o = 0.f;
#pragma unroll
            for (int j = 0; j < 8; ++j) { S[j] = eg * S[j] + kk[j] * u; o += S[j] * qq[j]; }
            o += __shfl_xor(o, 1); o += __shfl_xor(o, 2); o += __shfl_xor(o, 4); o += __shfl_xor(o, 8);
            if ((lane & 15) == 0) GO[(row0 + t + i) * ld + h * HD + e] = o;
        }
#pragma unroll
        for (int i = 0; i < NT; ++i) { ck0[i] = nk0[i]; ck1[i] = nk1[i]; cq0[i] = nq0[i]; cq1[i] = nq1[i]; cv[i] = nv[i]; cg[i] = ng[i]; cb[i] = nb[i]; }
    }
#undef GDN_LOAD
#pragma unroll
    for (int i = 0; i < 8; ++i) Sout[(size_t)(d0 + i) * HD + e] = S[i];
}

__device__ __forceinline__ void sb_query_simple(Frame& F, int b, int h, int t, LAS float* qs) {
    const bf16* Qb = WSP(bf16, WS_Q); const bf16* Kb = WSP(bf16, WS_K); const bf16* Vb = WSP(bf16, WS_V); bf16* MIX = WSP(bf16, WS_MIX);
    const size_t row = (size_t)b * T + t; const int lane = F.lane;
    { const unsigned w = *(const unsigned*)(Qb + row * SBW + h * HD + 2 * lane); qs[2 * lane] = bf_lo(w); qs[2 * lane + 1] = bf_hi(w); }
    LDS_WAIT(); asm volatile("" ::: "memory");
    const float ch = kin(12)[h];
    float o0 = 0.f, o1 = 0.f, R = 0.f;
    const int nblk = (t + 63) >> 6;
    for (int blk = nblk - 1; blk >= 0; --blk) {
        const int k0 = blk * 64, key = k0 + lane; const bool valid = key < t;
        const v4u* kr = (const v4u*)(Kb + ((size_t)b * T + key) * SBW + h * HD);
        float dot = 0.f;
#pragma unroll
        for (int c = 0; c < 16; ++c) { const v4u w = kr[c]; const f32x4 qa = *(const LAS f32x4*)(qs + 8 * c), qb = *(const LAS f32x4*)(qs + 8 * c + 4);
            dot += bf_lo(w.x) * qa.x + bf_hi(w.x) * qa.y + bf_lo(w.y) * qa.z + bf_hi(w.y) * qa.w + bf_lo(w.z) * qb.x + bf_hi(w.z) * qb.y + bf_lo(w.w) * qb.z + bf_hi(w.w) * qb.w; }
        const float z = dot * SB_SCALE + ch;
        const float sp = softplus_f(z);
        const float L = valid ? -sp : 0.f, lb = z - sp;
        float s = L;
#pragma unroll
        for (int o = 1; o < 64; o <<= 1) { const float tmp = __shfl_down(s, o); if (lane + o < 64) s += tmp; }
        const float tot = __shfl(s, 0);
        const float a = valid ? __expf(lb + (s - L) + R) : 0.f;
        R += tot;
        const bf16* vr = Vb + ((size_t)b * T + k0) * SBW + h * HD + 2 * lane;
#pragma unroll 8
        for (int j = 0; j < 64; ++j) { const float aj = __shfl(a, j); const unsigned w = *(const unsigned*)(vr + (size_t)j * SBW); o0 += aj * bf_lo(w); o1 += aj * bf_hi(w); }
    }
    const float ss = wave_sum(o0 * o0 + o1 * o1); const float rs = rsqrtf(ss * (1.f / HD) + EPS);
    const float* nw = kin(13);
    *(unsigned*)(MIX + row * D + h * HD + 2 * lane) = pk2(o0 * rs * nw[2 * lane], o1 * rs * nw[2 * lane + 1]);
}

__device__ __forceinline__ void sb_decode_block(Frame& F, int bh, int blk) {
    const int b = bh >> 3, h = bh & 7;
    const float* q = SSP(S_PROJ) + (size_t)b * IN_COLS + h * HD;
    const float* CK = kin(2); const float* CV = kin(3); const int* PT = (const int*)kin(4);
    int lane = F.lane; asm volatile("" : "+v"(lane));
    const int half = lane >> 5, l32 = lane & 31;
    const f32x4 q4 = *(const f32x4*)(q + 4 * l32);
    const float k2 = kin(12)[h] * 1.4426950408889634f, k1 = SB_SCALE * 1.4426950408889634f;
    const int p0 = blk * 64;
    const int page = PT[b * NPAGES + (p0 >> 7)];
    const size_t base = (((size_t)page * PAGE + (p0 & 127)) * NH + h) * HD;
    int zi = 0;
#pragma unroll
    for (int hb = 0; hb < 2; ++hb) {
        f32x4 kv[16];
#pragma unroll
        for (int i = 0; i < 16; ++i) kv[i] = __builtin_nontemporal_load((const f32x4*)(CK + base + (size_t)(32 * hb + 2 * i + half) * (NH * HD) + 4 * l32));
#pragma unroll
        for (int i = 0; i < 16; ++i) {
            float p = (kv[i].x * q4.x + kv[i].y * q4.y) + (kv[i].z * q4.z + kv[i].w * q4.w);
            { int pi = __builtin_bit_cast(int, p);
              p += __builtin_bit_cast(float, __builtin_amdgcn_update_dpp(0, pi, 0xB1, 0xF, 0xF, false)); pi = __builtin_bit_cast(int, p);
              p += __builtin_bit_cast(float, __builtin_amdgcn_update_dpp(0, pi, 0x4E, 0xF, 0xF, false)); pi = __builtin_bit_cast(int, p);
              p += __builtin_bit_cast(float, __builtin_amdgcn_update_dpp(0, pi, 0x141, 0xF, 0xF, false)); pi = __builtin_bit_cast(int, p);
              p += __builtin_bit_cast(float, __builtin_amdgcn_update_dpp(0, pi, 0x140, 0xF, 0xF, false)); pi = __builtin_bit_cast(int, p);
              p += __builtin_bit_cast(float, __builtin_amdgcn_ds_swizzle(pi, 0x401F)); }
            const int pe = __builtin_amdgcn_readlane(__builtin_bit_cast(int, p), 0), po = __builtin_amdgcn_readlane(__builtin_bit_cast(int, p), 32);
            asm volatile("s_nop 3\n\tv_writelane_b32 %0, %1, %2" : "+v"(zi) : "s"(pe), "i"(32 * hb + 2 * i)); asm volatile("v_writelane_b32 %0, %1, %2" : "+v"(zi) : "s"(po), "i"(32 * hb + 2 * i + 1));
        }
    }
    const float z = __builtin_bit_cast(float, zi);
    const float e = __builtin_amdgcn_exp2f(-(z * k1 + k2));
    const float be = __builtin_amdgcn_rcpf(1.0f + e), m = 1.0f - be;
    float s = m;
#pragma unroll
    for (int o = 1; o < 64; o <<= 1) { const float t = __shfl_down(s, o); if (lane + o < 64) s *= t; }
    const float tot = __shfl(s, 0);
    const float sx = __shfl_down(s, 1);
    const float a = be * (lane < 63 ? sx : 1.0f);
    f32x4 o4 = {0.f, 0.f, 0.f, 0.f};
#pragma unroll
    for (int hb = 0; hb < 2; ++hb) {
        f32x4 vv[16];
#pragma unroll
        for (int i = 0; i < 16; ++i) vv[i] = __builtin_nontemporal_load((const f32x4*)(CV + base + (size_t)(32 * hb + 2 * i + half) * (NH * HD) + 4 * l32));
#pragma unroll
        for (int i = 0; i < 16; ++i) { const float aj = __shfl(a, 32 * hb + 2 * i + half); o4 += aj * vv[i]; }
    }
    o4.x += __shfl_xor(o4.x, 32); o4.y += __shfl_xor(o4.y, 32); o4.z += __shfl_xor(o4.z, 32); o4.w += __shfl_xor(o4.w, 32);
    float* P = SSP(S_PART) + ((size_t)bh * DSEG + blk) * DPART;
    if (half == 0) *(f32x4*)(P + 4 * l32) = o4; if (lane == 0) P[128] = tot;
}
__device__ __forceinline__ void sb_decode_pull(Frame& F, unsigned* qctr, volatile LAS unsigned* stop) {
    for (;;) {
        if (stop && __builtin_amdgcn_readfirstlane(*stop) != 0u) break;
        const unsigned v = __hip_atomic_fetch_add(qctr, 1u, __ATOMIC_RELAXED, __HIP_MEMORY_SCOPE_AGENT);
        const int it = (int)(__builtin_amdgcn_readfirstlane(v) >> 6);
        if (it >= MS * NH * DSEG) break;
        sb_decode_block(F, ((it >> 11) << 3) | (it & 7), (it >> 3) & 255);
    }
}

__device__ __forceinline__ unsigned offb(unsigned row, unsigned ch) { return 256u * row + 16u * (ch ^ (((row & 3u) << 2) | ((row >> 2) & 3u))); }
constexpr float LOG2E = 1.4426950408889634f;

__device__ __forceinline__ void sb_attn_unit(Frame& F, int b, int h, int qb) {
    const bf16* Qb = WSP(bf16, WS_Q); const bf16* Kb = WSP(bf16, WS_K); const bf16* Vb = WSP(bf16, WS_V); bf16* MIX = WSP(bf16, WS_MIX);
    const int lane = F.lane, r32 = lane & 31, hh = lane >> 5;
    const int q0w = 256 * qb + 32 * F.wave;
    LAS unsigned char* KB0 = F.lds + RING_OFF; LAS unsigned char* VB0 = F.lds + RING_OFF + 32768;
    bf16x8 qf[8];
    { const bf16* qp = Qb + ((size_t)b * T + q0w + r32) * SBW + h * HD + 8 * hh;
#pragma unroll
      for (int s = 0; s < 8; ++s) qf[s] = *(const bf16x8*)(qp + 16 * s); }
    const float k1 = SB_SCALE * LOG2E, k2 = kin(12)[h] * LOG2E;
    f32x16 oacc[4];
#pragma unroll
    for (int d = 0; d < 4; ++d)
#pragma unroll
        for (int i = 0; i < 16; ++i) oacc[d][i] = 0.f;
    float R = 1.f;
    const int nt = 4 * qb + 4;
    const int srow = F.tid >> 4, sch = F.tid & 15;
    const size_t gbase = ((size_t)b * T) * SBW + h * HD + sch * 8;
    v4u rk[2], rv[2];
#define SB_LOAD(k0_) do { _Pragma("unroll") for (int i_ = 0; i_ < 2; ++i_) { const size_t o_ = gbase + (size_t)((k0_) + srow + 32 * i_) * SBW; rk[i_] = *(const v4u*)(Kb + o_); rv[i_] = *(const v4u*)(Vb + o_); } } while (0)
    const unsigned kwo = (unsigned)((sch >> 1) * 1024 + srow * 32 + (((sch & 1) ^ ((srow >> 3) & 1)) * 16));
    const unsigned vwo = (unsigned)((((srow >> 3) * 4 + (sch >> 2)) * 512) + (srow & 7) * 64 + (sch & 3) * 16);
#define SB_WRITE(buf_) do { _Pragma("unroll") for (int i_ = 0; i_ < 2; ++i_) { *(LAS v4u*)(KB0 + (buf_) * 16384 + kwo + i_ * 8192) = rk[i_]; *(LAS v4u*)(VB0 + (buf_) * 16384 + vwo + i_ * 8192) = rv[i_]; } } while (0)
    SB_LOAD(64 * (nt - 1)); SB_WRITE(0);
    __syncthreads();
    const int tq = (lane & 15) >> 2, tp = lane & 3, tblk = (lane >> 4) & 1;
    const unsigned kro = (unsigned)(r32 * 32 + ((hh ^ ((r32 >> 3) & 1)) * 16));
    const unsigned vro = (unsigned)((4 * hh + tq) * 64 + tblk * 32 + tp * 8);
    for (int it = 0; it < nt; ++it) {
        const int kt = nt - 1 - it, buf = it & 1, k0 = 64 * kt;
        if (it + 1 < nt) SB_LOAD(64 * (kt - 1));
        if (k0 < q0w + 31) {
            const bool diag = (k0 + 63 >= q0w);
            LAS unsigned char* Kt = KB0 + buf * 16384; LAS unsigned char* Vt = VB0 + buf * 16384;
            f32x16 sacc[2];
#pragma unroll
            for (int kb = 0; kb < 2; ++kb) {
#pragma unroll
                for (int i = 0; i < 16; ++i) sacc[kb][i] = 0.f;
#pragma unroll
                for (int s = 0; s < 8; ++s) { const bf16x8 kf = *(const LAS bf16x8*)(Kt + kro + (kb * 8 + s) * 1024); sacc[kb] = __builtin_amdgcn_mfma_f32_32x32x16_bf16(kf, qf[s], sacc[kb], 0, 0, 0); }
            }
            float after = R;
            unsigned pp[2][8];
            const int qabs = q0w + r32;
#define SB_TILE(DIAG_) do { _Pragma("unroll") for (int kb = 1; kb >= 0; --kb) _Pragma("unroll") for (int g = 3; g >= 0; --g) { \
                    float be[4], m[4]; \
                    _Pragma("unroll") for (int j = 0; j < 4; ++j) { \
                        const float e = __builtin_amdgcn_exp2f(-(sacc[kb][4 * g + j] * k1 + k2)); \
                        be[j] = __builtin_amdgcn_rcpf(1.0f + e); m[j] = 1.0f - be[j]; \
                        if (DIAG_) { const bool vd = (k0 + 32 * kb + 8 * g + 4 * hh + j) < qabs; be[j] = vd ? be[j] : 0.f; m[j] = vd ? m[j] : 1.f; } } \
                    const float s3 = m[3], s2 = m[2] * s3, s1 = m[1] * s2, s0 = m[0] * s1; \
                    const float p4 = __shfl_xor(s0, 32); \
                    const float base = after * (hh == 0 ? p4 : 1.0f); \
                    const float a0 = be[0] * s1 * base, a1 = be[1] * s2 * base, a2 = be[2] * s3 * base, a3 = be[3] * base; \
                    after *= s0 * p4; \
                    pp[kb][2 * g] = cvt2bf(a0, a1); pp[kb][2 * g + 1] = cvt2bf(a2, a3); } } while (0)
            if (diag) SB_TILE(true); else SB_TILE(false);
#undef SB_TILE
            R = after;
#pragma unroll
            for (int kb = 0; kb < 2; ++kb)
#pragma unroll
                for (int sp = 0; sp < 2; ++sp) {
                    const v4u pw = {pp[kb][4 * sp], pp[kb][4 * sp + 1], pp[kb][4 * sp + 2], pp[kb][4 * sp + 3]};
                    const bf16x8 pf = __builtin_bit_cast(bf16x8, pw);
                    const int keybase = 32 * kb + 16 * sp;
#pragma unroll
                    for (int db = 0; db < 4; ++db) {
                        const s16x4 lo = __builtin_amdgcn_ds_read_tr16_b64_v4i16((LAS s16x4*)(Vt + vro + ((keybase >> 3) * 4 + db) * 512));
                        const s16x4 hi = __builtin_amdgcn_ds_read_tr16_b64_v4i16((LAS s16x4*)(Vt + vro + (((keybase >> 3) + 1) * 4 + db) * 512));
                        const bf16x8 vf = __builtin_shufflevector(lo, hi, 0, 1, 2, 3, 4, 5, 6, 7);
                        oacc[db] = __builtin_amdgcn_mfma_f32_32x32x16_bf16(vf, pf, oacc[db], 0, 0, 0);
                    }
                }
        }
        if (it + 1 < nt) SB_WRITE(buf ^ 1);
        __syncthreads();
    }
#undef SB_LOAD
#undef SB_WRITE
    float ss = 0.f;
#pragma unroll
    for (int d = 0; d < 4; ++d)
#pragma unroll
        for (int i = 0; i < 16; ++i) ss += oacc[d][i] * oacc[d][i];
    ss += __shfl_xor(ss, 32);
    const float rs = rsqrtf(ss * (1.f / HD) + EPS);
    const float* nw = kin(13);
    bf16* op = MIX + ((size_t)b * T + q0w + r32) * D + h * HD + 4 * hh;
#pragma unroll
    for (int d = 0; d < 4; ++d)
#pragma unroll
        for (int g = 0; g < 4; ++g) { const int dd = 32 * d + 8 * g + 4 * hh; const f32x4 w4 = *(const f32x4*)(nw + dd);
            v2u w; w.x = cvt2bf(oacc[d][4 * g] * rs * w4.x, oacc[d][4 * g + 1] * rs * w4.y); w.y = cvt2bf(oacc[d][4 * g + 2] * rs * w4.z, oacc[d][4 * g + 3] * rs * w4.w);
            *(v2u*)(op + 32 * d + 8 * g) = w; }
}

constexpr int GREC_WF = 0, GREC_KTF = 16384, GREC_UF = 32768, GREC_SCAN = 49152  , GREC_QF = 49152, GREC_QKF = 65536, GREC_BYTES = 73728;
constexpr int NCHUNK = T / 64;
constexpr int PL_LOW = 0  , PL_TK = 16384, PL_TQ = 32768, PL_TKBG = 49152, PL_TKT = 65536, PL_TVB = 81920, PL_TT = 98304  , PL_GC = 107520  , PL_BETA = 107776, PL_CW = 108032  ;
__device__ __forceinline__ unsigned rowimg(unsigned row, unsigned c16) { return ((row >> 5) * 8 + (c16 >> 1)) * 1024 + (row & 31) * 32 + (((c16 & 1) ^ ((row >> 3) & 1)) * 16); }
__device__ __forceinline__ unsigned trimg(unsigned row, unsigned c16) { return ((row >> 3) * 4 + (c16 >> 2)) * 512 + (row & 7) * 64 + (c16 & 3) * 16; }

__device__ __forceinline__ void gdn_prep_unit(Frame& F, int chain, int ci, unsigned char* rec, float* EGp, unsigned* qctr) {
    int lane = F.lane, tid = F.tid; asm volatile("" : "+v"(lane), "+v"(tid));
    const int b = chain >> 3, h = chain & 7, r32 = lane & 31, hh = lane >> 5;
    const size_t R0 = (size_t)b * T + 64 * ci;
    unsigned lb0 = 0; asm volatile("" : "+v"(lb0));
    LAS unsigned char* L = F.lds + lb0;
    LAS float* GC = (LAS float*)(L + PL_GC); LAS float* BE = (LAS float*)(L + PL_BETA); LAS float* LOW = (LAS float*)(L + PL_LOW);
    const bf16* CIN = WSP(bf16, WS_CIN); const float* cw = kin(14);
    for (int i = tid - 64; i >= 0 && i < 4 * 3 * 128; i += 448) { const int j = i / 384, seg = (i / 128) % 3, c = i & 127; ((LAS float*)(L + PL_CW))[i] = cw[j * CONVCH + seg * GW + h * HD + c]; }
    if (tid == 0) F.MISC[16] = 0u;
    if (F.wave == 0) { float g = WSP(float, WS_G)[(R0 + lane) * NH + h];
#pragma unroll
        for (int o = 1; o < 64; o <<= 1) { const float t = __shfl_up(g, o); if (lane >= o) g += t; }
        GC[lane] = g; BE[lane] = WSP(float, WS_BETA)[(R0 + lane) * NH + h]; }
    __syncthreads();
    {
        const int t = tid >> 3, sub = tid & 7; const int tseq = 64 * ci + t;
        const float gc = GC[t], gl = GC[63], be = BE[t];
        const float egc = __expf(gc), egl = __expf(gl - gc);
        float val[3][16];
        v4u cin[4][3][2]; float tmask[4];
#pragma unroll
        for (int j = 0; j < 4; ++j) { const bool ok = (tseq - 3 + j) >= 0; tmask[j] = ok ? 1.f : 0.f; const size_t rr = ok ? (R0 + t - 3 + j) : R0;
#pragma unroll
            for (int seg = 0; seg < 3; ++seg) { const bf16* p = CIN + rr * CONVCH + seg * GW + h * HD + 16 * sub; cin[j][seg][0] = *(const v4u*)p; cin[j][seg][1] = *(const v4u*)(p + 8); } }
#pragma unroll
        for (int seg = 0; seg < 3; ++seg) {
            float a[16];
#pragma unroll
            for (int e = 0; e < 16; ++e) a[e] = 0.f;
#pragma unroll
            for (int j = 0; j < 4; ++j) {
                const v4u w0 = cin[j][seg][0], w1 = cin[j][seg][1];
                const unsigned ww[8] = {w0.x, w0.y, w0.z, w0.w, w1.x, w1.y, w1.z, w1.w};
                const LAS f32x4* wl = (const LAS f32x4*)(L + PL_CW + ((j * 3 + seg) * 128 + 16 * sub) * 4);
                const f32x4 c0 = wl[0] * tmask[j], c1 = wl[1] * tmask[j], c2 = wl[2] * tmask[j], c3 = wl[3] * tmask[j];
                const float cwv[16] = {c0.x, c0.y, c0.z, c0.w, c1.x, c1.y, c1.z, c1.w, c2.x, c2.y, c2.z, c2.w, c3.x, c3.y, c3.z, c3.w};
#pragma unroll
                for (int e = 0; e < 8; ++e) { a[2 * e] += bf_lo(ww[e]) * cwv[2 * e]; a[2 * e + 1] += bf_hi(ww[e]) * cwv[2 * e + 1]; }
            }
            float ss = 0.f;
#pragma unroll
            for (int e = 0; e < 16; ++e) { a[e] = silu_f(a[e]); ss += a[e] * a[e]; }
            if (seg < 2) { ss += __shfl_xor(ss, 1); ss += __shfl_xor(ss, 2); ss += __shfl_xor(ss, 4); float sc = rsqrtf(ss + 1e-6f); if (seg == 0) sc *= SB_SCALE;
#pragma unroll
                for (int e = 0; e < 16; ++e) a[e] *= sc; }
#pragma unroll
            for (int e = 0; e < 16; ++e) val[seg][e] = a[e];
        }
#define PK8(dst, src, mul, o) do { dst.x = cvt2bf(src[o] * (mul), src[o + 1] * (mul)); dst.y = cvt2bf(src[o + 2] * (mul), src[o + 3] * (mul)); dst.z = cvt2bf(src[o + 4] * (mul), src[o + 5] * (mul)); dst.w = cvt2bf(src[o + 6] * (mul), src[o + 7] * (mul)); } while (0)
        v4u p0, p1;
        PK8(p0, val[1], 1.0f, 0); PK8(p1, val[1], 1.0f, 8); *(LAS v4u*)(L + PL_TK + rowimg(t, 2 * sub)) = p0; *(LAS v4u*)(L + PL_TK + rowimg(t, 2 * sub + 1)) = p1;
        PK8(p0, val[1], be * egc, 0); PK8(p1, val[1], be * egc, 8); *(LAS v4u*)(L + PL_TKBG + trimg(t, 2 * sub)) = p0; *(LAS v4u*)(L + PL_TKBG + trimg(t, 2 * sub + 1)) = p1;
        PK8(p0, val[1], egl, 0); PK8(p1, val[1], egl, 8); *(LAS v4u*)(L + PL_TKT + trimg(t, 2 * sub)) = p0; *(LAS v4u*)(L + PL_TKT + trimg(t, 2 * sub + 1)) = p1;
        PK8(p0, val[0], 1.0f, 0); PK8(p1, val[0], 1.0f, 8); *(LAS v4u*)(L + PL_TQ + rowimg(t, 2 * sub)) = p0; *(LAS v4u*)(L + PL_TQ + rowimg(t, 2 * sub + 1)) = p1;
        PK8(p0, val[2], be, 0); PK8(p1, val[2], be, 8); *(LAS v4u*)(L + PL_TVB + trimg(t, 2 * sub)) = p0; *(LAS v4u*)(L + PL_TVB + trimg(t, 2 * sub + 1)) = p1;
        { float qg[16];
#pragma unroll
          for (int e = 0; e < 16; ++e) qg[e] = val[0][e] * egc;
          unsigned char* qf = rec + GREC_QF + ((t >> 5) * 8 + sub) * 1024 + (t & 31) * 16;
          v4u f0, f1; f0.x = cvt2bf(qg[0], qg[1]); f0.y = cvt2bf(qg[2], qg[3]); f0.z = cvt2bf(qg[8], qg[9]); f0.w = cvt2bf(qg[10], qg[11]);
          f1.x = cvt2bf(qg[4], qg[5]); f1.y = cvt2bf(qg[6], qg[7]); f1.z = cvt2bf(qg[12], qg[13]); f1.w = cvt2bf(qg[14], qg[15]);
          *(v4u*)qf = f0; *(v4u*)(qf + 512) = f1; }
#undef PK8
        if (tid == 0) *EGp = __expf(gl);
    }
    __syncthreads();
    {
        const int which = F.wave >> 2, ta = (F.wave >> 1) & 1, tb = F.wave & 1;
        const unsigned aro = r32 * 32 + ((hh ^ ((r32 >> 3) & 1)) * 16);
        f32x16 acc;
#pragma unroll
        for (int i = 0; i < 16; ++i) acc[i] = 0.f;
        const bool zero_tile = (which == 0) ? (ta < tb) : (ta > tb);
        if (!zero_tile) {
#pragma unroll
            for (int ks = 0; ks < 8; ++ks) {
                const bf16x8 af = *(const LAS bf16x8*)(L + PL_TK + aro + (ta * 8 + ks) * 1024);
                const bf16x8 bfr = *(const LAS bf16x8*)(L + (which == 0 ? PL_TK : PL_TQ) + aro + (tb * 8 + ks) * 1024);
                acc = __builtin_amdgcn_mfma_f32_32x32x16_bf16(af, bfr, acc, 0, 0, 0);
            }
        }
        if (which == 0) {
            const int s = 32 * tb + r32; const float gs = GC[s];
#pragma unroll
            for (int g = 0; g < 4; ++g) { const int c0 = 32 * ta + 8 * g + 4 * hh; const f32x4 gc4 = *(const LAS f32x4*)(GC + c0), be4 = *(const LAS f32x4*)(BE + c0);
#pragma unroll
                for (int j = 0; j < 4; ++j) { const float e = __expf(fminf(gc4[j] - gs, 0.f)); const float v = be4[j] * acc[4 * g + j] * e; LOW[(c0 + j) * 64 + s] = (c0 + j > s) ? v : 0.f; } }
        } else {
            const int c = 32 * tb + r32; const float gcc = GC[c]; float v[16];
#pragma unroll
            for (int g = 0; g < 4; ++g) { const int s0 = 32 * ta + 8 * g + 4 * hh; const f32x4 gc4 = *(const LAS f32x4*)(GC + s0);
#pragma unroll
                for (int j = 0; j < 4; ++j) { const float e = __expf(fminf(gcc - gc4[j], 0.f)); const float x = acc[4 * g + j] * e; v[4 * g + j] = (c >= s0 + j) ? x : 0.f; } }
#pragma unroll
            for (int s = 0; s < 2; ++s) { v4u f; f.x = cvt2bf(v[8 * s], v[8 * s + 1]); f.y = cvt2bf(v[8 * s + 2], v[8 * s + 3]); f.z = cvt2bf(v[8 * s + 4], v[8 * s + 5]); f.w = cvt2bf(v[8 * s + 6], v[8 * s + 7]);
                *(v4u*)(rec + GREC_QKF + (tb * 4 + 2 * ta + s) * 1024 + lane * 16) = f; }
        }
    }
    __syncthreads();
    if (F.wave != 0) sb_decode_pull(F, qctr, F.MISC + 16);
    if (F.wave == 0) {
        float Tc[64];
#pragma unroll
        for (int c = 0; c < 64; ++c) {
            float a0 = 0.f, a1 = 0.f, a2 = 0.f, a3 = 0.f;
#pragma unroll
            for (int s4 = 0; s4 < (c + 3) / 4; ++s4) { const f32x4 l4 = *(const LAS f32x4*)(LOW + c * 64 + 4 * s4);
                a0 += l4.x * Tc[4 * s4]; if (4 * s4 + 1 < c) a1 += l4.y * Tc[4 * s4 + 1]; if (4 * s4 + 2 < c) a2 += l4.z * Tc[4 * s4 + 2]; if (4 * s4 + 3 < c) a3 += l4.w * Tc[4 * s4 + 3]; }
            Tc[c] = ((c == lane) ? 1.f : 0.f) - ((a0 + a1) + (a2 + a3));
        }
#pragma unroll
        for (int c = 0; c < 64; ++c) *(LAS bf16*)(L + PL_TT + c * 144 + lane * 2) = (bf16)f2bf(Tc[c]);
        F.MISC[16] = 1u;
    }
    __syncthreads();
    {
        const int tq = (lane & 15) >> 2, tp = lane & 3, tblk = (lane >> 4) & 1;
        const unsigned trn = hh * 2048 + tq * 64 + tblk * 32 + tp * 8;
        const unsigned trm = (4 * hh + tq) * 64 + tblk * 32 + tp * 8;
        const unsigned tro = r32 * 144 + hh * 16;
        {
            const int ct = F.wave >> 2, et = F.wave & 3; f32x16 acc;
#pragma unroll
            for (int i = 0; i < 16; ++i) acc[i] = 0.f;
#pragma unroll
            for (int ks = 0; ks < 4; ++ks) {
                const bf16x8 af = *(const LAS bf16x8*)(L + PL_TT + tro + ct * 32 * 144 + ks * 32);
                const s16x4 lo = __builtin_amdgcn_ds_read_tr16_b64_v4i16((LAS s16x4*)(L + PL_TVB + trn + ks * 4096 + et * 512));
                const s16x4 hi = __builtin_amdgcn_ds_read_tr16_b64_v4i16((LAS s16x4*)(L + PL_TVB + trn + ks * 4096 + et * 512 + 256));
                acc = __builtin_amdgcn_mfma_f32_32x32x16_bf16(af, __builtin_shufflevector(lo, hi, 0, 1, 2, 3, 4, 5, 6, 7), acc, 0, 0, 0);
            }
            v4u f0, f1; f0.x = cvt2bf(acc[0], acc[1]); f0.y = cvt2bf(acc[2], acc[3]); f0.z = cvt2bf(acc[4], acc[5]); f0.w = cvt2bf(acc[6], acc[7]);
            f1.x = cvt2bf(acc[8], acc[9]); f1.y = cvt2bf(acc[10], acc[11]); f1.z = cvt2bf(acc[12], acc[13]); f1.w = cvt2bf(acc[14], acc[15]);
            unsigned char* up = rec + GREC_UF + (et * 2 + ct) * 2048 + lane * 32; *(v4u*)up = f0; *(v4u*)(up + 16) = f1;
        }
        {
            const int dt = F.wave >> 1, ct = F.wave & 1; f32x16 acc;
#pragma unroll
            for (int i = 0; i < 16; ++i) acc[i] = 0.f;
#pragma unroll
            for (int ks = 0; ks < 4; ++ks) {
                const s16x4 lo = __builtin_amdgcn_ds_read_tr16_b64_v4i16((LAS s16x4*)(L + PL_TKBG + trn + ks * 4096 + dt * 512));
                const s16x4 hi = __builtin_amdgcn_ds_read_tr16_b64_v4i16((LAS s16x4*)(L + PL_TKBG + trn + ks * 4096 + dt * 512 + 256));
                const bf16x8 bfr = *(const LAS bf16x8*)(L + PL_TT + tro + ct * 32 * 144 + ks * 32);
                acc = __builtin_amdgcn_mfma_f32_32x32x16_bf16(__builtin_shufflevector(lo, hi, 0, 1, 2, 3, 4, 5, 6, 7), bfr, acc, 0, 0, 0);
            }
#pragma unroll
            for (int s = 0; s < 2; ++s) { v4u f; f.x = cvt2bf(-acc[8 * s], -acc[8 * s + 1]); f.y = cvt2bf(-acc[8 * s + 2], -acc[8 * s + 3]); f.z = cvt2bf(-acc[8 * s + 4], -acc[8 * s + 5]); f.w = cvt2bf(-acc[8 * s + 6], -acc[8 * s + 7]);
                *(v4u*)(rec + GREC_WF + (ct * 8 + 2 * dt + s) * 1024 + lane * 16) = f; }
        }
        {
#pragma unroll
            for (int q = 0; q < 2; ++q) { const int f = 2 * F.wave + q, dt = f >> 2, ksp = f & 3;
                const s16x4 lo = __builtin_amdgcn_ds_read_tr16_b64_v4i16((LAS s16x4*)(L + PL_TKT + trm + (2 * ksp) * 2048 + dt * 512));
                const s16x4 hi = __builtin_amdgcn_ds_read_tr16_b64_v4i16((LAS s16x4*)(L + PL_TKT + trm + (2 * ksp + 1) * 2048 + dt * 512));
                const bf16x8 kf = __builtin_shufflevector(lo, hi, 0, 1, 2, 3, 4, 5, 6, 7);
                *(bf16x8*)(rec + GREC_KTF + (dt * 4 + ksp) * 1024 + lane * 16) = kf; }
        }
    }
    __syncthreads();
}

__device__ __forceinline__ void gdn_scan_chain(Frame& F, int chain) {
    const int lane = F.lane, r32 = lane & 31, hh = lane >> 5, et = F.wave;
    const unsigned char* recs = F.ws + WS_GREC + (size_t)chain * NCHUNK * GREC_BYTES;
    const float* EG = WSP(float, WS_GEG) + chain * NCHUNK;
    unsigned char* sfr = F.ws + WS_GSF + ((size_t)chain * NCHUNK * 4 + et) * 8192 + lane * 16;
    LAS unsigned char* L = F.lds;
    f32x16 S[4];
#pragma unroll
    for (int d = 0; d < 4; ++d)
#pragma unroll
        for (int i = 0; i < 16; ++i) S[d][i] = 0.f;
#define GS_DMA(ci_, slot_) do { const unsigned char* g_ = recs + (size_t)(ci_) * GREC_BYTES + lane * 16; \
        _Pragma("unroll") for (int p_ = 0; p_ < 6; ++p_) __builtin_amdgcn_global_load_lds((const unsigned*)(g_ + (F.wave + 8 * p_) * 1024), (LAS unsigned*)(L + (slot_) * GREC_SCAN + (F.wave + 8 * p_) * 1024), 16, 0, 0); } while (0)
    const float egv = EG[lane];
    asm volatile("s_waitcnt vmcnt(0)" ::: "memory");
    GS_DMA(0, 0); GS_DMA(1, 1);
    asm volatile("s_waitcnt vmcnt(6)" ::: "memory"); __builtin_amdgcn_s_barrier(); asm volatile("" ::: "memory");
    for (int ci = 0; ci < NCHUNK; ++ci) {
        const int slot = ci % 3;
        { const int cn = (ci + 2 < NCHUNK) ? ci + 2 : ci; GS_DMA(cn, (ci + 2) % 3); }
        if (F.wave < 4) {
            const LAS unsigned char* A = L + slot * GREC_SCAN + lane * 16;
            const float eg = __builtin_bit_cast(float, __builtin_amdgcn_readlane(__builtin_bit_cast(int, egv), ci));
            bf16x8 sf[8];
#pragma unroll
            for (int ks = 0; ks < 8; ++ks) { const int d = ks >> 1, s = ks & 1; v4u w; w.x = cvt2bf(S[d][8 * s], S[d][8 * s + 1]); w.y = cvt2bf(S[d][8 * s + 2], S[d][8 * s + 3]); w.z = cvt2bf(S[d][8 * s + 4], S[d][8 * s + 5]); w.w = cvt2bf(S[d][8 * s + 6], S[d][8 * s + 7]); sf[ks] = __builtin_bit_cast(bf16x8, w);
                *(v4u*)(sfr + (size_t)ci * 32768 + ks * 1024) = w; }
            f32x16 vn[2];
#pragma unroll
            for (int ct = 0; ct < 2; ++ct) {
                const LAS unsigned char* up = L + slot * GREC_SCAN + GREC_UF + (et * 2 + ct) * 2048 + lane * 32;
                const v4u u0 = *(const LAS v4u*)up, u1 = *(const LAS v4u*)(up + 16);
                const unsigned uw[8] = {u0.x, u0.y, u0.z, u0.w, u1.x, u1.y, u1.z, u1.w};
#pragma unroll
                for (int i = 0; i < 8; ++i) { vn[ct][2 * i] = bf_lo(uw[i]); vn[ct][2 * i + 1] = bf_hi(uw[i]); }
#pragma unroll
                for (int ks = 0; ks < 8; ++ks) vn[ct] = __builtin_amdgcn_mfma_f32_32x32x16_bf16(*(const LAS bf16x8*)(A + GREC_WF + (ct * 8 + ks) * 1024), sf[ks], vn[ct], 0, 0, 0);
            }
            bf16x8 vf[4];
#pragma unroll
            for (int ks = 0; ks < 4; ++ks) { const int ct = ks >> 1, s = ks & 1; v4u w; w.x = cvt2bf(vn[ct][8 * s], vn[ct][8 * s + 1]); w.y = cvt2bf(vn[ct][8 * s + 2], vn[ct][8 * s + 3]); w.z = cvt2bf(vn[ct][8 * s + 4], vn[ct][8 * s + 5]); w.w = cvt2bf(vn[ct][8 * s + 6], vn[ct][8 * s + 7]); vf[ks] = __builtin_bit_cast(bf16x8, w); }
#pragma unroll
            for (int d = 0; d < 4; ++d) {
#pragma unroll
                for (int i = 0; i < 16; ++i) S[d][i] *= eg;
#pragma unroll
                for (int ks = 0; ks < 4; ++ks) S[d] = __builtin_amdgcn_mfma_f32_32x32x16_bf16(*(const LAS bf16x8*)(A + GREC_KTF + (d * 4 + ks) * 1024), vf[ks], S[d], 0, 0, 0);
            }
            asm volatile("s_waitcnt vmcnt(14) lgkmcnt(0)" ::: "memory");
        } else {
            asm volatile("s_waitcnt vmcnt(6)" ::: "memory");
        }
        __builtin_amdgcn_s_barrier(); asm volatile("" ::: "memory");
    }
#undef GS_DMA
    asm volatile("s_waitcnt vmcnt(0)" ::: "memory"); __syncthreads();
    if (F.wave < 4) { float* so = F.out + OUT_GREC + (size_t)chain * HD * HD + 32 * et + r32;
#pragma unroll
        for (int d = 0; d < 4; ++d)
#pragma unroll
            for (int i = 0; i < 16; ++i) so[(size_t)(32 * d + (i & 3) + 8 * (i >> 2) + 4 * hh) * HD] = S[d][i]; }
}

__device__ __forceinline__ void gdn_out_unit(Frame& F, int chain, int ci) {
    int lane = F.lane, tid = F.tid; asm volatile("" : "+v"(lane), "+v"(tid));
    const int b = chain >> 3, h = chain & 7, r32 = lane & 31, hh = lane >> 5, et = F.wave & 3, ct = F.wave >> 2;
    const unsigned char* rec = F.ws + WS_GREC + ((size_t)chain * NCHUNK + ci) * GREC_BYTES + lane * 16;
    const unsigned char* sfp = F.ws + WS_GSF + (((size_t)chain * NCHUNK + ci) * 4 + et) * 8192 + lane * 16;
    LAS float* OT = (LAS float*)(F.lds);
    bf16x8 sf[8];
#pragma unroll
    for (int ks = 0; ks < 8; ++ks) sf[ks] = *(const bf16x8*)(sfp + ks * 1024);
    f32x16 vn[2], o;
#pragma unroll
    for (int c2 = 0; c2 < 2; ++c2) {
        const unsigned char* up = F.ws + WS_GREC + ((size_t)chain * NCHUNK + ci) * GREC_BYTES + GREC_UF + (et * 2 + c2) * 2048 + lane * 32;
        const v4u u0 = *(const v4u*)up, u1 = *(const v4u*)(up + 16);
        const unsigned uw[8] = {u0.x, u0.y, u0.z, u0.w, u1.x, u1.y, u1.z, u1.w};
#pragma unroll
        for (int i = 0; i < 8; ++i) { vn[c2][2 * i] = bf_lo(uw[i]); vn[c2][2 * i + 1] = bf_hi(uw[i]); }
#pragma unroll
        for (int ks = 0; ks < 8; ++ks) vn[c2] = __builtin_amdgcn_mfma_f32_32x32x16_bf16(*(const bf16x8*)(rec + GREC_WF + (c2 * 8 + ks) * 1024), sf[ks], vn[c2], 0, 0, 0);
    }
#pragma unroll
    for (int i = 0; i < 16; ++i) o[i] = 0.f;
#pragma unroll
    for (int ks = 0; ks < 8; ++ks) o = __builtin_amdgcn_mfma_f32_32x32x16_bf16(*(const bf16x8*)(rec + GREC_QF + (ct * 8 + ks) * 1024), sf[ks], o, 0, 0, 0);
#pragma unroll
    for (int ks = 0; ks < 4; ++ks) { const int c2 = ks >> 1, s = ks & 1; v4u w; w.x = cvt2bf(vn[c2][8 * s], vn[c2][8 * s + 1]); w.y = cvt2bf(vn[c2][8 * s + 2], vn[c2][8 * s + 3]); w.z = cvt2bf(vn[c2][8 * s + 4], vn[c2][8 * s + 5]); w.w = cvt2bf(vn[c2][8 * s + 6], vn[c2][8 * s + 7]);
        o = __builtin_amdgcn_mfma_f32_32x32x16_bf16(*(const bf16x8*)(rec + GREC_QKF + (ct * 4 + ks) * 1024), __builtin_bit_cast(bf16x8, w), o, 0, 0, 0); }
#pragma unroll
    for (int i = 0; i < 16; ++i) OT[(32 * ct + (i & 3) + 8 * (i >> 2) + 4 * hh) * 132 + 32 * et + r32] = o[i];
    __syncthreads();
    {
        const int c = tid >> 3, sub = tid & 7; const size_t row = (size_t)b * T + 64 * ci + c;
        const LAS f32x4* op = (const LAS f32x4*)(OT + c * 132 + 16 * sub);
        const f32x4 a0 = op[0], a1 = op[1], a2 = op[2], a3 = op[3];
        float x[16] = {a0.x, a0.y, a0.z, a0.w, a1.x, a1.y, a1.z, a1.w, a2.x, a2.y, a2.z, a2.w, a3.x, a3.y, a3.z, a3.w};
        float ss = 0.f;
#pragma unroll
        for (int e = 0; e < 16; ++e) ss += x[e] * x[e];
        ss += __shfl_xor(ss, 1); ss += __shfl_xor(ss, 2); ss += __shfl_xor(ss, 4);
        const float rs = rsqrtf(ss * (1.f / HD) + EPS);
        const bf16* zp = WSP(bf16, WS_Z) + row * GW + h * HD + 16 * sub; const v4u z0 = *(const v4u*)zp, z1 = *(const v4u*)(zp + 8);
        const unsigned zw[8] = {z0.x, z0.y, z0.z, z0.w, z1.x, z1.y, z1.z, z1.w};
        const float* gn = kin(17) + 16 * sub;
        unsigned ow[8];
#pragma unroll
        for (int e = 0; e < 8; ++e) ow[e] = cvt2bf(x[2 * e] * rs * gn[2 * e] * silu_f(bf_lo(zw[e])), x[2 * e + 1] * rs * gn[2 * e + 1] * silu_f(bf_hi(zw[e])));
        bf16* mp = WSP(bf16, WS_MIX) + row * D + SBW + h * HD + 16 * sub;
        *(v4u*)mp = (v4u){ow[0], ow[1], ow[2], ow[3]}; *(v4u*)(mp + 8) = (v4u){ow[4], ow[5], ow[6], ow[7]};
    }
    __syncthreads();
}

#ifndef REP_PHASE
#define REP_PHASE -1
#endif
#ifndef REP_N
#define REP_N 0
#endif
#ifndef REP_SCAN
#define REP_SCAN 0
#endif
#ifndef REP_ATTN
#define REP_ATTN 0
#endif

__device__ __forceinline__ void p2_mixers(Frame& F, unsigned* qctr) {
    _Pragma("unroll") for (int rs_ = 0; rs_ < 1 + REP_SCAN; ++rs_) if (F.bid < NB * NH) gdn_scan_chain(F, F.bid);
    __syncthreads();
    _Pragma("unroll") for (int ra_ = 0; ra_ < 1 + REP_ATTN; ++ra_)
    for (int u = F.bid; u < NB * NH * 16; u += F.G) { const int bh = u & 15, qb = u >> 4; sb_attn_unit(F, bh >> 3, bh & 7, qb); }
    const int gw = F.bid * NWAVES + F.wave, NGW = F.G * NWAVES;
    for (int it = gw; it < MS * NH * 32; it += NGW) {
        const int chain = it >> 5, slice = it & 31, b = chain >> 3, h = chain & 7;
        gdn_recur_wave<false>(SSP(S_GQ), SSP(S_GK), SSP(S_GV), SSP(S_G), SSP(S_BETA), GW, NH, (size_t)b, 1, h, slice,
                              kin(6) + (size_t)chain * HD * HD, F.out + OUT_GRECS + (size_t)chain * HD * HD, SSP(S_GO), F.lane);
    }
    sb_decode_pull(F, qctr, nullptr);
}

__device__ __forceinline__ void p2_finish(Frame& F) {
    const int gw = F.bid * NWAVES + F.wave, NGW = F.G * NWAVES;
    const float* gnw = kin(17);
    for (int u = F.bid; u < NB * NH * NCHUNK; u += F.G) gdn_out_unit(F, u & 15, u >> 4);
    if (F.wave == 0 && F.G - 1 - F.bid < MS * NH) {
        const int bh = F.G - 1 - F.bid, b = bh >> 3, h = bh & 7;
        { const f32x2 o = *(const f32x2*)(SSP(S_GO) + (size_t)b * GW + h * HD + 2 * F.lane);
          const float rs = rsqrtf(wave_sum(o.x * o.x + o.y * o.y) * (1.f / HD) + EPS);
          const float* z = SSP(S_PROJ) + (size_t)b * IN_COLS + O_GZ + h * HD + 2 * F.lane;
          float* mo = SSP(S_MIX) + (size_t)b * D + SBW + h * HD + 2 * F.lane;
          mo[0] = o.x * rs * gnw[2 * F.lane] * silu_f(z[0]); mo[1] = o.y * rs * gnw[2 * F.lane + 1] * silu_f(z[1]); }
        { float o0 = 0.f, o1 = 0.f, R = 1.f;
          const float* P = SSP(S_PART) + (size_t)bh * DSEG * DPART;
          for (int s0 = DSEG - 32; s0 >= 0; s0 -= 32) {
              float pa[32], pb[32], pr[32];
#pragma unroll
              for (int i = 0; i < 32; ++i) { const float* Pi = P + (size_t)(s0 + i) * DPART; const f32x2 v = *(const f32x2*)(Pi + 2 * F.lane); pa[i] = v.x; pb[i] = v.y; pr[i] = Pi[128]; }
#pragma unroll
              for (int i = 31; i >= 0; --i) { o0 += R * pa[i]; o1 += R * pb[i]; R *= pr[i]; } }
          const float rs = rsqrtf(wave_sum(o0 * o0 + o1 * o1) * (1.f / HD) + EPS); const float* nw = kin(13);
          float* mo = SSP(S_MIX) + (size_t)b * D + h * HD + 2 * F.lane; mo[0] = o0 * rs * nw[2 * F.lane]; mo[1] = o1 * rs * nw[2 * F.lane + 1]; }
    }
}

__device__ __forceinline__ void p4b_fixup(Frame& F) {
    const float* TAIL = WSP(float, WS_TAIL); const float* FIXG = WSP(float, WS_FIXG); const float* FIXU = WSP(float, WS_FIXU); bf16* ACT = WSP(bf16, WS_ACT); const float* cw = kin(22);
    const int total = 32 * 2 * DFF;
    for (int i = F.bid * 512 + F.tid; i < total; i += F.G * 512) {
        const int pm = i / (2 * DFF), rr = (i / DFF) & 1, c = i % DFF;
        if ((pm & 15) == 0) continue;
        const float t0 = TAIL[((size_t)(pm - 1) * 2 + 0) * DFF + c], t1 = TAIL[((size_t)(pm - 1) * 2 + 1) * DFF + c];
        float g = FIXG[((size_t)pm * 2 + rr) * DFF + c];
        g += (rr == 0) ? (cw[c] * t0 + cw[DFF + c] * t1) : (cw[c] * t1);
        ACT[(size_t)(pm * 256 + rr) * DFF + c] = (bf16)f2bf(silu_f(g) * FIXU[((size_t)pm * 2 + rr) * DFF + c]);
    }
    const float* st = kin(7); const float* GP = SSP(S_GP); const float* UP = SSP(S_UP); float* SACT = SSP(S_ACT);
    for (int i = F.bid * 512 + F.tid; i < MS * DFF; i += F.G * 512) {
        const int b = i / DFF, c = i % DFF;
        const float s0 = st[((size_t)b * 2 + 0) * DFF + c], s1 = st[((size_t)b * 2 + 1) * DFF + c], gp = GP[i];
        const float g = cw[c] * s0 + cw[DFF + c] * s1 + cw[2 * DFF + c] * gp;
        SACT[i] = silu_f(g) * UP[i];
        F.out[OUT_FCONVS + ((size_t)b * 2 + 0) * DFF + c] = s1; F.out[OUT_FCONVS + ((size_t)b * 2 + 1) * DFF + c] = gp;
    }
}

__device__ __forceinline__ void p7_final(Frame& F) {
    const int gw = F.bid * NWAVES + F.wave, NGW = F.G * NWAVES;
    const float* fw = kin(27); const float* ss3 = (const float*)(F.ctl + CW_SUMSQ3);
    for (int m = gw; m < M; m += NGW) {
        const float rs = rsqrtf(ss3[m] * (1.f / D) + EPS);
        f32x4* y = (f32x4*)(F.out + OUT_Y + (size_t)m * D) + F.lane; const f32x4* w = (const f32x4*)fw + F.lane;
#pragma unroll
        for (int j = 0; j < 8; ++j) { const f32x4 hv = __builtin_nontemporal_load(y + 64 * j); __builtin_nontemporal_store(hv * rs * w[64 * j], y + 64 * j); }
    }
    if (F.bid == 0) {
        const int b = F.wave; float v[32]; float s = 0.f;
#pragma unroll
        for (int j = 0; j < 32; ++j) { const int c = F.lane + 64 * j; const float h = SSP(S_H2)[(size_t)b * D + c] + SSP(S_PP)[(size_t)b * D + c] * sigmoid_f(SSP(S_PG)[(size_t)b * D + c]); v[j] = h; s += h * h; }
        const float rs = rsqrtf(wave_sum(s) * (1.f / D) + EPS);
#pragma unroll
        for (int j = 0; j < 32; ++j) { const int c = F.lane + 64 * j; F.out[OUT_YS + (size_t)b * D + c] = v[j] * rs * fw[c]; }
    }
}

constexpr int NPHASES = 12;

constexpr int WS_DUMMY_WORDS = 3 * M;
constexpr int N_LAUNCHES = MK_N_LAUNCHES;
struct Args { const float* in[28]; float* out; unsigned char* ws; int ph_lo, ph_hi; };
__global__ void __launch_bounds__(NWAVES * 64, 2) hymba_fwd(Args args) {
    extern __shared__ __attribute__((aligned(16))) unsigned char lds[];
    Frame F;
    F.lds = (LAS unsigned char*)lds;
    F.MISC = (volatile LAS unsigned*)(F.lds + MISC_OFF);
    F.tid = threadIdx.x; F.lane = F.tid & 63; F.wave = __builtin_amdgcn_readfirstlane(F.tid >> 6);
    F.G = gridDim.x; F.bid = blockIdx.x;
    F.ws = args.ws; F.ctl = (unsigned*)(args.ws + WS_CTL); F.out = args.out;
    for (int u = F.tid; u < (LDS_BYTES - LDSCTL_OFF) / 4; u += NWAVES * 64) ((LAS unsigned*)(F.lds + LDSCTL_OFF))[u] = 0u;
    __syncthreads();
    XcdBarrier bar; bar.bar = F.ctl + CW_BAR; bar.x = 0; bar.st = nullptr;
    if (N_LAUNCHES == 1) bar = xcd_barrier_post(F.ctl + CW_BAR, F.MISC + 8);
#define GRID_BAR() do { if (N_LAUNCHES == 1) xcd_barrier(bar); } while (0)
    const int lo = args.ph_lo, hi = args.ph_hi;
#define IN(k) (lo <= (k) && (k) < hi)
#define NREP(k) ((k) == REP_PHASE ? 1 + REP_N : 1)
    float* ss1 = (float*)(F.ctl + CW_SUMSQ1); float* ss2 = (float*)(F.ctl + CW_SUMSQ2); float* ss3 = (float*)(F.ctl + CW_SUMSQ3); float* dummy = WSP(float, WS_DUMMY);

    if (IN(0)) { _Pragma("unroll") for (int rep = 0; rep < NREP(0); ++rep) p0_prologue(F); GRID_BAR(); }
    if (IN(1)) { _Pragma("unroll") for (int rep = 0; rep < NREP(1); ++rep) {
        { pg8::Gemm g{WSP(bf16, WS_XN), WSP(bf16, WS_WIN), M, NPROJ_PAD, D}; pg8::StaticOrder S; S.init(M, NPROJ_PAD, F.G, F.bid);
          pg8::EpiProj E{WSP(bf16, WS_Q), WSP(bf16, WS_K), WSP(bf16, WS_V), WSP(bf16, WS_CIN), WSP(bf16, WS_Z), F.out + OUT_K, F.out + OUT_V, F.out + OUT_GCONV, WSP(float, WS_G), WSP(float, WS_BETA), kin(15), kin(16)};
          pg8::gemm_phase<pg8::EpiProj, pg8::StaticOrder, true, true>(F.lds + RING_OFF, g, S, E); }
        { pg8::Gemm g{WSP(bf16, WS_PB), WSP(bf16, WS_WPP), M, D, PLE}; pg8::StaticOrder S; S.init(M, D, F.G, F.bid);
          pg8::EpiBf16 E{WSP(bf16, WS_PP), D};
          pg8::gemm_phase<pg8::EpiBf16, pg8::StaticOrder, true, true>(F.lds + RING_OFF, g, S, E); }
        { SEpiStore E{SSP(S_PROJ), IN_COLS, IN_COLS}; sample_gemm(F, SSP(S_A), D, false, WSP(bf16, WS_WIN), 225, E); }
        if (rep == 0) { constexpr int T0 = (29 * 32) % 256; convert_set(F, 1, (F.bid - T0) * NWAVES + F.wave, (F.G - T0) * NWAVES); }
        }
        GRID_BAR();
    }
    if (IN(2)) { _Pragma("unroll") for (int rep = 0; rep < NREP(2); ++rep) {
        for (int u = F.bid; u < NB * NH * NCHUNK; u += F.G) { const int chain = u & 15, ci = u >> 4;
            gdn_prep_unit(F, chain, ci, F.ws + WS_GREC + ((size_t)chain * NCHUNK + ci) * GREC_BYTES, WSP(float, WS_GEG) + chain * NCHUNK + ci, F.ctl + CW_QUEUE); }
        gdn_prep_sample(F); }
        GRID_BAR(); }
    if (IN(3)) { _Pragma("unroll") for (int rep = 0; rep < NREP(3); ++rep) p2_mixers(F, F.ctl + CW_QUEUE); GRID_BAR(); }
    if (IN(4)) { _Pragma("unroll") for (int rep = 0; rep < NREP(4); ++rep) p2_finish(F); GRID_BAR(); }
    if (IN(5)) { _Pragma("unroll") for (int rep = 0; rep < NREP(5); ++rep) {
        { pg8::Gemm g{WSP(bf16, WS_MIX), WSP(bf16, WS_WOUT), M, D, D}; pg8::StaticOrder S; S.init(M, D, F.G, F.bid);
          pg8::EpiResid<false> E{kin(0), WSP(bf16, WS_H1B), rep == 0 ? ss1 : dummy, D};
          pg8::gemm_phase<pg8::EpiResid<false>, pg8::StaticOrder, true, true>(F.lds + RING_OFF, g, S, E); }
        { SEpiAdd E{kin(1), SSP(S_H1), D}; sample_gemm(F, SSP(S_MIX), D, false, WSP(bf16, WS_WOUT), D / 32, E); }
        }
        GRID_BAR();
    }
    if (IN(6)) { _Pragma("unroll") for (int rep = 0; rep < NREP(6); ++rep) {
        { pg8::Gemm g{WSP(bf16, WS_H1B), WSP(bf16, WS_WGU), M, NGU, D}; pg8::StaticOrder S; S.init(M, NGU, F.G, F.bid);
          pg8::EpiGateUp E{ss1, kin(22), WSP(bf16, WS_ACT), WSP(float, WS_TAIL), WSP(float, WS_FIXG), WSP(float, WS_FIXU), F.out + OUT_FCONV, (PG8_LAS float*)(F.lds + HALO_OFF)};
          pg8::gemm_phase<pg8::EpiGateUp, pg8::StaticOrder, true, true>(F.lds + RING_OFF, g, S, E); }
        { SEpiGateUp E{SSP(S_GP), SSP(S_UP)}; sample_gemm(F, SSP(S_H1), D, true, WSP(bf16, WS_WGU), NGU / 32, E); }
        if (rep == 0) { constexpr int T1 = (43 * 32) % 256; convert_set(F, 2, (F.bid - T1) * NWAVES + F.wave, (F.G - T1) * NWAVES); }
        }
        GRID_BAR();
    }
    if (IN(7)) { _Pragma("unroll") for (int rep = 0; rep < NREP(7); ++rep) p4b_fixup(F); GRID_BAR(); }
    if (IN(8)) { _Pragma("unroll") for (int rep = 0; rep < NREP(8); ++rep) {
        { pg8::Gemm g{WSP(bf16, WS_ACT), WSP(bf16, WS_WDN), M, D, DFF}; pg8::StaticOrder S; S.init(M, D, F.G, F.bid);
          pg8::EpiResid<true> E{WSP(bf16, WS_H1B), WSP(bf16, WS_H2B), rep == 0 ? ss2 : dummy, D};
          pg8::gemm_phase<pg8::EpiResid<true>, pg8::StaticOrder, true, true>(F.lds + RING_OFF, g, S, E); }
        { SEpiAdd E{SSP(S_H1), SSP(S_H2), D}; sample_gemm(F, SSP(S_ACT), DFF, false, WSP(bf16, WS_WDN), D / 32, E); }
        }
        GRID_BAR();
    }
    if (IN(9)) { _Pragma("unroll") for (int rep = 0; rep < NREP(9); ++rep) {
        { pg8::Gemm g{WSP(bf16, WS_H2B), WSP(bf16, WS_WPG), M, D, D}; pg8::StaticOrder S; S.init(M, D, F.G, F.bid);
          pg8::EpiPle E{WSP(bf16, WS_H2B), WSP(bf16, WS_PP), ss2, F.out + OUT_Y, rep == 0 ? ss3 : dummy, D};
          pg8::gemm_phase<pg8::EpiPle, pg8::StaticOrder, true, true>(F.lds + RING_OFF, g, S, E); }
        { SEpiStore E{SSP(S_PG), D, D}; sample_gemm(F, SSP(S_H2), D, true, WSP(bf16, WS_WPG), D / 32, E); }
        { SEpiStore E{SSP(S_PP), D, D}; sample_gemm(F, kin(9), PLE, false, WSP(bf16, WS_WPP), D / 32, E); }
        }
        GRID_BAR();
    }
    if (IN(10)) { p7_final(F); }
#undef IN
#undef GRID_BAR
}

extern "C" void kernel_launch(void* const* d_in, const int* in_sizes, int n_in, void* d_out, int out_size, void* d_ws, size_t ws_size, hipStream_t stream) {
    static int grid = 0;
    if (grid == 0) {
        if (n_in != 28 || (size_t)out_size != OUT_END || ws_size < WS_END) { fprintf(stderr, "kernel_launch: unexpected sizes n_in %d out %d ws %zu (need %zu, %zu)\n", n_in, out_size, ws_size, (size_t)OUT_END, (size_t)WS_END); grid = -1; return; }
        int dev = 0, cus = 0, per_cu = 0;
        if (hipGetDevice(&dev) != hipSuccess || hipDeviceGetAttribute(&cus, hipDeviceAttributeMultiprocessorCount, dev) != hipSuccess) { grid = -1; return; }
        if (hipFuncSetAttribute((const void*)hymba_fwd, hipFuncAttributeMaxDynamicSharedMemorySize, LDS_BYTES) != hipSuccess) { fprintf(stderr, "kernel_launch: hipFuncSetAttribute failed\n"); grid = -1; return; }
        if (hipOccupancyMaxActiveBlocksPerMultiprocessor(&per_cu, (const void*)hymba_fwd, NWAVES * 64, LDS_BYTES) != hipSuccess || per_cu < 1) { fprintf(stderr, "kernel_launch: occupancy query says %d\n", per_cu); }
        (void)hipGetLastError();
        grid = cus;
    }
    if (grid < 0) return;
    (void)hipMemsetAsync((char*)d_ws + WS_CTL, 0, CTL_ZERO_BYTES, stream);
    Args a{};
    for (int i = 0; i < 28; ++i) a.in[i] = (const float*)d_in[i];
    a.out = (float*)d_out; a.ws = (unsigned char*)d_ws;
    if (N_LAUNCHES == 1) { a.ph_lo = 0; a.ph_hi = NPHASES; hipLaunchKernelGGL(hymba_fwd, dim3(grid), dim3(NWAVES * 64), LDS_BYTES, stream, a); }
    else for (int p = 0; p < 11; ++p) { a.ph_lo = p; a.ph_hi = p + 1; hipLaunchKernelGGL(hymba_fwd, dim3(grid), dim3(NWAVES * 64), LDS_BYTES, stream, a); }
}
```
